# Optimizing an MI355X kernel written in HIP

```python
import jax, jax.numpy as jnp
from jax import lax
import numpy as np

D_MODEL = 1024
BATCH = 4
SEQ = 4096
DEPTH = 4

N_MIXERS = 2
NORM_EPS = 1e-6
N_MOD = 6
LRU_WIDTH = D_MODEL
LRU_BLOCKS = 4
LRU_BLOCK_W = LRU_WIDTH // LRU_BLOCKS
CONV_WIDTH = 4
LRU_C = 8.0
ATTN_HEADS = 8
HEAD_DIM = D_MODEL // ATTN_HEADS
MOBA_BLOCK = 256
MOBA_TOPK = 3
MOBA_ROW_BLOCK = 128
N_EXPERTS = 32
TOP_K = 4
D_EXPERT = D_MODEL
SWIGLU_LIMIT = 7.0
SWIGLU_ALPHA = 1.702
MOE_ROW_BLOCK = 256

kernel_name = 'hybrid_rglru_moba_moe_adaln'


def rms_norm(x, g):
    xf = x.astype(jnp.float32)
    y = xf * lax.rsqrt(jnp.mean(xf * xf, axis=-1, keepdims=True) + NORM_EPS)
    return (y * g.astype(jnp.float32)).astype(x.dtype)


def group_rows(group_ids, n_groups, row_block):
    n = group_ids.shape[0]
    order = jnp.argsort(group_ids).astype(jnp.int32)
    g_sorted = group_ids[order]
    counts = jnp.bincount(group_ids, length=n_groups).astype(jnp.int32)
    padded = (counts + row_block - 1) // row_block * row_block
    pad_end = jnp.cumsum(padded)
    pad_start = pad_end - padded
    grp_start = jnp.cumsum(counts) - counts
    dest = pad_start[g_sorted] + jnp.arange(n, dtype=jnp.int32) - grp_start[g_sorted]
    n_row_blocks = -(-n // row_block) + n_groups
    row_item = jnp.full((n_row_blocks * row_block,), n, jnp.int32).at[dest].set(order)
    starts = jnp.arange(n_row_blocks, dtype=jnp.int32) * row_block
    block_group = jnp.minimum(jnp.searchsorted(pad_end, starts, side='right'), n_groups - 1)
    return row_item.reshape(n_row_blocks, row_block), block_group.astype(jnp.int32)


def causal_depthwise_conv(x, w, b):
    y = lax.conv_general_dilated(x, w[:, None, :], window_strides=(1,),
                                 padding=[(CONV_WIDTH - 1, 0)],
                                 dimension_numbers=('NWC', 'WIO', 'NWC'),
                                 feature_group_count=x.shape[-1])
    return y + b


def _lru_combine(left, right):
    a_l, h_l = left
    a_r, h_r = right
    return a_l * a_r, a_r * h_l + h_r


def rglru_mixer(h, w_in, conv_w, conv_b, w_a, b_a, w_x, b_x, lam, w_out):
    B, S, _ = h.shape
    gate_branch, rec_branch = jnp.split(h @ w_in, 2, axis=-1)
    xc = causal_depthwise_conv(rec_branch, conv_w, conv_b)
    xg = xc.reshape(B, S, LRU_BLOCKS, LRU_BLOCK_W)
    r = jax.nn.sigmoid((jnp.einsum('bsgi,gij->bsgj', xg, w_a).reshape(B, S, LRU_WIDTH) + b_a).astype(jnp.float32))
    i = jax.nn.sigmoid((jnp.einsum('bsgi,gij->bsgj', xg, w_x).reshape(B, S, LRU_WIDTH) + b_x).astype(jnp.float32))
    log_a = -LRU_C * r * jax.nn.softplus(-lam.astype(jnp.float32))
    a = jnp.exp(log_a)
    u = jnp.sqrt(-jnp.expm1(2.0 * log_a)) * (i * xc.astype(jnp.float32))
    _, hs = lax.associative_scan(_lru_combine, (a, u), axis=1)
    y = jax.nn.gelu(gate_branch, approximate=True) * hs.astype(h.dtype)
    return y @ w_out


def moba_mixer(h, w_qkv, q_g, k_g, w_out):
    B, S, D = h.shape
    BH = B * ATTN_HEADS
    f32 = jnp.float32
    qkv = (h @ w_qkv).reshape(B, S, 3, ATTN_HEADS, HEAD_DIM).transpose(2, 0, 3, 1, 4)
    q = rms_norm(qkv[0], q_g) * (HEAD_DIM ** -0.5)
    k = rms_norm(qkv[1], k_g)
    v = qkv[2]
    nb = -(-S // MOBA_BLOCK)
    sp = nb * MOBA_BLOCK
    topk = min(MOBA_TOPK, nb)
    padw = ((0, 0), (0, 0), (0, sp - S), (0, 0))
    qb = jnp.pad(q, padw).reshape(B, ATTN_HEADS, nb, MOBA_BLOCK, HEAD_DIM)
    kb = jnp.pad(k, padw).reshape(B, ATTN_HEADS, nb, MOBA_BLOCK, HEAD_DIM)
    vb = jnp.pad(v, padw).reshape(B, ATTN_HEADS, nb, MOBA_BLOCK, HEAD_DIM)

    q_blk = jnp.arange(S) // MOBA_BLOCK
    k_mean = jnp.mean(kb.astype(f32), axis=3)
    gate = jnp.einsum('bhsd,bhnd->bhsn', q.astype(f32), k_mean)
    fully_past = jnp.arange(nb)[None, :] < q_blk[:, None]
    gate = jnp.where(fully_past, gate, -jnp.inf)
    _, sel = lax.top_k(gate, topk)
    sel_valid = sel < q_blk[:, None]

    s_own = jnp.einsum('bhnqd,bhnkd->bhnqk', qb, kb).astype(f32)
    causal = jnp.tril(jnp.ones((MOBA_BLOCK, MOBA_BLOCK), dtype=bool))
    s_own = jnp.where(causal, s_own, -jnp.inf)
    m_own = jnp.max(s_own, axis=-1)
    p_own = jnp.exp(s_own - m_own[..., None])
    l_own = jnp.sum(p_own, axis=-1)
    o_own = jnp.einsum('bhnqk,bhnkd->bhnqd', p_own, vb.astype(f32))
    m_own = m_own.reshape(B, ATTN_HEADS, sp)[:, :, :S]
    l_own = l_own.reshape(B, ATTN_HEADS, sp)[:, :, :S]
    o_own = o_own.reshape(B, ATTN_HEADS, sp, HEAD_DIM)[:, :, :S]

    n_pairs = BH * S * topk
    n_groups = BH * nb
    pair_query = jnp.arange(n_pairs, dtype=jnp.int32) // topk
    group = (pair_query // S) * nb + sel.reshape(-1).astype(jnp.int32)
    group = jnp.where(sel_valid.reshape(-1), group, n_groups)
    row_item, block_group = group_rows(group, n_groups + 1, MOBA_ROW_BLOCK)
    q_flat = q.reshape(BH * S, HEAD_DIM)
    k_flat = kb.reshape(n_groups, MOBA_BLOCK, HEAD_DIM)
    v_flat = vb.reshape(n_groups, MOBA_BLOCK, HEAD_DIM)

    def attend_block(args):
        items, g = args
        q_rows = q_flat[jnp.minimum(items, n_pairs - 1) // topk].astype(f32)
        g = jnp.minimum(g, n_groups - 1)
        s = q_rows @ k_flat[g].astype(f32).T
        m = jnp.max(s, axis=-1)
        p = jnp.exp(s - m[:, None])
        return m, jnp.sum(p, axis=-1), p @ v_flat[g].astype(f32)

    m_rows, l_rows, o_rows = lax.map(attend_block, (row_item, block_group))
    items = row_item.reshape(-1)
    m_pair = jnp.full((n_pairs,), -jnp.inf, f32).at[items].set(m_rows.reshape(-1), mode='drop')
    l_pair = jnp.zeros((n_pairs,), f32).at[items].set(l_rows.reshape(-1), mode='drop')
    o_pair = jnp.zeros((n_pairs, HEAD_DIM), f32).at[items].set(o_rows.reshape(-1, HEAD_DIM), mode='drop')
    m_pair = jnp.where(sel_valid, m_pair.reshape(B, ATTN_HEADS, S, topk), -jnp.inf)
    l_pair = l_pair.reshape(B, ATTN_HEADS, S, topk)
    o_pair = o_pair.reshape(B, ATTN_HEADS, S, topk, HEAD_DIM)

    m_all = jnp.maximum(m_own, jnp.max(m_pair, axis=-1))
    w_own = jnp.exp(m_own - m_all)
    w_pair = jnp.exp(m_pair - m_all[..., None])
    num = o_own * w_own[..., None] + jnp.einsum('bhsk,bhskd->bhsd', w_pair, o_pair)
    den = l_own * w_own + jnp.sum(w_pair * l_pair, axis=-1)
    out = (num / den[..., None]).astype(h.dtype)
    out = out.transpose(0, 2, 1, 3).reshape(B, S, D)
    return out @ w_out


def moe_ffn(h, router_w, router_b, w_gu, b_gu, w_down, b_down):
    B, S, D = h.shape
    T = B * S
    n = T * TOP_K
    xt = h.reshape(T, D)
    logits = (xt @ router_w).astype(jnp.float32) + router_b.astype(jnp.float32)
    top_logits, top_e = lax.top_k(logits, TOP_K)
    top_w = jax.nn.softmax(top_logits, axis=-1).reshape(-1)
    row_item, block_expert = group_rows(top_e.reshape(-1).astype(jnp.int32), N_EXPERTS, MOE_ROW_BLOCK)

    def expert_block(args):
        items, e = args
        it = jnp.minimum(items, n - 1)
        xb = xt[it // TOP_K]
        gu = xb @ w_gu[e] + b_gu[e]
        gate_v = jnp.minimum(gu[:, :D_EXPERT], SWIGLU_LIMIT)
        up_v = jnp.clip(gu[:, D_EXPERT:], -SWIGLU_LIMIT, SWIGLU_LIMIT)
        act = gate_v * jax.nn.sigmoid(SWIGLU_ALPHA * gate_v) * (up_v + 1.0)
        y = act @ w_down[e] + b_down[e]
        return y * top_w[it][:, None].astype(y.dtype)

    y_rows = lax.map(expert_block, (row_item, block_expert))
    y = jnp.zeros((T, D), h.dtype).at[row_item.reshape(-1)].add(y_rows.reshape(-1, D), mode='drop')
    return y.reshape(B, S, D)


def setup_inputs(seed: int = 0) -> dict:
    key = jax.random.key(seed)
    ks = jax.random.split(key, 24)
    n_lru = (DEPTH + N_MIXERS - 1) // N_MIXERS
    n_attn = DEPTH // N_MIXERS
    D = D_MODEL
    nrm = lambda k, shape, s: jax.random.normal(k, shape, jnp.float32) * s
    u = jax.random.uniform(ks[11], (n_lru, LRU_WIDTH), jnp.float32, minval=0.9, maxval=0.999)
    sg = u ** (1.0 / LRU_C)
    lam = jnp.log(sg) - jnp.log1p(-sg)
    return {
        'x': nrm(ks[0], (BATCH, SEQ, D), 1.0),
        'c': nrm(ks[1], (BATCH, D), 1.0),
        'norm_mix_g': 1.0 + nrm(ks[2], (DEPTH, D), 0.02),
        'norm_ffn_g': 1.0 + nrm(ks[3], (DEPTH, D), 0.02),
        'w_mod': nrm(ks[4], (DEPTH, D, N_MOD * D), 0.5 * D ** -0.5),
        'b_mod': nrm(ks[5], (DEPTH, N_MOD * D), 0.02),
        'lru_w_in': nrm(ks[6], (n_lru, D, 2 * LRU_WIDTH), D ** -0.5),
        'lru_conv_w': nrm(ks[7], (n_lru, CONV_WIDTH, LRU_WIDTH), CONV_WIDTH ** -0.5),
        'lru_conv_b': nrm(ks[8], (n_lru, LRU_WIDTH), 0.02),
        'lru_w_a': nrm(ks[9], (n_lru, LRU_BLOCKS, LRU_BLOCK_W, LRU_BLOCK_W), LRU_BLOCK_W ** -0.5),
        'lru_b_a': nrm(ks[10], (n_lru, LRU_WIDTH), 0.02),
        'lru_w_x': nrm(ks[12], (n_lru, LRU_BLOCKS, LRU_BLOCK_W, LRU_BLOCK_W), LRU_BLOCK_W ** -0.5),
        'lru_b_x': nrm(ks[13], (n_lru, LRU_WIDTH), 0.02),
        'lru_lambda': lam,
        'lru_w_out': nrm(ks[14], (n_lru, LRU_WIDTH, D), LRU_WIDTH ** -0.5),
        'attn_w_qkv': nrm(ks[15], (n_attn, D, 3 * D), D ** -0.5),
        'attn_q_norm_g': 1.0 + nrm(ks[16], (n_attn, HEAD_DIM), 0.02),
        'attn_k_norm_g': 1.0 + nrm(ks[17], (n_attn, HEAD_DIM), 0.02),
        'attn_w_out': nrm(ks[18], (n_attn, D, D), D ** -0.5),
        'router_w': nrm(ks[19], (DEPTH, D, N_EXPERTS), D ** -0.5),
        'router_b': nrm(ks[20], (DEPTH, N_EXPERTS), 0.01),
        'expert_w_gu': nrm(ks[21], (DEPTH, N_EXPERTS, D, 2 * D_EXPERT), D ** -0.5),
        'expert_b_gu': nrm(ks[22], (DEPTH, N_EXPERTS, 2 * D_EXPERT), 0.01),
        'expert_w_down': nrm(ks[23], (DEPTH, N_EXPERTS, D_EXPERT, D), D_EXPERT ** -0.5),
        'expert_b_down': nrm(jax.random.fold_in(key, 99), (DEPTH, N_EXPERTS, D), 0.01),
    }


def reference(x, c, norm_mix_g, norm_ffn_g, w_mod, b_mod, lru_w_in, lru_conv_w, lru_conv_b,
              lru_w_a, lru_b_a, lru_w_x, lru_b_x, lru_lambda, lru_w_out, attn_w_qkv,
              attn_q_norm_g, attn_k_norm_g, attn_w_out, router_w, router_b, expert_w_gu,
              expert_b_gu, expert_w_down, expert_b_down):
    cond = jax.nn.silu(c)
    for i in range(DEPTH):
        mod = cond @ w_mod[i] + b_mod[i]
        sh1, sc1, g1, sh2, sc2, g2 = jnp.split(mod[:, None, :], N_MOD, axis=-1)
        h = rms_norm(x, norm_mix_g[i]) * (1.0 + sc1) + sh1
        j = i // N_MIXERS
        if i % N_MIXERS == 0:
            mixed = rglru_mixer(h, lru_w_in[j], lru_conv_w[j], lru_conv_b[j], lru_w_a[j], lru_b_a[j],
                                lru_w_x[j], lru_b_x[j], lru_lambda[j], lru_w_out[j])
        else:
            mixed = moba_mixer(h, attn_w_qkv[j], attn_q_norm_g[j], attn_k_norm_g[j], attn_w_out[j])
        x = x + g1 * mixed
        h = rms_norm(x, norm_ffn_g[i]) * (1.0 + sc2) + sh2
        x = x + g2 * moe_ffn(h, router_w[i], router_b[i], expert_w_gu[i], expert_b_gu[i],
                             expert_w_down[i], expert_b_down[i])
    return x
```

```cpp
#include <hip/hip_runtime.h>
#include <stdint.h>
#include <stdio.h>

#define LAS __attribute__((address_space(3)))
#define GAS __attribute__((address_space(1)))
typedef unsigned short bf16_t;
typedef short bf16x8 __attribute__((ext_vector_type(8)));
typedef float f32x4 __attribute__((ext_vector_type(4)));
typedef float f32x2 __attribute__((ext_vector_type(2)));
typedef unsigned u32x4 __attribute__((ext_vector_type(4)));
typedef unsigned u32x2 __attribute__((ext_vector_type(2)));

constexpr int BATCH = 4, SEQ = 4096, D = 1024, T = BATCH * SEQ, DEPTH = 4;
constexpr int NE = 32, TOPK = 4, NH = 8, HD = 128, NBLK = 16, MBLK = 256;
constexpr float NORM_EPS = 1e-6f;
constexpr int NWAVES = 8, NTHR = 512;
constexpr int CAP = T;
constexpr int MAXTILES = T * TOPK / 256 + NE;

constexpr size_t MiB = 1u << 20;
constexpr size_t WS_CTL = 0, CTL_ZERO_BYTES = 1 * MiB;
constexpr size_t WS_MOD = 1 * MiB;
constexpr size_t WS_SP8 = 2 * MiB;
constexpr size_t WS_KMEAN = 3 * MiB;
constexpr size_t WS_SEL = 4 * MiB;
constexpr size_t WS_ROWLIST = 5 * MiB;
constexpr size_t WS_TOPW = 7 * MiB;
constexpr size_t WS_PS = 8 * MiB;
constexpr size_t WS_PAR = 10 * MiB;
constexpr int PAR_NMG = 0, PAR_NFG = PAR_NMG + 4 * 1024, PAR_LCW = PAR_NFG + 4 * 1024, PAR_LCB = PAR_LCW + 2 * 4 * 1024, PAR_LBA = PAR_LCB + 2 * 1024, PAR_LBX = PAR_LBA + 2 * 1024,
              PAR_AQG = PAR_LBX + 2 * 1024, PAR_AKG = PAR_AQG + 256, PAR_RW = PAR_AKG + 256, PAR_RB = PAR_RW + 4 * 1024 * 32, PAR_BGU = PAR_RB + 128, PAR_BDN = PAR_BGU + 4 * 32 * 2048, PAR_END = PAR_BDN + 4 * 32 * 1024;
static_assert((size_t)PAR_END * 4 <= 6 * MiB, "param region");
constexpr size_t WS_WIN = 16 * MiB;
constexpr size_t WS_WG = 24 * MiB;
constexpr size_t WS_WLO = 26 * MiB;
constexpr size_t WS_WQKV = 30 * MiB;
constexpr size_t WS_WAO = 42 * MiB;
constexpr size_t WS_WGU = 64 * MiB;
constexpr size_t WS_WDN = 576 * MiB;
constexpr size_t WS_XA = 832 * MiB;
constexpr size_t WS_XB = 896 * MiB;
constexpr size_t WS_H = 960 * MiB;
constexpr size_t WS_GB = 992 * MiB;
constexpr size_t WS_RB = 1024 * MiB;
constexpr size_t WS_XC = 1056 * MiB;
constexpr size_t WS_AF = 1088 * MiB;
constexpr size_t WS_UF = 1152 * MiB;
constexpr size_t WS_YB = 1216 * MiB;
constexpr size_t WS_Q = 1248 * MiB, WS_K = 1280 * MiB, WS_V = 1312 * MiB;
constexpr size_t WS_ACT = 1344 * MiB;
constexpr size_t WS_YK = 1488 * MiB;
constexpr size_t WS_END = 1616 * MiB;

constexpr int CW_BAR = 4096;
constexpr int CW_CNT = 65536;

constexpr int RING_BYTES = 131072;
constexpr int LDS_TAB = RING_BYTES;
constexpr int LDS_UNITS = LDS_TAB + 1024;
constexpr int LDS_MOE = LDS_UNITS + 512;
constexpr int LDS_MISC = LDS_MOE + 512;
constexpr int LDS_X = LDS_MISC + 256;
constexpr int LDS_BYTES = 147456;

__device__ __forceinline__ float bf2f(unsigned h) { return __uint_as_float(h << 16); }
__device__ __forceinline__ float bflo(unsigned u) { return __uint_as_float(u << 16); }
__device__ __forceinline__ float bfhi(unsigned u) { return __uint_as_float(u & 0xffff0000u); }
__device__ __forceinline__ unsigned cvt_pk_bf16(float lo, float hi) { unsigned r; asm("v_cvt_pk_bf16_f32 %0, %1, %2" : "=v"(r) : "v"(lo), "v"(hi)); return r; }
__device__ __forceinline__ float wave_sum(float v) {
#pragma unroll
    for (int o = 1; o < 64; o <<= 1) v += __shfl_xor(v, o);
    return v;
}
__device__ __forceinline__ float fast_exp(float x) { return __builtin_amdgcn_exp2f(x * 1.4426950408889634f); }
__device__ __forceinline__ float sigmoidf_(float x) { return __builtin_amdgcn_rcpf(1.0f + fast_exp(-x)); }
#define LDS_WAIT() asm volatile("s_waitcnt lgkmcnt(0)" ::: "memory")
#define VM_WAIT() asm volatile("s_waitcnt vmcnt(0)" ::: "memory")

#define XB_TMO      128
#define XB_XCNT(j)  (256  + 64 * (j))
#define XB_XSUB(j)  (1280 + 64 * (j))
#define XB_XGEN(j)  (2304 + 64 * (j))
#define XB_TOP      3328
#define XB_TOPGEN   3392
#define XCD_BAR_WORDS 3456
#define XB_SPIN_CAP (1u << 18)
__device__ __forceinline__ unsigned xb_ld(unsigned* p)              { return __hip_atomic_load(p, __ATOMIC_RELAXED, __HIP_MEMORY_SCOPE_AGENT); }
__device__ __forceinline__ unsigned xb_add(unsigned* p, unsigned v) { return __hip_atomic_fetch_add(p, v, __ATOMIC_RELAXED, __HIP_MEMORY_SCOPE_AGENT); }
__device__ __forceinline__ unsigned xb_xcc_id() { return (unsigned)__builtin_amdgcn_s_getreg((3 << 11) | 20) & 0xFu; }
#define XB_SPIN(cond, bar) do { unsigned _sp = 0; while (cond) { __builtin_amdgcn_s_sleep(1); \
    if ((++_sp & 255u) == 0u) { if (xb_ld(&(bar)[XB_TMO])) break; if (_sp > XB_SPIN_CAP) { atomicAdd(&(bar)[XB_TMO], 1u); break; } } } } while (0)
struct XcdBarrier { unsigned* bar; unsigned x; volatile LAS unsigned* st; };
__device__ __forceinline__ XcdBarrier xcd_barrier_post(unsigned* bar, volatile LAS unsigned* st) {
    XcdBarrier b; b.bar = bar; b.x = xb_xcc_id(); b.st = st;
    if (threadIdx.x == 0) (void)xb_add(&bar[XB_XCNT(b.x)], 1u);
    return b;
}
__device__ __forceinline__ void xcd_barrier_complete(unsigned* bar, unsigned x, unsigned& nloc, unsigned& nx) {
    const unsigned G = gridDim.x * gridDim.y * gridDim.z;
    unsigned sum, cnt, mine, sp = 0u;
    for (;;) {
        sum = 0u; cnt = 0u; mine = 0u;
#pragma unroll
        for (unsigned j = 0; j < 16; ++j) { const unsigned c = xb_ld(&bar[XB_XCNT(j)]); sum += c; cnt += (c > 0u) ? 1u : 0u; mine = (j == x) ? c : mine; }
        if (sum == G) break;
        __builtin_amdgcn_s_sleep(1);
        if ((++sp & 255u) == 0u) { if (xb_ld(&bar[XB_TMO])) break; if (sp > XB_SPIN_CAP) { atomicAdd(&bar[XB_TMO], 1u); break; } }
    }
    nloc = mine > 0u ? mine : 1u; nx = cnt > 0u ? cnt : 1u;
}
__device__ __forceinline__ void xcd_barrier(const XcdBarrier& b) {
    asm volatile("s_waitcnt vmcnt(0)" ::: "memory");
    __syncthreads();
    if (threadIdx.x == 0) {
        unsigned* bar = b.bar;
        __builtin_amdgcn_s_waitcnt(0);
        unsigned nloc = b.st[0], nx = b.st[1];
        if (nloc == 0u) { xcd_barrier_complete(bar, b.x, nloc, nx); b.st[0] = nloc; b.st[1] = nx; }
        const unsigned old = xb_add(&bar[XB_XSUB(b.x)], 1u);
        const unsigned gen = old / nloc;
        if (old + 1u == (gen + 1u) * nloc) {
            __builtin_amdgcn_fence(__ATOMIC_RELEASE, "agent");
            asm volatile("s_waitcnt vmcnt(0)" ::: "memory");
            const unsigned og = xb_add(&bar[XB_TOP], 1u);
            const unsigned tg = og / nx;
            if (og + 1u == (tg + 1u) * nx) xb_add(&bar[XB_TOPGEN], 1u);
            else XB_SPIN(xb_ld(&bar[XB_TOPGEN]) == tg, bar);
            __builtin_amdgcn_fence(__ATOMIC_ACQUIRE, "agent");
            xb_add(&bar[XB_XGEN(b.x)], 1u);
            asm volatile("s_waitcnt vmcnt(0)" ::: "memory");
        } else {
            XB_SPIN(xb_ld(&bar[XB_XGEN(b.x)]) == gen, bar);
            __builtin_amdgcn_fence(__ATOMIC_ACQUIRE, "agent");
            asm volatile("s_waitcnt vmcnt(0)" ::: "memory");
        }
    }
    __syncthreads();
}

namespace pg8 {
constexpr int BM = 256, BK = 64, HALF = 128, HTB = HALF * BK * 2, STAGE_BYTES = 8 * HTB, NXCD = 8, WGM = 8;
__host__ __device__ __forceinline__ int lds_byte(int r, int c) { const int st = (r >> 4) * 2 + (c >> 5), rr = r & 15, cc = c & 31, ob = rr * 64 + cc * 2; return st * 1024 + (ob ^ (((ob >> 9) & 1) << 5)); }
__host__ __device__ __forceinline__ void stage_rc(int b, int& R, int& C) { const int st = b / 1024, sb = b % 1024, swz = sb ^ (((sb >> 9) & 1) << 5); R = (st >> 1) * 16 + swz / 64; C = (st & 1) * 32 + (swz % 64) / 2; }
__host__ __device__ __forceinline__ int perm32(int rho) { const int n = rho >> 4, i = rho & 15; return 8 * (i >> 2) + 4 * n + (i & 3); }

struct Unit { int pm, pn, e, valid, j; };

struct ProbPlain {
    static constexpr bool GATHER = false;
    const bf16_t* A; const bf16_t* Bt; int M, N, K, lda; int acol_sh;
    int nM, nN, nwg, G, c;
    __device__ __forceinline__ void init(const bf16_t* A_, const bf16_t* Bt_, int M_, int N_, int K_, int lda_, int acol_sh_, int G_, int c_) {
        A = A_; Bt = Bt_; M = M_; N = N_; K = K_; lda = lda_; acol_sh = acol_sh_; nM = M / BM; nN = N / BM; nwg = nM * nN; G = G_; c = c_; }
    __device__ __forceinline__ bool next(int i, Unit& u) const {
        const long L = (long)i * G + c; if (L >= nwg) return false;
        int wgid = (int)L; { const int q = nwg / NXCD, r = nwg % NXCD, xcd = wgid % NXCD, off = wgid / NXCD; wgid = (xcd < r ? xcd * (q + 1) : r * (q + 1) + (xcd - r) * q) + off; }
        const int nig = WGM * nN, gid = wgid / nig, fm = gid * WGM, gsz = (nM - fm) < WGM ? (nM - fm) : WGM;
        u.pm = fm + ((wgid % nig) % gsz); u.pn = (wgid % nig) / gsz; u.e = 0; u.valid = 256; u.j = 0; return true;
    }
    __device__ __forceinline__ const char* a_base(const Unit& u) const { const int ac = acol_sh >= 0 ? (u.pn >> acol_sh) * 256 : 0; return (const char*)(A + (size_t)u.pm * BM * lda + ac); }
    __device__ __forceinline__ const char* b_base(const Unit& u) const { return (const char*)(Bt + (size_t)u.pn * BM * K); }
    __device__ __forceinline__ void fill_tab(const Unit&, LAS unsigned*) const {}
    __device__ __forceinline__ void a_off(const Unit&, const int (&R)[2], const int (&C)[2], unsigned (&v)[2][2], const LAS unsigned*) const {
#pragma unroll
        for (int h = 0; h < 2; ++h)
#pragma unroll
            for (int i = 0; i < 2; ++i) v[h][i] = (unsigned)((h * HALF + R[i]) * lda + C[i]) * 2u;
    }
};
template <bool GATHER_> struct ProbMoE {
    static constexpr bool GATHER = GATHER_;
    const bf16_t* A; const bf16_t* Bt; int K, lda; size_t bstride;
    const unsigned* rowlist; const LAS int* units; int nunits;
    __device__ __forceinline__ bool next(int i, Unit& u) const {
        if (i >= nunits) return false;
        u.pm = __builtin_amdgcn_readfirstlane(units[i * 4 + 0]); u.pn = __builtin_amdgcn_readfirstlane(units[i * 4 + 1]);
        const int ej = __builtin_amdgcn_readfirstlane(units[i * 4 + 2]); u.e = ej & 255; u.j = ej >> 8; u.valid = __builtin_amdgcn_readfirstlane(units[i * 4 + 3]); return true;
    }
    __device__ __forceinline__ const char* a_base(const Unit& u) const { return GATHER ? (const char*)A : (const char*)(A + (size_t)u.pm * BM * lda); }
    __device__ __forceinline__ const char* b_base(const Unit& u) const { return (const char*)(Bt + (size_t)u.e * bstride + (size_t)u.pn * BM * K); }
    __device__ __forceinline__ void fill_tab(const Unit& u, LAS unsigned* tab) const {
        if (GATHER && threadIdx.x < 256) {
            const unsigned* rl = rowlist + (size_t)u.e * CAP + u.j * 256;
            const int r = (int)threadIdx.x < u.valid ? (int)threadIdx.x : 0;
            tab[threadIdx.x] = rl[r] >> 2;
        }
    }
    __device__ __forceinline__ void a_off(const Unit&, const int (&R)[2], const int (&C)[2], unsigned (&v)[2][2], const LAS unsigned* tab) const {
#pragma unroll
        for (int h = 0; h < 2; ++h)
#pragma unroll
            for (int i = 0; i < 2; ++i) {
                if (GATHER) v[h][i] = (tab[h * HALF + R[i]] * (unsigned)lda + (unsigned)C[i]) * 2u;
                else v[h][i] = (unsigned)((h * HALF + R[i]) * lda + C[i]) * 2u;
            }
    }
};

template <class Epi, class Prob, bool ALIGN_EPI, bool SP2>
__device__ __forceinline__ void gemm_phase(LAS unsigned char* lds, LAS unsigned* tab, const Prob& P, const Epi& E) {
    int tid = threadIdx.x; asm volatile("" : "+v"(tid));
    const int wid = __builtin_amdgcn_readfirstlane(tid >> 6), lane = tid & 63, wr = wid >> 2, wc = wid & 3, fr = lane & 15, fq = lane >> 4;
    const int K = P.K, nt = K / BK;
    int Rr[2], Cc[2]; unsigned voffB[2];
#pragma unroll
    for (int i = 0; i < 2; ++i) { int R, C; stage_rc(tid * 16 + i * 8192, R, C); Rr[i] = R; Cc[i] = C; const int Rb = Epi::PERM ? ((R & ~31) + perm32(R & 31)) : R; voffB[i] = (unsigned)(Rb * K + C) * 2u; }
    const size_t kstep = (size_t)(BK * 2);
    const size_t hstepB = (size_t)HALF * K * 2;
    const unsigned ldsw = (unsigned)wid * 1024u;
    const int aoff = lds_byte(wr * 64 + fr, fq * 8), boff = lds_byte(wc * 32 + fr, fq * 8);
#define PG8_SA(b, h) (((b) * 2 + (h)) * HTB)
#define PG8_SB(b, h) ((4 + (b) * 2 + (h)) * HTB)
#define PG8_STAGE(bufoff, gbase, voff) do { _Pragma("unroll") for (int _i = 0; _i < 2; ++_i) \
        __builtin_amdgcn_global_load_lds((const unsigned*)((const char*)(gbase) + (voff)[_i]), (LAS unsigned*)(lds + (bufoff) + ldsw + _i * 8192), 16, 0, 0); } while (0)
#define PG8_LDA(dst, b, h) do { _Pragma("unroll") for (int m = 0; m < 4; ++m) _Pragma("unroll") for (int k = 0; k < 2; ++k) dst[m][k] = *(const LAS bf16x8*)(lds + PG8_SA(b, h) + aoff + m * 2048 + k * 1024); } while (0)
#define PG8_LDB(dst, b, h) do { _Pragma("unroll") for (int n = 0; n < 2; ++n) _Pragma("unroll") for (int k = 0; k < 2; ++k) dst[n][k] = *(const LAS bf16x8*)(lds + PG8_SB(b, h) + boff + n * 2048 + k * 1024); } while (0)
#define PG8_MMA(ai, bj, At, Bt) do { __builtin_amdgcn_s_setprio(1); _Pragma("unroll") for (int m = 0; m < 4; ++m) _Pragma("unroll") for (int n = 0; n < 2; ++n) _Pragma("unroll") for (int k = 0; k < 2; ++k) \
        acc[ai][bj][m][n] = __builtin_amdgcn_mfma_f32_16x16x32_bf16(Bt[n][k], At[m][k], acc[ai][bj][m][n], 0, 0, 0); __builtin_amdgcn_s_setprio(0); } while (0)
#define PG8_WAIT_V(n) asm volatile("s_waitcnt vmcnt(" #n ")" ::: "memory")
#define PG8_WAIT_L(n) asm volatile("s_waitcnt lgkmcnt(" #n ")" ::: "memory")
#define PG8_BAR __builtin_amdgcn_s_barrier()
#define PG8_SCHED __builtin_amdgcn_sched_barrier(0)
    Unit cur, nxt; int ui = 0;
    if (!P.next(0, cur)) return;
    unsigned vcur[2][2];
    if constexpr (Prob::GATHER) { P.fill_tab(cur, tab); asm volatile("s_waitcnt vmcnt(0) lgkmcnt(0)" ::: "memory"); PG8_BAR; asm volatile("" ::: "memory"); }
    P.a_off(cur, Rr, Cc, vcur, tab);
    if constexpr (Prob::GATHER) { asm volatile("s_waitcnt lgkmcnt(0)" ::: "memory"); }
    f32x4 acc[2][2][4][2];
#pragma unroll
    for (int a = 0; a < 2; ++a)
#pragma unroll
        for (int b = 0; b < 2; ++b)
#pragma unroll
            for (int m = 0; m < 4; ++m)
#pragma unroll
                for (int n = 0; n < 2; ++n) acc[a][b][m][n] = (f32x4){0.f, 0.f, 0.f, 0.f};
    bf16x8 At[4][2], B0[2][2], B1[2][2];
    const char* cA = P.a_base(cur); const char* cB = P.b_base(cur);
    static_assert(SP2, "only the two-MFMA-blocks-per-barrier-pair loop is kept");
    PG8_STAGE(PG8_SB(0, 0), cB, voffB); PG8_STAGE(PG8_SB(0, 1), cB + hstepB, voffB); PG8_STAGE(PG8_SA(0, 0), cA, vcur[0]); PG8_STAGE(PG8_SA(0, 1), cA, vcur[1]);
    if (wr == 1) PG8_BAR;
    PG8_WAIT_V(2); PG8_BAR;
    PG8_STAGE(PG8_SB(1, 0), cB + kstep, voffB); PG8_STAGE(PG8_SA(1, 0), cA + kstep, vcur[0]); PG8_STAGE(PG8_SB(1, 1), cB + hstepB + kstep, voffB);
    PG8_WAIT_V(6); PG8_BAR;
    for (;;) {
        const bool has_next = P.next(ui + 1, nxt);
        const char* nA = has_next ? P.a_base(nxt) : cA; const char* nB = has_next ? P.b_base(nxt) : cB;
        if constexpr (Prob::GATHER) { if (has_next) P.fill_tab(nxt, tab); }
        for (int t = 0; t < nt; t += 2) {
            const bool last = (t == nt - 2);
            const char* a1 = cA + (size_t)(t + 1) * kstep;
            const char* a2 = last ? nA : cA + (size_t)(t + 2) * kstep; const char* b2 = last ? nB : cB + (size_t)(t + 2) * kstep;
            const char* a3 = a2 + kstep; const char* b3 = b2 + kstep;
            PG8_LDB(B0, 0, 0); PG8_LDB(B1, 0, 1); PG8_SCHED; PG8_LDA(At, 0, 0); PG8_STAGE(PG8_SA(1, 1), a1, vcur[1]);
            if constexpr (Prob::GATHER) { if (last && has_next) P.a_off(nxt, Rr, Cc, vcur, tab); }
            PG8_WAIT_V(8); PG8_WAIT_L(0); PG8_BAR; PG8_MMA(0, 0, At, B0); PG8_MMA(0, 1, At, B1); PG8_BAR; PG8_SCHED;
            PG8_LDA(At, 0, 1); PG8_STAGE(PG8_SB(0, 0), b2, voffB); PG8_STAGE(PG8_SB(0, 1), b2 + hstepB, voffB); PG8_STAGE(PG8_SA(0, 0), a2, vcur[0]);
            PG8_WAIT_V(8); PG8_WAIT_L(0); PG8_BAR; PG8_MMA(1, 0, At, B0); PG8_MMA(1, 1, At, B1); PG8_BAR; PG8_SCHED;
            PG8_LDB(B0, 1, 0); PG8_LDB(B1, 1, 1); PG8_SCHED; PG8_LDA(At, 1, 0); PG8_STAGE(PG8_SA(0, 1), a2, vcur[1]);
            PG8_WAIT_V(8); PG8_WAIT_L(0); PG8_BAR; PG8_MMA(0, 0, At, B0); PG8_MMA(0, 1, At, B1); PG8_BAR; PG8_SCHED;
            PG8_LDA(At, 1, 1); PG8_STAGE(PG8_SB(1, 0), b3, voffB); PG8_STAGE(PG8_SB(1, 1), b3 + hstepB, voffB); PG8_STAGE(PG8_SA(1, 0), a3, vcur[0]);
            PG8_WAIT_V(8); PG8_WAIT_L(0); PG8_BAR; PG8_MMA(1, 0, At, B0); PG8_MMA(1, 1, At, B1); PG8_BAR; PG8_SCHED;
        }
        if constexpr (ALIGN_EPI) { if (wr == 0) PG8_BAR; }
        E(acc, cur, wr, wc, fr, fq);
        if (!has_next) break;
#pragma unroll
        for (int a = 0; a < 2; ++a)
#pragma unroll
            for (int b = 0; b < 2; ++b)
#pragma unroll
                for (int m = 0; m < 4; ++m)
#pragma unroll
                    for (int n = 0; n < 2; ++n) acc[a][b][m][n] = (f32x4){0.f, 0.f, 0.f, 0.f};
        cur = nxt; cA = nA; cB = nB; ++ui;
        if constexpr (ALIGN_EPI) { if (wr == 1) PG8_BAR; }
    }
    PG8_WAIT_V(0);
    if constexpr (!ALIGN_EPI) { if (wr == 0) PG8_BAR; }
    PG8_BAR;
#undef PG8_SA
#undef PG8_SB
#undef PG8_STAGE
#undef PG8_LDA
#undef PG8_LDB
#undef PG8_MMA
#undef PG8_WAIT_V
#undef PG8_WAIT_L
#undef PG8_BAR
#undef PG8_SCHED
}

typedef f32x4 AccT[2][2][4][2];
__device__ __forceinline__ float gelu_tanh(float x) {
    const float z = 1.5957691216057308f * (x + 0.044715f * x * x * x);
    return x * __builtin_amdgcn_rcpf(1.0f + __builtin_amdgcn_exp2f(-1.4426950408889634f * z));
}
struct EpiWin {
    static constexpr bool PERM = true;
    bf16_t* GB; bf16_t* RB;
    __device__ __forceinline__ void operator()(const AccT& acc, const Unit& u, int wr, int wc, int fr, int fq) const {
        const int row0 = u.pm * BM + wr * 64 + fr; const bool gate = u.pn < 4;
        bf16_t* base = GB + (size_t)(u.pn >> 2) * ((WS_RB - WS_GB) / 2); const int col0 = (u.pn & 3) * BM + wc * 32 + 8 * fq;
#pragma unroll
        for (int ai = 0; ai < 2; ++ai)
#pragma unroll
            for (int m = 0; m < 4; ++m) { bf16_t* rowp = base + (size_t)(row0 + ai * HALF + m * 16) * D + col0;
#pragma unroll
                for (int bj = 0; bj < 2; ++bj) { f32x4 v0 = acc[ai][bj][m][0], v1 = acc[ai][bj][m][1];
                    if (gate) {
#pragma unroll
                        for (int j = 0; j < 4; ++j) { v0[j] = gelu_tanh(v0[j]); v1[j] = gelu_tanh(v1[j]); } }
                    u32x4 w; w.x = cvt_pk_bf16(v0[0], v0[1]); w.y = cvt_pk_bf16(v0[2], v0[3]); w.z = cvt_pk_bf16(v1[0], v1[1]); w.w = cvt_pk_bf16(v1[2], v1[3]);
                    *(u32x4*)(rowp + bj * HALF) = w; } }
    }
};
struct EpiQKV {
    static constexpr bool PERM = true;
    bf16_t* Q; bf16_t* Kb; bf16_t* V;
    __device__ __forceinline__ void operator()(const AccT& acc, const Unit& u, int wr, int wc, int fr, int fq) const {
        const int row0 = u.pm * BM + wr * 64 + fr; const int t = u.pn >> 2;
        bf16_t* base = Q + (size_t)t * ((WS_K - WS_Q) / 2); const int col0 = (u.pn & 3) * BM + wc * 32 + 8 * fq;
#pragma unroll
        for (int ai = 0; ai < 2; ++ai)
#pragma unroll
            for (int m = 0; m < 4; ++m) { bf16_t* rowp = base + (size_t)(row0 + ai * HALF + m * 16) * D + col0;
#pragma unroll
                for (int bj = 0; bj < 2; ++bj) { const f32x4 v0 = acc[ai][bj][m][0], v1 = acc[ai][bj][m][1];
                    u32x4 w; w.x = cvt_pk_bf16(v0[0], v0[1]); w.y = cvt_pk_bf16(v0[2], v0[3]); w.z = cvt_pk_bf16(v1[0], v1[1]); w.w = cvt_pk_bf16(v1[2], v1[3]);
                    *(u32x4*)(rowp + bj * HALF) = w; } }
    }
};
struct EpiGates {
    static constexpr bool PERM = false;
    const bf16_t* XC; float* AF; float* UF; const float* ba; const float* bx; const float* sp8;
    __device__ __forceinline__ void operator()(const AccT& acc, const Unit& u, int wr, int wc, int fr, int fq) const {
        const int row0 = u.pm * BM + wr * 64 + fr; const int ch0 = (u.pn >> 1) * 256 + (u.pn & 1) * 128 + wc * 32 + 4 * fq;
        f32x4 bav[2], bxv[2], spv[2];
#pragma unroll
        for (int n = 0; n < 2; ++n) { bav[n] = *(const f32x4*)(ba + ch0 + n * 16); bxv[n] = *(const f32x4*)(bx + ch0 + n * 16); spv[n] = *(const f32x4*)(sp8 + ch0 + n * 16); }
#pragma unroll
        for (int ai = 0; ai < 2; ++ai)
#pragma unroll
            for (int m = 0; m < 4; ++m) { const size_t ro = (size_t)(row0 + ai * HALF + m * 16) * D + ch0;
#pragma unroll
                for (int n = 0; n < 2; ++n) { const u32x2 xw = *(const u32x2*)(XC + ro + n * 16);
                    const float xcv[4] = {bflo(xw.x), bfhi(xw.x), bflo(xw.y), bfhi(xw.y)};
                    f32x4 av, uv;
#pragma unroll
                    for (int j = 0; j < 4; ++j) { const float r = sigmoidf_(acc[ai][0][m][n][j] + bav[n][j]), ig = sigmoidf_(acc[ai][1][m][n][j] + bxv[n][j]);
                        const float la = -spv[n][j] * r; const float a = fast_exp(la); const float om = -expm1f(2.0f * la);
                        av[j] = a; uv[j] = __builtin_sqrtf(om) * ig * xcv[j]; }
                    *(f32x4*)(AF + ro + n * 16) = av; *(f32x4*)(UF + ro + n * 16) = uv; } }
    }
};
struct EpiResid {
    static constexpr bool PERM = false;
    const float* X; float* XB; const float* g1;
    __device__ __forceinline__ void operator()(const AccT& acc, const Unit& u, int wr, int wc, int fr, int fq) const {
        const int row0 = u.pm * BM + wr * 64 + fr, col0 = u.pn * BM + wc * 32 + 4 * fq; const int b = (u.pm * BM) / SEQ;
        f32x4 gv[2][2];
#pragma unroll
        for (int bj = 0; bj < 2; ++bj)
#pragma unroll
            for (int n = 0; n < 2; ++n) gv[bj][n] = *(const f32x4*)(g1 + (size_t)b * 6 * D + col0 + bj * HALF + n * 16);
#pragma unroll
        for (int ai = 0; ai < 2; ++ai)
#pragma unroll
            for (int m = 0; m < 4; ++m) { const size_t ro = (size_t)(row0 + ai * HALF + m * 16) * D + col0;
#pragma unroll
                for (int bj = 0; bj < 2; ++bj)
#pragma unroll
                    for (int n = 0; n < 2; ++n) { const f32x4 xv = *(const f32x4*)(X + ro + bj * HALF + n * 16);
                        *(f32x4*)(XB + ro + bj * HALF + n * 16) = xv + gv[bj][n] * acc[ai][bj][m][n]; }
                asm volatile("" ::: "memory"); }
    }
};
struct EpiSwiglu {
    static constexpr bool PERM = true;
    bf16_t* ACT; const float* bgu;
    __device__ __forceinline__ void operator()(const AccT& acc, const Unit& u, int wr, int wc, int fr, int fq) const {
        const int row0 = u.pm * BM + wr * 64 + fr; const int j0 = u.pn * HALF + wc * 32 + 8 * fq;
        const float* bp = bgu + (size_t)u.e * 2 * D + j0;
        const f32x4 bg0 = *(const f32x4*)(bp), bg1 = *(const f32x4*)(bp + 4), bu0 = *(const f32x4*)(bp + D), bu1 = *(const f32x4*)(bp + D + 4);
#pragma unroll
        for (int ai = 0; ai < 2; ++ai)
#pragma unroll
            for (int m = 0; m < 4; ++m) {
                float o[8];
#pragma unroll
                for (int n = 0; n < 2; ++n)
#pragma unroll
                    for (int j = 0; j < 4; ++j) { const float g = acc[ai][0][m][n][j] + (n ? bg1[j] : bg0[j]), up = acc[ai][1][m][n][j] + (n ? bu1[j] : bu0[j]);
                        const float gv = fminf(g, 7.0f), uv = fminf(fmaxf(up, -7.0f), 7.0f);
                        o[n * 4 + j] = gv * sigmoidf_(1.702f * gv) * (uv + 1.0f); }
                u32x4 w; w.x = cvt_pk_bf16(o[0], o[1]); w.y = cvt_pk_bf16(o[2], o[3]); w.z = cvt_pk_bf16(o[4], o[5]); w.w = cvt_pk_bf16(o[6], o[7]);
                *(u32x4*)(ACT + (size_t)(row0 + ai * HALF + m * 16) * D + j0) = w; }
    }
};
struct EpiDown {
    static constexpr bool PERM = true;
    bf16_t* YK; const float* bdn; const unsigned* rowlist; const float* topw;
    __device__ __forceinline__ void operator()(const AccT& acc, const Unit& u, int wr, int wc, int fr, int fq) const {
        const int c0 = u.pn * BM + wc * 32 + 8 * fq;
        const float* bp = bdn + (size_t)u.e * D + c0;
        f32x4 bv[2][2];
#pragma unroll
        for (int bj = 0; bj < 2; ++bj) { bv[bj][0] = *(const f32x4*)(bp + bj * HALF); bv[bj][1] = *(const f32x4*)(bp + bj * HALF + 4); }
        const unsigned* rl = rowlist + (size_t)u.e * CAP + u.j * 256;
#pragma unroll
        for (int ai = 0; ai < 2; ++ai)
#pragma unroll
            for (int m = 0; m < 4; ++m) { const int r = ai * HALF + wr * 64 + m * 16 + fr;
                if (r < u.valid) { const unsigned dest = rl[r]; const float w = topw[dest];
                    bf16_t* rowp = YK + (size_t)dest * D + c0;
#pragma unroll
                    for (int bj = 0; bj < 2; ++bj) { const f32x4 v0 = (acc[ai][bj][m][0] + bv[bj][0]) * w, v1 = (acc[ai][bj][m][1] + bv[bj][1]) * w;
                        u32x4 o; o.x = cvt_pk_bf16(v0[0], v0[1]); o.y = cvt_pk_bf16(v0[2], v0[3]); o.z = cvt_pk_bf16(v1[0], v1[1]); o.w = cvt_pk_bf16(v1[2], v1[3]);
                        *(u32x4*)(rowp + bj * HALF) = o; } } }
    }
};
}

namespace att {
typedef short s16x4 __attribute__((ext_vector_type(4)));
typedef float f32x16 __attribute__((ext_vector_type(16)));
constexpr int NW = 8, QBLK = 32, KVBLK = 64, QB = NW * QBLK, DH = 128, LD = 1024;
constexpr int SHM_V = KVBLK * DH * 2, SHM_K = KVBLK * DH * 2;
constexpr int ATT_LDS_BYTES = 2 * SHM_V + 2 * SHM_K + NW * 64 * 4;
constexpr float SCALE = 0.08838834764831845f;
constexpr float THR = 8.f;
#define KSWZ(row, colB) ((row) * 256 + ((colB) ^ (((row) & 7) << 4)))
#define SBAR() __builtin_amdgcn_sched_barrier(0)
__device__ __forceinline__ int v_st(int k, int c) { const int kk = (k & ~0xC) | ((k & 4) << 1) | ((k & 8) >> 1); return ((kk >> 3) * 4 + (c >> 5)) * 512 + ((kk & 7) * 32 + (c & 31)) * 2; }
__device__ __forceinline__ int v_rd_base(int lane) { return ((lane & 3) << 3) | (((lane >> 2) & 3) << 6) | (((lane >> 4) & 1) << 5) | (((lane >> 5) & 1) << 8); }
constexpr int v_rd_off(int d0, int ks, int half) { return d0 * 512 + ks * 4096 + half * 2048; }
__device__ __forceinline__ int crow(int r, int hi) { return (r & 3) + 8 * (r >> 2) + 4 * hi; }
__device__ __forceinline__ unsigned cvtpk(float lo, float hi) { unsigned r; asm volatile("v_cvt_pk_bf16_f32 %0, %1, %2" : "=v"(r) : "v"(lo), "v"(hi)); return r; }
__device__ __forceinline__ bf16x8 ld8(const bf16_t* p) { return *reinterpret_cast<const bf16x8*>(p); }
__device__ __forceinline__ void mask_causal(f32x16& p0, f32x16& p1, int dq) {
    const float NEG = -__builtin_inff();
#pragma unroll
    for (int r = 0; r < 16; ++r) {
        const int c = (r & 3) + 8 * (r >> 2);
        if (dq - c < 0) p0[r] = NEG;
        if (dq - c - 32 < 0) p1[r] = NEG;
    }
}
__device__ __forceinline__ void mask_all(f32x16& p0, f32x16& p1, bool keep) {
    const float NEG = -__builtin_inff();
#pragma unroll
    for (int r = 0; r < 16; ++r) { p0[r] = keep ? p0[r] : NEG; p1[r] = keep ? p1[r] : NEG; }
}
__device__ __forceinline__ void partialSM(f32x16& p0, f32x16& p1, float& m_reg, float& mn, float& alpha) {
    float pmax = p0[0]; for (int r = 1; r < 16; ++r) pmax = fmaxf(pmax, p0[r]); for (int r = 0; r < 16; ++r) pmax = fmaxf(pmax, p1[r]);
    { auto rr = __builtin_amdgcn_permlane32_swap(__float_as_uint(pmax), __float_as_uint(pmax), false, false);
      pmax = fmaxf(__uint_as_float(rr[0]), __uint_as_float(rr[1])); }
    constexpr float C2 = 1.4426950408889634f * SCALE;
    if (__builtin_expect(__all((pmax - m_reg) * SCALE <= THR), 1)) { mn = m_reg; alpha = 1.f; }
    else { mn = fmaxf(m_reg, pmax); alpha = __builtin_amdgcn_exp2f((m_reg - mn) * C2); m_reg = mn; }
    const float mnL = -mn * C2;
    for (int r = 0; r < 16; ++r) p0[r] = fmaf(p0[r], C2, mnL); for (int r = 0; r < 16; ++r) p1[r] = fmaf(p1[r], C2, mnL);
    for (int r = 0; r < 16; ++r) p0[r] = __builtin_amdgcn_exp2f(p0[r]);
}
__device__ __forceinline__ void finishSM(f32x16& p0, f32x16& p1, float alpha, float& l_reg, bf16x8& pa0, bf16x8& pa1, bf16x8& pa2, bf16x8& pa3) {
    for (int r = 0; r < 16; ++r) p1[r] = __builtin_amdgcn_exp2f(p1[r]);
    float ps = 0; for (int r = 0; r < 16; ++r) ps += p0[r]; for (int r = 0; r < 16; ++r) ps += p1[r];
    { auto rr = __builtin_amdgcn_permlane32_swap(__float_as_uint(ps), __float_as_uint(ps), false, false);
      ps = __uint_as_float(rr[0]) + __uint_as_float(rr[1]); }
    l_reg = l_reg * alpha + ps;
#define PK4(P, B_, OUT) do { unsigned a0 = cvtpk(P[B_+0], P[B_+1]), a1 = cvtpk(P[B_+2], P[B_+3]);                          \
        unsigned b0 = cvtpk(P[B_+4], P[B_+5]), b1 = cvtpk(P[B_+6], P[B_+7]);                                             \
        auto r0 = __builtin_amdgcn_permlane32_swap(a0, b0, false, false); auto r1 = __builtin_amdgcn_permlane32_swap(a1, b1, false, false); \
        u32x4 w = {r0[0], r1[0], r0[1], r1[1]}; OUT = *reinterpret_cast<bf16x8*>(&w); } while (0)
    PK4(p0, 0, pa0); PK4(p0, 8, pa1); PK4(p1, 0, pa2); PK4(p1, 8, pa3);
#undef PK4
}
template <int KB>
__device__ __forceinline__ void qkt(f32x16& p0, f32x16& p1, const char* K_lds, int r32, int hi, const bf16x8* qr) {
    p0 = f32x16{}; p1 = f32x16{};
    const char* kb[4];
#pragma unroll
    for (int dd = 0; dd < 4; ++dd) kb[dd] = K_lds + KB * SHM_K + KSWZ(r32, (dd * 16 + hi * 8) * 2);
#pragma unroll
    for (int d0 = 0; d0 < 8; ++d0) { const char* a = kb[d0 & 3] + (d0 >> 2) * 128;
        bf16x8 b0 = *reinterpret_cast<const bf16x8*>(a);
        bf16x8 b1 = *reinterpret_cast<const bf16x8*>(a + 32 * 256);
        p0 = __builtin_amdgcn_mfma_f32_32x32x16_bf16(b0, qr[d0], p0, 0, 0, 0);
        p1 = __builtin_amdgcn_mfma_f32_32x32x16_bf16(b1, qr[d0], p1, 0, 0, 0); }
}
template <int VB>
__device__ __forceinline__ void pv_tile(f32x16* o, int vb0, bf16x8 pa0, bf16x8 pa1, bf16x8 pa2, bf16x8 pa3) {
#define TRRD(dst, off) asm volatile("ds_read_b64_tr_b16 %0, %1 offset:%2" : "=&v"(dst) : "v"(vb0), "i"(off) : "memory")
#define PV_D0(d0) do { s16x4 l0, l1, l2, l3, h0, h1, h2, h3; constexpr int b_ = VB * SHM_V + v_rd_off(d0, 0, 0); \
        TRRD(l0, b_); TRRD(h0, b_ + 2048); TRRD(l1, b_ + 4096); TRRD(h1, b_ + 6144); TRRD(l2, b_ + 8192); TRRD(h2, b_ + 10240); TRRD(l3, b_ + 12288); TRRD(h3, b_ + 14336); \
        asm volatile("s_waitcnt lgkmcnt(0)" ::: "memory"); SBAR();   \
        o[d0] = __builtin_amdgcn_mfma_f32_32x32x16_bf16(pa0, (bf16x8){l0[0], l0[1], l0[2], l0[3], h0[0], h0[1], h0[2], h0[3]}, o[d0], 0, 0, 0);   \
        o[d0] = __builtin_amdgcn_mfma_f32_32x32x16_bf16(pa1, (bf16x8){l1[0], l1[1], l1[2], l1[3], h1[0], h1[1], h1[2], h1[3]}, o[d0], 0, 0, 0);   \
        o[d0] = __builtin_amdgcn_mfma_f32_32x32x16_bf16(pa2, (bf16x8){l2[0], l2[1], l2[2], l2[3], h2[0], h2[1], h2[2], h2[3]}, o[d0], 0, 0, 0);   \
        o[d0] = __builtin_amdgcn_mfma_f32_32x32x16_bf16(pa3, (bf16x8){l3[0], l3[1], l3[2], l3[3], h3[0], h3[1], h3[2], h3[3]}, o[d0], 0, 0, 0); } while (0)
    PV_D0(0); PV_D0(1); PV_D0(2); PV_D0(3);
#undef PV_D0
#undef TRRD
}
struct BlockRef { const bf16_t* Q; const bf16_t* K; const bf16_t* V; bf16_t* O; const unsigned* M; int qb; };
struct Seam { bf16x8 qr[8]; bf16x8 st_v0, st_v1, st_k0, st_k1; };
#define VMW() asm volatile("s_waitcnt vmcnt(0)" ::: "memory")
#define VMWN(n) asm volatile("s_waitcnt vmcnt(%0)" :: "i"(n) : "memory")
#define GLD8(ubase) (*reinterpret_cast<const bf16x8*>((ubase) + toff))
#define SLOAD_H(Kp, Vp, k0) do { const char* kb__ = (const char*)(Kp) + (size_t)(k0) * (LD * 2); const char* vb__ = (const char*)(Vp) + (size_t)(k0) * (LD * 2); \
                         S.st_v0 = GLD8(vb__); S.st_v1 = GLD8(vb__ + 32 * LD * 2); S.st_k0 = GLD8(kb__); S.st_k1 = GLD8(kb__ + 32 * LD * 2); } while (0)
#define SWRITE_HK(bf) do { *(bf16x8*)(K_lds + (bf) * SHM_K + kws) = S.st_k0; *(bf16x8*)(K_lds + (bf) * SHM_K + kws + 32 * 256) = S.st_k1; } while (0)
#define SWRITE_HV(bf) do { *(bf16x8*)(V_lds + (bf) * SHM_V + vst0) = S.st_v0; *(bf16x8*)(V_lds + (bf) * SHM_V + vst1) = S.st_v1; } while (0)
#define SWRITE_H(bf) do { SWRITE_HV(bf); SWRITE_HK(bf); } while (0)
__device__ __forceinline__ void moba_prime(const BlockRef& cur, char* lds, Seam& S, int tid) {
    const int wid = __builtin_amdgcn_readfirstlane(tid >> 6), lane = tid & 63, r32 = lane & 31, hi = lane >> 5;
    const int sr = tid >> 4, sc = (tid & 15) * 8, kws = KSWZ(sr, sc * 2); char* K_lds = lds + 2 * SHM_V;
    const unsigned toff = (unsigned)(sr * LD + sc) * 2u, qoff = (unsigned)(r32 * LD + hi * 8) * 2u;
    { const char* qb_ = (const char*)cur.Q + (size_t)(wid * QBLK) * (LD * 2);
#pragma unroll
      for (int d0 = 0; d0 < 8; ++d0) S.qr[d0] = *reinterpret_cast<const bf16x8*>(qb_ + d0 * 32 + qoff); }
    SLOAD_H(cur.K, cur.V, 0); VMW(); SWRITE_HK(0);
    __syncthreads();
}
__device__ __forceinline__ void moba_block(const BlockRef& cur, const BlockRef& nxt, char* lds, Seam& S, int tid) {
    const int wid = __builtin_amdgcn_readfirstlane(tid >> 6), lane = tid & 63, r32 = lane & 31, hi = lane >> 5;
    const int NT = 4 * (cur.qb + 1);
    const int P0 = cur.qb * QB;
    const int qlo = P0 + wid * QBLK, qm = qlo + r32 - 4 * hi;
    const unsigned msk = cur.M[wid * QBLK + r32];
    char* V_lds = lds; char* K_lds = lds + 2 * SHM_V;
    float* ws = (float*)(lds + 2 * SHM_V + 2 * SHM_K) + wid * 64; float* li_l = ws, * al_l = ws + 32;
    float m_reg = -1e30f, l_reg = 0; f32x16 o[4] = {};
    const int sr = tid >> 4, sc = (tid & 15) * 8, vst0 = v_st(sr, sc), vst1 = v_st(32 + sr, sc), kws = KSWZ(sr, sc * 2);
    const unsigned toff = (unsigned)(sr * LD + sc) * 2u, qoff = (unsigned)(r32 * LD + hi * 8) * 2u;
    const int vb0 = (int)(uintptr_t)V_lds + v_rd_base(lane);
    const bf16_t* Kh = cur.K; const bf16_t* Vh = cur.V;
#define RESC(a) do { if (__any((a) < 1.f)) { if (hi == 0) al_l[r32] = (a); asm volatile("s_waitcnt lgkmcnt(0)" ::: "memory");              \
                     for (int d_ = 0; d_ < 4; ++d_) for (int r = 0; r < 16; ++r) o[d_][r] *= al_l[crow(r, hi)]; } } while (0)
#define KBASE(t) ((t) * KVBLK)
#define MASKT(P0_, P1_, t) do { const int kb_ = KBASE(t); const int jb_ = (t) >> 2; \
        if (jb_ < cur.qb) { mask_all(P0_, P1_, ((msk >> jb_) & 1u) != 0u); } \
        else if (kb_ + KVBLK - 1 > qlo) mask_causal(P0_, P1_, qm - kb_); } while (0)
    constexpr int NQL = 8;
#define SEAM_K0() do { VMWN(NQL); SWRITE_HK(0); SBAR(); } while (0)
    f32x16 pA0, pA1, pB0, pB1; float mnA, mnB, alA, alB; bf16x8 pa0, pa1, pa2, pa3;
    SWRITE_HV(0); SBAR();
    if (NT > 1) { SLOAD_H(Kh, Vh, KBASE(1)); }
    SBAR(); qkt<0>(pA0, pA1, K_lds, r32, hi, S.qr);
    MASKT(pA0, pA1, 0); partialSM(pA0, pA1, m_reg, mnA, alA);
    if (NT > 1) { VMW(); SWRITE_H(1); }
    __syncthreads();
#define HALF_STEP(PX0, PX1, mnX, alX, PY0, PY1, alY, t, KB, VB, SB) do {                                                      \
        SBAR(); qkt<KB>(PX0, PX1, K_lds, r32, hi, S.qr);                                             \
        finishSM(PY0, PY1, alY, l_reg, pa0, pa1, pa2, pa3); SBAR();                                                           \
        if ((t) + 1 < NT) { SLOAD_H(Kh, Vh, KBASE((t) + 1)); SBAR(); }                                               \
        pv_tile<VB>(o, vb0, pa0, pa1, pa2, pa3); MASKT(PX0, PX1, (t)); partialSM(PX0, PX1, m_reg, mnX, alX);                                        \
        __syncthreads();                                                                                                      \
        if ((t) + 1 < NT) { VMW(); SWRITE_H(SB); }                                                                          \
        RESC(alX); __syncthreads(); } while (0)
    for (int t = 1; t + 1 < NT; t += 2) {
        HALF_STEP(pB0, pB1, mnB, alB, pA0, pA1, alA, t, 1, 0, 0);
        HALF_STEP(pA0, pA1, mnA, alA, pB0, pB1, alB, t + 1, 0, 1, 1);
    }
    const bool even = (NT & 1) == 0;
    if (even) { SBAR(); qkt<1>(pB0, pB1, K_lds, r32, hi, S.qr); SBAR(); }
    SLOAD_H(nxt.K, nxt.V, 0); SBAR();
    { const char* qb_ = (const char*)nxt.Q + (size_t)(wid * QBLK) * (LD * 2);
#pragma unroll
      for (int d0 = 0; d0 < 8; ++d0) S.qr[d0] = *reinterpret_cast<const bf16x8*>(qb_ + d0 * 32 + qoff); }
    SBAR();
    finishSM(pA0, pA1, alA, l_reg, pa0, pa1, pa2, pa3); SBAR();
    pv_tile<0>(o, vb0, pa0, pa1, pa2, pa3);
    if (even) { MASKT(pB0, pB1, NT - 1); partialSM(pB0, pB1, m_reg, mnB, alB); __syncthreads(); RESC(alB);
        finishSM(pB0, pB1, alB, l_reg, pa0, pa1, pa2, pa3); SBAR(); pv_tile<1>(o, vb0, pa0, pa1, pa2, pa3); }
    SBAR(); SEAM_K0();
    if (hi == 0) li_l[r32] = l_reg; asm volatile("s_waitcnt lgkmcnt(0)" ::: "memory");
    float rli[16];
#pragma unroll
    for (int r = 0; r < 16; ++r) rli[r] = __builtin_amdgcn_rcpf(li_l[crow(r, hi)]);
    char* Ow = (char*)cur.O + (size_t)(wid * QBLK) * (LD * 2);
    const unsigned ooff = (unsigned)(4 * hi * LD + r32) * 2u;
#pragma unroll
    for (int r = 0; r < 16; ++r) { char* Or = Ow + (size_t)((r & 3) + 8 * (r >> 2)) * (LD * 2);
#pragma unroll
        for (int d0 = 0; d0 < 4; ++d0) { const float v = o[d0][r] * rli[r];
            const float vn = __shfl_xor(v, 1);
            if ((r32 & 1) == 0) *(unsigned*)(Or + d0 * 64 + ooff) = cvtpk(v, vn); } }
    __syncthreads();
#undef RESC
#undef KBASE
#undef MASKT
#undef SEAM_K0
#undef HALF_STEP
}
#undef VMW
#undef VMWN
#undef SLOAD_H
#undef GLD8
#undef SWRITE_HK
#undef SWRITE_HV
#undef SWRITE_H
}

struct Args { const float* in[25]; float* out; unsigned char* ws; int ph_lo, ph_hi, li, pad; };
enum { IN_X = 0, IN_C, IN_NMG, IN_NFG, IN_WMOD, IN_BMOD, IN_LWIN, IN_LCW, IN_LCB, IN_LWA, IN_LBA, IN_LWX, IN_LBX, IN_LLAM, IN_LWOUT,
       IN_AQKV, IN_AQG, IN_AKG, IN_AWOUT, IN_RW, IN_RB, IN_WGU, IN_BGU, IN_WDN, IN_BDN };
struct Frame {
    LAS unsigned char* lds;
    unsigned char* ws;
    int tid, lane, wave, vcu, G;
};

__device__ __forceinline__ void cvt_tile(const float* W, int ldw, int k0, int n0, bf16_t* WT, int ldt, int drow0, LAS float* scr, int lane) {
    const int q = lane & 15, rr = lane >> 4;
    f32x4 v[16];
#pragma unroll
    for (int i = 0; i < 16; ++i) v[i] = *(const f32x4*)(W + (size_t)(k0 + 4 * i + rr) * ldw + n0 + 4 * q);
#pragma unroll
    for (int i = 0; i < 16; ++i) { LAS float* s = scr + (4 * i + rr) * 65 + 4 * q; s[0] = v[i][0]; s[1] = v[i][1]; s[2] = v[i][2]; s[3] = v[i][3]; }
    LDS_WAIT();
    const int c = lane & 7;
#pragma unroll
    for (int jj = 0; jj < 8; ++jj) { const int n = (lane >> 3) + 8 * jj; const LAS float* s = scr + (8 * c) * 65 + n;
        u32x4 o; o.x = cvt_pk_bf16(s[0 * 65], s[1 * 65]); o.y = cvt_pk_bf16(s[2 * 65], s[3 * 65]); o.z = cvt_pk_bf16(s[4 * 65], s[5 * 65]); o.w = cvt_pk_bf16(s[6 * 65], s[7 * 65]);
        *(u32x4*)(WT + (size_t)(drow0 + n) * ldt + k0 + 8 * c) = o; }
    LDS_WAIT();
}
__device__ __forceinline__ void phase_prologue(Frame& F, const Args& a) {
    if (blockIdx.x < 96) {
        LAS float* cond = (LAS float*)F.lds;
        LAS float* red = (LAS float*)(F.lds + 16384);
        const float* c = a.in[IN_C];
        for (int i = F.tid; i < BATCH * D; i += NTHR) { const float x = c[i]; cond[i] = x * sigmoidf_(x); }
        __syncthreads();
        const int l = blockIdx.x / 24, n0 = (blockIdx.x % 24) * 256;
        const float* W = a.in[IN_WMOD] + (size_t)l * D * 6 * D + n0 + 4 * F.lane;
        f32x4 acc[4];
#pragma unroll
        for (int b = 0; b < 4; ++b) acc[b] = (f32x4){0.f, 0.f, 0.f, 0.f};
        const int kb = F.wave * 128;
#pragma unroll 8
        for (int k = 0; k < 128; ++k) { const f32x4 w = *(const f32x4*)(W + (size_t)(kb + k) * 6 * D);
#pragma unroll
            for (int b = 0; b < 4; ++b) acc[b] += w * cond[b * D + kb + k]; }
#pragma unroll
        for (int b = 0; b < 4; ++b) *(LAS f32x4*)(red + (F.wave * 4 + b) * 256 + 4 * F.lane) = acc[b];
        __syncthreads();
        float* MOD = (float*)(F.ws + WS_MOD);
        for (int o = F.tid; o < 1024; o += NTHR) { const int b = o >> 8, n = o & 255; float s = 0.f;
#pragma unroll
            for (int w = 0; w < 8; ++w) s += red[(w * 4 + b) * 256 + n];
            MOD[((size_t)l * BATCH + b) * 6 * D + n0 + n] = s + a.in[IN_BMOD][(size_t)l * 6 * D + n0 + n]; }
        __syncthreads();
    }
    { const int g = blockIdx.x * NTHR + F.tid; if (g < 2 * D) { const float lam = a.in[IN_LLAM][g]; const float z = -lam;
        const float sp = z > 20.f ? z : log1pf(__expf(z)); ((float*)(F.ws + WS_SP8))[g] = 8.0f * sp; } }
    { float* PAR = (float*)(F.ws + WS_PAR); const int g = blockIdx.x * NTHR + F.tid, GS = F.G * NTHR;
#define CPY(dst, src, n) for (int i = g; i < (n) / 4; i += GS) *(f32x4*)(PAR + (dst) + 4 * i) = *(const f32x4*)(a.in[src] + 4 * i)
      CPY(PAR_NMG, IN_NMG, 4 * 1024); CPY(PAR_NFG, IN_NFG, 4 * 1024); CPY(PAR_LCW, IN_LCW, 2 * 4 * 1024); CPY(PAR_LCB, IN_LCB, 2 * 1024); CPY(PAR_LBA, IN_LBA, 2 * 1024); CPY(PAR_LBX, IN_LBX, 2 * 1024);
      CPY(PAR_AQG, IN_AQG, 256); CPY(PAR_AKG, IN_AKG, 256); CPY(PAR_RW, IN_RW, 4 * 1024 * 32); CPY(PAR_RB, IN_RB, 128); CPY(PAR_BGU, IN_BGU, 4 * 32 * 2048); CPY(PAR_BDN, IN_BDN, 4 * 32 * 1024);
#undef CPY
    }
    LAS float* scr = (LAS float*)(F.lds + F.wave * 16640);
    const int gw = F.vcu * NWAVES + F.wave, NGW = F.G * NWAVES;
    constexpr int I0 = 128 * 512, I1 = 128 * 256, I2 = 2 * 512, I3 = 16 * 16, I4 = 2 * 256, I5 = 2 * 768, I6 = 2 * 256;
    constexpr int NITEMS = I0 + I1 + I2 + I3 + I4 + I5 + I6;
    for (int it = gw; it < NITEMS; it += NGW) {
        int r = it;
        if (r < I0) { const int mat = r >> 9, q = r & 511, kb = q >> 5, nb = q & 31, n0 = nb * 64;
            const int dr = n0 < D ? (n0 >> 7) * 256 + (n0 & 127) : ((n0 - D) >> 7) * 256 + 128 + ((n0 - D) & 127);
            cvt_tile(a.in[IN_WGU] + (size_t)mat * D * 2 * D, 2 * D, kb * 64, n0, (bf16_t*)(F.ws + WS_WGU) + (size_t)mat * 2 * D * D, D, dr, scr, F.lane); continue; } r -= I0;
        if (r < I1) { const int mat = r >> 8, q = r & 255, kb = q >> 4, nb = q & 15;
            cvt_tile(a.in[IN_WDN] + (size_t)mat * D * D, D, kb * 64, nb * 64, (bf16_t*)(F.ws + WS_WDN) + (size_t)mat * D * D, D, nb * 64, scr, F.lane); continue; } r -= I1;
        if (r < I2) { const int mat = r >> 9, q = r & 511, kb = q >> 5, nb = q & 31;
            cvt_tile(a.in[IN_LWIN] + (size_t)mat * D * 2 * D, 2 * D, kb * 64, nb * 64, (bf16_t*)(F.ws + WS_WIN) + (size_t)mat * 2 * D * D, D, nb * 64, scr, F.lane); continue; } r -= I2;
        if (r < I3) { const int mat = r >> 4, q = r & 15, kb = q >> 2, nb = q & 3;
            const int layer = mat >> 3, ax = (mat >> 2) & 1, g = mat & 3, n0 = nb * 64;
            const float* src = (ax ? a.in[IN_LWX] : a.in[IN_LWA]) + (size_t)(layer * 4 + g) * 256 * 256;
            const int dr = (g * 2 + (n0 >> 7)) * 256 + ax * 128 + (n0 & 127);
            cvt_tile(src, 256, kb * 64, n0, (bf16_t*)(F.ws + WS_WG) + (size_t)layer * 2048 * 256, 256, dr, scr, F.lane); continue; } r -= I3;
        if (r < I4) { const int mat = r >> 8, q = r & 255, kb = q >> 4, nb = q & 15;
            cvt_tile(a.in[IN_LWOUT] + (size_t)mat * D * D, D, kb * 64, nb * 64, (bf16_t*)(F.ws + WS_WLO) + (size_t)mat * D * D, D, nb * 64, scr, F.lane); continue; } r -= I4;
        if (r < I5) { const int mat = r / 768, q = r % 768, kb = q / 48, nb = q % 48;
            cvt_tile(a.in[IN_AQKV] + (size_t)mat * D * 3 * D, 3 * D, kb * 64, nb * 64, (bf16_t*)(F.ws + WS_WQKV) + (size_t)mat * 3 * D * D, D, nb * 64, scr, F.lane); continue; } r -= I5;
        { const int mat = r >> 8, q = r & 255, kb = q >> 4, nb = q & 15;
            cvt_tile(a.in[IN_AWOUT] + (size_t)mat * D * D, D, kb * 64, nb * 64, (bf16_t*)(F.ws + WS_WAO) + (size_t)mat * D * D, D, nb * 64, scr, F.lane); }
    }
}

__device__ __forceinline__ void phase_norm(Frame& F, const float* xin, float* out, int layer, bool final_) {
    const float* PAR = (const float*)(F.ws + WS_PAR);
    const int gw = F.vcu * NWAVES + F.wave; const int m0 = gw * 8; const int b = m0 / SEQ;
    const float* MOD = (const float*)(F.ws + WS_MOD);
    const bool first = (layer == 0);
    f32x4 gain[4], sc[4], sh[4], g2[4];
#pragma unroll
    for (int j = 0; j < 4; ++j) { const int c = 4 * F.lane + 256 * j;
        if (!final_) { gain[j] = *(const f32x4*)(PAR + PAR_NMG + (size_t)layer * D + c);
            sh[j] = *(const f32x4*)(MOD + ((size_t)layer * BATCH + b) * 6 * D + c); sc[j] = *(const f32x4*)(MOD + ((size_t)layer * BATCH + b) * 6 * D + D + c); }
        if (!first) g2[j] = *(const f32x4*)(MOD + ((size_t)(layer - 1) * BATCH + b) * 6 * D + 5 * D + c); }
    const float* XB = (const float*)(F.ws + WS_XB); float* XA = (float*)(F.ws + WS_XA);
    const bf16_t* YK = (const bf16_t*)(F.ws + WS_YK); bf16_t* H = (bf16_t*)(F.ws + WS_H);
    for (int r = 0; r < 8; ++r) { const int m = m0 + r;
        f32x4 x[4];
#pragma unroll
        for (int j = 0; j < 4; ++j) { const int c = 4 * F.lane + 256 * j;
            if (first) x[j] = *(const f32x4*)(xin + (size_t)m * D + c);
            else { const u32x2 w = *(const u32x2*)(YK + (size_t)m * D + c); const f32x4 s = (f32x4){bflo(w.x), bfhi(w.x), bflo(w.y), bfhi(w.y)};
                x[j] = *(const f32x4*)(XB + (size_t)m * D + c) + g2[j] * s;
                if (final_) *(f32x4*)(out + (size_t)m * D + c) = x[j]; else *(f32x4*)(XA + (size_t)m * D + c) = x[j]; } }
        if (final_) continue;
        float ss = 0.f;
#pragma unroll
        for (int j = 0; j < 4; ++j) ss += (x[j][0] * x[j][0] + x[j][1] * x[j][1]) + (x[j][2] * x[j][2] + x[j][3] * x[j][3]);
        const float rstd = __builtin_amdgcn_rsqf(wave_sum(ss) * (1.0f / D) + NORM_EPS);
#pragma unroll
        for (int j = 0; j < 4; ++j) { const int c = 4 * F.lane + 256 * j;
            const f32x4 h = x[j] * rstd * gain[j] * (1.0f + sc[j]) + sh[j];
            u32x2 o; o.x = cvt_pk_bf16(h[0], h[1]); o.y = cvt_pk_bf16(h[2], h[3]); *(u32x2*)(H + (size_t)m * D + c) = o; }
    }
}

constexpr int MOE_TOK = T / TOPK;
__device__ __forceinline__ void phase_router(Frame& F, int layer) {
    if (F.vcu >= MOE_TOK / 64) return;
    const float* PAR = (const float*)(F.ws + WS_PAR);
    LAS float* rw = (LAS float*)F.lds;
    LAS unsigned* lcnt = (LAS unsigned*)(F.lds + LDS_X);
    LAS unsigned* lbase = lcnt + 32;
    LAS unsigned* pend = lcnt + 64;
    { const float* RW = PAR + PAR_RW + (size_t)layer * D * NE;
      for (int i = F.tid; i < D * NE / 4; i += NTHR) { const int col = i >> 3, ch = i & 7; const f32x4 v = *(const f32x4*)(RW + (size_t)i * 4);
          *(LAS f32x4*)(rw + col * 32 + ((ch ^ ((col >> 2) & 7)) << 2)) = v; }
      if (F.tid < 32) lcnt[F.tid] = 0u; }
    __syncthreads();
    const int gw = F.vcu * NWAVES + F.wave; const int m0 = gw * 8; const int b = m0 / SEQ;
    const float* MOD = (const float*)(F.ws + WS_MOD);
    f32x4 gain[4], sc[4], sh[4];
#pragma unroll
    for (int j = 0; j < 4; ++j) { const int c = 4 * F.lane + 256 * j; gain[j] = *(const f32x4*)(PAR + PAR_NFG + (size_t)layer * D + c);
        sh[j] = *(const f32x4*)(MOD + ((size_t)layer * BATCH + b) * 6 * D + 3 * D + c); sc[j] = *(const f32x4*)(MOD + ((size_t)layer * BATCH + b) * 6 * D + 4 * D + c); }
    const float* XB = (const float*)(F.ws + WS_XB); bf16_t* H = (bf16_t*)(F.ws + WS_H);
    const float rbias = PAR[PAR_RB + layer * NE + (F.lane & 31)];
    const int sw = F.lane & 7;
    for (int rp = 0; rp < 4; ++rp) {
        f32x4 h[2][4];
#pragma unroll
        for (int q = 0; q < 2; ++q) { const int m = m0 + rp * 2 + q;
            f32x4 x[4]; float ss = 0.f;
#pragma unroll
            for (int j = 0; j < 4; ++j) { x[j] = *(const f32x4*)(XB + (size_t)m * D + 4 * F.lane + 256 * j); ss += (x[j][0] * x[j][0] + x[j][1] * x[j][1]) + (x[j][2] * x[j][2] + x[j][3] * x[j][3]); }
            const float rstd = __builtin_amdgcn_rsqf(wave_sum(ss) * (1.0f / D) + NORM_EPS);
#pragma unroll
            for (int j = 0; j < 4; ++j) { h[q][j] = x[j] * rstd * gain[j] * (1.0f + sc[j]) + sh[j];
                u32x2 o; o.x = cvt_pk_bf16(h[q][j][0], h[q][j][1]); o.y = cvt_pk_bf16(h[q][j][2], h[q][j][3]); *(u32x2*)(H + (size_t)m * D + 4 * F.lane + 256 * j) = o; } }
        float v[64];
#pragma unroll
        for (int i = 0; i < 64; ++i) v[i] = 0.f;
#pragma unroll
        for (int j = 0; j < 4; ++j)
#pragma unroll
            for (int cc = 0; cc < 4; ++cc) { const int col = 4 * F.lane + 256 * j + cc; const LAS float* rp_ = rw + col * 32;
#pragma unroll
                for (int eq = 0; eq < 8; ++eq) { const f32x4 w = *(const LAS f32x4*)(rp_ + ((eq ^ sw) << 2));
#pragma unroll
                    for (int k = 0; k < 4; ++k) { v[eq * 4 + k] = fmaf(h[0][j][cc], w[k], v[eq * 4 + k]); v[32 + eq * 4 + k] = fmaf(h[1][j][cc], w[k], v[32 + eq * 4 + k]); } } }
#pragma unroll
        for (int i = 0; i < 32; ++i) { const bool up = (F.lane & 32) != 0; const float send = up ? v[i] : v[32 + i]; const float recv = __shfl_xor(send, 32); v[i] = (up ? v[32 + i] : v[i]) + recv; }
#pragma unroll
        for (int i = 0; i < 16; ++i) { const bool up = (F.lane & 16) != 0; const float send = up ? v[i] : v[16 + i]; const float recv = __shfl_xor(send, 16); v[i] = (up ? v[16 + i] : v[i]) + recv; }
#pragma unroll
        for (int i = 0; i < 8; ++i) { const bool up = (F.lane & 8) != 0; const float send = up ? v[i] : v[8 + i]; const float recv = __shfl_xor(send, 8); v[i] = (up ? v[8 + i] : v[i]) + recv; }
#pragma unroll
        for (int i = 0; i < 4; ++i) { const bool up = (F.lane & 4) != 0; const float send = up ? v[i] : v[4 + i]; const float recv = __shfl_xor(send, 4); v[i] = (up ? v[4 + i] : v[i]) + recv; }
#pragma unroll
        for (int i = 0; i < 2; ++i) { const bool up = (F.lane & 2) != 0; const float send = up ? v[i] : v[2 + i]; const float recv = __shfl_xor(send, 2); v[i] = (up ? v[2 + i] : v[i]) + recv; }
        { const bool up = (F.lane & 1) != 0; const float send = up ? v[0] : v[1]; const float recv = __shfl_xor(send, 1); v[0] = (up ? v[1] : v[0]) + recv; }
        float logit = v[0] + rbias;
        float tv[4]; int te[4];
#pragma unroll
        for (int k = 0; k < 4; ++k) { float bv = logit; int be = F.lane & 31;
#pragma unroll
            for (int o = 1; o < 32; o <<= 1) { const float ov = __shfl_xor(bv, o); const int oe = __shfl_xor(be, o); if (ov > bv || (ov == bv && oe < be)) { bv = ov; be = oe; } }
            tv[k] = bv; te[k] = be; if ((F.lane & 31) == be) logit = -__builtin_inff(); }
        const float e1 = __expf(tv[1] - tv[0]), e2 = __expf(tv[2] - tv[0]), e3 = __expf(tv[3] - tv[0]); const float inv = 1.0f / (1.0f + e1 + e2 + e3);
        const int kk = F.lane & 31;
        if (kk < 4) { const int e = kk == 0 ? te[0] : (kk == 1 ? te[1] : (kk == 2 ? te[2] : te[3]));
            const float w = (kk == 0 ? 1.0f : (kk == 1 ? e1 : (kk == 2 ? e2 : e3))) * inv;
            const unsigned rank = __hip_atomic_fetch_add(&lcnt[e], 1u, __ATOMIC_RELAXED, __HIP_MEMORY_SCOPE_WORKGROUP);
            const int rl = F.wave * 8 + rp * 2 + (F.lane >> 5);
            pend[(rl * 4 + kk) * 2 + 0] = (unsigned)e | (rank << 8); pend[(rl * 4 + kk) * 2 + 1] = __float_as_uint(w); }
    }
    __syncthreads();
    unsigned* gcnt = (unsigned*)(F.ws + WS_CTL) + CW_CNT + 64 * layer;
    if (F.tid < 32) lbase[F.tid] = __hip_atomic_fetch_add(gcnt + F.tid, lcnt[F.tid], __ATOMIC_RELAXED, __HIP_MEMORY_SCOPE_AGENT);
    __syncthreads();
    if (F.tid < 256) { const int rl = F.tid >> 2, k = F.tid & 3; const unsigned p0 = pend[(rl * 4 + k) * 2], p1 = pend[(rl * 4 + k) * 2 + 1];
        const unsigned e = p0 & 255u, rank = p0 >> 8; const unsigned pos = lbase[e] + rank; const unsigned tok = (unsigned)(F.vcu * 64 + rl);
        ((unsigned*)(F.ws + WS_ROWLIST))[(size_t)e * CAP + pos] = tok * 4u + (unsigned)k;
        ((float*)(F.ws + WS_TOPW))[tok * 4u + k] = __uint_as_float(p1); }
}

__device__ __forceinline__ int moe_units(Frame& F, int layer, int npn) {
    LAS int* moe = (LAS int*)(F.lds + LDS_MOE);
    LAS int* units = (LAS int*)(F.lds + LDS_UNITS);
    if (F.wave == 0) {
        const unsigned* gcnt = (const unsigned*)(F.ws + WS_CTL) + CW_CNT + 64 * layer;
        const int e_ = F.lane & 31;
        const int cnt = (int)gcnt[e_]; const int ntl = (cnt + 255) >> 8;
        int incl = ntl;
#pragma unroll
        for (int o = 1; o < 32; o <<= 1) { const int t = __shfl_up(incl, o); if ((F.lane & 31) >= o) incl += t; }
        const int start = incl - ntl; const int ts = __shfl(incl, 31);
        const int c = blockIdx.x, xcd = c & 7, slot = c >> 3, rpx = 32 / npn;
        const int i = F.lane;
        const int rt = (i * 8 + xcd) * rpx + slot / npn, pn = slot % npn;
        int e = 0, st = 0, cn = 0;
        for (int q = 0; q < 32; ++q) { const int s_ = __shfl(start, q), n_ = __shfl(ntl, q), c_ = __shfl(cnt, q); if (rt >= s_ && rt < s_ + n_) { e = q; st = s_; cn = c_; } }
        const bool ok = (F.lane < 32) && (rt < ts);
        const unsigned long long bal = __ballot(ok);
        if (ok) { const int j = rt - st; int valid = cn - j * 256; valid = valid > 256 ? 256 : valid;
            units[i * 4 + 0] = rt; units[i * 4 + 1] = pn; units[i * 4 + 2] = e | (j << 8); units[i * 4 + 3] = valid; }
        if (F.lane == 0) moe[40] = __popcll(bal);
    }
    __syncthreads();
    return __builtin_amdgcn_readfirstlane(moe[40]);
}

__device__ __forceinline__ void phase_conv(Frame& F, int j) {
    const float* PAR = (const float*)(F.ws + WS_PAR);
    const int g = F.vcu * NTHR + F.tid; const int chunk = g & 127, seg = g >> 7; const int c0 = chunk * 8, m0 = seg * 16; const int s0 = m0 & (SEQ - 1);
    const bf16_t* RB = (const bf16_t*)(F.ws + WS_RB); bf16_t* XC = (bf16_t*)(F.ws + WS_XC);
    float w[4][8], bias[8];
#pragma unroll
    for (int k = 0; k < 4; ++k) { const f32x4 w0 = *(const f32x4*)(PAR + PAR_LCW + ((size_t)j * 4 + k) * D + c0), w1 = *(const f32x4*)(PAR + PAR_LCW + ((size_t)j * 4 + k) * D + c0 + 4);
#pragma unroll
        for (int i = 0; i < 4; ++i) { w[k][i] = w0[i]; w[k][4 + i] = w1[i]; } }
    { const f32x4 b0 = *(const f32x4*)(PAR + PAR_LCB + (size_t)j * D + c0), b1 = *(const f32x4*)(PAR + PAR_LCB + (size_t)j * D + c0 + 4);
#pragma unroll
      for (int i = 0; i < 4; ++i) { bias[i] = b0[i]; bias[4 + i] = b1[i]; } }
    float x0[8], x1[8], x2[8];
#pragma unroll
    for (int i = 0; i < 8; ++i) { x0[i] = 0.f; x1[i] = 0.f; x2[i] = 0.f; }
    if (s0 != 0) {
        const u32x4 r0 = *(const u32x4*)(RB + (size_t)(m0 - 3) * D + c0), r1 = *(const u32x4*)(RB + (size_t)(m0 - 2) * D + c0), r2 = *(const u32x4*)(RB + (size_t)(m0 - 1) * D + c0);
#pragma unroll
        for (int i = 0; i < 4; ++i) { x0[2 * i] = bflo(r0[i]); x0[2 * i + 1] = bfhi(r0[i]); x1[2 * i] = bflo(r1[i]); x1[2 * i + 1] = bfhi(r1[i]); x2[2 * i] = bflo(r2[i]); x2[2 * i + 1] = bfhi(r2[i]); }
    }
#pragma unroll 4
    for (int t = 0; t < 16; ++t) {
        const u32x4 rr = *(const u32x4*)(RB + (size_t)(m0 + t) * D + c0);
        float x3[8], y[8];
#pragma unroll
        for (int i = 0; i < 4; ++i) { x3[2 * i] = bflo(rr[i]); x3[2 * i + 1] = bfhi(rr[i]); }
#pragma unroll
        for (int i = 0; i < 8; ++i) { y[i] = bias[i] + w[0][i] * x0[i] + w[1][i] * x1[i] + w[2][i] * x2[i] + w[3][i] * x3[i]; x0[i] = x1[i]; x1[i] = x2[i]; x2[i] = x3[i]; }
        u32x4 o; o.x = cvt_pk_bf16(y[0], y[1]); o.y = cvt_pk_bf16(y[2], y[3]); o.z = cvt_pk_bf16(y[4], y[5]); o.w = cvt_pk_bf16(y[6], y[7]);
        *(u32x4*)(XC + (size_t)(m0 + t) * D + c0) = o;
    }
}
__device__ __forceinline__ void phase_scan1(Frame& F) {
    const int item = F.vcu; const int m0 = item * 64; const int ch = 2 * F.tid;
    const float* AF = (const float*)(F.ws + WS_AF); const float* UF = (const float*)(F.ws + WS_UF);
    f32x2 h = (f32x2){0.f, 0.f}, p = (f32x2){1.f, 1.f};
#pragma unroll 8
    for (int t = 0; t < 64; ++t) { const f32x2 av = *(const f32x2*)(AF + (size_t)(m0 + t) * D + ch), uv = *(const f32x2*)(UF + (size_t)(m0 + t) * D + ch);
        h = av * h + uv; p = p * av; }
    float* PS = (float*)(F.ws + WS_PS);
    *(f32x4*)(PS + ((size_t)item * D + ch) * 2) = (f32x4){p[0], h[0], p[1], h[1]};
}
__device__ __forceinline__ void phase_scan2(Frame& F) {
    const int item = F.vcu; const int m0 = item * 64; const int ch = 2 * F.tid; const int c = item & 63, b = item >> 6;
    const float* AF = (const float*)(F.ws + WS_AF); const float* UF = (const float*)(F.ws + WS_UF);
    const float* PS = (const float*)(F.ws + WS_PS); const bf16_t* GB = (const bf16_t*)(F.ws + WS_GB); bf16_t* YB = (bf16_t*)(F.ws + WS_YB);
    f32x2 h = (f32x2){0.f, 0.f};
#pragma unroll 8
    for (int jj = 0; jj < c; ++jj) { const f32x4 s = *(const f32x4*)(PS + ((size_t)(b * 64 + jj) * D + ch) * 2); h[0] = s[0] * h[0] + s[1]; h[1] = s[2] * h[1] + s[3]; }
#pragma unroll 8
    for (int t = 0; t < 64; ++t) { const f32x2 av = *(const f32x2*)(AF + (size_t)(m0 + t) * D + ch), uv = *(const f32x2*)(UF + (size_t)(m0 + t) * D + ch);
        const unsigned gw_ = *(const unsigned*)(GB + (size_t)(m0 + t) * D + ch);
        h = av * h + uv;
        *(unsigned*)(YB + (size_t)(m0 + t) * D + ch) = cvt_pk_bf16(bflo(gw_) * h[0], bfhi(gw_) * h[1]); }
}

__device__ __forceinline__ void phase_qknorm(Frame& F, int j) {
    const float* PAR = (const float*)(F.ws + WS_PAR);
    bf16_t* Q = (bf16_t*)(F.ws + WS_Q); bf16_t* Kb = (bf16_t*)(F.ws + WS_K); float* KM = (float*)(F.ws + WS_KMEAN);
    LAS float* red = (LAS float*)F.lds;
    const int rr = F.lane >> 4, cq = F.lane & 15;
    f32x4 qg0 = *(const f32x4*)(PAR + PAR_AQG + (size_t)j * HD + cq * 8), qg1 = *(const f32x4*)(PAR + PAR_AQG + (size_t)j * HD + cq * 8 + 4);
    f32x4 kg0 = *(const f32x4*)(PAR + PAR_AKG + (size_t)j * HD + cq * 8), kg1 = *(const f32x4*)(PAR + PAR_AKG + (size_t)j * HD + cq * 8 + 4);
    for (int it = F.vcu; it < BATCH * NBLK * NH; it += F.G) {
        const int h = it & 7, blk = (it >> 3) & 15, b = it >> 7;
        const size_t base = ((size_t)(b * SEQ + blk * MBLK + F.wave * 32)) * D + h * HD + cq * 8;
        float ks[8];
#pragma unroll
        for (int i = 0; i < 8; ++i) ks[i] = 0.f;
#pragma unroll 2
        for (int i = 0; i < 8; ++i) { const size_t off = base + (size_t)(i * 4 + rr) * D;
            const u32x4 qw = *(const u32x4*)(Q + off), kw = *(const u32x4*)(Kb + off);
            float qv[8], kv[8]; float sq = 0.f, sk = 0.f;
#pragma unroll
            for (int e = 0; e < 4; ++e) { qv[2 * e] = bflo(qw[e]); qv[2 * e + 1] = bfhi(qw[e]); kv[2 * e] = bflo(kw[e]); kv[2 * e + 1] = bfhi(kw[e]); }
#pragma unroll
            for (int e = 0; e < 8; ++e) { sq += qv[e] * qv[e]; sk += kv[e] * kv[e]; }
#pragma unroll
            for (int o = 1; o < 16; o <<= 1) { sq += __shfl_xor(sq, o); sk += __shfl_xor(sk, o); }
            const float rq = __builtin_amdgcn_rsqf(sq * (1.0f / HD) + NORM_EPS), rk = __builtin_amdgcn_rsqf(sk * (1.0f / HD) + NORM_EPS);
#pragma unroll
            for (int e = 0; e < 8; ++e) { qv[e] = qv[e] * rq * (e < 4 ? qg0[e & 3] : qg1[e & 3]); kv[e] = kv[e] * rk * (e < 4 ? kg0[e & 3] : kg1[e & 3]); ks[e] += kv[e]; }
            u32x4 qo, ko;
#pragma unroll
            for (int e = 0; e < 4; ++e) { qo[e] = cvt_pk_bf16(qv[2 * e], qv[2 * e + 1]); ko[e] = cvt_pk_bf16(kv[2 * e], kv[2 * e + 1]); }
            *(u32x4*)(Q + off) = qo; *(u32x4*)(Kb + off) = ko; }
#pragma unroll
        for (int e = 0; e < 8; ++e) { ks[e] += __shfl_xor(ks[e], 16); ks[e] += __shfl_xor(ks[e], 32); }
        __syncthreads();
        if (F.lane < 16) {
#pragma unroll
            for (int e = 0; e < 8; ++e) red[F.wave * 128 + cq * 8 + e] = ks[e]; }
        __syncthreads();
        if (F.tid < 128) { float s = 0.f;
#pragma unroll
            for (int w = 0; w < 8; ++w) s += red[w * 128 + F.tid];
            KM[(((size_t)b * NH + h) * NBLK + blk) * HD + F.tid] = s * (1.0f / MBLK); }
    }
}
__device__ __forceinline__ void phase_gate(Frame& F) {
    const bf16_t* Q = (const bf16_t*)(F.ws + WS_Q); const float* KM = (const float*)(F.ws + WS_KMEAN); unsigned* SEL = (unsigned*)(F.ws + WS_SEL);
    LAS float* km = (LAS float*)F.lds;
    const int it = F.vcu; const int s8 = it & 7, h = (it >> 3) & 7, b = it >> 6;
    for (int i = F.tid; i < NBLK * HD / 4; i += NTHR) *(LAS f32x4*)(km + 4 * i) = *(const f32x4*)(KM + ((size_t)b * NH + h) * NBLK * HD + 4 * i);
    __syncthreads();
    const int s = s8 * 512 + F.tid; const int qb = __builtin_amdgcn_readfirstlane(s >> 8);
    u32x4 qw[16];
    const bf16_t* qp = Q + ((size_t)(b * SEQ + s)) * D + h * HD;
#pragma unroll
    for (int i = 0; i < 16; ++i) qw[i] = *(const u32x4*)(qp + 8 * i);
    float v1 = -__builtin_inff(), v2 = v1, v3 = v1; int i1 = -1, i2 = -1, i3 = -1;
    for (int n = 0; n < qb; ++n) { float sc = 0.f;
#pragma unroll
        for (int i = 0; i < 16; ++i) { const f32x4 k0 = *(const LAS f32x4*)(km + n * HD + 8 * i), k1 = *(const LAS f32x4*)(km + n * HD + 8 * i + 4);
            sc += bflo(qw[i][0]) * k0[0] + bfhi(qw[i][0]) * k0[1] + bflo(qw[i][1]) * k0[2] + bfhi(qw[i][1]) * k0[3]
                + bflo(qw[i][2]) * k1[0] + bfhi(qw[i][2]) * k1[1] + bflo(qw[i][3]) * k1[2] + bfhi(qw[i][3]) * k1[3]; }
        if (sc > v1) { v3 = v2; i3 = i2; v2 = v1; i2 = i1; v1 = sc; i1 = n; }
        else if (sc > v2) { v3 = v2; i3 = i2; v2 = sc; i2 = n; }
        else if (sc > v3) { v3 = sc; i3 = n; } }
    unsigned m = 0u; if (i1 >= 0) m |= 1u << i1; if (i2 >= 0) m |= 1u << i2; if (i3 >= 0) m |= 1u << i3;
    SEL[((size_t)b * NH + h) * SEQ + s] = m;
}
__device__ __forceinline__ att::BlockRef att_ref(Frame& F, int L, int pass) {
    const int bh = L >> 3, x = L & 7; const int qb = pass ? 15 - x : x; const int b = bh >> 3, h = bh & 7;
    att::BlockRef r; const size_t ro = ((size_t)(b * SEQ + qb * MBLK)) * D + h * HD;
    r.Q = (const bf16_t*)(F.ws + WS_Q) + ro; r.O = (bf16_t*)(F.ws + WS_YB) + ro;
    r.K = (const bf16_t*)(F.ws + WS_K) + (size_t)(b * SEQ) * D + h * HD; r.V = (const bf16_t*)(F.ws + WS_V) + (size_t)(b * SEQ) * D + h * HD;
    r.M = (const unsigned*)(F.ws + WS_SEL) + (size_t)bh * SEQ + qb * MBLK; r.qb = qb; return r;
}
__device__ __forceinline__ void phase_attn(Frame& F, char* lds) {
    const int total = BATCH * NH * 8, stride = F.G;
    int L = F.vcu; if (L >= total) return;
    int pass = 0;
    att::BlockRef cur = att_ref(F, L, 0);
    att::Seam S;
    att::moba_prime(cur, lds, S, F.tid);
    for (;;) {
        const bool more_pass = pass == 0, more_item = L + stride < total, last = !more_pass && !more_item;
        int passn = pass + 1, Ln = L;
        if (!more_pass) { passn = 0; Ln = more_item ? L + stride : L; }
        const att::BlockRef nxt = last ? cur : att_ref(F, Ln, passn);
        att::moba_block(cur, nxt, lds, S, F.tid);
        if (last) break;
        cur = nxt; pass = passn; L = Ln;
    }
}

constexpr int NPH = 42;
__global__ void __launch_bounds__(NTHR, 2) fwd(Args args) {
    extern __shared__ __attribute__((aligned(16))) unsigned char lds_[];
    Frame F;
    F.lds = (LAS unsigned char*)lds_; F.ws = args.ws;
    F.tid = threadIdx.x; F.lane = F.tid & 63; F.wave = __builtin_amdgcn_readfirstlane(F.tid >> 6);
    F.G = gridDim.x; { const int bx = blockIdx.x; F.vcu = (F.G % 8 == 0) ? (bx % 8) * (F.G / 8) + bx / 8 : bx; }
    volatile LAS unsigned* MISC = (volatile LAS unsigned*)(F.lds + LDS_MISC);
    if (F.tid < 64) MISC[F.tid] = 0u;
    __syncthreads();
    const int lo = args.ph_lo, hi = args.ph_hi;
    unsigned* ctl = (unsigned*)(F.ws + WS_CTL);
    XcdBarrier bar; bar.bar = ctl + CW_BAR + args.li * XCD_BAR_WORDS; bar.x = 0; bar.st = nullptr;
    if (hi - lo > 1) bar = xcd_barrier_post(ctl + CW_BAR + args.li * XCD_BAR_WORDS, MISC + 8);
#ifdef ONLY
#define EN(code) ((code) == ONLY)
#else
#define EN(code) true
#endif
#define IN(k) (lo <= (k) && (k) < hi)
#define SEAM(k) do { if (IN(k) && IN((k) + 1)) xcd_barrier(bar); } while (0)
#define PF() Frame Fp = F; asm volatile("" : "+v"(Fp.tid)); Fp.lane = Fp.tid & 63
    LAS unsigned* tab = (LAS unsigned*)(F.lds + LDS_TAB);
    const float* xin = args.in[IN_X]; float* out = args.out; const float* PAR = (const float*)(F.ws + WS_PAR);

    if (EN(0) && IN(0)) { PF(); phase_prologue(Fp, args); } SEAM(0);

#pragma nounroll
    for (int l = 0; l < DEPTH; ++l) {
        const int pb = 1 + 10 * l; const int j = l >> 1; const bool lru = (l & 1) == 0;
        if (EN(10) && IN(pb + 0)) { PF(); phase_norm(Fp, xin, out, l, false); } SEAM(pb + 0);
        if (lru) {
            if (EN(21) && IN(pb + 1)) { pg8::ProbPlain P; P.init((const bf16_t*)(F.ws + WS_H), (const bf16_t*)(F.ws + WS_WIN) + (size_t)j * 2 * D * D, T, 2 * D, D, D, -1, F.G, (int)blockIdx.x);
                pg8::EpiWin E{(bf16_t*)(F.ws + WS_GB), (bf16_t*)(F.ws + WS_RB)};
                pg8::gemm_phase<pg8::EpiWin, pg8::ProbPlain, true, true>(F.lds, tab, P, E); } SEAM(pb + 1);
            if (EN(22) && IN(pb + 2)) { PF(); phase_conv(Fp, j); } SEAM(pb + 2);
            if (EN(23) && IN(pb + 3)) { pg8::ProbPlain P; P.init((const bf16_t*)(F.ws + WS_XC), (const bf16_t*)(F.ws + WS_WG) + (size_t)j * 2048 * 256, T, 2 * D, 256, D, 1, F.G, (int)blockIdx.x);
                pg8::EpiGates E{(const bf16_t*)(F.ws + WS_XC), (float*)(F.ws + WS_AF), (float*)(F.ws + WS_UF), PAR + PAR_LBA + (size_t)j * D, PAR + PAR_LBX + (size_t)j * D, (const float*)(F.ws + WS_SP8) + (size_t)j * D};
                pg8::gemm_phase<pg8::EpiGates, pg8::ProbPlain, true, true>(F.lds, tab, P, E); } SEAM(pb + 3);
            if (EN(24) && IN(pb + 4)) { PF(); phase_scan1(Fp); } SEAM(pb + 4);
            if (EN(25) && IN(pb + 5)) { PF(); phase_scan2(Fp); } SEAM(pb + 5);
        } else {
            if (EN(31) && IN(pb + 1)) { pg8::ProbPlain P; P.init((const bf16_t*)(F.ws + WS_H), (const bf16_t*)(F.ws + WS_WQKV) + (size_t)j * 3 * D * D, T, 3 * D, D, D, -1, F.G, (int)blockIdx.x);
                pg8::EpiQKV E{(bf16_t*)(F.ws + WS_Q), (bf16_t*)(F.ws + WS_K), (bf16_t*)(F.ws + WS_V)};
                pg8::gemm_phase<pg8::EpiQKV, pg8::ProbPlain, true, true>(F.lds, tab, P, E); } SEAM(pb + 1);
            if (EN(32) && IN(pb + 2)) { PF(); phase_qknorm(Fp, j); } SEAM(pb + 2);
            if (EN(33) && IN(pb + 3)) { PF(); phase_gate(Fp); } SEAM(pb + 3);
            if (EN(34) && IN(pb + 4)) { PF(); phase_attn(Fp, (char*)lds_); } SEAM(pb + 4);
        }
        if (EN(16) && IN(pb + 6)) { pg8::ProbPlain P; P.init((const bf16_t*)(F.ws + WS_YB), (const bf16_t*)(F.ws + (lru ? WS_WLO : WS_WAO)) + (size_t)j * D * D, T, D, D, D, -1, F.G, (int)blockIdx.x);
            pg8::EpiResid E{l == 0 ? xin : (const float*)(F.ws + WS_XA), (float*)(F.ws + WS_XB), (const float*)(F.ws + WS_MOD) + (size_t)l * BATCH * 6 * D + 2 * D};
            pg8::gemm_phase<pg8::EpiResid, pg8::ProbPlain, false, true>(F.lds, tab, P, E); } SEAM(pb + 6);
        if (EN(17) && IN(pb + 7)) { PF(); phase_router(Fp, l); } SEAM(pb + 7);
        if (EN(18) && IN(pb + 8)) { PF(); const int nu = moe_units(Fp, l, 8);
            pg8::ProbMoE<true> P; P.A = (const bf16_t*)(F.ws + WS_H); P.Bt = (const bf16_t*)(F.ws + WS_WGU) + (size_t)l * NE * 2 * D * D; P.K = D; P.lda = D; P.bstride = (size_t)2 * D * D;
            P.rowlist = (const unsigned*)(F.ws + WS_ROWLIST); P.units = (const LAS int*)(F.lds + LDS_UNITS); P.nunits = nu;
            pg8::EpiSwiglu E{(bf16_t*)(F.ws + WS_ACT), PAR + PAR_BGU + (size_t)l * NE * 2 * D};
            pg8::gemm_phase<pg8::EpiSwiglu, pg8::ProbMoE<true>, true, true>(F.lds, tab, P, E); } SEAM(pb + 8);
        if (EN(19) && IN(pb + 9)) { PF(); const int nu = moe_units(Fp, l, 4);
            pg8::ProbMoE<false> P; P.A = (const bf16_t*)(F.ws + WS_ACT); P.Bt = (const bf16_t*)(F.ws + WS_WDN) + (size_t)l * NE * D * D; P.K = D; P.lda = D; P.bstride = (size_t)D * D;
            P.rowlist = (const unsigned*)(F.ws + WS_ROWLIST); P.units = (const LAS int*)(F.lds + LDS_UNITS); P.nunits = nu;
            pg8::EpiDown E{(bf16_t*)(F.ws + WS_YK), PAR + PAR_BDN + (size_t)l * NE * D, (const unsigned*)(F.ws + WS_ROWLIST), (const float*)(F.ws + WS_TOPW)};
            pg8::gemm_phase<pg8::EpiDown, pg8::ProbMoE<false>, true, true>(F.lds, tab, P, E); } SEAM(pb + 9);
    }
    if (EN(41) && IN(41)) { PF(); phase_norm(Fp, xin, out, DEPTH, true); }
#undef IN
#undef SEAM
#undef EN
}

#ifndef DEBUG_CHECKS
#define DEBUG_CHECKS 0
#endif
#ifndef CHK_FROM
#define CHK_FROM 0
#endif
#if DEBUG_CHECKS
constexpr int CW_CHK = 70000;
__device__ __forceinline__ unsigned hsh(unsigned x) { x ^= x >> 16; x *= 0x7feb352du; x ^= x >> 15; x *= 0x846ca68bu; x ^= x >> 16; return x; }
__device__ __forceinline__ bool cls(float got, float ref, float rt, float at) { return (fabsf(got - ref) <= rt * fabsf(ref) + at); }
__device__ __forceinline__ float bfq(const bf16_t* p, size_t i) { return __uint_as_float(((unsigned)p[i]) << 16); }
__device__ __forceinline__ float gelu_ref(float x) { return 0.5f * x * (1.0f + tanhf(0.7978845608028654f * (x + 0.044715f * x * x * x))); }
__global__ void __launch_bounds__(64) chk(Args a, int id, int l, int code) {
    const int j = l >> 1;
    unsigned char* ws = a.ws; unsigned* ctl = (unsigned*)(ws + WS_CTL); const int lane = threadIdx.x;
    const float* MOD = (const float*)(ws + WS_MOD); const float* PAR = (const float*)(ws + WS_PAR);
    const bf16_t* H = (const bf16_t*)(ws + WS_H);
    bool bad = false;
    for (int it = 0; it < 8; ++it) {
        const unsigned sd = hsh(blockIdx.x * 131u + it * 7919u + id * 104729u + 12345u);
        if (id == 1) {
            const int l = sd & 3, b = (sd >> 2) & 3, n = (sd >> 4) % (6 * D); float s = 0.f;
            for (int k = lane; k < D; k += 64) { const float c = a.in[IN_C][b * D + k]; s += (c / (1.0f + expf(-c))) * a.in[IN_WMOD][((size_t)l * D + k) * 6 * D + n]; }
            s = wave_sum(s) + a.in[IN_BMOD][l * 6 * D + n];
            if (!cls(MOD[((size_t)l * BATCH + b) * 6 * D + n], s, 1e-3f, 1e-3f)) bad = true;
        } else if (id == 2) {
            const int m = sd % T, b = m / SEQ; float ss = 0.f;
            for (int k = lane; k < D; k += 64) { const float x = a.in[IN_X][(size_t)m * D + k]; ss += x * x; }
            const float rstd = 1.0f / sqrtf(wave_sum(ss) / D + NORM_EPS);
            for (int k = lane; k < D; k += 64) { const float x = a.in[IN_X][(size_t)m * D + k];
                const float h = x * rstd * a.in[IN_NMG][k] * (1.0f + MOD[(size_t)b * 6 * D + D + k]) + MOD[(size_t)b * 6 * D + k];
                if (!cls(bfq(H, (size_t)m * D + k), h, 0.01f, 0.01f)) bad = true; }
        } else if (id == 3) {
            const int m = sd % T, n = (sd >> 14) % (2 * D); float s = 0.f;
            for (int k = lane; k < D; k += 64) s += bfq(H, (size_t)m * D + k) * a.in[IN_LWIN][((size_t)j * D + k) * 2 * D + n];
            s = wave_sum(s);
            const float got = n < D ? bfq((const bf16_t*)(ws + WS_GB), (size_t)m * D + n) : bfq((const bf16_t*)(ws + WS_RB), (size_t)m * D + n - D);
            const float ref = n < D ? gelu_ref(s) : s;
            if (!cls(got, ref, 0.02f, 0.02f)) bad = true;
        } else if (id == 4) {
            const int m = sd % T, c = (sd >> 14) % D, s0 = m % SEQ; const bf16_t* RB = (const bf16_t*)(ws + WS_RB);
            float y = a.in[IN_LCB][j * D + c];
            for (int k = 0; k < 4; ++k) { const int t = s0 - 3 + k; if (t >= 0) y += a.in[IN_LCW][(j * 4 + k) * D + c] * bfq(RB, (size_t)(m - 3 + k) * D + c); }
            if (!cls(bfq((const bf16_t*)(ws + WS_XC), (size_t)m * D + c), y, 0.01f, 0.01f)) bad = true;
        } else if (id == 5) {
            const int m = sd % T, ch = (sd >> 14) % D, g = ch >> 8, jc = ch & 255; const bf16_t* XC = (const bf16_t*)(ws + WS_XC);
            float sa = 0.f, sx = 0.f;
            for (int i = lane; i < 256; i += 64) { const float xv = bfq(XC, (size_t)m * D + g * 256 + i); sa += xv * a.in[IN_LWA][((size_t)(j * 4 + g) * 256 + i) * 256 + jc]; sx += xv * a.in[IN_LWX][((size_t)(j * 4 + g) * 256 + i) * 256 + jc]; }
            sa = wave_sum(sa) + a.in[IN_LBA][j * D + ch]; sx = wave_sum(sx) + a.in[IN_LBX][j * D + ch];
            const float r = 1.0f / (1.0f + expf(-sa)), ig = 1.0f / (1.0f + expf(-sx)); const float lam = a.in[IN_LLAM][j * D + ch];
            const float la = -8.0f * r * log1pf(expf(-lam)); const float av = expf(la), uv = sqrtf(-expm1f(2.0f * la)) * ig * bfq(XC, (size_t)m * D + ch);
            if (!cls(((const float*)(ws + WS_AF))[(size_t)m * D + ch], av, 2e-3f, 1e-4f)) bad = true;
            if (!cls(((const float*)(ws + WS_UF))[(size_t)m * D + ch], uv, 0.03f, 0.003f)) bad = true;
        } else if (id == 6) {
            const int b = sd & 3, ch = ((sd >> 2) + lane * 17) % D; const float* AF = (const float*)(ws + WS_AF); const float* UF = (const float*)(ws + WS_UF);
            const bf16_t* GB = (const bf16_t*)(ws + WS_GB); const bf16_t* YB = (const bf16_t*)(ws + WS_YB);
            float h = 0.f;
            for (int t = 0; t < SEQ; ++t) { const size_t o = ((size_t)b * SEQ + t) * D + ch; h = AF[o] * h + UF[o];
                if ((t & 127) == 77 || t == SEQ - 1 || t == 0 || t == 64) { if (!cls(bfq(YB, o), bfq(GB, o) * h, 0.02f, 0.01f)) bad = true; } }
        } else if (id == 7) {
            const int m = sd % T, n = (sd >> 14) % D, b = m / SEQ; float s = 0.f; const bf16_t* YB = (const bf16_t*)(ws + WS_YB);
            for (int k = lane; k < D; k += 64) s += bfq(YB, (size_t)m * D + k) * a.in[IN_LWOUT][((size_t)j * D + k) * D + n];
            s = wave_sum(s);
            const float ref = (l == 0 ? a.in[IN_X][(size_t)m * D + n] : ((const float*)(ws + WS_XA))[(size_t)m * D + n]) + MOD[((size_t)l * BATCH + b) * 6 * D + 2 * D + n] * s;
            if (!cls(((const float*)(ws + WS_XB))[(size_t)m * D + n], ref, 0.01f, 0.01f)) bad = true;
        } else if (id == 8) {
            __shared__ float hrow[D];
            const int m = sd % MOE_TOK, b = m / SEQ; const float* XB = (const float*)(ws + WS_XB); float ss = 0.f;
            for (int k = lane; k < D; k += 64) { const float x = XB[(size_t)m * D + k]; ss += x * x; }
            const float rstd = 1.0f / sqrtf(wave_sum(ss) / D + NORM_EPS);
            __syncthreads();
            for (int k = lane; k < D; k += 64) { const float x = XB[(size_t)m * D + k];
                const float h = x * rstd * a.in[IN_NFG][l * D + k] * (1.0f + MOD[((size_t)l * BATCH + b) * 6 * D + 4 * D + k]) + MOD[((size_t)l * BATCH + b) * 6 * D + 3 * D + k]; hrow[k] = h;
                if (!cls(bfq(H, (size_t)m * D + k), h, 0.01f, 0.01f)) bad = true; }
            __syncthreads();
            const int e = lane & 31; float lg = a.in[IN_RB][l * NE + e];
            for (int k = 0; k < D; ++k) lg += hrow[k] * a.in[IN_RW][((size_t)l * D + k) * NE + e];
            int rank = 0; float mx = -1e30f;
            for (int q = 0; q < 32; ++q) { const float o = __shfl(lg, q); if (o > lg || (o == lg && q < e)) ++rank; mx = fmaxf(mx, o); }
            const bool sel = rank < 4; float den = 0.f;
            for (int q = 0; q < 32; ++q) { const float o = __shfl(lg, q); const int rk = __shfl(rank, q); if (rk < 4) den += expf(o - mx); }
            const float wref = expf(lg - mx) / den;
            float v4 = 0.f, v5 = 0.f; for (int q = 0; q < 32; ++q) { const float o = __shfl(lg, q); const int rk = __shfl(rank, q); if (rk == 3) v4 = o; if (rk == 4) v5 = o; }
            const unsigned* gcnt = ctl + CW_CNT + 64 * l; const unsigned* RL = (const unsigned*)(ws + WS_ROWLIST); const float* TW = (const float*)(ws + WS_TOPW);
            if (v4 - v5 > 1e-3f && lane < 32) {
                const int cnt = (int)gcnt[e]; int found = -1;
                for (int p = 0; p < cnt; ++p) { const unsigned r = RL[(size_t)e * CAP + p]; if ((int)(r >> 2) == m) found = (int)r; }
                if (sel) { if (found < 0) bad = true; else if (!cls(TW[found], wref, 0.01f, 1e-3f)) bad = true; }
                else if (found >= 0) bad = true;
            }
            unsigned tot = 0; for (int q = 0; q < 32; ++q) tot += gcnt[q]; if (tot != (unsigned)T) bad = true;
        } else if (id == 9 || id == 10) {
            const unsigned* gcnt = ctl + CW_CNT + 64 * l; const unsigned* RL = (const unsigned*)(ws + WS_ROWLIST); const float* TW = (const float*)(ws + WS_TOPW);
            const int e = sd & 31; int ts = 0; for (int q = 0; q < e; ++q) ts += ((int)gcnt[q] + 255) >> 8;
            const int cnt = (int)gcnt[e]; if (cnt == 0) continue;
            const int pos = (sd >> 5) % cnt; const unsigned dest = RL[(size_t)e * CAP + pos]; const int tok = dest >> 2; const size_t arow = (size_t)ts * 256 + pos;
            const int col = (sd >> 17) % D; const bf16_t* ACT = (const bf16_t*)(ws + WS_ACT);
            if (id == 9) { float sg = 0.f, su = 0.f;
                for (int k = lane; k < D; k += 64) { const float hv = bfq(H, (size_t)tok * D + k); sg += hv * a.in[IN_WGU][((size_t)(l * NE + e) * D + k) * 2 * D + col]; su += hv * a.in[IN_WGU][((size_t)(l * NE + e) * D + k) * 2 * D + D + col]; }
                sg = wave_sum(sg) + a.in[IN_BGU][(size_t)(l * NE + e) * 2 * D + col]; su = wave_sum(su) + a.in[IN_BGU][(size_t)(l * NE + e) * 2 * D + D + col];
                const float gv = fminf(sg, 7.f), uv = fminf(fmaxf(su, -7.f), 7.f); const float ref = gv / (1.0f + expf(-1.702f * gv)) * (uv + 1.0f);
                if (!cls(bfq(ACT, arow * D + col), ref, 0.03f, 0.02f)) bad = true;
            } else { float s = 0.f;
                for (int k = lane; k < D; k += 64) s += bfq(ACT, arow * D + k) * a.in[IN_WDN][((size_t)(l * NE + e) * D + k) * D + col];
                s = (wave_sum(s) + a.in[IN_BDN][(size_t)(l * NE + e) * D + col]) * TW[dest];
                if (!cls(bfq((const bf16_t*)(ws + WS_YK), (size_t)dest * D + col), s, 0.03f, 0.01f)) bad = true; }
        } else if (id == 11) {
            const int m = sd % T, h = (sd >> 14) & 7, which = (sd >> 17) % 3; float r0 = 0.f, r1 = 0.f;
            for (int k = 0; k < D; ++k) { const float hv = bfq(H, (size_t)m * D + k); const float* w = a.in[IN_AQKV] + ((size_t)j * D + k) * 3 * D + which * D + h * HD; r0 += hv * w[lane]; r1 += hv * w[lane + 64]; }
            const bf16_t* buf = (const bf16_t*)(ws + (which == 0 ? WS_Q : (which == 1 ? WS_K : WS_V)));
            const float g0 = bfq(buf, (size_t)m * D + h * HD + lane), g1 = bfq(buf, (size_t)m * D + h * HD + lane + 64);
            if (which == 2) { if (!cls(g0, r0, 0.02f, 0.02f) || !cls(g1, r1, 0.02f, 0.02f)) bad = true; }
            else { const float rs = 1.0f / sqrtf(wave_sum(r0 * r0 + r1 * r1) / HD + NORM_EPS); const float* gg = a.in[which == 0 ? IN_AQG : IN_AKG] + j * HD;
                if (!cls(g0, r0 * rs * gg[lane], 0.03f, 0.03f) || !cls(g1, r1 * rs * gg[lane + 64], 0.03f, 0.03f)) bad = true; }
        } else if (id == 12) {
            const int b = sd & 3, h = (sd >> 2) & 7, blk = (sd >> 5) & 15; const bf16_t* Kb = (const bf16_t*)(ws + WS_K); const float* KM = (const float*)(ws + WS_KMEAN);
            float s0 = 0.f, s1 = 0.f;
            for (int r = 0; r < MBLK; ++r) { const size_t o = ((size_t)b * SEQ + blk * MBLK + r) * D + h * HD; s0 += bfq(Kb, o + lane); s1 += bfq(Kb, o + lane + 64); }
            const float* km = KM + (((size_t)b * NH + h) * NBLK + blk) * HD;
            if (!cls(km[lane], s0 / MBLK, 0.03f, 0.003f) || !cls(km[lane + 64], s1 / MBLK, 0.03f, 0.003f)) bad = true;
            const int s = (sd >> 9) % SEQ, qb = s >> 8; const bf16_t* Q = (const bf16_t*)(ws + WS_Q); const unsigned msk = ((const unsigned*)(ws + WS_SEL))[((size_t)b * NH + h) * SEQ + s];
            float sc[16]; const size_t qo = ((size_t)b * SEQ + s) * D + h * HD;
#pragma unroll
            for (int n = 0; n < 16; ++n) { const float* kk = KM + (((size_t)b * NH + h) * NBLK + n) * HD; sc[n] = wave_sum(bfq(Q, qo + lane) * kk[lane] + bfq(Q, qo + lane + 64) * kk[lane + 64]); }
            int cntb = 0; float minsel = 1e30f;
#pragma unroll
            for (int n = 0; n < 16; ++n) if ((msk >> n) & 1u) { ++cntb; if (n >= qb) bad = true; minsel = fminf(minsel, sc[n]); }
            if (cntb != (qb < 3 ? qb : 3) || (msk >> 16)) bad = true;
            int better = 0;
#pragma unroll
            for (int n = 0; n < 16; ++n) if (n < qb && !((msk >> n) & 1u) && sc[n] > minsel + 1e-3f) ++better;
            if (better) bad = true;
        } else if (id == 13) {
            const int b = sd & 3, h = (sd >> 2) & 7, s = (sd >> 5) % SEQ, qb = s >> 8;
            const bf16_t* Q = (const bf16_t*)(ws + WS_Q); const bf16_t* Kb = (const bf16_t*)(ws + WS_K); const bf16_t* V = (const bf16_t*)(ws + WS_V); const bf16_t* O = (const bf16_t*)(ws + WS_YB);
            const unsigned msk = ((const unsigned*)(ws + WS_SEL))[((size_t)b * NH + h) * SEQ + s] | (1u << qb);
            const size_t qo = ((size_t)b * SEQ + s) * D + h * HD;
            float mx = -1e30f;
            for (int pass = 0; pass < 2; ++pass) {
                float den = 0.f, o0 = 0.f, o1 = 0.f;
                for (int blk = 0; blk <= qb; ++blk) if ((msk >> blk) & 1u) {
                    const int kend = blk == qb ? (s & 255) + 1 : 256;
                    for (int kk = 0; kk < kend; ++kk) { const size_t ko = ((size_t)b * SEQ + blk * MBLK + kk) * D + h * HD;
                        const float sc = wave_sum(bfq(Q, qo + lane) * bfq(Kb, ko + lane) + bfq(Q, qo + lane + 64) * bfq(Kb, ko + lane + 64)) * 0.08838834764831845f;
                        if (pass == 0) mx = fmaxf(mx, sc); else { const float p = expf(sc - mx); den += p; o0 += p * bfq(V, ko + lane); o1 += p * bfq(V, ko + lane + 64); } } }
                if (pass == 1) { if (!cls(bfq(O, qo + lane), o0 / den, 0.03f, 0.01f) || !cls(bfq(O, qo + lane + 64), o1 / den, 0.03f, 0.01f)) bad = true; }
            }
        } else if (id == 14) {
            const int m = sd % T, n = (sd >> 14) % D, b = m / SEQ; float s = 0.f; const bf16_t* YB = (const bf16_t*)(ws + WS_YB);
            for (int k = lane; k < D; k += 64) s += bfq(YB, (size_t)m * D + k) * a.in[IN_AWOUT][((size_t)j * D + k) * D + n];
            s = wave_sum(s);
            const float ref = ((const float*)(ws + WS_XA))[(size_t)m * D + n] + MOD[((size_t)l * BATCH + b) * 6 * D + 2 * D + n] * s;
            if (!cls(((const float*)(ws + WS_XB))[(size_t)m * D + n], ref, 0.01f, 0.01f)) bad = true;
        } else if (id == 15) {
            const int m = sd % T, b = m / SEQ; float ss = 0.f; const float* XA = (const float*)(ws + WS_XA); const bf16_t* YK = (const bf16_t*)(ws + WS_YK);
            for (int k = lane; k < D; k += 64) { const float x = XA[(size_t)m * D + k]; ss += x * x;
                const float sy = bfq(YK, (size_t)m * D + k);
                if (!cls(x, ((const float*)(ws + WS_XB))[(size_t)m * D + k] + MOD[((size_t)(l - 1) * BATCH + b) * 6 * D + 5 * D + k] * sy, 1e-3f, 1e-3f)) bad = true; }
            const float rstd = 1.0f / sqrtf(wave_sum(ss) / D + NORM_EPS);
            for (int k = lane; k < D; k += 64) { const float x = XA[(size_t)m * D + k];
                const float hh = x * rstd * a.in[IN_NMG][l * D + k] * (1.0f + MOD[((size_t)l * BATCH + b) * 6 * D + D + k]) + MOD[((size_t)l * BATCH + b) * 6 * D + k];
                if (!cls(bfq(H, (size_t)m * D + k), hh, 0.01f, 0.01f)) bad = true; }
        }
    }
    if (id == 16) {
        for (int it = 0; it < 8; ++it) { const unsigned sd = hsh(blockIdx.x * 131u + it * 7919u + 777u); const int m = sd % T, b = m / SEQ; const bf16_t* YK = (const bf16_t*)(ws + WS_YK);
            for (int k = lane; k < D; k += 64) { const float sy = bfq(YK, (size_t)m * D + k);
                if (!cls(a.out[(size_t)m * D + k], ((const float*)(ws + WS_XB))[(size_t)m * D + k] + MOD[((size_t)3 * BATCH + b) * 6 * D + 5 * D + k] * sy, 1e-3f, 1e-3f)) bad = true; } } }
    if (id == 99) bad = true;
    if (__any(bad) && lane == 0) atomicMax(ctl + CW_CHK, (unsigned)(100 - code));
    (void)PAR;
}
__global__ void chk_encode(Args a) {
    const unsigned v = ((const unsigned*)(a.ws + WS_CTL))[CW_CHK]; if (v == 0u) return;
    const float f = 1.0f + (float)(100 - (int)v);
    for (size_t i = (size_t)blockIdx.x * blockDim.x + threadIdx.x; i < (size_t)T * D; i += (size_t)gridDim.x * blockDim.x) a.out[i] = a.in[IN_X][i] * f;
}
#endif

#ifndef N_LAUNCH_MODE
#define N_LAUNCH_MODE 0
#endif
extern "C" void kernel_launch(void* const* d_in, const int* in_sizes, int n_in, void* d_out, int out_size, void* d_ws, size_t ws_size, hipStream_t stream) {
    static int grid = 0;
    if (grid == 0) {
        if (n_in != 25 || out_size != T * D || ws_size < WS_END) { fprintf(stderr, "kernel_launch: unexpected shapes (n_in %d out %d ws %zu)\n", n_in, out_size, ws_size); grid = -1; return; }
        int dev = 0, cus = 0;
        if (hipGetDevice(&dev) != hipSuccess || hipDeviceGetAttribute(&cus, hipDeviceAttributeMultiprocessorCount, dev) != hipSuccess) { grid = -1; return; }
        if (hipFuncSetAttribute((const void*)fwd, hipFuncAttributeMaxDynamicSharedMemorySize, LDS_BYTES) != hipSuccess) { fprintf(stderr, "kernel_launch: hipFuncSetAttribute failed\n"); grid = -1; return; }
        int per_cu = 0;
        if (hipOccupancyMaxActiveBlocksPerMultiprocessor(&per_cu, (const void*)fwd, NTHR, LDS_BYTES) != hipSuccess || per_cu < 1) fprintf(stderr, "kernel_launch: occupancy query says %d\n", per_cu);
        (void)hipGetLastError();
        if (cus < 256) { fprintf(stderr, "kernel_launch: %d CUs < 256\n", cus); grid = -1; return; }
        grid = 256;
    }
    if (grid < 0) return;
    (void)hipMemsetAsync((char*)d_ws + WS_CTL, 0, CTL_ZERO_BYTES, stream);
    Args a{};
    for (int i = 0; i < 25; ++i) a.in[i] = (const float*)d_in[i];
    a.out = (float*)d_out; a.ws = (unsigned char*)d_ws; a.pad = 0;
#if N_LAUNCH_MODE == 1
    a.ph_lo = 0; a.ph_hi = NPH; a.li = 0;
    hipLaunchKernelGGL(fwd, dim3(grid), dim3(NTHR), LDS_BYTES, stream, a);
#else
    int ordinal = 0; (void)ordinal;
    for (int p = 0; p < NPH; ++p) {
        const int l = (p - 1) / 10, o = (p - 1) % 10;
        if (p >= 1 && p <= 40 && (l & 1) == 1 && o == 5) continue;
        a.ph_lo = p; a.ph_hi = p + 1; a.li = 0;
        hipLaunchKernelGGL(fwd, dim3(grid), dim3(NTHR), LDS_BYTES, stream, a);
#if DEBUG_CHECKS
        {
            const int lch = (p - 1) / 10, och = (p - 1) % 10; int cid = 0;
            if (p == 0) cid = 1;
            else if (p == 41) cid = 16;
            else if ((lch & 1) == 0) { const int t[10] = {lch == 0 ? 2 : 15, 3, 4, 5, 0, 6, 7, 8, 9, 10}; cid = t[och]; }
            else { const int t[10] = {15, 0, 11, 12, 13, 0, 14, 8, 9, 10}; cid = t[och]; }
            if (cid && p >= CHK_FROM) { ++ordinal; hipLaunchKernelGGL(chk, dim3(64), dim3(64), 0, stream, a, cid, lch < 0 ? 0 : (p == 41 ? 3 : lch), ordinal); }
            if (p == 41) { ++ordinal; hipLaunchKernelGGL(chk, dim3(64), dim3(64), 0, stream, a, 99, 0, ordinal); }
        }
#endif
    }
#if DEBUG_CHECKS
    hipLaunchKernelGGL(chk_encode, dim3(1024), dim3(256), 0, stream, a);
#endif
#endif
}
```

```cpp
#include <hip/hip_runtime.h>
#include <stdint.h>
#include <stdio.h>

#define LAS __attribute__((address_space(3)))
#define GAS __attribute__((address_space(1)))
typedef unsigned short bf16_t;
typedef short bf16x8 __attribute__((ext_vector_type(8)));
typedef float f32x4 __attribute__((ext_vector_type(4)));
typedef float f32x2 __attribute__((ext_vector_type(2)));
typedef unsigned u32x4 __attribute__((ext_vector_type(4)));
typedef unsigned u32x2 __attribute__((ext_vector_type(2)));

constexpr int BATCH = 4, SEQ = 4096, D = 1024, T = BATCH * SEQ, DEPTH = 4;
constexpr int NE = 32, TOPK = 4, NH = 8, HD = 128, NBLK = 16, MBLK = 256;
constexpr float NORM_EPS = 1e-6f;
constexpr int NWAVES = 8, NTHR = 512;
constexpr int CAP = T;
constexpr int MAXTILES = T * TOPK / 256 + NE;

constexpr size_t MiB = 1u << 20;
constexpr size_t WS_CTL = 0, CTL_ZERO_BYTES = 1 * MiB;
constexpr size_t WS_MOD = 1 * MiB;
constexpr size_t WS_SP8 = 2 * MiB;
constexpr size_t WS_KMEAN = 3 * MiB;
constexpr size_t WS_SEL = 4 * MiB;
constexpr size_t WS_ROWLIST = 5 * MiB;
constexpr size_t WS_TOPW = 7 * MiB;
constexpr size_t WS_PS = 8 * MiB;
constexpr size_t WS_PAR = 10 * MiB;
constexpr int PAR_NMG = 0, PAR_NFG = PAR_NMG + 4 * 1024, PAR_LCW = PAR_NFG + 4 * 1024, PAR_LCB = PAR_LCW + 2 * 4 * 1024, PAR_LBA = PAR_LCB + 2 * 1024, PAR_LBX = PAR_LBA + 2 * 1024,
              PAR_AQG = PAR_LBX + 2 * 1024, PAR_AKG = PAR_AQG + 256, PAR_RW = PAR_AKG + 256, PAR_RB = PAR_RW + 4 * 1024 * 32, PAR_BGU = PAR_RB + 128, PAR_BDN = PAR_BGU + 4 * 32 * 2048, PAR_END = PAR_BDN + 4 * 32 * 1024;
static_assert((size_t)PAR_END * 4 <= 6 * MiB, "param region");
constexpr size_t WS_WIN = 16 * MiB;
constexpr size_t WS_WG = 24 * MiB;
constexpr size_t WS_WLO = 26 * MiB;
constexpr size_t WS_WQKV = 30 * MiB;
constexpr size_t WS_WAO = 42 * MiB;
constexpr size_t WS_WGU = 64 * MiB;
constexpr size_t WS_WDN = 576 * MiB;
constexpr size_t WS_XA = 832 * MiB;
constexpr size_t WS_XB = 896 * MiB;
constexpr size_t WS_H = 960 * MiB;
constexpr size_t WS_GB = 992 * MiB;
constexpr size_t WS_RB = 1024 * MiB;
constexpr size_t WS_XC = 1056 * MiB;
constexpr size_t WS_AF = 1088 * MiB;
constexpr size_t WS_UF = 1152 * MiB;
constexpr size_t WS_YB = 1216 * MiB;
constexpr size_t WS_Q = 1248 * MiB, WS_K = 1280 * MiB, WS_V = 1312 * MiB;
constexpr size_t WS_ACT = 1344 * MiB;
constexpr size_t WS_YK = 1488 * MiB;
constexpr size_t WS_END = 1616 * MiB;

constexpr int CW_BAR = 4096;
constexpr int CW_CNT = 65536;

constexpr int RING_BYTES = 131072;
constexpr int LDS_TAB = RING_BYTES;
constexpr int LDS_UNITS = LDS_TAB + 1024;
constexpr int LDS_MOE = LDS_UNITS + 512;
constexpr int LDS_MISC = LDS_MOE + 512;
constexpr int LDS_X = LDS_MISC + 256;
constexpr int LDS_BYTES = 147456;

__device__ __forceinline__ float bf2f(unsigned h) { return __uint_as_float(h << 16); }
__device__ __forceinline__ float bflo(unsigned u) { return __uint_as_float(u << 16); }
__device__ __forceinline__ float bfhi(unsigned u) { return __uint_as_float(u & 0xffff0000u); }
__device__ __forceinline__ unsigned cvt_pk_bf16(float lo, float hi) { unsigned r; asm("v_cvt_pk_bf16_f32 %0, %1, %2" : "=v"(r) : "v"(lo), "v"(hi)); return r; }
__device__ __forceinline__ float wave_sum(float v) {
#pragma unroll
    for (int o = 1; o < 64; o <<= 1) v += __shfl_xor(v, o);
    return v;
}
__device__ __forceinline__ float fast_exp(float x) { return __builtin_amdgcn_exp2f(x * 1.4426950408889634f); }
__device__ __forceinline__ float sigmoidf_(float x) { return __builtin_amdgcn_rcpf(1.0f + fast_exp(-x)); }
#define LDS_WAIT() asm volatile("s_waitcnt lgkmcnt(0)" ::: "memory")
#define VM_WAIT() asm volatile("s_waitcnt vmcnt(0)" ::: "memory")

#define XB_TMO      128
#define XB_XCNT(j)  (256  + 64 * (j))
#define XB_XSUB(j)  (1280 + 64 * (j))
#define XB_XGEN(j)  (2304 + 64 * (j))
#define XB_TOP      3328
#define XB_TOPGEN   3392
#define XCD_BAR_WORDS 3456
#define XB_SPIN_CAP (1u << 18)
__device__ __forceinline__ unsigned xb_ld(unsigned* p)              { return __hip_atomic_load(p, __ATOMIC_RELAXED, __HIP_MEMORY_SCOPE_AGENT); }
__device__ __forceinline__ unsigned xb_add(unsigned* p, unsigned v) { return __hip_atomic_fetch_add(p, v, __ATOMIC_RELAXED, __HIP_MEMORY_SCOPE_AGENT); }
__device__ __forceinline__ unsigned xb_xcc_id() { return (unsigned)__builtin_amdgcn_s_getreg((3 << 11) | 20) & 0xFu; }
#define XB_SPIN(cond, bar) do { unsigned _sp = 0; while (cond) { __builtin_amdgcn_s_sleep(1); \
    if ((++_sp & 255u) == 0u) { if (xb_ld(&(bar)[XB_TMO])) break; if (_sp > XB_SPIN_CAP) { atomicAdd(&(bar)[XB_TMO], 1u); break; } } } } while (0)
struct XcdBarrier { unsigned* bar; unsigned x; volatile LAS unsigned* st; };
__device__ __forceinline__ XcdBarrier xcd_barrier_post(unsigned* bar, volatile LAS unsigned* st) {
    XcdBarrier b; b.bar = bar; b.x = xb_xcc_id(); b.st = st;
    if (threadIdx.x == 0) (void)xb_add(&bar[XB_XCNT(b.x)], 1u);
    return b;
}
__device__ __forceinline__ void xcd_barrier_complete(unsigned* bar, unsigned x, unsigned& nloc, unsigned& nx) {
    const unsigned G = gridDim.x * gridDim.y * gridDim.z;
    unsigned sum, cnt, mine, sp = 0u;
    for (;;) {
        sum = 0u; cnt = 0u; mine = 0u;
#pragma unroll
        for (unsigned j = 0; j < 16; ++j) { const unsigned c = xb_ld(&bar[XB_XCNT(j)]); sum += c; cnt += (c > 0u) ? 1u : 0u; mine = (j == x) ? c : mine; }
        if (sum == G) break;
        __builtin_amdgcn_s_sleep(1);
        if ((++sp & 255u) == 0u) { if (xb_ld(&bar[XB_TMO])) break; if (sp > XB_SPIN_CAP) { atomicAdd(&bar[XB_TMO], 1u); break; } }
    }
    nloc = mine > 0u ? mine : 1u; nx = cnt > 0u ? cnt : 1u;
}
__device__ __forceinline__ void xcd_barrier(const XcdBarrier& b) {
    asm volatile("s_waitcnt vmcnt(0)" ::: "memory");
    __syncthreads();
    if (threadIdx.x == 0) {
        unsigned* bar = b.bar;
        __builtin_amdgcn_s_waitcnt(0);
        unsigned nloc = b.st[0], nx = b.st[1];
        if (nloc == 0u) { xcd_barrier_complete(bar, b.x, nloc, nx); b.st[0] = nloc; b.st[1] = nx; }
        const unsigned old = xb_add(&bar[XB_XSUB(b.x)], 1u);
        const unsigned gen = old / nloc;
        if (old + 1u == (gen + 1u) * nloc) {
            __builtin_amdgcn_fence(__ATOMIC_RELEASE, "agent");
            asm volatile("s_waitcnt vmcnt(0)" ::: "memory");
            const unsigned og = xb_add(&bar[XB_TOP], 1u);
            const unsigned tg = og / nx;
            if (og + 1u == (tg + 1u) * nx) xb_add(&bar[XB_TOPGEN], 1u);
            else XB_SPIN(xb_ld(&bar[XB_TOPGEN]) == tg, bar);
            __builtin_amdgcn_fence(__ATOMIC_ACQUIRE, "agent");
            xb_add(&bar[XB_XGEN(b.x)], 1u);
            asm volatile("s_waitcnt vmcnt(0)" ::: "memory");
        } else {
            XB_SPIN(xb_ld(&bar[XB_XGEN(b.x)]) == gen, bar);
            __builtin_amdgcn_fence(__ATOMIC_ACQUIRE, "agent");
            asm volatile("s_waitcnt vmcnt(0)" ::: "memory");
        }
    }
    __syncthreads();
}

namespace pg8 {
constexpr int BM = 256, BK = 64, HALF = 128, HTB = HALF * BK * 2, STAGE_BYTES = 8 * HTB, NXCD = 8, WGM = 8;
__host__ __device__ __forceinline__ int lds_byte(int r, int c) { const int st = (r >> 4) * 2 + (c >> 5), rr = r & 15, cc = c & 31, ob = rr * 64 + cc * 2; return st * 1024 + (ob ^ (((ob >> 9) & 1) << 5)); }
__host__ __device__ __forceinline__ void stage_rc(int b, int& R, int& C) { const int st = b / 1024, sb = b % 1024, swz = sb ^ (((sb >> 9) & 1) << 5); R = (st >> 1) * 16 + swz / 64; C = (st & 1) * 32 + (swz % 64) / 2; }
__host__ __device__ __forceinline__ int perm32(int rho) { const int n = rho >> 4, i = rho & 15; return 8 * (i >> 2) + 4 * n + (i & 3); }

struct Unit { int pm, pn, e, valid, j; };

struct ProbPlain {
    static constexpr bool GATHER = false;
    const bf16_t* A; const bf16_t* Bt; int M, N, K, lda; int acol_sh;
    int nM, nN, nwg, G, c;
    __device__ __forceinline__ void init(const bf16_t* A_, const bf16_t* Bt_, int M_, int N_, int K_, int lda_, int acol_sh_, int G_, int c_) {
        A = A_; Bt = Bt_; M = M_; N = N_; K = K_; lda = lda_; acol_sh = acol_sh_; nM = M / BM; nN = N / BM; nwg = nM * nN; G = G_; c = c_; }
    __device__ __forceinline__ bool next(int i, Unit& u) const {
        const long L = (long)i * G + c; if (L >= nwg) return false;
        int wgid = (int)L; { const int q = nwg / NXCD, r = nwg % NXCD, xcd = wgid % NXCD, off = wgid / NXCD; wgid = (xcd < r ? xcd * (q + 1) : r * (q + 1) + (xcd - r) * q) + off; }
        const int nig = WGM * nN, gid = wgid / nig, fm = gid * WGM, gsz = (nM - fm) < WGM ? (nM - fm) : WGM;
        u.pm = fm + ((wgid % nig) % gsz); u.pn = (wgid % nig) / gsz; u.e = 0; u.valid = 256; u.j = 0; return true;
    }
    __device__ __forceinline__ const char* a_base(const Unit& u) const { const int ac = acol_sh >= 0 ? (u.pn >> acol_sh) * 256 : 0; return (const char*)(A + (size_t)u.pm * BM * lda + ac); }
    __device__ __forceinline__ const char* b_base(const Unit& u) const { return (const char*)(Bt + (size_t)u.pn * BM * K); }
    __device__ __forceinline__ void fill_tab(const Unit&, LAS unsigned*) const {}
    __device__ __forceinline__ void a_off(const Unit&, const int (&R)[2], const int (&C)[2], unsigned (&v)[2][2], const LAS unsigned*) const {
#pragma unroll
        for (int h = 0; h < 2; ++h)
#pragma unroll
            for (int i = 0; i < 2; ++i) v[h][i] = (unsigned)((h * HALF + R[i]) * lda + C[i]) * 2u;
    }
};
template <bool GATHER_> struct ProbMoE {
    static constexpr bool GATHER = GATHER_;
    const bf16_t* A; const bf16_t* Bt; int K, lda; size_t bstride;
    const unsigned* rowlist; const LAS int* units; int nunits;
    __device__ __forceinline__ bool next(int i, Unit& u) const {
        if (i >= nunits) return false;
        u.pm = __builtin_amdgcn_readfirstlane(units[i * 4 + 0]); u.pn = __builtin_amdgcn_readfirstlane(units[i * 4 + 1]);
        const int ej = __builtin_amdgcn_readfirstlane(units[i * 4 + 2]); u.e = ej & 255; u.j = ej >> 8; u.valid = __builtin_amdgcn_readfirstlane(units[i * 4 + 3]); return true;
    }
    __device__ __forceinline__ const char* a_base(const Unit& u) const { return GATHER ? (const char*)A : (const char*)(A + (size_t)u.pm * BM * lda); }
    __device__ __forceinline__ const char* b_base(const Unit& u) const { return (const char*)(Bt + (size_t)u.e * bstride + (size_t)u.pn * BM * K); }
    __device__ __forceinline__ void fill_tab(const Unit& u, LAS unsigned* tab) const {
        if (GATHER && threadIdx.x < 256) {
            const unsigned* rl = rowlist + (size_t)u.e * CAP + u.j * 256;
            const int r = (int)threadIdx.x < u.valid ? (int)threadIdx.x : 0;
            tab[threadIdx.x] = rl[r] >> 2;
        }
    }
    __device__ __forceinline__ void a_off(const Unit&, const int (&R)[2], const int (&C)[2], unsigned (&v)[2][2], const LAS unsigned* tab) const {
#pragma unroll
        for (int h = 0; h < 2; ++h)
#pragma unroll
            for (int i = 0; i < 2; ++i) {
                if (GATHER) v[h][i] = (tab[h * HALF + R[i]] * (unsigned)lda + (unsigned)C[i]) * 2u;
                else v[h][i] = (unsigned)((h * HALF + R[i]) * lda + C[i]) * 2u;
            }
    }
};

template <class Epi, class Prob, bool ALIGN_EPI, bool SP2>
__device__ __forceinline__ void gemm_phase(LAS unsigned char* lds, LAS unsigned* tab, const Prob& P, const Epi& E) {
    int tid = threadIdx.x; asm volatile("" : "+v"(tid));
    const int wid = __builtin_amdgcn_readfirstlane(tid >> 6), lane = tid & 63, wr = wid >> 2, wc = wid & 3, fr = lane & 15, fq = lane >> 4;
    const int K = P.K, nt = K / BK;
    int Rr[2], Cc[2]; unsigned voffB[2];
#pragma unroll
    for (int i = 0; i < 2; ++i) { int R, C; stage_rc(tid * 16 + i * 8192, R, C); Rr[i] = R; Cc[i] = C; const int Rb = Epi::PERM ? ((R & ~31) + perm32(R & 31)) : R; voffB[i] = (unsigned)(Rb * K + C) * 2u; }
    const size_t kstep = (size_t)(BK * 2);
    const size_t hstepB = (size_t)HALF * K * 2;
    const unsigned ldsw = (unsigned)wid * 1024u;
    const int aoff = lds_byte(wr * 64 + fr, fq * 8), boff = lds_byte(wc * 32 + fr, fq * 8);
#define PG8_SA(b, h) (((b) * 2 + (h)) * HTB)
#define PG8_SB(b, h) ((4 + (b) * 2 + (h)) * HTB)
#define PG8_STAGE(bufoff, gbase, voff) do { _Pragma("unroll") for (int _i = 0; _i < 2; ++_i) \
        __builtin_amdgcn_global_load_lds((const unsigned*)((const char*)(gbase) + (voff)[_i]), (LAS unsigned*)(lds + (bufoff) + ldsw + _i * 8192), 16, 0, 0); } while (0)
#define PG8_LDA(dst, b, h) do { _Pragma("unroll") for (int m = 0; m < 4; ++m) _Pragma("unroll") for (int k = 0; k < 2; ++k) dst[m][k] = *(const LAS bf16x8*)(lds + PG8_SA(b, h) + aoff + m * 2048 + k * 1024); } while (0)
#define PG8_LDB(dst, b, h) do { _Pragma("unroll") for (int n = 0; n < 2; ++n) _Pragma("unroll") for (int k = 0; k < 2; ++k) dst[n][k] = *(const LAS bf16x8*)(lds + PG8_SB(b, h) + boff + n * 2048 + k * 1024); } while (0)
#define PG8_MMA(ai, bj, At, Bt) do { __builtin_amdgcn_s_setprio(1); _Pragma("unroll") for (int m = 0; m < 4; ++m) _Pragma("unroll") for (int n = 0; n < 2; ++n) _Pragma("unroll") for (int k = 0; k < 2; ++k) \
        acc[ai][bj][m][n] = __builtin_amdgcn_mfma_f32_16x16x32_bf16(Bt[n][k], At[m][k], acc[ai][bj][m][n], 0, 0, 0); __builtin_amdgcn_s_setprio(0); } while (0)
#define PG8_WAIT_V(n) asm volatile("s_waitcnt vmcnt(" #n ")" ::: "memory")
#define PG8_WAIT_L(n) asm volatile("s_waitcnt lgkmcnt(" #n ")" ::: "memory")
#define PG8_BAR __builtin_amdgcn_s_barrier()
#define PG8_SCHED __builtin_amdgcn_sched_barrier(0)
    Unit cur, nxt; int ui = 0;
    if (!P.next(0, cur)) return;
    unsigned vcur[2][2];
    if constexpr (Prob::GATHER) { P.fill_tab(cur, tab); asm volatile("s_waitcnt vmcnt(0) lgkmcnt(0)" ::: "memory"); PG8_BAR; asm volatile("" ::: "memory"); }
    P.a_off(cur, Rr, Cc, vcur, tab);
    if constexpr (Prob::GATHER) { asm volatile("s_waitcnt lgkmcnt(0)" ::: "memory"); }
    f32x4 acc[2][2][4][2];
#pragma unroll
    for (int a = 0; a < 2; ++a)
#pragma unroll
        for (int b = 0; b < 2; ++b)
#pragma unroll
            for (int m = 0; m < 4; ++m)
#pragma unroll
                for (int n = 0; n < 2; ++n) acc[a][b][m][n] = (f32x4){0.f, 0.f, 0.f, 0.f};
    bf16x8 At[4][2], B0[2][2], B1[2][2];
    const char* cA = P.a_base(cur); const char* cB = P.b_base(cur);
    static_assert(SP2, "only the two-MFMA-blocks-per-barrier-pair loop is kept");
    PG8_STAGE(PG8_SB(0, 0), cB, voffB); PG8_STAGE(PG8_SB(0, 1), cB + hstepB, voffB); PG8_STAGE(PG8_SA(0, 0), cA, vcur[0]); PG8_STAGE(PG8_SA(0, 1), cA, vcur[1]);
    if (wr == 1) PG8_BAR;
    PG8_WAIT_V(2); PG8_BAR;
    PG8_STAGE(PG8_SB(1, 0), cB + kstep, voffB); PG8_STAGE(PG8_SA(1, 0), cA + kstep, vcur[0]); PG8_STAGE(PG8_SB(1, 1), cB + hstepB + kstep, voffB);
    PG8_WAIT_V(6); PG8_BAR;
    for (;;) {
        const bool has_next = P.next(ui + 1, nxt);
        const char* nA = has_next ? P.a_base(nxt) : cA; const char* nB = has_next ? P.b_base(nxt) : cB;
        if constexpr (Prob::GATHER) { if (has_next) P.fill_tab(nxt, tab); }
        for (int t = 0; t < nt; t += 2) {
            const bool last = (t == nt - 2);
            const char* a1 = cA + (size_t)(t + 1) * kstep;
            const char* a2 = last ? nA : cA + (size_t)(t + 2) * kstep; const char* b2 = last ? nB : cB + (size_t)(t + 2) * kstep;
            const char* a3 = a2 + kstep; const char* b3 = b2 + kstep;
            PG8_LDB(B0, 0, 0); PG8_LDB(B1, 0, 1); PG8_SCHED; PG8_LDA(At, 0, 0); PG8_STAGE(PG8_SA(1, 1), a1, vcur[1]);
            if constexpr (Prob::GATHER) { if (last && has_next) P.a_off(nxt, Rr, Cc, vcur, tab); }
            PG8_WAIT_V(8); PG8_WAIT_L(0); PG8_BAR; PG8_MMA(0, 0, At, B0); PG8_MMA(0, 1, At, B1); PG8_BAR; PG8_SCHED;
            PG8_LDA(At, 0, 1); PG8_STAGE(PG8_SB(0, 0), b2, voffB); PG8_STAGE(PG8_SB(0, 1), b2 + hstepB, voffB); PG8_STAGE(PG8_SA(0, 0), a2, vcur[0]);
            PG8_WAIT_V(8); PG8_WAIT_L(0); PG8_BAR; PG8_MMA(1, 0, At, B0); PG8_MMA(1, 1, At, B1); PG8_BAR; PG8_SCHED;
            PG8_LDB(B0, 1, 0); PG8_LDB(B1, 1, 1); PG8_SCHED; PG8_LDA(At, 1, 0); PG8_STAGE(PG8_SA(0, 1), a2, vcur[1]);
            PG8_WAIT_V(8); PG8_WAIT_L(0); PG8_BAR; PG8_MMA(0, 0, At, B0); PG8_MMA(0, 1, At, B1); PG8_BAR; PG8_SCHED;
            PG8_LDA(At, 1, 1); PG8_STAGE(PG8_SB(1, 0), b3, voffB); PG8_STAGE(PG8_SB(1, 1), b3 + hstepB, voffB); PG8_STAGE(PG8_SA(1, 0), a3, vcur[0]);
            PG8_WAIT_V(8); PG8_WAIT_L(0); PG8_BAR; PG8_MMA(1, 0, At, B0); PG8_MMA(1, 1, At, B1); PG8_BAR; PG8_SCHED;
        }
        if constexpr (ALIGN_EPI) { if (wr == 0) PG8_BAR; }
        E(acc, cur, wr, wc, fr, fq);
        if (!has_next) break;
#pragma unroll
        for (int a = 0; a < 2; ++a)
#pragma unroll
            for (int b = 0; b < 2; ++b)
#pragma unroll
                for (int m = 0; m < 4; ++m)
#pragma unroll
                    for (int n = 0; n < 2; ++n) acc[a][b][m][n] = (f32x4){0.f, 0.f, 0.f, 0.f};
        cur = nxt; cA = nA; cB = nB; ++ui;
        if constexpr (ALIGN_EPI) { if (wr == 1) PG8_BAR; }
    }
    PG8_WAIT_V(0);
    if constexpr (!ALIGN_EPI) { if (wr == 0) PG8_BAR; }
    PG8_BAR;
#undef PG8_SA
#undef PG8_SB
#undef PG8_STAGE
#undef PG8_LDA
#undef PG8_LDB
#undef PG8_MMA
#undef PG8_WAIT_V
#undef PG8_WAIT_L
#undef PG8_BAR
#undef PG8_SCHED
}

typedef f32x4 AccT[2][2][4][2];
__device__ __forceinline__ float gelu_tanh(float x) {
    const float z = 1.5957691216057308f * (x + 0.044715f * x * x * x);
    return x * __builtin_amdgcn_rcpf(1.0f + __builtin_amdgcn_exp2f(-1.4426950408889634f * z));
}
struct EpiWin {
    static constexpr bool PERM = true;
    bf16_t* GB; bf16_t* RB;
    __device__ __forceinline__ void operator()(const AccT& acc, const Unit& u, int wr, int wc, int fr, int fq) const {
        const int row0 = u.pm * BM + wr * 64 + fr; const bool gate = u.pn < 4;
        bf16_t* base = GB + (size_t)(u.pn >> 2) * ((WS_RB - WS_GB) / 2); const int col0 = (u.pn & 3) * BM + wc * 32 + 8 * fq;
#pragma unroll
        for (int ai = 0; ai < 2; ++ai)
#pragma unroll
            for (int m = 0; m < 4; ++m) { bf16_t* rowp = base + (size_t)(row0 + ai * HALF + m * 16) * D + col0;
#pragma unroll
                for (int bj = 0; bj < 2; ++bj) { f32x4 v0 = acc[ai][bj][m][0], v1 = acc[ai][bj][m][1];
                    if (gate) {
#pragma unroll
                        for (int j = 0; j < 4; ++j) { v0[j] = gelu_tanh(v0[j]); v1[j] = gelu_tanh(v1[j]); } }
                    u32x4 w; w.x = cvt_pk_bf16(v0[0], v0[1]); w.y = cvt_pk_bf16(v0[2], v0[3]); w.z = cvt_pk_bf16(v1[0], v1[1]); w.w = cvt_pk_bf16(v1[2], v1[3]);
                    *(u32x4*)(rowp + bj * HALF) = w; } }
    }
};
struct EpiQKV {
    static constexpr bool PERM = true;
    bf16_t* Q; bf16_t* Kb; bf16_t* V;
    __device__ __forceinline__ void operator()(const AccT& acc, const Unit& u, int wr, int wc, int fr, int fq) const {
        const int row0 = u.pm * BM + wr * 64 + fr; const int t = u.pn >> 2;
        bf16_t* base = Q + (size_t)t * ((WS_K - WS_Q) / 2); const int col0 = (u.pn & 3) * BM + wc * 32 + 8 * fq;
#pragma unroll
        for (int ai = 0; ai < 2; ++ai)
#pragma unroll
            for (int m = 0; m < 4; ++m) { bf16_t* rowp = base + (size_t)(row0 + ai * HALF + m * 16) * D + col0;
#pragma unroll
                for (int bj = 0; bj < 2; ++bj) { const f32x4 v0 = acc[ai][bj][m][0], v1 = acc[ai][bj][m][1];
                    u32x4 w; w.x = cvt_pk_bf16(v0[0], v0[1]); w.y = cvt_pk_bf16(v0[2], v0[3]); w.z = cvt_pk_bf16(v1[0], v1[1]); w.w = cvt_pk_bf16(v1[2], v1[3]);
                    *(u32x4*)(rowp + bj * HALF) = w; } }
    }
};
struct EpiGates {
    static constexpr bool PERM = false;
    const bf16_t* XC; float* AF; float* UF; const float* ba; const float* bx; const float* sp8;
    __device__ __forceinline__ void operator()(const AccT& acc, const Unit& u, int wr, int wc, int fr, int fq) const {
        const int row0 = u.pm * BM + wr * 64 + fr; const int ch0 = (u.pn >> 1) * 256 + (u.pn & 1) * 128 + wc * 32 + 4 * fq;
        f32x4 bav[2], bxv[2], spv[2];
#pragma unroll
        for (int n = 0; n < 2; ++n) { bav[n] = *(const f32x4*)(ba + ch0 + n * 16); bxv[n] = *(const f32x4*)(bx + ch0 + n * 16); spv[n] = *(const f32x4*)(sp8 + ch0 + n * 16); }
#pragma unroll
        for (int ai = 0; ai < 2; ++ai)
#pragma unroll
            for (int m = 0; m < 4; ++m) { const size_t ro = (size_t)(row0 + ai * HALF + m * 16) * D + ch0;
#pragma unroll
                for (int n = 0; n < 2; ++n) { const u32x2 xw = *(const u32x2*)(XC + ro + n * 16);
                    const float xcv[4] = {bflo(xw.x), bfhi(xw.x), bflo(xw.y), bfhi(xw.y)};
                    f32x4 av, uv;
#pragma unroll
                    for (int j = 0; j < 4; ++j) { const float r = sigmoidf_(acc[ai][0][m][n][j] + bav[n][j]), ig = sigmoidf_(acc[ai][1][m][n][j] + bxv[n][j]);
                        const float la = -spv[n][j] * r; const float a = fast_exp(la); const float om = -expm1f(2.0f * la);
                        av[j] = a; uv[j] = __builtin_sqrtf(om) * ig * xcv[j]; }
                    *(f32x4*)(AF + ro + n * 16) = av; *(f32x4*)(UF + ro + n * 16) = uv; } }
    }
};
struct EpiResid {
    static constexpr bool PERM = false;
    const float* X; float* XB; const float* g1;
    __device__ __forceinline__ void operator()(const AccT& acc, const Unit& u, int wr, int wc, int fr, int fq) const {
        const int row0 = u.pm * BM + wr * 64 + fr, col0 = u.pn * BM + wc * 32 + 4 * fq; const int b = (u.pm * BM) / SEQ;
        f32x4 gv[2][2];
#pragma unroll
        for (int bj = 0; bj < 2; ++bj)
#pragma unroll
            for (int n = 0; n < 2; ++n) gv[bj][n] = *(const f32x4*)(g1 + (size_t)b * 6 * D + col0 + bj * HALF + n * 16);
#pragma unroll
        for (int ai = 0; ai < 2; ++ai)
#pragma unroll
            for (int m = 0; m < 4; ++m) { const size_t ro = (size_t)(row0 + ai * HALF + m * 16) * D + col0;
#pragma unroll
                for (int bj = 0; bj < 2; ++bj)
#pragma unroll
                    for (int n = 0; n < 2; ++n) { const f32x4 xv = *(const f32x4*)(X + ro + bj * HALF + n * 16);
                        *(f32x4*)(XB + ro + bj * HALF + n * 16) = xv + gv[bj][n] * acc[ai][bj][m][n]; }
                asm volatile("" ::: "memory"); }
    }
};
struct EpiSwiglu {
    static constexpr bool PERM = true;
    bf16_t* ACT; const float* bgu;
    __device__ __forceinline__ void operator()(const AccT& acc, const Unit& u, int wr, int wc, int fr, int fq) const {
        const int row0 = u.pm * BM + wr * 64 + fr; const int j0 = u.pn * HALF + wc * 32 + 8 * fq;
        const float* bp = bgu + (size_t)u.e * 2 * D + j0;
        const f32x4 bg0 = *(const f32x4*)(bp), bg1 = *(const f32x4*)(bp + 4), bu0 = *(const f32x4*)(bp + D), bu1 = *(const f32x4*)(bp + D + 4);
#pragma unroll
        for (int ai = 0; ai < 2; ++ai)
#pragma unroll
            for (int m = 0; m < 4; ++m) {
                float o[8];
#pragma unroll
                for (int n = 0; n < 2; ++n)
#pragma unroll
                    for (int j = 0; j < 4; ++j) { const float g = acc[ai][0][m][n][j] + (n ? bg1[j] : bg0[j]), up = acc[ai][1][m][n][j] + (n ? bu1[j] : bu0[j]);
                        const float gv = fminf(g, 7.0f), uv = fminf(fmaxf(up, -7.0f), 7.0f);
                        o[n * 4 + j] = gv * sigmoidf_(1.702f * gv) * (uv + 1.0f); }
                u32x4 w; w.x = cvt_pk_bf16(o[0], o[1]); w.y = cvt_pk_bf16(o[2], o[3]); w.z = cvt_pk_bf16(o[4], o[5]); w.w = cvt_pk_bf16(o[6], o[7]);
                *(u32x4*)(ACT + (size_t)(row0 + ai * HALF + m * 16) * D + j0) = w; }
    }
};
struct EpiDown {
    static constexpr bool PERM = true;
    bf16_t* YK; const float* bdn; const unsigned* rowlist; const float* topw;
    __device__ __forceinline__ void operator()(const AccT& acc, const Unit& u, int wr, int wc, int fr, int fq) const {
        const int c0 = u.pn * BM + wc * 32 + 8 * fq;
        const float* bp = bdn + (size_t)u.e * D + c0;
        f32x4 bv[2][2];
#pragma unroll
        for (int bj = 0; bj < 2; ++bj) { bv[bj][0] = *(const f32x4*)(bp + bj * HALF); bv[bj][1] = *(const f32x4*)(bp + bj * HALF + 4); }
        const unsigned* rl = rowlist + (size_t)u.e * CAP + u.j * 256;
#pragma unroll
        for (int ai = 0; ai < 2; ++ai)
#pragma unroll
            for (int m = 0; m < 4; ++m) { const int r = ai * HALF + wr * 64 + m * 16 + fr;
                if (r < u.valid) { const unsigned dest = rl[r]; const float w = topw[dest];
                    bf16_t* rowp = YK + (size_t)dest * D + c0;
#pragma unroll
                    for (int bj = 0; bj < 2; ++bj) { const f32x4 v0 = (acc[ai][bj][m][0] + bv[bj][0]) * w, v1 = (acc[ai][bj][m][1] + bv[bj][1]) * w;
                        u32x4 o; o.x = cvt_pk_bf16(v0[0], v0[1]); o.y = cvt_pk_bf16(v0[2], v0[3]); o.z = cvt_pk_bf16(v1[0], v1[1]); o.w = cvt_pk_bf16(v1[2], v1[3]);
                        *(u32x4*)(rowp + bj * HALF) = o; } } }
    }
};
}

namespace att {
typedef short s16x4 __attribute__((ext_vector_type(4)));
typedef float f32x16 __attribute__((ext_vector_type(16)));
constexpr int NW = 8, QBLK = 32, KVBLK = 64, QB = NW * QBLK, DH = 128, LD = 1024;
constexpr int SHM_V = KVBLK * DH * 2, SHM_K = KVBLK * DH * 2;
constexpr int ATT_LDS_BYTES = 2 * SHM_V + 2 * SHM_K + NW * 64 * 4;
constexpr float SCALE = 0.08838834764831845f;
constexpr float THR = 8.f;
#define KSWZ(row, colB) ((row) * 256 + ((colB) ^ (((row) & 7) << 4)))
#define SBAR() __builtin_amdgcn_sched_barrier(0)
__device__ __forceinline__ int v_st(int k, int c) { const int kk = (k & ~0xC) | ((k & 4) << 1) | ((k & 8) >> 1); return ((kk >> 3) * 4 + (c >> 5)) * 512 + ((kk & 7) * 32 + (c & 31)) * 2; }
__device__ __forceinline__ int v_rd_base(int lane) { return ((lane & 3) << 3) | (((lane >> 2) & 3) << 6) | (((lane >> 4) & 1) << 5) | (((lane >> 5) & 1) << 8); }
constexpr int v_rd_off(int d0, int ks, int half) { return d0 * 512 + ks * 4096 + half * 2048; }
__device__ __forceinline__ int crow(int r, int hi) { return (r & 3) + 8 * (r >> 2) + 4 * hi; }
__device__ __forceinline__ unsigned cvtpk(float lo, float hi) { unsigned r; asm volatile("v_cvt_pk_bf16_f32 %0, %1, %2" : "=v"(r) : "v"(lo), "v"(hi)); return r; }
__device__ __forceinline__ bf16x8 ld8(const bf16_t* p) { return *reinterpret_cast<const bf16x8*>(p); }
__device__ __forceinline__ void mask_causal(f32x16& p0, f32x16& p1, int dq) {
    const float NEG = -__builtin_inff();
#pragma unroll
    for (int r = 0; r < 16; ++r) {
        const int c = (r & 3) + 8 * (r >> 2);
        if (dq - c < 0) p0[r] = NEG;
        if (dq - c - 32 < 0) p1[r] = NEG;
    }
}
__device__ __forceinline__ void mask_all(f32x16& p0, f32x16& p1, bool keep) {
    const float NEG = -__builtin_inff();
#pragma unroll
    for (int r = 0; r < 16; ++r) { p0[r] = keep ? p0[r] : NEG; p1[r] = keep ? p1[r] : NEG; }
}
__device__ __forceinline__ void partialSM(f32x16& p0, f32x16& p1, float& m_reg, float& mn, float& alpha) {
    float pmax = p0[0]; for (int r = 1; r < 16; ++r) pmax = fmaxf(pmax, p0[r]); for (int r = 0; r < 16; ++r) pmax = fmaxf(pmax, p1[r]);
    { auto rr = __builtin_amdgcn_permlane32_swap(__float_as_uint(pmax), __float_as_uint(pmax), false, false);
      pmax = fmaxf(__uint_as_float(rr[0]), __uint_as_float(rr[1])); }
    constexpr float C2 = 1.4426950408889634f * SCALE;
    if (__builtin_expect(__all((pmax - m_reg) * SCALE <= THR), 1)) { mn = m_reg; alpha = 1.f; }
    else { mn = fmaxf(m_reg, pmax); alpha = __builtin_amdgcn_exp2f((m_reg - mn) * C2); m_reg = mn; }
    const float mnL = -mn * C2;
    for (int r = 0; r < 16; ++r) p0[r] = fmaf(p0[r], C2, mnL); for (int r = 0; r < 16; ++r) p1[r] = fmaf(p1[r], C2, mnL);
    for (int r = 0; r < 16; ++r) p0[r] = __builtin_amdgcn_exp2f(p0[r]);
}
__device__ __forceinline__ void finishSM(f32x16& p0, f32x16& p1, float alpha, float& l_reg, bf16x8& pa0, bf16x8& pa1, bf16x8& pa2, bf16x8& pa3) {
    for (int r = 0; r < 16; ++r) p1[r] = __builtin_amdgcn_exp2f(p1[r]);
    float ps = 0; for (int r = 0; r < 16; ++r) ps += p0[r]; for (int r = 0; r < 16; ++r) ps += p1[r];
    { auto rr = __builtin_amdgcn_permlane32_swap(__float_as_uint(ps), __float_as_uint(ps), false, false);
      ps = __uint_as_float(rr[0]) + __uint_as_float(rr[1]); }
    l_reg = l_reg * alpha + ps;
#define PK4(P, B_, OUT) do { unsigned a0 = cvtpk(P[B_+0], P[B_+1]), a1 = cvtpk(P[B_+2], P[B_+3]);                          \
        unsigned b0 = cvtpk(P[B_+4], P[B_+5]), b1 = cvtpk(P[B_+6], P[B_+7]);                                             \
        auto r0 = __builtin_amdgcn_permlane32_swap(a0, b0, false, false); auto r1 = __builtin_amdgcn_permlane32_swap(a1, b1, false, false); \
        u32x4 w = {r0[0], r1[0], r0[1], r1[1]}; OUT = *reinterpret_cast<bf16x8*>(&w); } while (0)
    PK4(p0, 0, pa0); PK4(p0, 8, pa1); PK4(p1, 0, pa2); PK4(p1, 8, pa3);
#undef PK4
}
template <int KB>
__device__ __forceinline__ void qkt(f32x16& p0, f32x16& p1, const char* K_lds, int r32, int hi, const bf16x8* qr) {
    p0 = f32x16{}; p1 = f32x16{};
    const char* kb[4];
#pragma unroll
    for (int dd = 0; dd < 4; ++dd) kb[dd] = K_lds + KB * SHM_K + KSWZ(r32, (dd * 16 + hi * 8) * 2);
#pragma unroll
    for (int d0 = 0; d0 < 8; ++d0) { const char* a = kb[d0 & 3] + (d0 >> 2) * 128;
        bf16x8 b0 = *reinterpret_cast<const bf16x8*>(a);
        bf16x8 b1 = *reinterpret_cast<const bf16x8*>(a + 32 * 256);
        p0 = __builtin_amdgcn_mfma_f32_32x32x16_bf16(b0, qr[d0], p0, 0, 0, 0);
        p1 = __builtin_amdgcn_mfma_f32_32x32x16_bf16(b1, qr[d0], p1, 0, 0, 0); }
}
template <int VB>
__device__ __forceinline__ void pv_tile(f32x16* o, int vb0, bf16x8 pa0, bf16x8 pa1, bf16x8 pa2, bf16x8 pa3) {
#define TRRD(dst, off) asm volatile("ds_read_b64_tr_b16 %0, %1 offset:%2" : "=&v"(dst) : "v"(vb0), "i"(off) : "memory")
#define PV_D0(d0) do { s16x4 l0, l1, l2, l3, h0, h1, h2, h3; constexpr int b_ = VB * SHM_V + v_rd_off(d0, 0, 0); \
        TRRD(l0, b_); TRRD(h0, b_ + 2048); TRRD(l1, b_ + 4096); TRRD(h1, b_ + 6144); TRRD(l2, b_ + 8192); TRRD(h2, b_ + 10240); TRRD(l3, b_ + 12288); TRRD(h3, b_ + 14336); \
        asm volatile("s_waitcnt lgkmcnt(0)" ::: "memory"); SBAR();   \
        o[d0] = __builtin_amdgcn_mfma_f32_32x32x16_bf16(pa0, (bf16x8){l0[0], l0[1], l0[2], l0[3], h0[0], h0[1], h0[2], h0[3]}, o[d0], 0, 0, 0);   \
        o[d0] = __builtin_amdgcn_mfma_f32_32x32x16_bf16(pa1, (bf16x8){l1[0], l1[1], l1[2], l1[3], h1[0], h1[1], h1[2], h1[3]}, o[d0], 0, 0, 0);   \
        o[d0] = __builtin_amdgcn_mfma_f32_32x32x16_bf16(pa2, (bf16x8){l2[0], l2[1], l2[2], l2[3], h2[0], h2[1], h2[2], h2[3]}, o[d0], 0, 0, 0);   \
        o[d0] = __builtin_amdgcn_mfma_f32_32x32x16_bf16(pa3, (bf16x8){l3[0], l3[1], l3[2], l3[3], h3[0], h3[1], h3[2], h3[3]}, o[d0], 0, 0, 0); } while (0)
    PV_D0(0); PV_D0(1); PV_D0(2); PV_D0(3);
#undef PV_D0
#undef TRRD
}
struct BlockRef { const bf16_t* Q; const bf16_t* K; const bf16_t* V; bf16_t* O; const unsigned* M; int qb; };
struct Seam { bf16x8 qr[8]; bf16x8 st_v0, st_v1, st_k0, st_k1; };
#define VMW() asm volatile("s_waitcnt vmcnt(0)" ::: "memory")
#define VMWN(n) asm volatile("s_waitcnt vmcnt(%0)" :: "i"(n) : "memory")
#define GLD8(ubase) (*reinterpret_cast<const bf16x8*>((ubase) + toff))
#define SLOAD_H(Kp, Vp, k0) do { const char* kb__ = (const char*)(Kp) + (size_t)(k0) * (LD * 2); const char* vb__ = (const char*)(Vp) + (size_t)(k0) * (LD * 2); \
                         S.st_v0 = GLD8(vb__); S.st_v1 = GLD8(vb__ + 32 * LD * 2); S.st_k0 = GLD8(kb__); S.st_k1 = GLD8(kb__ + 32 * LD * 2); } while (0)
#define SWRITE_HK(bf) do { *(bf16x8*)(K_lds + (bf) * SHM_K + kws) = S.st_k0; *(bf16x8*)(K_lds + (bf) * SHM_K + kws + 32 * 256) = S.st_k1; } while (0)
#define SWRITE_HV(bf) do { *(bf16x8*)(V_lds + (bf) * SHM_V + vst0) = S.st_v0; *(bf16x8*)(V_lds + (bf) * SHM_V + vst1) = S.st_v1; } while (0)
#define SWRITE_H(bf) do { SWRITE_HV(bf); SWRITE_HK(bf); } while (0)
__device__ __forceinline__ void moba_prime(const BlockRef& cur, char* lds, Seam& S, int tid) {
    const int wid = __builtin_amdgcn_readfirstlane(tid >> 6), lane = tid & 63, r32 = lane & 31, hi = lane >> 5;
    const int sr = tid >> 4, sc = (tid & 15) * 8, kws = KSWZ(sr, sc * 2); char* K_lds = lds + 2 * SHM_V;
    const unsigned toff = (unsigned)(sr * LD + sc) * 2u, qoff = (unsigned)(r32 * LD + hi * 8) * 2u;
    { const char* qb_ = (const char*)cur.Q + (size_t)(wid * QBLK) * (LD * 2);
#pragma unroll
      for (int d0 = 0; d0 < 8; ++d0) S.qr[d0] = *reinterpret_cast<const bf16x8*>(qb_ + d0 * 32 + qoff); }
    SLOAD_H(cur.K, cur.V, 0); VMW(); SWRITE_HK(0);
    __syncthreads();
}
__device__ __forceinline__ void moba_block(const BlockRef& cur, const BlockRef& nxt, char* lds, Seam& S, int tid) {
    const int wid = __builtin_amdgcn_readfirstlane(tid >> 6), lane = tid & 63, r32 = lane & 31, hi = lane >> 5;
    const int NT = 4 * (cur.qb + 1);
    const int P0 = cur.qb * QB;
    const int qlo = P0 + wid * QBLK, qm = qlo + r32 - 4 * hi;
    const unsigned msk = cur.M[wid * QBLK + r32];
    char* V_lds = lds; char* K_lds = lds + 2 * SHM_V;
    float* ws = (float*)(lds + 2 * SHM_V + 2 * SHM_K) + wid * 64; float* li_l = ws, * al_l = ws + 32;
    float m_reg = -1e30f, l_reg = 0; f32x16 o[4] = {};
    const int sr = tid >> 4, sc = (tid & 15) * 8, vst0 = v_st(sr, sc), vst1 = v_st(32 + sr, sc), kws = KSWZ(sr, sc * 2);
    const unsigned toff = (unsigned)(sr * LD + sc) * 2u, qoff = (unsigned)(r32 * LD + hi * 8) * 2u;
    const int vb0 = (int)(uintptr_t)V_lds + v_rd_base(lane);
    const bf16_t* Kh = cur.K; const bf16_t* Vh = cur.V;
#define RESC(a) do { if (__any((a) < 1.f)) { if (hi == 0) al_l[r32] = (a); asm volatile("s_waitcnt lgkmcnt(0)" ::: "memory");              \
                     for (int d_ = 0; d_ < 4; ++d_) for (int r = 0; r < 16; ++r) o[d_][r] *= al_l[crow(r, hi)]; } } while (0)
#define KBASE(t) ((t) * KVBLK)
#define MASKT(P0_, P1_, t) do { const int kb_ = KBASE(t); const int jb_ = (t) >> 2; \
        if (jb_ < cur.qb) { mask_all(P0_, P1_, ((msk >> jb_) & 1u) != 0u); } \
        else if (kb_ + KVBLK - 1 > qlo) mask_causal(P0_, P1_, qm - kb_); } while (0)
    constexpr int NQL = 8;
#define SEAM_K0() do { VMWN(NQL); SWRITE_HK(0); SBAR(); } while (0)
    f32x16 pA0, pA1, pB0, pB1; float mnA, mnB, alA, alB; bf16x8 pa0, pa1, pa2, pa3;
    SWRITE_HV(0); SBAR();
    if (NT > 1) { SLOAD_H(Kh, Vh, KBASE(1)); }
    SBAR(); qkt<0>(pA0, pA1, K_lds, r32, hi, S.qr);
    MASKT(pA0, pA1, 0); partialSM(pA0, pA1, m_reg, mnA, alA);
    if (NT > 1) { VMW(); SWRITE_H(1); }
    __syncthreads();
#define HALF_STEP(PX0, PX1, mnX, alX, PY0, PY1, alY, t, KB, VB, SB) do {                                                      \
        SBAR(); qkt<KB>(PX0, PX1, K_lds, r32, hi, S.qr);                                             \
        finishSM(PY0, PY1, alY, l_reg, pa0, pa1, pa2, pa3); SBAR();                                                           \
        if ((t) + 1 < NT) { SLOAD_H(Kh, Vh, KBASE((t) + 1)); SBAR(); }                                               \
        pv_tile<VB>(o, vb0, pa0, pa1, pa2, pa3); MASKT(PX0, PX1, (t)); partialSM(PX0, PX1, m_reg, mnX, alX);                                        \
        __syncthreads();                                                                                                      \
        if ((t) + 1 < NT) { VMW(); SWRITE_H(SB); }                                                                          \
        RESC(alX); __syncthreads(); } while (0)
    for (int t = 1; t + 1 < NT; t += 2) {
        HALF_STEP(pB0, pB1, mnB, alB, pA0, pA1, alA, t, 1, 0, 0);
        HALF_STEP(pA0, pA1, mnA, alA, pB0, pB1, alB, t + 1, 0, 1, 1);
    }
    const bool even = (NT & 1) == 0;
    if (even) { SBAR(); qkt<1>(pB0, pB1, K_lds, r32, hi, S.qr); SBAR(); }
    SLOAD_H(nxt.K, nxt.V, 0); SBAR();
    { const char* qb_ = (const char*)nxt.Q + (size_t)(wid * QBLK) * (LD * 2);
#pragma unroll
      for (int d0 = 0; d0 < 8; ++d0) S.qr[d0] = *reinterpret_cast<const bf16x8*>(qb_ + d0 * 32 + qoff); }
    SBAR();
    finishSM(pA0, pA1, alA, l_reg, pa0, pa1, pa2, pa3); SBAR();
    pv_tile<0>(o, vb0, pa0, pa1, pa2, pa3);
    if (even) { MASKT(pB0, pB1, NT - 1); partialSM(pB0, pB1, m_reg, mnB, alB); __syncthreads(); RESC(alB);
        finishSM(pB0, pB1, alB, l_reg, pa0, pa1, pa2, pa3); SBAR(); pv_tile<1>(o, vb0, pa0, pa1, pa2, pa3); }
    SBAR(); SEAM_K0();
    if (hi == 0) li_l[r32] = l_reg; asm volatile("s_waitcnt lgkmcnt(0)" ::: "memory");
    float rli[16];
#pragma unroll
    for (int r = 0; r < 16; ++r) rli[r] = __builtin_amdgcn_rcpf(li_l[crow(r, hi)]);
    char* Ow = (char*)cur.O + (size_t)(wid * QBLK) * (LD * 2);
    const unsigned ooff = (unsigned)(4 * hi * LD + r32) * 2u;
#pragma unroll
    for (int r = 0; r < 16; ++r) { char* Or = Ow + (size_t)((r & 3) + 8 * (r >> 2)) * (LD * 2);
#pragma unroll
        for (int d0 = 0; d0 < 4; ++d0) { const float v = o[d0][r] * rli[r];
            const float vn = __shfl_xor(v, 1);
            if ((r32 & 1) == 0) *(unsigned*)(Or + d0 * 64 + ooff) = cvtpk(v, vn); } }
    __syncthreads();
#undef RESC
#undef KBASE
#undef MASKT
#undef SEAM_K0
#undef HALF_STEP
}
#undef VMW
#undef VMWN
#undef SLOAD_H
#undef GLD8
#undef SWRITE_HK
#undef SWRITE_HV
#undef SWRITE_H
}

struct Args { const float* in[25]; float* out; unsigned char* ws; int ph_lo, ph_hi, li, pad; };
enum { IN_X = 0, IN_C, IN_NMG, IN_NFG, IN_WMOD, IN_BMOD, IN_LWIN, IN_LCW, IN_LCB, IN_LWA, IN_LBA, IN_LWX, IN_LBX, IN_LLAM, IN_LWOUT,
       IN_AQKV, IN_AQG, IN_AKG, IN_AWOUT, IN_RW, IN_RB, IN_WGU, IN_BGU, IN_WDN, IN_BDN };
struct Frame {
    LAS unsigned char* lds;
    unsigned char* ws;
    int tid, lane, wave, vcu, G;
};

__device__ __forceinline__ void cvt_tile(const float* W, int ldw, int k0, int n0, bf16_t* WT, int ldt, int drow0, LAS float* scr, int lane) {
    const int q = lane & 15, rr = lane >> 4;
    f32x4 v[16];
#pragma unroll
    for (int i = 0; i < 16; ++i) v[i] = *(const f32x4*)(W + (size_t)(k0 + 4 * i + rr) * ldw + n0 + 4 * q);
#pragma unroll
    for (int i = 0; i < 16; ++i) { LAS float* s = scr + (4 * i + rr) * 65 + 4 * q; s[0] = v[i][0]; s[1] = v[i][1]; s[2] = v[i][2]; s[3] = v[i][3]; }
    LDS_WAIT();
    const int c = lane & 7;
#pragma unroll
    for (int jj = 0; jj < 8; ++jj) { const int n = (lane >> 3) + 8 * jj; const LAS float* s = scr + (8 * c) * 65 + n;
        u32x4 o; o.x = cvt_pk_bf16(s[0 * 65], s[1 * 65]); o.y = cvt_pk_bf16(s[2 * 65], s[3 * 65]); o.z = cvt_pk_bf16(s[4 * 65], s[5 * 65]); o.w = cvt_pk_bf16(s[6 * 65], s[7 * 65]);
        *(u32x4*)(WT + (size_t)(drow0 + n) * ldt + k0 + 8 * c) = o; }
    LDS_WAIT();
}
__device__ __forceinline__ void phase_prologue(Frame& F, const Args& a) {
    if (blockIdx.x < 96) {
        LAS float* cond = (LAS float*)F.lds;
        LAS float* red = (LAS float*)(F.lds + 16384);
        const float* c = a.in[IN_C];
        for (int i = F.tid; i < BATCH * D; i += NTHR) { const float x = c[i]; cond[i] = x * sigmoidf_(x); }
        __syncthreads();
        const int l = blockIdx.x / 24, n0 = (blockIdx.x % 24) * 256;
        const float* W = a.in[IN_WMOD] + (size_t)l * D * 6 * D + n0 + 4 * F.lane;
        f32x4 acc[4];
#pragma unroll
        for (int b = 0; b < 4; ++b) acc[b] = (f32x4){0.f, 0.f, 0.f, 0.f};
        const int kb = F.wave * 128;
#pragma unroll 8
        for (int k = 0; k < 128; ++k) { const f32x4 w = *(const f32x4*)(W + (size_t)(kb + k) * 6 * D);
#pragma unroll
            for (int b = 0; b < 4; ++b) acc[b] += w * cond[b * D + kb + k]; }
#pragma unroll
        for (int b = 0; b < 4; ++b) *(LAS f32x4*)(red + (F.wave * 4 + b) * 256 + 4 * F.lane) = acc[b];
        __syncthreads();
        float* MOD = (float*)(F.ws + WS_MOD);
        for (int o = F.tid; o < 1024; o += NTHR) { const int b = o >> 8, n = o & 255; float s = 0.f;
#pragma unroll
            for (int w = 0; w < 8; ++w) s += red[(w * 4 + b) * 256 + n];
            MOD[((size_t)l * BATCH + b) * 6 * D + n0 + n] = s + a.in[IN_BMOD][(size_t)l * 6 * D + n0 + n]; }
        __syncthreads();
    }
    { const int g = blockIdx.x * NTHR + F.tid; if (g < 2 * D) { const float lam = a.in[IN_LLAM][g]; const float z = -lam;
        const float sp = z > 20.f ? z : log1pf(__expf(z)); ((float*)(F.ws + WS_SP8))[g] = 8.0f * sp; } }
    { float* PAR = (float*)(F.ws + WS_PAR); const int g = blockIdx.x * NTHR + F.tid, GS = F.G * NTHR;
#define CPY(dst, src, n) for (int i = g; i < (n) / 4; i += GS) *(f32x4*)(PAR + (dst) + 4 * i) = *(const f32x4*)(a.in[src] + 4 * i)
      CPY(PAR_NMG, IN_NMG, 4 * 1024); CPY(PAR_NFG, IN_NFG, 4 * 1024); CPY(PAR_LCW, IN_LCW, 2 * 4 * 1024); CPY(PAR_LCB, IN_LCB, 2 * 1024); CPY(PAR_LBA, IN_LBA, 2 * 1024); CPY(PAR_LBX, IN_LBX, 2 * 1024);
      CPY(PAR_AQG, IN_AQG, 256); CPY(PAR_AKG, IN_AKG, 256); CPY(PAR_RW, IN_RW, 4 * 1024 * 32); CPY(PAR_RB, IN_RB, 128); CPY(PAR_BGU, IN_BGU, 4 * 32 * 2048); CPY(PAR_BDN, IN_BDN, 4 * 32 * 1024);
#undef CPY
    }
    LAS float* scr = (LAS float*)(F.lds + F.wave * 16640);
    const int gw = F.vcu * NWAVES + F.wave, NGW = F.G * NWAVES;
    constexpr int I0 = 128 * 512, I1 = 128 * 256, I2 = 2 * 512, I3 = 16 * 16, I4 = 2 * 256, I5 = 2 * 768, I6 = 2 * 256;
    constexpr int NITEMS = I0 + I1 + I2 + I3 + I4 + I5 + I6;
    for (int it = gw; it < NITEMS; it += NGW) {
        int r = it;
        if (r < I0) { const int mat = r >> 9, q = r & 511, kb = q >> 5, nb = q & 31, n0 = nb * 64;
            const int dr = n0 < D ? (n0 >> 7) * 256 + (n0 & 127) : ((n0 - D) >> 7) * 256 + 128 + ((n0 - D) & 127);
            cvt_tile(a.in[IN_WGU] + (size_t)mat * D * 2 * D, 2 * D, kb * 64, n0, (bf16_t*)(F.ws + WS_WGU) + (size_t)mat * 2 * D * D, D, dr, scr, F.lane); continue; } r -= I0;
        if (r < I1) { const int mat = r >> 8, q = r & 255, kb = q >> 4, nb = q & 15;
            cvt_tile(a.in[IN_WDN] + (size_t)mat * D * D, D, kb * 64, nb * 64, (bf16_t*)(F.ws + WS_WDN) + (size_t)mat * D * D, D, nb * 64, scr, F.lane); continue; } r -= I1;
        if (r < I2) { const int mat = r >> 9, q = r & 511, kb = q >> 5, nb = q & 31;
            cvt_tile(a.in[IN_LWIN] + (size_t)mat * D * 2 * D, 2 * D, kb * 64, nb * 64, (bf16_t*)(F.ws + WS_WIN) + (size_t)mat * 2 * D * D, D, nb * 64, scr, F.lane); continue; } r -= I2;
        if (r < I3) { const int mat = r >> 4, q = r & 15, kb = q >> 2, nb = q & 3;
            const int layer = mat >> 3, ax = (mat >> 2) & 1, g = mat & 3, n0 = nb * 64;
            const float* src = (ax ? a.in[IN_LWX] : a.in[IN_LWA]) + (size_t)(layer * 4 + g) * 256 * 256;
            const int dr = (g * 2 + (n0 >> 7)) * 256 + ax * 128 + (n0 & 127);
            cvt_tile(src, 256, kb * 64, n0, (bf16_t*)(F.ws + WS_WG) + (size_t)layer * 2048 * 256, 256, dr, scr, F.lane); continue; } r -= I3;
        if (r < I4) { const int mat = r >> 8, q = r & 255, kb = q >> 4, nb = q & 15;
            cvt_tile(a.in[IN_LWOUT] + (size_t)mat * D * D, D, kb * 64, nb * 64, (bf16_t*)(F.ws + WS_WLO) + (size_t)mat * D * D, D, nb * 64, scr, F.lane); continue; } r -= I4;
        if (r < I5) { const int mat = r / 768, q = r % 768, kb = q / 48, nb = q % 48;
            cvt_tile(a.in[IN_AQKV] + (size_t)mat * D * 3 * D, 3 * D, kb * 64, nb * 64, (bf16_t*)(F.ws + WS_WQKV) + (size_t)mat * 3 * D * D, D, nb * 64, scr, F.lane); continue; } r -= I5;
        { const int mat = r >> 8, q = r & 255, kb = q >> 4, nb = q & 15;
            cvt_tile(a.in[IN_AWOUT] + (size_t)mat * D * D, D, kb * 64, nb * 64, (bf16_t*)(F.ws + WS_WAO) + (size_t)mat * D * D, D, nb * 64, scr, F.lane); }
    }
}

__device__ __forceinline__ void phase_norm(Frame& F, const float* xin, float* out, int layer, bool final_) {
    const float* PAR = (const float*)(F.ws + WS_PAR);
    const int gw = F.vcu * NWAVES + F.wave; const int m0 = gw * 8; const int b = m0 / SEQ;
    const float* MOD = (const float*)(F.ws + WS_MOD);
    const bool first = (layer == 0);
    f32x4 gain[4], sc[4], sh[4], g2[4];
#pragma unroll
    for (int j = 0; j < 4; ++j) { const int c = 4 * F.lane + 256 * j;
        if (!final_) { gain[j] = *(const f32x4*)(PAR + PAR_NMG + (size_t)layer * D + c);
            sh[j] = *(const f32x4*)(MOD + ((size_t)layer * BATCH + b) * 6 * D + c); sc[j] = *(const f32x4*)(MOD + ((size_t)layer * BATCH + b) * 6 * D + D + c); }
        if (!first) g2[j] = *(const f32x4*)(MOD + ((size_t)(layer - 1) * BATCH + b) * 6 * D + 5 * D + c); }
    const float* XB = (const float*)(F.ws + WS_XB); float* XA = (float*)(F.ws + WS_XA);
    const bf16_t* YK = (const bf16_t*)(F.ws + WS_YK); bf16_t* H = (bf16_t*)(F.ws + WS_H);
    for (int r = 0; r < 8; ++r) { const int m = m0 + r;
        f32x4 x[4];
#pragma unroll
        for (int j = 0; j < 4; ++j) { const int c = 4 * F.lane + 256 * j;
            if (first) x[j] = *(const f32x4*)(xin + (size_t)m * D + c);
            else { const u32x2 w = *(const u32x2*)(YK + (size_t)m * D + c); const f32x4 s = (f32x4){bflo(w.x), bfhi(w.x), bflo(w.y), bfhi(w.y)};
                x[j] = *(const f32x4*)(XB + (size_t)m * D + c) + g2[j] * s;
                if (final_) *(f32x4*)(out + (size_t)m * D + c) = x[j]; else *(f32x4*)(XA + (size_t)m * D + c) = x[j]; } }
        if (final_) continue;
        float ss = 0.f;
#pragma unroll
        for (int j = 0; j < 4; ++j) ss += (x[j][0] * x[j][0] + x[j][1] * x[j][1]) + (x[j][2] * x[j][2] + x[j][3] * x[j][3]);
        const float rstd = __builtin_amdgcn_rsqf(wave_sum(ss) * (1.0f / D) + NORM_EPS);
#pragma unroll
        for (int j = 0; j < 4; ++j) { const int c = 4 * F.lane + 256 * j;
            const f32x4 h = x[j] * rstd * gain[j] * (1.0f + sc[j]) + sh[j];
            u32x2 o; o.x = cvt_pk_bf16(h[0], h[1]); o.y = cvt_pk_bf16(h[2], h[3]); *(u32x2*)(H + (size_t)m * D + c) = o; }
    }
}

constexpr int MOE_TOK = T / TOPK;
__device__ __forceinline__ void phase_router(Frame& F, int layer) {
    if (F.vcu >= MOE_TOK / 64) return;
    const float* PAR = (const float*)(F.ws + WS_PAR);
    LAS float* rw = (LAS float*)F.lds;
    LAS unsigned* lcnt = (LAS unsigned*)(F.lds + LDS_X);
    LAS unsigned* lbase = lcnt + 32;
    LAS unsigned* pend = lcnt + 64;
    { const float* RW = PAR + PAR_RW + (size_t)layer * D * NE;
      for (int i = F.tid; i < D * NE / 4; i += NTHR) { const int col = i >> 3, ch = i & 7; const f32x4 v = *(const f32x4*)(RW + (size_t)i * 4);
          *(LAS f32x4*)(rw + col * 32 + ((ch ^ ((col >> 2) & 7)) << 2)) = v; }
      if (F.tid < 32) lcnt[F.tid] = 0u; }
    __syncthreads();
    const int gw = F.vcu * NWAVES + F.wave; const int m0 = gw * 8; const int b = m0 / SEQ;
    const float* MOD = (const float*)(F.ws + WS_MOD);
    f32x4 gain[4], sc[4], sh[4];
#pragma unroll
    for (int j = 0; j < 4; ++j) { const int c = 4 * F.lane + 256 * j; gain[j] = *(const f32x4*)(PAR + PAR_NFG + (size_t)layer * D + c);
        sh[j] = *(const f32x4*)(MOD + ((size_t)layer * BATCH + b) * 6 * D + 3 * D + c); sc[j] = *(const f32x4*)(MOD + ((size_t)layer * BATCH + b) * 6 * D + 4 * D + c); }
    const float* XB = (const float*)(F.ws + WS_XB); bf16_t* H = (bf16_t*)(F.ws + WS_H);
    const float rbias = PAR[PAR_RB + layer * NE + (F.lane & 31)];
    const int sw = F.lane & 7;
    for (int rp = 0; rp < 4; ++rp) {
        f32x4 h[2][4];
#pragma unroll
        for (int q = 0; q < 2; ++q) { const int m = m0 + rp * 2 + q;
            f32x4 x[4]; float ss = 0.f;
#pragma unroll
            for (int j = 0; j < 4; ++j) { x[j] = *(const f32x4*)(XB + (size_t)m * D + 4 * F.lane + 256 * j); ss += (x[j][0] * x[j][0] + x[j][1] * x[j][1]) + (x[j][2] * x[j][2] + x[j][3] * x[j][3]); }
            const float rstd = __builtin_amdgcn_rsqf(wave_sum(ss) * (1.0f / D) + NORM_EPS);
#pragma unroll
            for (int j = 0; j < 4; ++j) { h[q][j] = x[j] * rstd * gain[j] * (1.0f + sc[j]) + sh[j];
                u32x2 o; o.x = cvt_pk_bf16(h[q][j][0], h[q][j][1]); o.y = cvt_pk_bf16(h[q][j][2], h[q][j][3]); *(u32x2*)(H + (size_t)m * D + 4 * F.lane + 256 * j) = o; } }
        float v[64];
#pragma unroll
        for (int i = 0; i < 64; ++i) v[i] = 0.f;
#pragma unroll
        for (int j = 0; j < 4; ++j)
#pragma unroll
            for (int cc = 0; cc < 4; ++cc) { const int col = 4 * F.lane + 256 * j + cc; const LAS float* rp_ = rw + col * 32;
#pragma unroll
                for (int eq = 0; eq < 8; ++eq) { const f32x4 w = *(const LAS f32x4*)(rp_ + ((eq ^ sw) << 2));
#pragma unroll
                    for (int k = 0; k < 4; ++k) { v[eq * 4 + k] = fmaf(h[0][j][cc], w[k], v[eq * 4 + k]); v[32 + eq * 4 + k] = fmaf(h[1][j][cc], w[k], v[32 + eq * 4 + k]); } } }
#pragma unroll
        for (int i = 0; i < 32; ++i) { const bool up = (F.lane & 32) != 0; const float send = up ? v[i] : v[32 + i]; const float recv = __shfl_xor(send, 32); v[i] = (up ? v[32 + i] : v[i]) + recv; }
#pragma unroll
        for (int i = 0; i < 16; ++i) { const bool up = (F.lane & 16) != 0; const float send = up ? v[i] : v[16 + i]; const float recv = __shfl_xor(send, 16); v[i] = (up ? v[16 + i] : v[i]) + recv; }
#pragma unroll
        for (int i = 0; i < 8; ++i) { const bool up = (F.lane & 8) != 0; const float send = up ? v[i] : v[8 + i]; const float recv = __shfl_xor(send, 8); v[i] = (up ? v[8 + i] : v[i]) + recv; }
#pragma unroll
        for (int i = 0; i < 4; ++i) { const bool up = (F.lane & 4) != 0; const float send = up ? v[i] : v[4 + i]; const float recv = __shfl_xor(send, 4); v[i] = (up ? v[4 + i] : v[i]) + recv; }
#pragma unroll
        for (int i = 0; i < 2; ++i) { const bool up = (F.lane & 2) != 0; const float send = up ? v[i] : v[2 + i]; const float recv = __shfl_xor(send, 2); v[i] = (up ? v[2 + i] : v[i]) + recv; }
        { const bool up = (F.lane & 1) != 0; const float send = up ? v[0] : v[1]; const float recv = __shfl_xor(send, 1); v[0] = (up ? v[1] : v[0]) + recv; }
        float logit = v[0] + rbias;
        float tv[4]; int te[4];
#pragma unroll
        for (int k = 0; k < 4; ++k) { float bv = logit; int be = F.lane & 31;
#pragma unroll
            for (int o = 1; o < 32; o <<= 1) { const float ov = __shfl_xor(bv, o); const int oe = __shfl_xor(be, o); if (ov > bv || (ov == bv && oe < be)) { bv = ov; be = oe; } }
            tv[k] = bv; te[k] = be; if ((F.lane & 31) == be) logit = -__builtin_inff(); }
        const float e1 = __expf(tv[1] - tv[0]), e2 = __expf(tv[2] - tv[0]), e3 = __expf(tv[3] - tv[0]); const float inv = 1.0f / (1.0f + e1 + e2 + e3);
        const int kk = F.lane & 31;
        if (kk < 4) { const int e = kk == 0 ? te[0] : (kk == 1 ? te[1] : (kk == 2 ? te[2] : te[3]));
            const float w = (kk == 0 ? 1.0f : (kk == 1 ? e1 : (kk == 2 ? e2 : e3))) * inv;
            const unsigned rank = __hip_atomic_fetch_add(&lcnt[e], 1u, __ATOMIC_RELAXED, __HIP_MEMORY_SCOPE_WORKGROUP);
            const int rl = F.wave * 8 + rp * 2 + (F.lane >> 5);
            pend[(rl * 4 + kk) * 2 + 0] = (unsigned)e | (rank << 8); pend[(rl * 4 + kk) * 2 + 1] = __float_as_uint(w); }
    }
    __syncthreads();
    unsigned* gcnt = (unsigned*)(F.ws + WS_CTL) + CW_CNT + 64 * layer;
    if (F.tid < 32) lbase[F.tid] = __hip_atomic_fetch_add(gcnt + F.tid, lcnt[F.tid], __ATOMIC_RELAXED, __HIP_MEMORY_SCOPE_AGENT);
    __syncthreads();
    if (F.tid < 256) { const int rl = F.tid >> 2, k = F.tid & 3; const unsigned p0 = pend[(rl * 4 + k) * 2], p1 = pend[(rl * 4 + k) * 2 + 1];
        const unsigned e = p0 & 255u, rank = p0 >> 8; const unsigned pos = lbase[e] + rank; const unsigned tok = (unsigned)(F.vcu * 64 + rl);
        ((unsigned*)(F.ws + WS_ROWLIST))[(size_t)e * CAP + pos] = tok * 4u + (unsigned)k;
        ((float*)(F.ws + WS_TOPW))[tok * 4u + k] = __uint_as_float(p1); }
}

__device__ __forceinline__ int moe_units(Frame& F, int layer, int npn) {
    LAS int* moe = (LAS int*)(F.lds + LDS_MOE);
    LAS int* units = (LAS int*)(F.lds + LDS_UNITS);
    if (F.wave == 0) {
        const unsigned* gcnt = (const unsigned*)(F.ws + WS_CTL) + CW_CNT + 64 * layer;
        const int e_ = F.lane & 31;
        const int cnt = (int)gcnt[e_]; const int ntl = (cnt + 255) >> 8;
        int incl = ntl;
#pragma unroll
        for (int o = 1; o < 32; o <<= 1) { const int t = __shfl_up(incl, o); if ((F.lane & 31) >= o) incl += t; }
        const int start = incl - ntl; const int ts = __shfl(incl, 31);
        const int c = blockIdx.x, xcd = c & 7, slot = c >> 3, rpx = 32 / npn;
        const int i = F.lane;
        const int rt = (i * 8 + xcd) * rpx + slot / npn, pn = slot % npn;
        int e = 0, st = 0, cn = 0;
        for (int q = 0; q < 32; ++q) { const int s_ = __shfl(start, q), n_ = __shfl(ntl, q), c_ = __shfl(cnt, q); if (rt >= s_ && rt < s_ + n_) { e = q; st = s_; cn = c_; } }
        const bool ok = (F.lane < 32) && (rt < ts);
        const unsigned long long bal = __ballot(ok);
        if (ok) { const int j = rt - st; int valid = cn - j * 256; valid = valid > 256 ? 256 : valid;
            units[i * 4 + 0] = rt; units[i * 4 + 1] = pn; units[i * 4 + 2] = e | (j << 8); units[i * 4 + 3] = valid; }
        if (F.lane == 0) moe[40] = __popcll(bal);
    }
    __syncthreads();
    return __builtin_amdgcn_readfirstlane(moe[40]);
}

__device__ __forceinline__ void phase_conv(Frame& F, int j) {
    const float* PAR = (const float*)(F.ws + WS_PAR);
    const int g = F.vcu * NTHR + F.tid; const int chunk = g & 127, seg = g >> 7; const int c0 = chunk * 8, m0 = seg * 16; const int s0 = m0 & (SEQ - 1);
    const bf16_t* RB = (const bf16_t*)(F.ws + WS_RB); bf16_t* XC = (bf16_t*)(F.ws + WS_XC);
    float w[4][8], bias[8];
#pragma unroll
    for (int k = 0; k < 4; ++k) { const f32x4 w0 = *(const f32x4*)(PAR + PAR_LCW + ((size_t)j * 4 + k) * D + c0), w1 = *(const f32x4*)(PAR + PAR_LCW + ((size_t)j * 4 + k) * D + c0 + 4);
#pragma unroll
        for (int i = 0; i < 4; ++i) { w[k][i] = w0[i]; w[k][4 + i] = w1[i]; } }
    { const f32x4 b0 = *(const f32x4*)(PAR + PAR_LCB + (size_t)j * D + c0), b1 = *(const f32x4*)(PAR + PAR_LCB + (size_t)j * D + c0 + 4);
#pragma unroll
      for (int i = 0; i < 4; ++i) { bias[i] = b0[i]; bias[4 + i] = b1[i]; } }
    float x0[8], x1[8], x2[8];
#pragma unroll
    for (int i = 0; i < 8; ++i) { x0[i] = 0.f; x1[i] = 0.f; x2[i] = 0.f; }
    if (s0 != 0) {
        const u32x4 r0 = *(const u32x4*)(RB + (size_t)(m0 - 3) * D + c0), r1 = *(const u32x4*)(RB + (size_t)(m0 - 2) * D + c0), r2 = *(const u32x4*)(RB + (size_t)(m0 - 1) * D + c0);
#pragma unroll
        for (int i = 0; i < 4; ++i) { x0[2 * i] = bflo(r0[i]); x0[2 * i + 1] = bfhi(r0[i]); x1[2 * i] = bflo(r1[i]); x1[2 * i + 1] = bfhi(r1[i]); x2[2 * i] = bflo(r2[i]); x2[2 * i + 1] = bfhi(r2[i]); }
    }
#pragma unroll 4
    for (int t = 0; t < 16; ++t) {
        const u32x4 rr = *(const u32x4*)(RB + (size_t)(m0 + t) * D + c0);
        float x3[8], y[8];
#pragma unroll
        for (int i = 0; i < 4; ++i) { x3[2 * i] = bflo(rr[i]); x3[2 * i + 1] = bfhi(rr[i]); }
#pragma unroll
        for (int i = 0; i < 8; ++i) { y[i] = bias[i] + w[0][i] * x0[i] + w[1][i] * x1[i] + w[2][i] * x2[i] + w[3][i] * x3[i]; x0[i] = x1[i]; x1[i] = x2[i]; x2[i] = x3[i]; }
        u32x4 o; o.x = cvt_pk_bf16(y[0], y[1]); o.y = cvt_pk_bf16(y[2], y[3]); o.z = cvt_pk_bf16(y[4], y[5]); o.w = cvt_pk_bf16(y[6], y[7]);
        *(u32x4*)(XC + (size_t)(m0 + t) * D + c0) = o;
    }
}
__device__ __forceinline__ void phase_scan1(Frame& F) {
    const int item = F.vcu; const int m0 = item * 64; const int ch = 2 * F.tid;
    const float* AF = (const float*)(F.ws + WS_AF); const float* UF = (const float*)(F.ws + WS_UF);
    f32x2 h = (f32x2){0.f, 0.f}, p = (f32x2){1.f, 1.f};
#pragma unroll 8
    for (int t = 0; t < 64; ++t) { const f32x2 av = *(const f32x2*)(AF + (size_t)(m0 + t) * D + ch), uv = *(const f32x2*)(UF + (size_t)(m0 + t) * D + ch);
        h = av * h + uv; p = p * av; }
    float* PS = (float*)(F.ws + WS_PS);
    *(f32x4*)(PS + ((size_t)item * D + ch) * 2) = (f32x4){p[0], h[0], p[1], h[1]};
}
__device__ __forceinline__ void phase_scan2(Frame& F) {
    const int item = F.vcu; const int m0 = item * 64; const int ch = 2 * F.tid; const int c = item & 63, b = item >> 6;
    const float* AF = (const float*)(F.ws + WS_AF); const float* UF = (const float*)(F.ws + WS_UF);
    const float* PS = (const float*)(F.ws + WS_PS); const bf16_t* GB = (const bf16_t*)(F.ws + WS_GB); bf16_t* YB = (bf16_t*)(F.ws + WS_YB);
    f32x2 h = (f32x2){0.f, 0.f};
#pragma unroll 8
    for (int jj = 0; jj < c; ++jj) { const f32x4 s = *(const f32x4*)(PS + ((size_t)(b * 64 + jj) * D + ch) * 2); h[0] = s[0] * h[0] + s[1]; h[1] = s[2] * h[1] + s[3]; }
#pragma unroll 8
    for (int t = 0; t < 64; ++t) { const f32x2 av = *(const f32x2*)(AF + (size_t)(m0 + t) * D + ch), uv = *(const f32x2*)(UF + (size_t)(m0 + t) * D + ch);
        const unsigned gw_ = *(const unsigned*)(GB + (size_t)(m0 + t) * D + ch);
        h = av * h + uv;
        *(unsigned*)(YB + (size_t)(m0 + t) * D + ch) = cvt_pk_bf16(bflo(gw_) * h[0], bfhi(gw_) * h[1]); }
}

__device__ __forceinline__ void phase_qknorm(Frame& F, int j) {
    const float* PAR = (const float*)(F.ws + WS_PAR);
    bf16_t* Q = (bf16_t*)(F.ws + WS_Q); bf16_t* Kb = (bf16_t*)(F.ws + WS_K); float* KM = (float*)(F.ws + WS_KMEAN);
    LAS float* red = (LAS float*)F.lds;
    const int rr = F.lane >> 4, cq = F.lane & 15;
    f32x4 qg0 = *(const f32x4*)(PAR + PAR_AQG + (size_t)j * HD + cq * 8), qg1 = *(const f32x4*)(PAR + PAR_AQG + (size_t)j * HD + cq * 8 + 4);
    f32x4 kg0 = *(const f32x4*)(PAR + PAR_AKG + (size_t)j * HD + cq * 8), kg1 = *(const f32x4*)(PAR + PAR_AKG + (size_t)j * HD + cq * 8 + 4);
    for (int it = F.vcu; it < BATCH * NBLK * NH; it += F.G) {
        const int h = it & 7, blk = (it >> 3) & 15, b = it >> 7;
        const size_t base = ((size_t)(b * SEQ + blk * MBLK + F.wave * 32)) * D + h * HD + cq * 8;
        float ks[8];
#pragma unroll
        for (int i = 0; i < 8; ++i) ks[i] = 0.f;
#pragma unroll 2
        for (int i = 0; i < 8; ++i) { const size_t off = base + (size_t)(i * 4 + rr) * D;
            const u32x4 qw = *(const u32x4*)(Q + off), kw = *(const u32x4*)(Kb + off);
            float qv[8], kv[8]; float sq = 0.f, sk = 0.f;
#pragma unroll
            for (int e = 0; e < 4; ++e) { qv[2 * e] = bflo(qw[e]); qv[2 * e + 1] = bfhi(qw[e]); kv[2 * e] = bflo(kw[e]); kv[2 * e + 1] = bfhi(kw[e]); }
#pragma unroll
            for (int e = 0; e < 8; ++e) { sq += qv[e] * qv[e]; sk += kv[e] * kv[e]; }
#pragma unroll
            for (int o = 1; o < 16; o <<= 1) { sq += __shfl_xor(sq, o); sk += __shfl_xor(sk, o); }
            const float rq = __builtin_amdgcn_rsqf(sq * (1.0f / HD) + NORM_EPS), rk = __builtin_amdgcn_rsqf(sk * (1.0f / HD) + NORM_EPS);
#pragma unroll
            for (int e = 0; e < 8; ++e) { qv[e] = qv[e] * rq * (e < 4 ? qg0[e & 3] : qg1[e & 3]); kv[e] = kv[e] * rk * (e < 4 ? kg0[e & 3] : kg1[e & 3]); ks[e] += kv[e]; }
            u32x4 qo, ko;
#pragma unroll
            for (int e = 0; e < 4; ++e) { qo[e] = cvt_pk_bf16(qv[2 * e], qv[2 * e + 1]); ko[e] = cvt_pk_bf16(kv[2 * e], kv[2 * e + 1]); }
            *(u32x4*)(Q + off) = qo; *(u32x4*)(Kb + off) = ko; }
#pragma unroll
        for (int e = 0; e < 8; ++e) { ks[e] += __shfl_xor(ks[e], 16); ks[e] += __shfl_xor(ks[e], 32); }
        __syncthreads();
        if (F.lane < 16) {
#pragma unroll
            for (int e = 0; e < 8; ++e) red[F.wave * 128 + cq * 8 + e] = ks[e]; }
        __syncthreads();
        if (F.tid < 128) { float s = 0.f;
#pragma unroll
            for (int w = 0; w < 8; ++w) s += red[w * 128 + F.tid];
            KM[(((size_t)b * NH + h) * NBLK + blk) * HD + F.tid] = s * (1.0f / MBLK); }
    }
}
__device__ __forceinline__ void phase_gate(Frame& F) {
    const bf16_t* Q = (const bf16_t*)(F.ws + WS_Q); const float* KM = (const float*)(F.ws + WS_KMEAN); unsigned* SEL = (unsigned*)(F.ws + WS_SEL);
    LAS float* km = (LAS float*)F.lds;
    const int it = F.vcu; const int s8 = it & 7, h = (it >> 3) & 7, b = it >> 6;
    for (int i = F.tid; i < NBLK * HD / 4; i += NTHR) *(LAS f32x4*)(km + 4 * i) = *(const f32x4*)(KM + ((size_t)b * NH + h) * NBLK * HD + 4 * i);
    __syncthreads();
    const int s = s8 * 512 + F.tid; const int qb = __builtin_amdgcn_readfirstlane(s >> 8);
    u32x4 qw[16];
    const bf16_t* qp = Q + ((size_t)(b * SEQ + s)) * D + h * HD;
#pragma unroll
    for (int i = 0; i < 16; ++i) qw[i] = *(const u32x4*)(qp + 8 * i);
    float v1 = -__builtin_inff(), v2 = v1, v3 = v1; int i1 = -1, i2 = -1, i3 = -1;
    for (int n = 0; n < qb; ++n) { float sc = 0.f;
#pragma unroll
        for (int i = 0; i < 16; ++i) { const f32x4 k0 = *(const LAS f32x4*)(km + n * HD + 8 * i), k1 = *(const LAS f32x4*)(km + n * HD + 8 * i + 4);
            sc += bflo(qw[i][0]) * k0[0] + bfhi(qw[i][0]) * k0[1] + bflo(qw[i][1]) * k0[2] + bfhi(qw[i][1]) * k0[3]
                + bflo(qw[i][2]) * k1[0] + bfhi(qw[i][2]) * k1[1] + bflo(qw[i][3]) * k1[2] + bfhi(qw[i][3]) * k1[3]; }
        if (sc > v1) { v3 = v2; i3 = i2; v2 = v1; i2 = i1; v1 = sc; i1 = n; }
        else if (sc > v2) { v3 = v2; i3 = i2; v2 = sc; i2 = n; }
        else if (sc > v3) { v3 = sc; i3 = n; } }
    unsigned m = 0u; if (i1 >= 0) m |= 1u << i1; if (i2 >= 0) m |= 1u << i2; if (i3 >= 0) m |= 1u << i3;
    SEL[((size_t)b * NH + h) * SEQ + s] = m;
}
__device__ __forceinline__ att::BlockRef att_ref(Frame& F, int L, int pass) {
    const int bh = L >> 3, x = L & 7; const int qb = pass ? 15 - x : x; const int b = bh >> 3, h = bh & 7;
    att::BlockRef r; const size_t ro = ((size_t)(b * SEQ + qb * MBLK)) * D + h * HD;
    r.Q = (const bf16_t*)(F.ws + WS_Q) + ro; r.O = (bf16_t*)(F.ws + WS_YB) + ro;
    r.K = (const bf16_t*)(F.ws + WS_K) + (size_t)(b * SEQ) * D + h * HD; r.V = (const bf16_t*)(F.ws + WS_V) + (size_t)(b * SEQ) * D + h * HD;
    r.M = (const unsigned*)(F.ws + WS_SEL) + (size_t)bh * SEQ + qb * MBLK; r.qb = qb; return r;
}
__device__ __forceinline__ void phase_attn(Frame& F, char* lds) {
    const int total = BATCH * NH * 8, stride = F.G;
    int L = F.vcu; if (L >= total) return;
    int pass = 0;
    att::BlockRef cur = att_ref(F, L, 0);
    att::Seam S;
    att::moba_prime(cur, lds, S, F.tid);
    for (;;) {
        const bool more_pass = pass == 0, more_item = L + stride < total, last = !more_pass && !more_item;
        int passn = pass + 1, Ln = L;
        if (!more_pass) { passn = 0; Ln = more_item ? L + stride : L; }
        const att::BlockRef nxt = last ? cur : att_ref(F, Ln, passn);
        att::moba_block(cur, nxt, lds, S, F.tid);
        if (last) break;
        cur = nxt; pass = passn; L = Ln;
    }
}

constexpr int NPH = 42;
__global__ void __launch_bounds__(NTHR, 2) fwd(Args args) {
    extern __shared__ __attribute__((aligned(16))) unsigned char lds_[];
    Frame F;
    F.lds = (LAS unsigned char*)lds_; F.ws = args.ws;
    F.tid = threadIdx.x; F.lane = F.tid & 63; F.wave = __builtin_amdgcn_readfirstlane(F.tid >> 6);
    F.G = gridDim.x; { const int bx = blockIdx.x; F.vcu = (F.G % 8 == 0) ? (bx % 8) * (F.G / 8) + bx / 8 : bx; }
    volatile LAS unsigned* MISC = (volatile LAS unsigned*)(F.lds + LDS_MISC);
    if (F.tid < 64) MISC[F.tid] = 0u;
    __syncthreads();
    const int lo = args.ph_lo, hi = args.ph_hi;
    unsigned* ctl = (unsigned*)(F.ws + WS_CTL);
    XcdBarrier bar; bar.bar = ctl + CW_BAR + args.li * XCD_BAR_WORDS; bar.x = 0; bar.st = nullptr;
    if (hi - lo > 1) bar = xcd_barrier_post(ctl + CW_BAR + args.li * XCD_BAR_WORDS, MISC + 8);
#ifdef ONLY
#define EN(code) ((code) == ONLY)
#else
#define EN(code) true
#endif
#define IN(k) (lo <= (k) && (k) < hi)
#define SEAM(k) do { if (IN(k) && IN((k) + 1)) xcd_barrier(bar); } while (0)
#define PF() Frame Fp = F; asm volatile("" : "+v"(Fp.tid)); Fp.lane = Fp.tid & 63
    LAS unsigned* tab = (LAS unsigned*)(F.lds + LDS_TAB);
    const float* xin = args.in[IN_X]; float* out = args.out; const float* PAR = (const float*)(F.ws + WS_PAR);

    if (EN(0) && IN(0)) { PF(); phase_prologue(Fp, args); } SEAM(0);

#pragma nounroll
    for (int l = 0; l < DEPTH; ++l) {
        const int pb = 1 + 10 * l; const int j = l >> 1; const bool lru = (l & 1) == 0;
        if (EN(10) && IN(pb + 0)) { PF(); phase_norm(Fp, xin, out, l, false); } SEAM(pb + 0);
        if (lru) {
            if (EN(21) && IN(pb + 1)) { pg8::ProbPlain P; P.init((const bf16_t*)(F.ws + WS_H), (const bf16_t*)(F.ws + WS_WIN) + (size_t)j * 2 * D * D, T, 2 * D, D, D, -1, F.G, (int)blockIdx.x);
                pg8::EpiWin E{(bf16_t*)(F.ws + WS_GB), (bf16_t*)(F.ws + WS_RB)};
                pg8::gemm_phase<pg8::EpiWin, pg8::ProbPlain, true, true>(F.lds, tab, P, E); } SEAM(pb + 1);
            if (EN(22) && IN(pb + 2)) { PF(); phase_conv(Fp, j); } SEAM(pb + 2);
            if (EN(23) && IN(pb + 3)) { pg8::ProbPlain P; P.init((const bf16_t*)(F.ws + WS_XC), (const bf16_t*)(F.ws + WS_WG) + (size_t)j * 2048 * 256, T, 2 * D, 256, D, 1, F.G, (int)blockIdx.x);
                pg8::EpiGates E{(const bf16_t*)(F.ws + WS_XC), (float*)(F.ws + WS_AF), (float*)(F.ws + WS_UF), PAR + PAR_LBA + (size_t)j * D, PAR + PAR_LBX + (size_t)j * D, (const float*)(F.ws + WS_SP8) + (size_t)j * D};
                pg8::gemm_phase<pg8::EpiGates, pg8::ProbPlain, true, true>(F.lds, tab, P, E); } SEAM(pb + 3);
            if (EN(24) && IN(pb + 4)) { PF(); phase_scan1(Fp); } SEAM(pb + 4);
            if (EN(25) && IN(pb + 5)) { PF(); phase_scan2(Fp); } SEAM(pb + 5);
        } else {
            if (EN(31) && IN(pb + 1)) { pg8::ProbPlain P; P.init((const bf16_t*)(F.ws + WS_H), (const bf16_t*)(F.ws + WS_WQKV) + (size_t)j * 3 * D * D, T, 3 * D, D, D, -1, F.G, (int)blockIdx.x);
                pg8::EpiQKV E{(bf16_t*)(F.ws + WS_Q), (bf16_t*)(F.ws + WS_K), (bf16_t*)(F.ws + WS_V)};
                pg8::gemm_phase<pg8::EpiQKV, pg8::ProbPlain, true, true>(F.lds, tab, P, E); } SEAM(pb + 1);
            if (EN(32) && IN(pb + 2)) { PF(); phase_qknorm(Fp, j); } SEAM(pb + 2);
            if (EN(33) && IN(pb + 3)) { PF(); phase_gate(Fp); } SEAM(pb + 3);
            if (EN(34) && IN(pb + 4)) { PF(); phase_attn(Fp, (char*)lds_); } SEAM(pb + 4);
        }
        if (EN(16) && IN(pb + 6)) { pg8::ProbPlain P; P.init((const bf16_t*)(F.ws + WS_YB), (const bf16_t*)(F.ws + (lru ? WS_WLO : WS_WAO)) + (size_t)j * D * D, T, D, D, D, -1, F.G, (int)blockIdx.x);
            pg8::EpiResid E{l == 0 ? xin : (const float*)(F.ws + WS_XA), (float*)(F.ws + WS_XB), (const float*)(F.ws + WS_MOD) + (size_t)l * BATCH * 6 * D + 2 * D};
            pg8::gemm_phase<pg8::EpiResid, pg8::ProbPlain, false, true>(F.lds, tab, P, E); } SEAM(pb + 6);
        if (EN(17) && IN(pb + 7)) { PF(); phase_router(Fp, l); } SEAM(pb + 7);
        if (EN(18) && IN(pb + 8)) { PF(); const int nu = moe_units(Fp, l, 8);
            pg8::ProbMoE<true> P; P.A = (const bf16_t*)(F.ws + WS_H); P.Bt = (const bf16_t*)(F.ws + WS_WGU) + (size_t)l * NE * 2 * D * D; P.K = D; P.lda = D; P.bstride = (size_t)2 * D * D;
            P.rowlist = (const unsigned*)(F.ws + WS_ROWLIST); P.units = (const LAS int*)(F.lds + LDS_UNITS); P.nunits = nu;
            pg8::EpiSwiglu E{(bf16_t*)(F.ws + WS_ACT), PAR + PAR_BGU + (size_t)l * NE * 2 * D};
            pg8::gemm_phase<pg8::EpiSwiglu, pg8::ProbMoE<true>, true, true>(F.lds, tab, P, E); } SEAM(pb + 8);
        if (EN(19) && IN(pb + 9)) { PF(); const int nu = moe_units(Fp, l, 4);
            pg8::ProbMoE<false> P; P.A = (const bf16_t*)(F.ws + WS_ACT); P.Bt = (const bf16_t*)(F.ws + WS_WDN) + (size_t)l * NE * D * D; P.K = D; P.lda = D; P.bstride = (size_t)D * D;
            P.rowlist = (const unsigned*)(F.ws + WS_ROWLIST); P.units = (const LAS int*)(F.lds + LDS_UNITS); P.nunits = nu;
            pg8::EpiDown E{(bf16_t*)(F.ws + WS_YK), PAR + PAR_BDN + (size_t)l * NE * D, (const unsigned*)(F.ws + WS_ROWLIST), (const float*)(F.ws + WS_TOPW)};
            pg8::gemm_phase<pg8::EpiDown, pg8::ProbMoE<false>, true, true>(F.lds, tab, P, E); } SEAM(pb + 9);
    }
    if (EN(41) && IN(41)) { PF(); phase_norm(Fp, xin, out, DEPTH, true); }
#undef IN
#undef SEAM
#undef EN
}

#ifndef DEBUG_CHECKS
#define DEBUG_CHECKS 0
#endif
#ifndef CHK_FROM
#define CHK_FROM 0
#endif
#if DEBUG_CHECKS
constexpr int CW_CHK = 70000;
__device__ __forceinline__ unsigned hsh(unsigned x) { x ^= x >> 16; x *= 0x7feb352du; x ^= x >> 15; x *= 0x846ca68bu; x ^= x >> 16; return x; }
__device__ __forceinline__ bool cls(float got, float ref, float rt, float at) { return (fabsf(got - ref) <= rt * fabsf(ref) + at); }
__device__ __forceinline__ float bfq(const bf16_t* p, size_t i) { return __uint_as_float(((unsigned)p[i]) << 16); }
__device__ __forceinline__ float gelu_ref(float x) { return 0.5f * x * (1.0f + tanhf(0.7978845608028654f * (x + 0.044715f * x * x * x))); }
__global__ void __launch_bounds__(64) chk(Args a, int id, int l, int code) {
    const int j = l >> 1;
    unsigned char* ws = a.ws; unsigned* ctl = (unsigned*)(ws + WS_CTL); const int lane = threadIdx.x;
    const float* MOD = (const float*)(ws + WS_MOD); const float* PAR = (const float*)(ws + WS_PAR);
    const bf16_t* H = (const bf16_t*)(ws + WS_H);
    bool bad = false;
    for (int it = 0; it < 8; ++it) {
        const unsigned sd = hsh(blockIdx.x * 131u + it * 7919u + id * 104729u + 12345u);
        if (id == 1) {
            const int l = sd & 3, b = (sd >> 2) & 3, n = (sd >> 4) % (6 * D); float s = 0.f;
            for (int k = lane; k < D; k += 64) { const float c = a.in[IN_C][b * D + k]; s += (c / (1.0f + expf(-c))) * a.in[IN_WMOD][((size_t)l * D + k) * 6 * D + n]; }
            s = wave_sum(s) + a.in[IN_BMOD][l * 6 * D + n];
            if (!cls(MOD[((size_t)l * BATCH + b) * 6 * D + n], s, 1e-3f, 1e-3f)) bad = true;
        } else if (id == 2) {
            const int m = sd % T, b = m / SEQ; float ss = 0.f;
            for (int k = lane; k < D; k += 64) { const float x = a.in[IN_X][(size_t)m * D + k]; ss += x * x; }
            const float rstd = 1.0f / sqrtf(wave_sum(ss) / D + NORM_EPS);
            for (int k = lane; k < D; k += 64) { const float x = a.in[IN_X][(size_t)m * D + k];
                const float h = x * rstd * a.in[IN_NMG][k] * (1.0f + MOD[(size_t)b * 6 * D + D + k]) + MOD[(size_t)b * 6 * D + k];
                if (!cls(bfq(H, (size_t)m * D + k), h, 0.01f, 0.01f)) bad = true; }
        } else if (id == 3) {
            const int m = sd % T, n = (sd >> 14) % (2 * D); float s = 0.f;
            for (int k = lane; k < D; k += 64) s += bfq(H, (size_t)m * D + k) * a.in[IN_LWIN][((size_t)j * D + k) * 2 * D + n];
            s = wave_sum(s);
            const float got = n < D ? bfq((const bf16_t*)(ws + WS_GB), (size_t)m * D + n) : bfq((const bf16_t*)(ws + WS_RB), (size_t)m * D + n - D);
            const float ref = n < D ? gelu_ref(s) : s;
            if (!cls(got, ref, 0.02f, 0.02f)) bad = true;
        } else if (id == 4) {
            const int m = sd % T, c = (sd >> 14) % D, s0 = m % SEQ; const bf16_t* RB = (const bf16_t*)(ws + WS_RB);
            float y = a.in[IN_LCB][j * D + c];
            for (int k = 0; k < 4; ++k) { const int t = s0 - 3 + k; if (t >= 0) y += a.in[IN_LCW][(j * 4 + k) * D + c] * bfq(RB, (size_t)(m - 3 + k) * D + c); }
            if (!cls(bfq((const bf16_t*)(ws + WS_XC), (size_t)m * D + c), y, 0.01f, 0.01f)) bad = true;
        } else if (id == 5) {
            const int m = sd % T, ch = (sd >> 14) % D, g = ch >> 8, jc = ch & 255; const bf16_t* XC = (const bf16_t*)(ws + WS_XC);
            float sa = 0.f, sx = 0.f;
            for (int i = lane; i < 256; i += 64) { const float xv = bfq(XC, (size_t)m * D + g * 256 + i); sa += xv * a.in[IN_LWA][((size_t)(j * 4 + g) * 256 + i) * 256 + jc]; sx += xv * a.in[IN_LWX][((size_t)(j * 4 + g) * 256 + i) * 256 + jc]; }
            sa = wave_sum(sa) + a.in[IN_LBA][j * D + ch]; sx = wave_sum(sx) + a.in[IN_LBX][j * D + ch];
            const float r = 1.0f / (1.0f + expf(-sa)), ig = 1.0f / (1.0f + expf(-sx)); const float lam = a.in[IN_LLAM][j * D + ch];
            const float la = -8.0f * r * log1pf(expf(-lam)); const float av = expf(la), uv = sqrtf(-expm1f(2.0f * la)) * ig * bfq(XC, (size_t)m * D + ch);
            if (!cls(((const float*)(ws + WS_AF))[(size_t)m * D + ch], av, 2e-3f, 1e-4f)) bad = true;
            if (!cls(((const float*)(ws + WS_UF))[(size_t)m * D + ch], uv, 0.03f, 0.003f)) bad = true;
        } else if (id == 6) {
            const int b = sd & 3, ch = ((sd >> 2) + lane * 17) % D; const float* AF = (const float*)(ws + WS_AF); const float* UF = (const float*)(ws + WS_UF);
            const bf16_t* GB = (const bf16_t*)(ws + WS_GB); const bf16_t* YB = (const bf16_t*)(ws + WS_YB);
            float h = 0.f;
            for (int t = 0; t < SEQ; ++t) { const size_t o = ((size_t)b * SEQ + t) * D + ch; h = AF[o] * h + UF[o];
                if ((t & 127) == 77 || t == SEQ - 1 || t == 0 || t == 64) { if (!cls(bfq(YB, o), bfq(GB, o) * h, 0.02f, 0.01f)) bad = true; } }
        } else if (id == 7) {
            const int m = sd % T, n = (sd >> 14) % D, b = m / SEQ; float s = 0.f; const bf16_t* YB = (const bf16_t*)(ws + WS_YB);
            for (int k = lane; k < D; k += 64) s += bfq(YB, (size_t)m * D + k) * a.in[IN_LWOUT][((size_t)j * D + k) * D + n];
            s = wave_sum(s);
            const float ref = (l == 0 ? a.in[IN_X][(size_t)m * D + n] : ((const float*)(ws + WS_XA))[(size_t)m * D + n]) + MOD[((size_t)l * BATCH + b) * 6 * D + 2 * D + n] * s;
            if (!cls(((const float*)(ws + WS_XB))[(size_t)m * D + n], ref, 0.01f, 0.01f)) bad = true;
        } else if (id == 8) {
            __shared__ float hrow[D];
            const int m = sd % MOE_TOK, b = m / SEQ; const float* XB = (const float*)(ws + WS_XB); float ss = 0.f;
            for (int k = lane; k < D; k += 64) { const float x = XB[(size_t)m * D + k]; ss += x * x; }
            const float rstd = 1.0f / sqrtf(wave_sum(ss) / D + NORM_EPS);
            __syncthreads();
            for (int k = lane; k < D; k += 64) { const float x = XB[(size_t)m * D + k];
                const float h = x * rstd * a.in[IN_NFG][l * D + k] * (1.0f + MOD[((size_t)l * BATCH + b) * 6 * D + 4 * D + k]) + MOD[((size_t)l * BATCH + b) * 6 * D + 3 * D + k]; hrow[k] = h;
                if (!cls(bfq(H, (size_t)m * D + k), h, 0.01f, 0.01f)) bad = true; }
            __syncthreads();
            const int e = lane & 31; float lg = a.in[IN_RB][l * NE + e];
            for (int k = 0; k < D; ++k) lg += hrow[k] * a.in[IN_RW][((size_t)l * D + k) * NE + e];
            int rank = 0; float mx = -1e30f;
            for (int q = 0; q < 32; ++q) { const float o = __shfl(lg, q); if (o > lg || (o == lg && q < e)) ++rank; mx = fmaxf(mx, o); }
            const bool sel = rank < 4; float den = 0.f;
            for (int q = 0; q < 32; ++q) { const float o = __shfl(lg, q); const int rk = __shfl(rank, q); if (rk < 4) den += expf(o - mx); }
            const float wref = expf(lg - mx) / den;
            float v4 = 0.f, v5 = 0.f; for (int q = 0; q < 32; ++q) { const float o = __shfl(lg, q); const int rk = __shfl(rank, q); if (rk == 3) v4 = o; if (rk == 4) v5 = o; }
            const unsigned* gcnt = ctl + CW_CNT + 64 * l; const unsigned* RL = (const unsigned*)(ws + WS_ROWLIST); const float* TW = (const float*)(ws + WS_TOPW);
            if (v4 - v5 > 1e-3f && lane < 32) {
                const int cnt = (int)gcnt[e]; int found = -1;
                for (int p = 0; p < cnt; ++p) { const unsigned r = RL[(size_t)e * CAP + p]; if ((int)(r >> 2) == m) found = (int)r; }
                if (sel) { if (found < 0) bad = true; else if (!cls(TW[found], wref, 0.01f, 1e-3f)) bad = true; }
                else if (found >= 0) bad = true;
            }
            unsigned tot = 0; for (int q = 0; q < 32; ++q) tot += gcnt[q]; if (tot != (unsigned)T) bad = true;
        } else if (id == 9 || id == 10) {
            const unsigned* gcnt = ctl + CW_CNT + 64 * l; const unsigned* RL = (const unsigned*)(ws + WS_ROWLIST); const float* TW = (const float*)(ws + WS_TOPW);
            const int e = sd & 31; int ts = 0; for (int q = 0; q < e; ++q) ts += ((int)gcnt[q] + 255) >> 8;
            const int cnt = (int)gcnt[e]; if (cnt == 0) continue;
            const int pos = (sd >> 5) % cnt; const unsigned dest = RL[(size_t)e * CAP + pos]; const int tok = dest >> 2; const size_t arow = (size_t)ts * 256 + pos;
            const int col = (sd >> 17) % D; const bf16_t* ACT = (const bf16_t*)(ws + WS_ACT);
            if (id == 9) { float sg = 0.f, su = 0.f;
                for (int k = lane; k < D; k += 64) { const float hv = bfq(H, (size_t)tok * D + k); sg += hv * a.in[IN_WGU][((size_t)(l * NE + e) * D + k) * 2 * D + col]; su += hv * a.in[IN_WGU][((size_t)(l * NE + e) * D + k) * 2 * D + D + col]; }
                sg = wave_sum(sg) + a.in[IN_BGU][(size_t)(l * NE + e) * 2 * D + col]; su = wave_sum(su) + a.in[IN_BGU][(size_t)(l * NE + e) * 2 * D + D + col];
                const float gv = fminf(sg, 7.f), uv = fminf(fmaxf(su, -7.f), 7.f); const float ref = gv / (1.0f + expf(-1.702f * gv)) * (uv + 1.0f);
                if (!cls(bfq(ACT, arow * D + col), ref, 0.03f, 0.02f)) bad = true;
            } else { float s = 0.f;
                for (int k = lane; k < D; k += 64) s += bfq(ACT, arow * D + k) * a.in[IN_WDN][((size_t)(l * NE + e) * D + k) * D + col];
                s = (wave_sum(s) + a.in[IN_BDN][(size_t)(l * NE + e) * D + col]) * TW[dest];
                if (!cls(bfq((const bf16_t*)(ws + WS_YK), (size_t)dest * D + col), s, 0.03f, 0.01f)) bad = true; }
        } else if (id == 11) {
            const int m = sd % T, h = (sd >> 14) & 7, which = (sd >> 17) % 3; float r0 = 0.f, r1 = 0.f;
            for (int k = 0; k < D; ++k) { const float hv = bfq(H, (size_t)m * D + k); const float* w = a.in[IN_AQKV] + ((size_t)j * D + k) * 3 * D + which * D + h * HD; r0 += hv * w[lane]; r1 += hv * w[lane + 64]; }
            const bf16_t* buf = (const bf16_t*)(ws + (which == 0 ? WS_Q : (which == 1 ? WS_K : WS_V)));
            const float g0 = bfq(buf, (size_t)m * D + h * HD + lane), g1 = bfq(buf, (size_t)m * D + h * HD + lane + 64);
            if (which == 2) { if (!cls(g0, r0, 0.02f, 0.02f) || !cls(g1, r1, 0.02f, 0.02f)) bad = true; }
            else { const float rs = 1.0f / sqrtf(wave_sum(r0 * r0 + r1 * r1) / HD + NORM_EPS); const float* gg = a.in[which == 0 ? IN_AQG : IN_AKG] + j * HD;
                if (!cls(g0, r0 * rs * gg[lane], 0.03f, 0.03f) || !cls(g1, r1 * rs * gg[lane + 64], 0.03f, 0.03f)) bad = true; }
        } else if (id == 12) {
            const int b = sd & 3, h = (sd >> 2) & 7, blk = (sd >> 5) & 15; const bf16_t* Kb = (const bf16_t*)(ws + WS_K); const float* KM = (const float*)(ws + WS_KMEAN);
            float s0 = 0.f, s1 = 0.f;
            for (int r = 0; r < MBLK; ++r) { const size_t o = ((size_t)b * SEQ + blk * MBLK + r) * D + h * HD; s0 += bfq(Kb, o + lane); s1 += bfq(Kb, o + lane + 64); }
            const float* km = KM + (((size_t)b * NH + h) * NBLK + blk) * HD;
            if (!cls(km[lane], s0 / MBLK, 0.03f, 0.003f) || !cls(km[lane + 64], s1 / MBLK, 0.03f, 0.003f)) bad = true;
            const int s = (sd >> 9) % SEQ, qb = s >> 8; const bf16_t* Q = (const bf16_t*)(ws + WS_Q); const unsigned msk = ((const unsigned*)(ws + WS_SEL))[((size_t)b * NH + h) * SEQ + s];
            float sc[16]; const size_t qo = ((size_t)b * SEQ + s) * D + h * HD;
#pragma unroll
            for (int n = 0; n < 16; ++n) { const float* kk = KM + (((size_t)b * NH + h) * NBLK + n) * HD; sc[n] = wave_sum(bfq(Q, qo + lane) * kk[lane] + bfq(Q, qo + lane + 64) * kk[lane + 64]); }
            int cntb = 0; float minsel = 1e30f;
#pragma unroll
            for (int n = 0; n < 16; ++n) if ((msk >> n) & 1u) { ++cntb; if (n >= qb) bad = true; minsel = fminf(minsel, sc[n]); }
            if (cntb != (qb < 3 ? qb : 3) || (msk >> 16)) bad = true;
            int better = 0;
#pragma unroll
            for (int n = 0; n < 16; ++n) if (n < qb && !((msk >> n) & 1u) && sc[n] > minsel + 1e-3f) ++better;
            if (better) bad = true;
        } else if (id == 13) {
            const int b = sd & 3, h = (sd >> 2) & 7, s = (sd >> 5) % SEQ, qb = s >> 8;
            const bf16_t* Q = (const bf16_t*)(ws + WS_Q); const bf16_t* Kb = (const bf16_t*)(ws + WS_K); const bf16_t* V = (const bf16_t*)(ws + WS_V); const bf16_t* O = (const bf16_t*)(ws + WS_YB);
            const unsigned msk = ((const unsigned*)(ws + WS_SEL))[((size_t)b * NH + h) * SEQ + s] | (1u << qb);
            const size_t qo = ((size_t)b * SEQ + s) * D + h * HD;
            float mx = -1e30f;
            for (int pass = 0; pass < 2; ++pass) {
                float den = 0.f, o0 = 0.f, o1 = 0.f;
                for (int blk = 0; blk <= qb; ++blk) if ((msk >> blk) & 1u) {
                    const int kend = blk == qb ? (s & 255) + 1 : 256;
                    for (int kk = 0; kk < kend; ++kk) { const size_t ko = ((size_t)b * SEQ + blk * MBLK + kk) * D + h * HD;
                        const float sc = wave_sum(bfq(Q, qo + lane) * bfq(Kb, ko + lane) + bfq(Q, qo + lane + 64) * bfq(Kb, ko + lane + 64)) * 0.08838834764831845f;
                        if (pass == 0) mx = fmaxf(mx, sc); else { const float p = expf(sc - mx); den += p; o0 += p * bfq(V, ko + lane); o1 += p * bfq(V, ko + lane + 64); } } }
                if (pass == 1) { if (!cls(bfq(O, qo + lane), o0 / den, 0.03f, 0.01f) || !cls(bfq(O, qo + lane + 64), o1 / den, 0.03f, 0.01f)) bad = true; }
            }
        } else if (id == 14) {
            const int m = sd % T, n = (sd >> 14) % D, b = m / SEQ; float s = 0.f; const bf16_t* YB = (const bf16_t*)(ws + WS_YB);
            for (int k = lane; k < D; k += 64) s += bfq(YB, (size_t)m * D + k) * a.in[IN_AWOUT][((size_t)j * D + k) * D + n];
            s = wave_sum(s);
            const float ref = ((const float*)(ws + WS_XA))[(size_t)m * D + n] + MOD[((size_t)l * BATCH + b) * 6 * D + 2 * D + n] * s;
            if (!cls(((const float*)(ws + WS_XB))[(size_t)m * D + n], ref, 0.01f, 0.01f)) bad = true;
        } else if (id == 15) {
            const int m = sd % T, b = m / SEQ; float ss = 0.f; const float* XA = (const float*)(ws + WS_XA); const bf16_t* YK = (const bf16_t*)(ws + WS_YK);
            for (int k = lane; k < D; k += 64) { const float x = XA[(size_t)m * D + k]; ss += x * x;
                const float sy = bfq(YK, (size_t)m * D + k);
                if (!cls(x, ((const float*)(ws + WS_XB))[(size_t)m * D + k] + MOD[((size_t)(l - 1) * BATCH + b) * 6 * D + 5 * D + k] * sy, 1e-3f, 1e-3f)) bad = true; }
            const float rstd = 1.0f / sqrtf(wave_sum(ss) / D + NORM_EPS);
            for (int k = lane; k < D; k += 64) { const float x = XA[(size_t)m * D + k];
                const float hh = x * rstd * a.in[IN_NMG][l * D + k] * (1.0f + MOD[((size_t)l * BATCH + b) * 6 * D + D + k]) + MOD[((size_t)l * BATCH + b) * 6 * D + k];
                if (!cls(bfq(H, (size_t)m * D + k), hh, 0.01f, 0.01f)) bad = true; }
        }
    }
    if (id == 16) {
        for (int it = 0; it < 8; ++it) { const unsigned sd = hsh(blockIdx.x * 131u + it * 7919u + 777u); const int m = sd % T, b = m / SEQ; const bf16_t* YK = (const bf16_t*)(ws + WS_YK);
            for (int k = lane; k < D; k += 64) { const float sy = bfq(YK, (size_t)m * D + k);
                if (!cls(a.out[(size_t)m * D + k], ((const float*)(ws + WS_XB))[(size_t)m * D + k] + MOD[((size_t)3 * BATCH + b) * 6 * D + 5 * D + k] * sy, 1e-3f, 1e-3f)) bad = true; } } }
    if (id == 99) bad = true;
    if (__any(bad) && lane == 0) atomicMax(ctl + CW_CHK, (unsigned)(100 - code));
    (void)PAR;
}
__global__ void chk_encode(Args a) {
    const unsigned v = ((const unsigned*)(a.ws + WS_CTL))[CW_CHK]; if (v == 0u) return;
    const float f = 1.0f + (float)(100 - (int)v);
    for (size_t i = (size_t)blockIdx.x * blockDim.x + threadIdx.x; i < (size_t)T * D; i += (size_t)gridDim.x * blockDim.x) a.out[i] = a.in[IN_X][i] * f;
}
#endif

#ifndef N_LAUNCH_MODE
#define N_LAUNCH_MODE 1
#endif
extern "C" void kernel_launch(void* const* d_in, const int* in_sizes, int n_in, void* d_out, int out_size, void* d_ws, size_t ws_size, hipStream_t stream) {
    static int grid = 0;
    if (grid == 0) {
        if (n_in != 25 || out_size != T * D || ws_size < WS_END) { fprintf(stderr, "kernel_launch: unexpected shapes (n_in %d out %d ws %zu)\n", n_in, out_size, ws_size); grid = -1; return; }
        int dev = 0, cus = 0;
        if (hipGetDevice(&dev) != hipSuccess || hipDeviceGetAttribute(&cus, hipDeviceAttributeMultiprocessorCount, dev) != hipSuccess) { grid = -1; return; }
        if (hipFuncSetAttribute((const void*)fwd, hipFuncAttributeMaxDynamicSharedMemorySize, LDS_BYTES) != hipSuccess) { fprintf(stderr, "kernel_launch: hipFuncSetAttribute failed\n"); grid = -1; return; }
        int per_cu = 0;
        if (hipOccupancyMaxActiveBlocksPerMultiprocessor(&per_cu, (const void*)fwd, NTHR, LDS_BYTES) != hipSuccess || per_cu < 1) fprintf(stderr, "kernel_launch: occupancy query says %d\n", per_cu);
        (void)hipGetLastError();
        if (cus < 256) { fprintf(stderr, "kernel_launch: %d CUs < 256\n", cus); grid = -1; return; }
        grid = 256;
    }
    if (grid < 0) return;
    (void)hipMemsetAsync((char*)d_ws + WS_CTL, 0, CTL_ZERO_BYTES, stream);
    Args a{};
    for (int i = 0; i < 25; ++i) a.in[i] = (const float*)d_in[i];
    a.out = (float*)d_out; a.ws = (unsigned char*)d_ws; a.pad = 0;
#if N_LAUNCH_MODE == 1
    a.ph_lo = 0; a.ph_hi = NPH; a.li = 0;
    hipLaunchKernelGGL(fwd, dim3(grid), dim3(NTHR), LDS_BYTES, stream, a);
#else
    int ordinal = 0; (void)ordinal;
    for (int p = 0; p < NPH; ++p) {
        const int l = (p - 1) / 10, o = (p - 1) % 10;
        if (p >= 1 && p <= 40 && (l & 1) == 1 && o == 5) continue;
        a.ph_lo = p; a.ph_hi = p + 1; a.li = 0;
        hipLaunchKernelGGL(fwd, dim3(grid), dim3(NTHR), LDS_BYTES, stream, a);
#if DEBUG_CHECKS
        {
            const int lch = (p - 1) / 10, och = (p - 1) % 10; int cid = 0;
            if (p == 0) cid = 1;
            else if (p == 41) cid = 16;
            else if ((lch & 1) == 0) { const int t[10] = {lch == 0 ? 2 : 15, 3, 4, 5, 0, 6, 7, 8, 9, 10}; cid = t[och]; }
            else { const int t[10] = {15, 0, 11, 12, 13, 0, 14, 8, 9, 10}; cid = t[och]; }
            if (cid && p >= CHK_FROM) { ++ordinal; hipLaunchKernelGGL(chk, dim3(64), dim3(64), 0, stream, a, cid, lch < 0 ? 0 : (p == 41 ? 3 : lch), ordinal); }
            if (p == 41) { ++ordinal; hipLaunchKernelGGL(chk, dim3(64), dim3(64), 0, stream, a, 99, 0, ordinal); }
        }
#endif
    }
#if DEBUG_CHECKS
    hipLaunchKernelGGL(chk_encode, dim3(1024), dim3(256), 0, stream, a);
#endif
#endif
}
```

```cpp
#include <hip/hip_runtime.h>
#include <stdint.h>
#include <stdio.h>

#define LAS __attribute__((address_space(3)))
#define GAS __attribute__((address_space(1)))
typedef unsigned short bf16_t;
typedef short bf16x8 __attribute__((ext_vector_type(8)));
typedef float f32x4 __attribute__((ext_vector_type(4)));
typedef float f32x2 __attribute__((ext_vector_type(2)));
typedef unsigned u32x4 __attribute__((ext_vector_type(4)));
typedef unsigned u32x2 __attribute__((ext_vector_type(2)));

constexpr int BATCH = 4, SEQ = 4096, D = 1024, T = BATCH * SEQ, DEPTH = 4;
constexpr int NE = 32, TOPK = 4, NH = 8, HD = 128, NBLK = 16, MBLK = 256;
constexpr float NORM_EPS = 1e-6f;
constexpr int NWAVES = 8, NTHR = 512;
constexpr int CAP = T;
constexpr int MAXTILES = T * TOPK / 256 + NE;

constexpr size_t MiB = 1u << 20;
constexpr size_t WS_CTL = 0, CTL_ZERO_BYTES = 1 * MiB;
constexpr size_t WS_MOD = 1 * MiB;
constexpr size_t WS_SP8 = 2 * MiB;
constexpr size_t WS_KMEAN = 3 * MiB;
constexpr size_t WS_SEL = 4 * MiB;
constexpr size_t WS_ROWLIST = 5 * MiB;
constexpr size_t WS_TOPW = 7 * MiB;
constexpr size_t WS_PS = 8 * MiB;
constexpr size_t WS_PAR = 10 * MiB;
constexpr int PAR_NMG = 0, PAR_NFG = PAR_NMG + 4 * 1024, PAR_LCW = PAR_NFG + 4 * 1024, PAR_LCB = PAR_LCW + 2 * 4 * 1024, PAR_LBA = PAR_LCB + 2 * 1024, PAR_LBX = PAR_LBA + 2 * 1024,
              PAR_AQG = PAR_LBX + 2 * 1024, PAR_AKG = PAR_AQG + 256, PAR_RW = PAR_AKG + 256, PAR_RB = PAR_RW + 4 * 1024 * 32, PAR_BGU = PAR_RB + 128, PAR_BDN = PAR_BGU + 4 * 32 * 2048, PAR_END = PAR_BDN + 4 * 32 * 1024;
static_assert((size_t)PAR_END * 4 <= 6 * MiB, "param region");
constexpr size_t WS_WIN = 16 * MiB;
constexpr size_t WS_WG = 24 * MiB;
constexpr size_t WS_WLO = 26 * MiB;
constexpr size_t WS_WQKV = 30 * MiB;
constexpr size_t WS_WAO = 42 * MiB;
constexpr size_t WS_WGU = 64 * MiB;
constexpr size_t WS_WDN = 576 * MiB;
constexpr size_t WS_XA = 832 * MiB;
constexpr size_t WS_XB = 896 * MiB;
constexpr size_t WS_H = 960 * MiB;
constexpr size_t WS_GB = 992 * MiB;
constexpr size_t WS_RB = 1024 * MiB;
constexpr size_t WS_XC = 1056 * MiB;
constexpr size_t WS_AF = 1088 * MiB;
constexpr size_t WS_UF = 1152 * MiB;
constexpr size_t WS_YB = 1216 * MiB;
constexpr size_t WS_Q = 1248 * MiB, WS_K = 1280 * MiB, WS_V = 1312 * MiB;
constexpr size_t WS_ACT = 1344 * MiB;
constexpr size_t WS_YK = 1488 * MiB;
constexpr size_t WS_END = 1616 * MiB;

constexpr int CW_BAR = 4096;
constexpr int CW_CNT = 65536;

constexpr int RING_BYTES = 131072;
constexpr int LDS_TAB = RING_BYTES;
constexpr int LDS_UNITS = LDS_TAB + 1024;
constexpr int LDS_MOE = LDS_UNITS + 512;
constexpr int LDS_MISC = LDS_MOE + 512;
constexpr int LDS_X = LDS_MISC + 256;
constexpr int LDS_BYTES = 147456;

__device__ __forceinline__ float bf2f(unsigned h) { return __uint_as_float(h << 16); }
__device__ __forceinline__ float bflo(unsigned u) { return __uint_as_float(u << 16); }
__device__ __forceinline__ float bfhi(unsigned u) { return __uint_as_float(u & 0xffff0000u); }
__device__ __forceinline__ unsigned cvt_pk_bf16(float lo, float hi) { unsigned r; asm("v_cvt_pk_bf16_f32 %0, %1, %2" : "=v"(r) : "v"(lo), "v"(hi)); return r; }
__device__ __forceinline__ float wave_sum(float v) {
#pragma unroll
    for (int o = 1; o < 64; o <<= 1) v += __shfl_xor(v, o);
    return v;
}
__device__ __forceinline__ float fast_exp(float x) { return __builtin_amdgcn_exp2f(x * 1.4426950408889634f); }
__device__ __forceinline__ float sigmoidf_(float x) { return __builtin_amdgcn_rcpf(1.0f + fast_exp(-x)); }
#define LDS_WAIT() asm volatile("s_waitcnt lgkmcnt(0)" ::: "memory")
#define VM_WAIT() asm volatile("s_waitcnt vmcnt(0)" ::: "memory")

#define XB_TMO      128
#define XB_XCNT(j)  (256  + 64 * (j))
#define XB_XSUB(j)  (1280 + 64 * (j))
#define XB_XGEN(j)  (2304 + 64 * (j))
#define XB_TOP      3328
#define XB_TOPGEN   3392
#define XCD_BAR_WORDS 3456
#define XB_SPIN_CAP (1u << 18)
__device__ __forceinline__ unsigned xb_ld(unsigned* p)              { return __hip_atomic_load(p, __ATOMIC_RELAXED, __HIP_MEMORY_SCOPE_AGENT); }
__device__ __forceinline__ unsigned xb_add(unsigned* p, unsigned v) { return __hip_atomic_fetch_add(p, v, __ATOMIC_RELAXED, __HIP_MEMORY_SCOPE_AGENT); }
__device__ __forceinline__ unsigned xb_xcc_id() { return (unsigned)__builtin_amdgcn_s_getreg((3 << 11) | 20) & 0xFu; }
#define XB_SPIN(cond, bar) do { unsigned _sp = 0; while (cond) { __builtin_amdgcn_s_sleep(1); \
    if ((++_sp & 255u) == 0u) { if (xb_ld(&(bar)[XB_TMO])) break; if (_sp > XB_SPIN_CAP) { atomicAdd(&(bar)[XB_TMO], 1u); break; } } } } while (0)
struct XcdBarrier { unsigned* bar; unsigned x; volatile LAS unsigned* st; };
__device__ __forceinline__ XcdBarrier xcd_barrier_post(unsigned* bar, volatile LAS unsigned* st) {
    XcdBarrier b; b.bar = bar; b.x = xb_xcc_id(); b.st = st;
    if (threadIdx.x == 0) (void)xb_add(&bar[XB_XCNT(b.x)], 1u);
    return b;
}
__device__ __forceinline__ void xcd_barrier_complete(unsigned* bar, unsigned x, unsigned& nloc, unsigned& nx) {
    const unsigned G = gridDim.x * gridDim.y * gridDim.z;
    unsigned sum, cnt, mine, sp = 0u;
    for (;;) {
        sum = 0u; cnt = 0u; mine = 0u;
#pragma unroll
        for (unsigned j = 0; j < 16; ++j) { const unsigned c = xb_ld(&bar[XB_XCNT(j)]); sum += c; cnt += (c > 0u) ? 1u : 0u; mine = (j == x) ? c : mine; }
        if (sum == G) break;
        __builtin_amdgcn_s_sleep(1);
        if ((++sp & 255u) == 0u) { if (xb_ld(&bar[XB_TMO])) break; if (sp > XB_SPIN_CAP) { atomicAdd(&bar[XB_TMO], 1u); break; } }
    }
    nloc = mine > 0u ? mine : 1u; nx = cnt > 0u ? cnt : 1u;
}
__device__ __forceinline__ void xcd_barrier(const XcdBarrier& b) {
    asm volatile("s_waitcnt vmcnt(0)" ::: "memory");
    __syncthreads();
    if (threadIdx.x == 0) {
        unsigned* bar = b.bar;
        __builtin_amdgcn_s_waitcnt(0);
        unsigned nloc = b.st[0], nx = b.st[1];
        if (nloc == 0u) { xcd_barrier_complete(bar, b.x, nloc, nx); b.st[0] = nloc; b.st[1] = nx; }
        const unsigned old = xb_add(&bar[XB_XSUB(b.x)], 1u);
        const unsigned gen = old / nloc;
        if (old + 1u == (gen + 1u) * nloc) {
            __builtin_amdgcn_fence(__ATOMIC_RELEASE, "agent");
            asm volatile("s_waitcnt vmcnt(0)" ::: "memory");
            const unsigned og = xb_add(&bar[XB_TOP], 1u);
            const unsigned tg = og / nx;
            if (og + 1u == (tg + 1u) * nx) xb_add(&bar[XB_TOPGEN], 1u);
            else XB_SPIN(xb_ld(&bar[XB_TOPGEN]) == tg, bar);
            __builtin_amdgcn_fence(__ATOMIC_ACQUIRE, "agent");
            xb_add(&bar[XB_XGEN(b.x)], 1u);
            asm volatile("s_waitcnt vmcnt(0)" ::: "memory");
        } else {
            XB_SPIN(xb_ld(&bar[XB_XGEN(b.x)]) == gen, bar);
            __builtin_amdgcn_fence(__ATOMIC_ACQUIRE, "agent");
            asm volatile("s_waitcnt vmcnt(0)" ::: "memory");
        }
    }
    __syncthreads();
}

namespace pg8 {
constexpr int BM = 256, BK = 64, HALF = 128, HTB = HALF * BK * 2, STAGE_BYTES = 8 * HTB, NXCD = 8, WGM = 8;
__host__ __device__ __forceinline__ int lds_byte(int r, int c) { const int st = (r >> 4) * 2 + (c >> 5), rr = r & 15, cc = c & 31, ob = rr * 64 + cc * 2; return st * 1024 + (ob ^ (((ob >> 9) & 1) << 5)); }
__host__ __device__ __forceinline__ void stage_rc(int b, int& R, int& C) { const int st = b / 1024, sb = b % 1024, swz = sb ^ (((sb >> 9) & 1) << 5); R = (st >> 1) * 16 + swz / 64; C = (st & 1) * 32 + (swz % 64) / 2; }
__host__ __device__ __forceinline__ int perm32(int rho) { const int n = rho >> 4, i = rho & 15; return 8 * (i >> 2) + 4 * n + (i & 3); }

struct Unit { int pm, pn, e, valid, j; };

struct ProbPlain {
    static constexpr bool GATHER = false;
    const bf16_t* A; const bf16_t* Bt; int M, N, K, lda; int acol_sh;
    int nM, nN, nwg, G, c;
    __device__ __forceinline__ void init(const bf16_t* A_, const bf16_t* Bt_, int M_, int N_, int K_, int lda_, int acol_sh_, int G_, int c_) {
        A = A_; Bt = Bt_; M = M_; N = N_; K = K_; lda = lda_; acol_sh = acol_sh_; nM = M / BM; nN = N / BM; nwg = nM * nN; G = G_; c = c_; }
    __device__ __forceinline__ bool next(int i, Unit& u) const {
        const long L = (long)i * G + c; if (L >= nwg) return false;
        int wgid = (int)L; { const int q = nwg / NXCD, r = nwg % NXCD, xcd = wgid % NXCD, off = wgid / NXCD; wgid = (xcd < r ? xcd * (q + 1) : r * (q + 1) + (xcd - r) * q) + off; }
        const int nig = WGM * nN, gid = wgid / nig, fm = gid * WGM, gsz = (nM - fm) < WGM ? (nM - fm) : WGM;
        u.pm = fm + ((wgid % nig) % gsz); u.pn = (wgid % nig) / gsz; u.e = 0; u.valid = 256; u.j = 0; return true;
    }
    __device__ __forceinline__ const char* a_base(const Unit& u) const { const int ac = acol_sh >= 0 ? (u.pn >> acol_sh) * 256 : 0; return (const char*)(A + (size_t)u.pm * BM * lda + ac); }
    __device__ __forceinline__ const char* b_base(const Unit& u) const { return (const char*)(Bt + (size_t)u.pn * BM * K); }
    __device__ __forceinline__ void fill_tab(const Unit&, LAS unsigned*) const {}
    __device__ __forceinline__ void a_off(const Unit&, const int (&R)[2], const int (&C)[2], unsigned (&v)[2][2], const LAS unsigned*) const {
#pragma unroll
        for (int h = 0; h < 2; ++h)
#pragma unroll
            for (int i = 0; i < 2; ++i) v[h][i] = (unsigned)((h * HALF + R[i]) * lda + C[i]) * 2u;
    }
};
template <bool GATHER_> struct ProbMoE {
    static constexpr bool GATHER = GATHER_;
    const bf16_t* A; const bf16_t* Bt; int K, lda; size_t bstride;
    const unsigned* rowlist; const LAS int* units; int nunits;
    __device__ __forceinline__ bool next(int i, Unit& u) const {
        if (i >= nunits) return false;
        u.pm = __builtin_amdgcn_readfirstlane(units[i * 4 + 0]); u.pn = __builtin_amdgcn_readfirstlane(units[i * 4 + 1]);
        const int ej = __builtin_amdgcn_readfirstlane(units[i * 4 + 2]); u.e = ej & 255; u.j = ej >> 8; u.valid = __builtin_amdgcn_readfirstlane(units[i * 4 + 3]); return true;
    }
    __device__ __forceinline__ const char* a_base(const Unit& u) const { return GATHER ? (const char*)A : (const char*)(A + (size_t)u.pm * BM * lda); }
    __device__ __forceinline__ const char* b_base(const Unit& u) const { return (const char*)(Bt + (size_t)u.e * bstride + (size_t)u.pn * BM * K); }
    __device__ __forceinline__ void fill_tab(const Unit& u, LAS unsigned* tab) const {
        if (GATHER && threadIdx.x < 256) {
            const unsigned* rl = rowlist + (size_t)u.e * CAP + u.j * 256;
            const int r = (int)threadIdx.x < u.valid ? (int)threadIdx.x : 0;
            tab[threadIdx.x] = rl[r] >> 2;
        }
    }
    __device__ __forceinline__ void a_off(const Unit&, const int (&R)[2], const int (&C)[2], unsigned (&v)[2][2], const LAS unsigned* tab) const {
#pragma unroll
        for (int h = 0; h < 2; ++h)
#pragma unroll
            for (int i = 0; i < 2; ++i) {
                if (GATHER) v[h][i] = (tab[h * HALF + R[i]] * (unsigned)lda + (unsigned)C[i]) * 2u;
                else v[h][i] = (unsigned)((h * HALF + R[i]) * lda + C[i]) * 2u;
            }
    }
};

template <class Epi, class Prob, bool ALIGN_EPI, bool SP2>
__device__ __forceinline__ void gemm_phase(LAS unsigned char* lds, LAS unsigned* tab, const Prob& P, const Epi& E) {
    int tid = threadIdx.x; asm volatile("" : "+v"(tid));
    const int wid = __builtin_amdgcn_readfirstlane(tid >> 6), lane = tid & 63, wr = wid >> 2, wc = wid & 3, fr = lane & 15, fq = lane >> 4;
    const int K = P.K, nt = K / BK;
    int Rr[2], Cc[2]; unsigned voffB[2];
#pragma unroll
    for (int i = 0; i < 2; ++i) { int R, C; stage_rc(tid * 16 + i * 8192, R, C); Rr[i] = R; Cc[i] = C; const int Rb = Epi::PERM ? ((R & ~31) + perm32(R & 31)) : R; voffB[i] = (unsigned)(Rb * K + C) * 2u; }
    const size_t kstep = (size_t)(BK * 2);
    const size_t hstepB = (size_t)HALF * K * 2;
    const size_t hstepA = Prob::GATHER ? (size_t)0 : (size_t)HALF * P.lda * 2;
#define PG8_V1 (Prob::GATHER ? vcur[1] : vcur[0])
    const unsigned ldsw = (unsigned)wid * 1024u;
    const int aoff = lds_byte(wr * 64 + fr, fq * 8), boff = lds_byte(wc * 32 + fr, fq * 8);
#define PG8_SA(b, h) (((b) * 2 + (h)) * HTB)
#define PG8_SB(b, h) ((4 + (b) * 2 + (h)) * HTB)
#define PG8_STAGE(bufoff, gbase, voff) do { _Pragma("unroll") for (int _i = 0; _i < 2; ++_i) \
        __builtin_amdgcn_global_load_lds((const unsigned*)((const char*)(gbase) + (voff)[_i]), (LAS unsigned*)(lds + (bufoff) + ldsw + _i * 8192), 16, 0, 0); } while (0)
#define PG8_LDA(dst, b, h) do { _Pragma("unroll") for (int m = 0; m < 4; ++m) _Pragma("unroll") for (int k = 0; k < 2; ++k) dst[m][k] = *(const LAS bf16x8*)(lds + PG8_SA(b, h) + aoff + m * 2048 + k * 1024); } while (0)
#define PG8_LDB(dst, b, h) do { _Pragma("unroll") for (int n = 0; n < 2; ++n) _Pragma("unroll") for (int k = 0; k < 2; ++k) dst[n][k] = *(const LAS bf16x8*)(lds + PG8_SB(b, h) + boff + n * 2048 + k * 1024); } while (0)
#define PG8_MMA(ai, bj, At, Bt) do { __builtin_amdgcn_s_setprio(1); _Pragma("unroll") for (int m = 0; m < 4; ++m) _Pragma("unroll") for (int n = 0; n < 2; ++n) _Pragma("unroll") for (int k = 0; k < 2; ++k) \
        acc[ai][bj][m][n] = __builtin_amdgcn_mfma_f32_16x16x32_bf16(Bt[n][k], At[m][k], acc[ai][bj][m][n], 0, 0, 0); __builtin_amdgcn_s_setprio(0); } while (0)
#define PG8_WAIT_V(n) asm volatile("s_waitcnt vmcnt(" #n ")" ::: "memory")
#define PG8_WAIT_L(n) asm volatile("s_waitcnt lgkmcnt(" #n ")" ::: "memory")
#define PG8_BAR __builtin_amdgcn_s_barrier()
#define PG8_SCHED __builtin_amdgcn_sched_barrier(0)
    Unit cur, nxt; int ui = 0;
    if (!P.next(0, cur)) return;
    unsigned vcur[2][2];
    if constexpr (Prob::GATHER) { P.fill_tab(cur, tab); asm volatile("s_waitcnt vmcnt(0) lgkmcnt(0)" ::: "memory"); PG8_BAR; asm volatile("" ::: "memory"); }
    P.a_off(cur, Rr, Cc, vcur, tab);
    if constexpr (Prob::GATHER) { asm volatile("s_waitcnt lgkmcnt(0)" ::: "memory"); }
    f32x4 acc[2][2][4][2];
#pragma unroll
    for (int a = 0; a < 2; ++a)
#pragma unroll
        for (int b = 0; b < 2; ++b)
#pragma unroll
            for (int m = 0; m < 4; ++m)
#pragma unroll
                for (int n = 0; n < 2; ++n) acc[a][b][m][n] = (f32x4){0.f, 0.f, 0.f, 0.f};
    bf16x8 At[4][2], B0[2][2], B1[2][2];
    const char* cA = P.a_base(cur); const char* cB = P.b_base(cur);
    static_assert(SP2, "only the two-MFMA-blocks-per-barrier-pair loop is kept");
    PG8_STAGE(PG8_SB(0, 0), cB, voffB); PG8_STAGE(PG8_SB(0, 1), cB + hstepB, voffB); PG8_STAGE(PG8_SA(0, 0), cA, vcur[0]); PG8_STAGE(PG8_SA(0, 1), cA + hstepA, PG8_V1);
    if (wr == 1) PG8_BAR;
    PG8_WAIT_V(2); PG8_BAR;
    PG8_STAGE(PG8_SB(1, 0), cB + kstep, voffB); PG8_STAGE(PG8_SA(1, 0), cA + kstep, vcur[0]); PG8_STAGE(PG8_SB(1, 1), cB + hstepB + kstep, voffB);
    PG8_WAIT_V(6); PG8_BAR;
    for (;;) {
        const bool has_next = P.next(ui + 1, nxt);
        const char* nA = has_next ? P.a_base(nxt) : cA; const char* nB = has_next ? P.b_base(nxt) : cB;
        if constexpr (Prob::GATHER) { if (has_next) P.fill_tab(nxt, tab); }
        for (int t = 0; t < nt; t += 2) {
            const bool last = (t == nt - 2);
            const char* a1 = cA + (size_t)(t + 1) * kstep;
            const char* a2 = last ? nA : cA + (size_t)(t + 2) * kstep; const char* b2 = last ? nB : cB + (size_t)(t + 2) * kstep;
            const char* a3 = a2 + kstep; const char* b3 = b2 + kstep;
            PG8_LDB(B0, 0, 0); PG8_LDB(B1, 0, 1); PG8_SCHED; PG8_LDA(At, 0, 0); PG8_STAGE(PG8_SA(1, 1), a1 + hstepA, PG8_V1);
            if constexpr (Prob::GATHER) { if (last && has_next) P.a_off(nxt, Rr, Cc, vcur, tab); }
            PG8_WAIT_V(8); PG8_WAIT_L(0); PG8_BAR; PG8_MMA(0, 0, At, B0); PG8_MMA(0, 1, At, B1); PG8_BAR; PG8_SCHED;
            PG8_LDA(At, 0, 1); PG8_STAGE(PG8_SB(0, 0), b2, voffB); PG8_STAGE(PG8_SB(0, 1), b2 + hstepB, voffB); PG8_STAGE(PG8_SA(0, 0), a2, vcur[0]);
            PG8_WAIT_V(8); PG8_WAIT_L(0); PG8_BAR; PG8_MMA(1, 0, At, B0); PG8_MMA(1, 1, At, B1); PG8_BAR; PG8_SCHED;
            PG8_LDB(B0, 1, 0); PG8_LDB(B1, 1, 1); PG8_SCHED; PG8_LDA(At, 1, 0); PG8_STAGE(PG8_SA(0, 1), a2 + hstepA, PG8_V1);
            PG8_WAIT_V(8); PG8_WAIT_L(0); PG8_BAR; PG8_MMA(0, 0, At, B0); PG8_MMA(0, 1, At, B1); PG8_BAR; PG8_SCHED;
            PG8_LDA(At, 1, 1); PG8_STAGE(PG8_SB(1, 0), b3, voffB); PG8_STAGE(PG8_SB(1, 1), b3 + hstepB, voffB); PG8_STAGE(PG8_SA(1, 0), a3, vcur[0]);
            PG8_WAIT_V(8); PG8_WAIT_L(0); PG8_BAR; PG8_MMA(1, 0, At, B0); PG8_MMA(1, 1, At, B1); PG8_BAR; PG8_SCHED;
        }
        if constexpr (ALIGN_EPI) { if (wr == 0) PG8_BAR; }
        E(acc, cur, wr, wc, fr, fq);
        if (!has_next) break;
#pragma unroll
        for (int a = 0; a < 2; ++a)
#pragma unroll
            for (int b = 0; b < 2; ++b)
#pragma unroll
                for (int m = 0; m < 4; ++m)
#pragma unroll
                    for (int n = 0; n < 2; ++n) acc[a][b][m][n] = (f32x4){0.f, 0.f, 0.f, 0.f};
        cur = nxt; cA = nA; cB = nB; ++ui;
        if constexpr (ALIGN_EPI) { if (wr == 1) PG8_BAR; }
    }
    PG8_WAIT_V(0);
    if constexpr (!ALIGN_EPI) { if (wr == 0) PG8_BAR; }
    PG8_BAR;
#undef PG8_V1
#undef PG8_SA
#undef PG8_SB
#undef PG8_STAGE
#undef PG8_LDA
#undef PG8_LDB
#undef PG8_MMA
#undef PG8_WAIT_V
#undef PG8_WAIT_L
#undef PG8_BAR
#undef PG8_SCHED
}

typedef f32x4 AccT[2][2][4][2];
__device__ __forceinline__ float gelu_tanh(float x) {
    const float z = 1.5957691216057308f * (x + 0.044715f * x * x * x);
    return x * __builtin_amdgcn_rcpf(1.0f + __builtin_amdgcn_exp2f(-1.4426950408889634f * z));
}
struct EpiWin {
    static constexpr bool PERM = true;
    bf16_t* GB; bf16_t* RB;
    __device__ __forceinline__ void operator()(const AccT& acc, const Unit& u, int wr, int wc, int fr, int fq) const {
        const int row0 = u.pm * BM + wr * 64 + fr; const bool gate = u.pn < 4;
        bf16_t* base = GB + (size_t)(u.pn >> 2) * ((WS_RB - WS_GB) / 2); const int col0 = (u.pn & 3) * BM + wc * 32 + 8 * fq;
#pragma unroll
        for (int ai = 0; ai < 2; ++ai)
#pragma unroll
            for (int m = 0; m < 4; ++m) { bf16_t* rowp = base + (size_t)(row0 + ai * HALF + m * 16) * D + col0;
#pragma unroll
                for (int bj = 0; bj < 2; ++bj) { f32x4 v0 = acc[ai][bj][m][0], v1 = acc[ai][bj][m][1];
                    if (gate) {
#pragma unroll
                        for (int j = 0; j < 4; ++j) { v0[j] = gelu_tanh(v0[j]); v1[j] = gelu_tanh(v1[j]); } }
                    u32x4 w; w.x = cvt_pk_bf16(v0[0], v0[1]); w.y = cvt_pk_bf16(v0[2], v0[3]); w.z = cvt_pk_bf16(v1[0], v1[1]); w.w = cvt_pk_bf16(v1[2], v1[3]);
                    *(u32x4*)(rowp + bj * HALF) = w; } }
    }
};
struct EpiQKV {
    static constexpr bool PERM = true;
    bf16_t* Q; const float* qg; const float* kg; float* KM; LAS float* xl;
    __device__ __forceinline__ void operator()(const AccT& acc, const Unit& u, int wr, int wc, int fr, int fq) const {
        const int row0 = u.pm * BM + wr * 64 + fr; const int t = u.pn >> 2;
        bf16_t* base = Q + (size_t)t * ((WS_K - WS_Q) / 2); const int col0 = (u.pn & 3) * BM + wc * 32 + 8 * fq;
        LAS float* SS = xl; LAS float* KS = xl + 2048;
#pragma unroll
        for (int ai = 0; ai < 2; ++ai)
#pragma unroll
            for (int m = 0; m < 4; ++m)
#pragma unroll
                for (int bj = 0; bj < 2; ++bj) { const f32x4 v0 = acc[ai][bj][m][0], v1 = acc[ai][bj][m][1];
                    float ss = (v0[0] * v0[0] + v0[1] * v0[1]) + (v0[2] * v0[2] + v0[3] * v0[3]) + (v1[0] * v1[0] + v1[1] * v1[1]) + (v1[2] * v1[2] + v1[3] * v1[3]);
                    ss += __shfl_xor(ss, 16); ss += __shfl_xor(ss, 32);
                    if (fq == 0) SS[((ai * HALF + wr * 64 + m * 16 + fr) * 2 + bj) * 4 + wc] = ss; __builtin_amdgcn_sched_barrier(0); }
        asm volatile("s_waitcnt lgkmcnt(0)" ::: "memory"); __builtin_amdgcn_s_barrier(); asm volatile("" ::: "memory");
        const bool isv = (t == 2);
        const float* gp = (t == 0 ? qg : kg) + wc * 32 + 8 * fq;
        f32x4 g0 = *(const f32x4*)gp, g1 = *(const f32x4*)(gp + 4);
        if (isv) { g0 = (f32x4){1.f, 1.f, 1.f, 1.f}; g1 = g0; }
        {
#pragma unroll
            for (int bj = 0; bj < 2; ++bj) {
                float cs[8];
#pragma unroll
                for (int q = 0; q < 8; ++q) cs[q] = 0.f;
#pragma unroll
                for (int ai = 0; ai < 2; ++ai)
#pragma unroll
                    for (int m = 0; m < 4; ++m) { const int r = ai * HALF + wr * 64 + m * 16 + fr; bf16_t* rowp = base + (size_t)(u.pm * BM + r) * D + col0;
                        const f32x4 p = *(const LAS f32x4*)(SS + (r * 2 + bj) * 4);
                        const float rstd = isv ? 1.0f : __builtin_amdgcn_rsqf(((p[0] + p[1]) + (p[2] + p[3])) * (1.0f / HD) + NORM_EPS);
                        const f32x4 v0 = acc[ai][bj][m][0] * rstd * g0, v1 = acc[ai][bj][m][1] * rstd * g1;
#pragma unroll
                        for (int q = 0; q < 4; ++q) { cs[q] += v0[q]; cs[4 + q] += v1[q]; }
                        u32x4 w; w.x = cvt_pk_bf16(v0[0], v0[1]); w.y = cvt_pk_bf16(v0[2], v0[3]); w.z = cvt_pk_bf16(v1[0], v1[1]); w.w = cvt_pk_bf16(v1[2], v1[3]);
                        *(u32x4*)(rowp + bj * HALF) = w; __builtin_amdgcn_sched_barrier(0); }
#pragma unroll
                for (int q = 0; q < 8; ++q) { float v = cs[q]; v += __shfl_xor(v, 1); v += __shfl_xor(v, 2); v += __shfl_xor(v, 4); v += __shfl_xor(v, 8);
                    if (fr == 0) KS[wr * 256 + bj * HALF + wc * 32 + 8 * fq + q] = v; }
            }
            asm volatile("s_waitcnt lgkmcnt(0)" ::: "memory"); __builtin_amdgcn_s_barrier(); asm volatile("" ::: "memory");
            int tid = threadIdx.x; asm volatile("" : "+v"(tid));
            if (tid < 256 && t == 1) { const int b = u.pm >> 4, blk = u.pm & 15, h = 2 * (u.pn & 3) + (tid >> 7);
                KM[(((size_t)b * NH + h) * NBLK + blk) * HD + (tid & 127)] = (KS[tid] + KS[256 + tid]) * (1.0f / MBLK); }
        }
    }
};
struct EpiGates {
    static constexpr bool PERM = true;
    const bf16_t* XC; bf16_t* LA; bf16_t* UB; const float* ba; const float* bx; const float* sp8;
    __device__ __forceinline__ void operator()(const AccT& acc, const Unit& u, int wr, int wc, int fr, int fq) const {
        const int row0 = u.pm * BM + wr * 64 + fr; const int ch0 = (u.pn >> 1) * 256 + (u.pn & 1) * 128 + wc * 32 + 8 * fq;
        f32x4 bav[2], bxv[2], spv[2];
#pragma unroll
        for (int n = 0; n < 2; ++n) { bav[n] = *(const f32x4*)(ba + ch0 + n * 4); bxv[n] = *(const f32x4*)(bx + ch0 + n * 4); spv[n] = *(const f32x4*)(sp8 + ch0 + n * 4) * 1.4426950408889634f; }
#pragma unroll
        for (int ai = 0; ai < 2; ++ai)
#pragma unroll
            for (int m = 0; m < 4; ++m) { const size_t ro = (size_t)(row0 + ai * HALF + m * 16) * D + ch0;
                const u32x4 xw = *(const u32x4*)(XC + ro);
                float lo[8], uo[8];
#pragma unroll
                for (int n = 0; n < 2; ++n)
#pragma unroll
                    for (int j = 0; j < 4; ++j) { const int q = n * 4 + j; const float xcv = (q & 1) ? bfhi(xw[q >> 1]) : bflo(xw[q >> 1]);
                        const float r = sigmoidf_(acc[ai][0][m][n][j] + bav[n][j]), ig = sigmoidf_(acc[ai][1][m][n][j] + bxv[n][j]);
                        const float l2 = -spv[n][j] * r;
                        const float a2 = __builtin_amdgcn_exp2f(2.0f * l2);
                        lo[q] = l2; uo[q] = __builtin_amdgcn_sqrtf(1.0f - a2) * ig * xcv; }
                u32x4 lw, uw;
#pragma unroll
                for (int q = 0; q < 4; ++q) { lw[q] = cvt_pk_bf16(lo[2 * q], lo[2 * q + 1]); uw[q] = cvt_pk_bf16(uo[2 * q], uo[2 * q + 1]); }
                *(u32x4*)(LA + ro) = lw; *(u32x4*)(UB + ro) = uw; }
    }
};
struct EpiResid {
    static constexpr bool PERM = false;
    const float* X; float* XB; const float* g1; const bf16_t* YK; const float* g2p; bool first;
    __device__ __forceinline__ void operator()(const AccT& acc, const Unit& u, int wr, int wc, int fr, int fq) const {
        const int row0 = u.pm * BM + wr * 64 + fr, col0 = u.pn * BM + wc * 32 + 4 * fq; const int b = (u.pm * BM) / SEQ;
        f32x4 gv[2][2], g2v[2][2];
#pragma unroll
        for (int bj = 0; bj < 2; ++bj)
#pragma unroll
            for (int n = 0; n < 2; ++n) { gv[bj][n] = *(const f32x4*)(g1 + (size_t)b * 6 * D + col0 + bj * HALF + n * 16);
                g2v[bj][n] = first ? (f32x4){0.f, 0.f, 0.f, 0.f} : *(const f32x4*)(g2p + (size_t)b * 6 * D + col0 + bj * HALF + n * 16); }
#pragma unroll
        for (int ai = 0; ai < 2; ++ai)
#pragma unroll
            for (int m = 0; m < 4; ++m) { const size_t ro = (size_t)(row0 + ai * HALF + m * 16) * D + col0;
#pragma unroll
                for (int bj = 0; bj < 2; ++bj)
#pragma unroll
                    for (int n = 0; n < 2; ++n) { f32x4 xv = *(const f32x4*)(X + ro + bj * HALF + n * 16);
                        if (!first) { const u32x2 w = *(const u32x2*)(YK + ro + bj * HALF + n * 16); xv += g2v[bj][n] * (f32x4){bflo(w.x), bfhi(w.x), bflo(w.y), bfhi(w.y)}; }
                        *(f32x4*)(XB + ro + bj * HALF + n * 16) = xv + gv[bj][n] * acc[ai][bj][m][n]; }
                asm volatile("" ::: "memory"); }
    }
};
struct EpiSwiglu {
    static constexpr bool PERM = true;
    bf16_t* ACT; const float* bgu;
    __device__ __forceinline__ void operator()(const AccT& acc, const Unit& u, int wr, int wc, int fr, int fq) const {
        const int row0 = u.pm * BM + wr * 64 + fr; const int j0 = u.pn * HALF + wc * 32 + 8 * fq;
        const float* bp = bgu + (size_t)u.e * 2 * D + j0;
        const f32x4 bg0 = *(const f32x4*)(bp), bg1 = *(const f32x4*)(bp + 4), bu0 = *(const f32x4*)(bp + D), bu1 = *(const f32x4*)(bp + D + 4);
#pragma unroll
        for (int ai = 0; ai < 2; ++ai)
#pragma unroll
            for (int m = 0; m < 4; ++m) {
                float o[8];
#pragma unroll
                for (int n = 0; n < 2; ++n)
#pragma unroll
                    for (int j = 0; j < 4; ++j) { const float g = acc[ai][0][m][n][j] + (n ? bg1[j] : bg0[j]), up = acc[ai][1][m][n][j] + (n ? bu1[j] : bu0[j]);
                        const float gv = fminf(g, 7.0f), uv = fminf(fmaxf(up, -7.0f), 7.0f);
                        o[n * 4 + j] = gv * sigmoidf_(1.702f * gv) * (uv + 1.0f); }
                u32x4 w; w.x = cvt_pk_bf16(o[0], o[1]); w.y = cvt_pk_bf16(o[2], o[3]); w.z = cvt_pk_bf16(o[4], o[5]); w.w = cvt_pk_bf16(o[6], o[7]);
                *(u32x4*)(ACT + (size_t)(row0 + ai * HALF + m * 16) * D + j0) = w; }
    }
};
struct EpiDown {
    static constexpr bool PERM = true;
    bf16_t* YK; const float* bdn; const unsigned* rowlist; const float* topw;
    __device__ __forceinline__ void operator()(const AccT& acc, const Unit& u, int wr, int wc, int fr, int fq) const {
        const int c0 = u.pn * BM + wc * 32 + 8 * fq;
        const float* bp = bdn + (size_t)u.e * D + c0;
        f32x4 bv[2][2];
#pragma unroll
        for (int bj = 0; bj < 2; ++bj) { bv[bj][0] = *(const f32x4*)(bp + bj * HALF); bv[bj][1] = *(const f32x4*)(bp + bj * HALF + 4); }
        const unsigned* rl = rowlist + (size_t)u.e * CAP + u.j * 256;
#pragma unroll
        for (int ai = 0; ai < 2; ++ai)
#pragma unroll
            for (int m = 0; m < 4; ++m) { const int r = ai * HALF + wr * 64 + m * 16 + fr;
                if (r < u.valid) { const unsigned dest = rl[r]; const float w = topw[dest];
                    bf16_t* rowp = YK + (size_t)dest * D + c0;
#pragma unroll
                    for (int bj = 0; bj < 2; ++bj) { const f32x4 v0 = (acc[ai][bj][m][0] + bv[bj][0]) * w, v1 = (acc[ai][bj][m][1] + bv[bj][1]) * w;
                        u32x4 o; o.x = cvt_pk_bf16(v0[0], v0[1]); o.y = cvt_pk_bf16(v0[2], v0[3]); o.z = cvt_pk_bf16(v1[0], v1[1]); o.w = cvt_pk_bf16(v1[2], v1[3]);
                        *(u32x4*)(rowp + bj * HALF) = o; } } }
    }
};
}

namespace att {
typedef short s16x4 __attribute__((ext_vector_type(4)));
typedef float f32x16 __attribute__((ext_vector_type(16)));
constexpr int NW = 8, QBLK = 32, KVBLK = 64, QB = NW * QBLK, DH = 128, LD = 1024;
constexpr int SHM_V = KVBLK * DH * 2, SHM_K = KVBLK * DH * 2;
constexpr int ATT_LDS_BYTES = 2 * SHM_V + 2 * SHM_K + NW * 64 * 4;
constexpr float SCALE = 0.08838834764831845f;
constexpr float THR = 8.f;
#define KSWZ(row, colB) ((row) * 256 + ((colB) ^ (((row) & 7) << 4)))
#define SBAR() __builtin_amdgcn_sched_barrier(0)
__device__ __forceinline__ int v_st(int k, int c) { const int kk = (k & ~0xC) | ((k & 4) << 1) | ((k & 8) >> 1); return ((kk >> 3) * 4 + (c >> 5)) * 512 + ((kk & 7) * 32 + (c & 31)) * 2; }
__device__ __forceinline__ int v_rd_base(int lane) { return ((lane & 3) << 3) | (((lane >> 2) & 3) << 6) | (((lane >> 4) & 1) << 5) | (((lane >> 5) & 1) << 8); }
constexpr int v_rd_off(int d0, int ks, int half) { return d0 * 512 + ks * 4096 + half * 2048; }
__device__ __forceinline__ int crow(int r, int hi) { return (r & 3) + 8 * (r >> 2) + 4 * hi; }
__device__ __forceinline__ unsigned cvtpk(float lo, float hi) { unsigned r; asm volatile("v_cvt_pk_bf16_f32 %0, %1, %2" : "=v"(r) : "v"(lo), "v"(hi)); return r; }
__device__ __forceinline__ bf16x8 ld8(const bf16_t* p) { return *reinterpret_cast<const bf16x8*>(p); }
__device__ __forceinline__ void mask_causal(f32x16& p0, f32x16& p1, int dq) {
    const float NEG = -__builtin_inff();
#pragma unroll
    for (int r = 0; r < 16; ++r) {
        const int c = (r & 3) + 8 * (r >> 2);
        if (dq - c < 0) p0[r] = NEG;
        if (dq - c - 32 < 0) p1[r] = NEG;
    }
}
__device__ __forceinline__ void mask_all(f32x16& p0, f32x16& p1, bool keep) {
    const float NEG = -__builtin_inff();
#pragma unroll
    for (int r = 0; r < 16; ++r) { p0[r] = keep ? p0[r] : NEG; p1[r] = keep ? p1[r] : NEG; }
}
__device__ __forceinline__ void partialSM(f32x16& p0, f32x16& p1, float& m_reg, float& mn, float& alpha) {
    float pmax = p0[0]; for (int r = 1; r < 16; ++r) pmax = fmaxf(pmax, p0[r]); for (int r = 0; r < 16; ++r) pmax = fmaxf(pmax, p1[r]);
    { auto rr = __builtin_amdgcn_permlane32_swap(__float_as_uint(pmax), __float_as_uint(pmax), false, false);
      pmax = fmaxf(__uint_as_float(rr[0]), __uint_as_float(rr[1])); }
    constexpr float C2 = 1.4426950408889634f * SCALE;
    if (__builtin_expect(__all((pmax - m_reg) * SCALE <= THR), 1)) { mn = m_reg; alpha = 1.f; }
    else { mn = fmaxf(m_reg, pmax); alpha = __builtin_amdgcn_exp2f((m_reg - mn) * C2); m_reg = mn; }
    const float mnL = -mn * C2;
    for (int r = 0; r < 16; ++r) p0[r] = fmaf(p0[r], C2, mnL); for (int r = 0; r < 16; ++r) p1[r] = fmaf(p1[r], C2, mnL);
    for (int r = 0; r < 16; ++r) p0[r] = __builtin_amdgcn_exp2f(p0[r]);
}
__device__ __forceinline__ void finishSM(f32x16& p0, f32x16& p1, float alpha, float& l_reg, bf16x8& pa0, bf16x8& pa1, bf16x8& pa2, bf16x8& pa3) {
    for (int r = 0; r < 16; ++r) p1[r] = __builtin_amdgcn_exp2f(p1[r]);
    float ps = 0; for (int r = 0; r < 16; ++r) ps += p0[r]; for (int r = 0; r < 16; ++r) ps += p1[r];
    { auto rr = __builtin_amdgcn_permlane32_swap(__float_as_uint(ps), __float_as_uint(ps), false, false);
      ps = __uint_as_float(rr[0]) + __uint_as_float(rr[1]); }
    l_reg = l_reg * alpha + ps;
#define PK4(P, B_, OUT) do { unsigned a0 = cvtpk(P[B_+0], P[B_+1]), a1 = cvtpk(P[B_+2], P[B_+3]);                          \
        unsigned b0 = cvtpk(P[B_+4], P[B_+5]), b1 = cvtpk(P[B_+6], P[B_+7]);                                             \
        auto r0 = __builtin_amdgcn_permlane32_swap(a0, b0, false, false); auto r1 = __builtin_amdgcn_permlane32_swap(a1, b1, false, false); \
        u32x4 w = {r0[0], r1[0], r0[1], r1[1]}; OUT = *reinterpret_cast<bf16x8*>(&w); } while (0)
    PK4(p0, 0, pa0); PK4(p0, 8, pa1); PK4(p1, 0, pa2); PK4(p1, 8, pa3);
#undef PK4
}
template <int KB>
__device__ __forceinline__ void qkt(f32x16& p0, f32x16& p1, const char* K_lds, int r32, int hi, const bf16x8* qr) {
    p0 = f32x16{}; p1 = f32x16{};
    const char* kb[4];
#pragma unroll
    for (int dd = 0; dd < 4; ++dd) kb[dd] = K_lds + KB * SHM_K + KSWZ(r32, (dd * 16 + hi * 8) * 2);
#pragma unroll
    for (int d0 = 0; d0 < 8; ++d0) { const char* a = kb[d0 & 3] + (d0 >> 2) * 128;
        bf16x8 b0 = *reinterpret_cast<const bf16x8*>(a);
        bf16x8 b1 = *reinterpret_cast<const bf16x8*>(a + 32 * 256);
        p0 = __builtin_amdgcn_mfma_f32_32x32x16_bf16(b0, qr[d0], p0, 0, 0, 0);
        p1 = __builtin_amdgcn_mfma_f32_32x32x16_bf16(b1, qr[d0], p1, 0, 0, 0); }
}
template <int VB>
__device__ __forceinline__ void pv_tile(f32x16* o, int vb0, bf16x8 pa0, bf16x8 pa1, bf16x8 pa2, bf16x8 pa3) {
#define TRRD(dst, off) asm volatile("ds_read_b64_tr_b16 %0, %1 offset:%2" : "=&v"(dst) : "v"(vb0), "i"(off) : "memory")
#define PV_D0(d0) do { s16x4 l0, l1, l2, l3, h0, h1, h2, h3; constexpr int b_ = VB * SHM_V + v_rd_off(d0, 0, 0); \
        TRRD(l0, b_); TRRD(h0, b_ + 2048); TRRD(l1, b_ + 4096); TRRD(h1, b_ + 6144); TRRD(l2, b_ + 8192); TRRD(h2, b_ + 10240); TRRD(l3, b_ + 12288); TRRD(h3, b_ + 14336); \
        asm volatile("s_waitcnt lgkmcnt(0)" ::: "memory"); SBAR();   \
        o[d0] = __builtin_amdgcn_mfma_f32_32x32x16_bf16(pa0, (bf16x8){l0[0], l0[1], l0[2], l0[3], h0[0], h0[1], h0[2], h0[3]}, o[d0], 0, 0, 0);   \
        o[d0] = __builtin_amdgcn_mfma_f32_32x32x16_bf16(pa1, (bf16x8){l1[0], l1[1], l1[2], l1[3], h1[0], h1[1], h1[2], h1[3]}, o[d0], 0, 0, 0);   \
        o[d0] = __builtin_amdgcn_mfma_f32_32x32x16_bf16(pa2, (bf16x8){l2[0], l2[1], l2[2], l2[3], h2[0], h2[1], h2[2], h2[3]}, o[d0], 0, 0, 0);   \
        o[d0] = __builtin_amdgcn_mfma_f32_32x32x16_bf16(pa3, (bf16x8){l3[0], l3[1], l3[2], l3[3], h3[0], h3[1], h3[2], h3[3]}, o[d0], 0, 0, 0); } while (0)
    PV_D0(0); PV_D0(1); PV_D0(2); PV_D0(3);
#undef PV_D0
#undef TRRD
}
constexpr int KM_OFF = 69632;
__device__ __forceinline__ unsigned moba_gate(const bf16x8* qr, const float* km, int qb, int hi) {
    float v1 = -__builtin_inff(), v2 = v1, v3 = v1; int i1 = -1, i2 = -1, i3 = -1;
    for (int n = 0; n < qb; ++n) { const float* kp = km + n * DH + hi * 8; float sc = 0.f;
#pragma unroll
        for (int d0 = 0; d0 < 8; ++d0) { const f32x4 k0 = *(const f32x4*)(kp + d0 * 16), k1 = *(const f32x4*)(kp + d0 * 16 + 4); const bf16x8 q = qr[d0];
#pragma unroll
            for (int e = 0; e < 4; ++e) { sc += __uint_as_float(((unsigned)(unsigned short)q[e]) << 16) * k0[e]; sc += __uint_as_float(((unsigned)(unsigned short)q[4 + e]) << 16) * k1[e]; } }
        sc += __shfl_xor(sc, 32);
        if (sc > v1) { v3 = v2; i3 = i2; v2 = v1; i2 = i1; v1 = sc; i1 = n; }
        else if (sc > v2) { v3 = v2; i3 = i2; v2 = sc; i2 = n; }
        else if (sc > v3) { v3 = sc; i3 = n; } }
    unsigned m = 0u; if (i1 >= 0) m |= 1u << i1; if (i2 >= 0) m |= 1u << i2; if (i3 >= 0) m |= 1u << i3;
    return m;
}
struct BlockRef { const bf16_t* Q; const bf16_t* K; const bf16_t* V; bf16_t* O; int qb; };
struct Seam { bf16x8 qr[8]; bf16x8 st_v0, st_v1, st_k0, st_k1; };
#define VMW() asm volatile("s_waitcnt vmcnt(0)" ::: "memory")
#define VMWN(n) asm volatile("s_waitcnt vmcnt(%0)" :: "i"(n) : "memory")
#define GLD8(ubase) (*reinterpret_cast<const bf16x8*>((ubase) + toff))
#define SLOAD_H(Kp, Vp, k0) do { const char* kb__ = (const char*)(Kp) + (size_t)(k0) * (LD * 2); const char* vb__ = (const char*)(Vp) + (size_t)(k0) * (LD * 2); \
                         S.st_v0 = GLD8(vb__); S.st_v1 = GLD8(vb__ + 32 * LD * 2); S.st_k0 = GLD8(kb__); S.st_k1 = GLD8(kb__ + 32 * LD * 2); } while (0)
#define SWRITE_HK(bf) do { *(bf16x8*)(K_lds + (bf) * SHM_K + kws) = S.st_k0; *(bf16x8*)(K_lds + (bf) * SHM_K + kws + 32 * 256) = S.st_k1; } while (0)
#define SWRITE_HV(bf) do { *(bf16x8*)(V_lds + (bf) * SHM_V + vst0) = S.st_v0; *(bf16x8*)(V_lds + (bf) * SHM_V + vst1) = S.st_v1; } while (0)
#define SWRITE_H(bf) do { SWRITE_HV(bf); SWRITE_HK(bf); } while (0)
__device__ __forceinline__ void moba_prime(const BlockRef& cur, char* lds, Seam& S, int tid) {
    const int wid = __builtin_amdgcn_readfirstlane(tid >> 6), lane = tid & 63, r32 = lane & 31, hi = lane >> 5;
    const int sr = tid >> 4, sc = (tid & 15) * 8, kws = KSWZ(sr, sc * 2); char* K_lds = lds + 2 * SHM_V;
    const unsigned toff = (unsigned)(sr * LD + sc) * 2u, qoff = (unsigned)(r32 * LD + hi * 8) * 2u;
    { const char* qb_ = (const char*)cur.Q + (size_t)(wid * QBLK) * (LD * 2);
#pragma unroll
      for (int d0 = 0; d0 < 8; ++d0) S.qr[d0] = *reinterpret_cast<const bf16x8*>(qb_ + d0 * 32 + qoff); }
    SLOAD_H(cur.K, cur.V, 0); VMW(); SWRITE_HK(0);
    __syncthreads();
}
__device__ __forceinline__ void moba_block(const BlockRef& cur, const BlockRef& nxt, char* lds, Seam& S, int tid) {
    const int wid = __builtin_amdgcn_readfirstlane(tid >> 6), lane = tid & 63, r32 = lane & 31, hi = lane >> 5;
    const int NT = 4 * (cur.qb + 1);
    const int P0 = cur.qb * QB;
    const int qlo = P0 + wid * QBLK, qm = qlo + r32 - 4 * hi;
    const unsigned msk = moba_gate(S.qr, (const float*)(lds + KM_OFF), cur.qb, hi);
    char* V_lds = lds; char* K_lds = lds + 2 * SHM_V;
    float* ws = (float*)(lds + 2 * SHM_V + 2 * SHM_K) + wid * 64; float* li_l = ws, * al_l = ws + 32;
    float m_reg = -1e30f, l_reg = 0; f32x16 o[4] = {};
    const int sr = tid >> 4, sc = (tid & 15) * 8, vst0 = v_st(sr, sc), vst1 = v_st(32 + sr, sc), kws = KSWZ(sr, sc * 2);
    const unsigned toff = (unsigned)(sr * LD + sc) * 2u, qoff = (unsigned)(r32 * LD + hi * 8) * 2u;
    const int vb0 = (int)(uintptr_t)V_lds + v_rd_base(lane);
    const bf16_t* Kh = cur.K; const bf16_t* Vh = cur.V;
#define RESC(a) do { if (__any((a) < 1.f)) { if (hi == 0) al_l[r32] = (a); asm volatile("s_waitcnt lgkmcnt(0)" ::: "memory");              \
                     for (int d_ = 0; d_ < 4; ++d_) for (int r = 0; r < 16; ++r) o[d_][r] *= al_l[crow(r, hi)]; } } while (0)
#define KBASE(t) ((t) * KVBLK)
#define MASKT(P0_, P1_, t) do { const int kb_ = KBASE(t); const int jb_ = (t) >> 2; \
        if (jb_ < cur.qb) { mask_all(P0_, P1_, ((msk >> jb_) & 1u) != 0u); } \
        else if (kb_ + KVBLK - 1 > qlo) mask_causal(P0_, P1_, qm - kb_); } while (0)
    constexpr int NQL = 8;
#define SEAM_K0() do { VMWN(NQL); SWRITE_HK(0); SBAR(); } while (0)
    f32x16 pA0, pA1, pB0, pB1; float mnA, mnB, alA, alB; bf16x8 pa0, pa1, pa2, pa3;
    SWRITE_HV(0); SBAR();
    if (NT > 1) { SLOAD_H(Kh, Vh, KBASE(1)); }
    SBAR(); qkt<0>(pA0, pA1, K_lds, r32, hi, S.qr);
    MASKT(pA0, pA1, 0); partialSM(pA0, pA1, m_reg, mnA, alA);
    if (NT > 1) { VMW(); SWRITE_H(1); }
    __syncthreads();
#define HALF_STEP(PX0, PX1, mnX, alX, PY0, PY1, alY, t, KB, VB, SB) do {                                                      \
        SBAR(); qkt<KB>(PX0, PX1, K_lds, r32, hi, S.qr);                                             \
        finishSM(PY0, PY1, alY, l_reg, pa0, pa1, pa2, pa3); SBAR();                                                           \
        if ((t) + 1 < NT) { SLOAD_H(Kh, Vh, KBASE((t) + 1)); SBAR(); }                                               \
        pv_tile<VB>(o, vb0, pa0, pa1, pa2, pa3); MASKT(PX0, PX1, (t)); partialSM(PX0, PX1, m_reg, mnX, alX);                                        \
        __syncthreads();                                                                                                      \
        if ((t) + 1 < NT) { VMW(); SWRITE_H(SB); }                                                                          \
        RESC(alX); __syncthreads(); } while (0)
    for (int t = 1; t + 1 < NT; t += 2) {
        HALF_STEP(pB0, pB1, mnB, alB, pA0, pA1, alA, t, 1, 0, 0);
        HALF_STEP(pA0, pA1, mnA, alA, pB0, pB1, alB, t + 1, 0, 1, 1);
    }
    const bool even = (NT & 1) == 0;
    if (even) { SBAR(); qkt<1>(pB0, pB1, K_lds, r32, hi, S.qr); SBAR(); }
    SLOAD_H(nxt.K, nxt.V, 0); SBAR();
    { const char* qb_ = (const char*)nxt.Q + (size_t)(wid * QBLK) * (LD * 2);
#pragma unroll
      for (int d0 = 0; d0 < 8; ++d0) S.qr[d0] = *reinterpret_cast<const bf16x8*>(qb_ + d0 * 32 + qoff); }
    SBAR();
    finishSM(pA0, pA1, alA, l_reg, pa0, pa1, pa2, pa3); SBAR();
    pv_tile<0>(o, vb0, pa0, pa1, pa2, pa3);
    if (even) { MASKT(pB0, pB1, NT - 1); partialSM(pB0, pB1, m_reg, mnB, alB); __syncthreads(); RESC(alB);
        finishSM(pB0, pB1, alB, l_reg, pa0, pa1, pa2, pa3); SBAR(); pv_tile<1>(o, vb0, pa0, pa1, pa2, pa3); }
    SBAR(); SEAM_K0();
    if (hi == 0) li_l[r32] = l_reg; asm volatile("s_waitcnt lgkmcnt(0)" ::: "memory");
    float rli[16];
#pragma unroll
    for (int r = 0; r < 16; ++r) rli[r] = __builtin_amdgcn_rcpf(li_l[crow(r, hi)]);
    char* Ow = (char*)cur.O + (size_t)(wid * QBLK) * (LD * 2);
    const unsigned ooff = (unsigned)(4 * hi * LD + r32) * 2u;
#pragma unroll
    for (int r = 0; r < 16; ++r) { char* Or = Ow + (size_t)((r & 3) + 8 * (r >> 2)) * (LD * 2);
#pragma unroll
        for (int d0 = 0; d0 < 4; ++d0) { const float v = o[d0][r] * rli[r];
            const float vn = __shfl_xor(v, 1);
            if ((r32 & 1) == 0) *(unsigned*)(Or + d0 * 64 + ooff) = cvtpk(v, vn); } }
    __syncthreads();
#undef RESC
#undef KBASE
#undef MASKT
#undef SEAM_K0
#undef HALF_STEP
}
#undef VMW
#undef VMWN
#undef SLOAD_H
#undef GLD8
#undef SWRITE_HK
#undef SWRITE_HV
#undef SWRITE_H
}

struct Args { const float* in[25]; float* out; unsigned char* ws; int ph_lo, ph_hi, li, pad; };
enum { IN_X = 0, IN_C, IN_NMG, IN_NFG, IN_WMOD, IN_BMOD, IN_LWIN, IN_LCW, IN_LCB, IN_LWA, IN_LBA, IN_LWX, IN_LBX, IN_LLAM, IN_LWOUT,
       IN_AQKV, IN_AQG, IN_AKG, IN_AWOUT, IN_RW, IN_RB, IN_WGU, IN_BGU, IN_WDN, IN_BDN };
struct Frame {
    LAS unsigned char* lds;
    unsigned char* ws;
    int tid, lane, wave, vcu, G;
};

__device__ __forceinline__ void cvt_tile(const float* W, int ldw, int k0, int n0, bf16_t* WT, int ldt, int drow0, LAS float* scr, int lane) {
    const int q = lane & 15, rr = lane >> 4;
    f32x4 v[16];
#pragma unroll
    for (int i = 0; i < 16; ++i) v[i] = *(const f32x4*)(W + (size_t)(k0 + 4 * i + rr) * ldw + n0 + 4 * q);
#pragma unroll
    for (int i = 0; i < 16; ++i) { LAS float* s = scr + (4 * i + rr) * 65 + 4 * q; s[0] = v[i][0]; s[1] = v[i][1]; s[2] = v[i][2]; s[3] = v[i][3]; }
    LDS_WAIT();
    const int c = lane & 7;
#pragma unroll
    for (int jj = 0; jj < 8; ++jj) { const int n = (lane >> 3) + 8 * jj; const LAS float* s = scr + (8 * c) * 65 + n;
        u32x4 o; o.x = cvt_pk_bf16(s[0 * 65], s[1 * 65]); o.y = cvt_pk_bf16(s[2 * 65], s[3 * 65]); o.z = cvt_pk_bf16(s[4 * 65], s[5 * 65]); o.w = cvt_pk_bf16(s[6 * 65], s[7 * 65]);
        *(u32x4*)(WT + (size_t)(drow0 + n) * ldt + k0 + 8 * c) = o; }
    LDS_WAIT();
}
__device__ __forceinline__ void phase_prologue(Frame& F, const Args& a) {
    if (blockIdx.x < 96) {
        LAS float* cond = (LAS float*)F.lds;
        LAS float* red = (LAS float*)(F.lds + 16384);
        const float* c = a.in[IN_C];
        for (int i = F.tid; i < BATCH * D; i += NTHR) { const float x = c[i]; cond[i] = x * sigmoidf_(x); }
        __syncthreads();
        const int l = blockIdx.x / 24, n0 = (blockIdx.x % 24) * 256;
        const float* W = a.in[IN_WMOD] + (size_t)l * D * 6 * D + n0 + 4 * F.lane;
        f32x4 acc[4];
#pragma unroll
        for (int b = 0; b < 4; ++b) acc[b] = (f32x4){0.f, 0.f, 0.f, 0.f};
        const int kb = F.wave * 128;
#pragma unroll 8
        for (int k = 0; k < 128; ++k) { const f32x4 w = *(const f32x4*)(W + (size_t)(kb + k) * 6 * D);
#pragma unroll
            for (int b = 0; b < 4; ++b) acc[b] += w * cond[b * D + kb + k]; }
#pragma unroll
        for (int b = 0; b < 4; ++b) *(LAS f32x4*)(red + (F.wave * 4 + b) * 256 + 4 * F.lane) = acc[b];
        __syncthreads();
        float* MOD = (float*)(F.ws + WS_MOD);
        for (int o = F.tid; o < 1024; o += NTHR) { const int b = o >> 8, n = o & 255; float s = 0.f;
#pragma unroll
            for (int w = 0; w < 8; ++w) s += red[(w * 4 + b) * 256 + n];
            MOD[((size_t)l * BATCH + b) * 6 * D + n0 + n] = s + a.in[IN_BMOD][(size_t)l * 6 * D + n0 + n]; }
        __syncthreads();
    }
    { const int g = blockIdx.x * NTHR + F.tid; if (g < 2 * D) { const float lam = a.in[IN_LLAM][g]; const float z = -lam;
        const float sp = z > 20.f ? z : log1pf(__expf(z)); ((float*)(F.ws + WS_SP8))[g] = 8.0f * sp; } }
    { float* PAR = (float*)(F.ws + WS_PAR); const int g = blockIdx.x * NTHR + F.tid, GS = F.G * NTHR;
#define CPY(dst, src, n) for (int i = g; i < (n) / 4; i += GS) *(f32x4*)(PAR + (dst) + 4 * i) = *(const f32x4*)(a.in[src] + 4 * i)
      CPY(PAR_NMG, IN_NMG, 4 * 1024); CPY(PAR_NFG, IN_NFG, 4 * 1024); CPY(PAR_LCW, IN_LCW, 2 * 4 * 1024); CPY(PAR_LCB, IN_LCB, 2 * 1024); CPY(PAR_LBA, IN_LBA, 2 * 1024); CPY(PAR_LBX, IN_LBX, 2 * 1024);
      CPY(PAR_AQG, IN_AQG, 256); CPY(PAR_AKG, IN_AKG, 256); CPY(PAR_RW, IN_RW, 4 * 1024 * 32); CPY(PAR_RB, IN_RB, 128); CPY(PAR_BGU, IN_BGU, 4 * 32 * 2048); CPY(PAR_BDN, IN_BDN, 4 * 32 * 1024);
#undef CPY
    }
    LAS float* scr = (LAS float*)(F.lds + F.wave * 16640);
    const int gw = F.vcu * NWAVES + F.wave, NGW = F.G * NWAVES;
    constexpr int I0 = 128 * 512, I1 = 128 * 256, I2 = 2 * 512, I3 = 16 * 16, I4 = 2 * 256, I5 = 2 * 768, I6 = 2 * 256;
    constexpr int NITEMS = I0 + I1 + I2 + I3 + I4 + I5 + I6;
    for (int it = gw; it < NITEMS; it += NGW) {
        int r = it;
        if (r < I0) { const int mat = r >> 9, q = r & 511, kb = q >> 5, nb = q & 31, n0 = nb * 64;
            const int dr = n0 < D ? (n0 >> 7) * 256 + (n0 & 127) : ((n0 - D) >> 7) * 256 + 128 + ((n0 - D) & 127);
            cvt_tile(a.in[IN_WGU] + (size_t)mat * D * 2 * D, 2 * D, kb * 64, n0, (bf16_t*)(F.ws + WS_WGU) + (size_t)mat * 2 * D * D, D, dr, scr, F.lane); continue; } r -= I0;
        if (r < I1) { const int mat = r >> 8, q = r & 255, kb = q >> 4, nb = q & 15;
            cvt_tile(a.in[IN_WDN] + (size_t)mat * D * D, D, kb * 64, nb * 64, (bf16_t*)(F.ws + WS_WDN) + (size_t)mat * D * D, D, nb * 64, scr, F.lane); continue; } r -= I1;
        if (r < I2) { const int mat = r >> 9, q = r & 511, kb = q >> 5, nb = q & 31;
            cvt_tile(a.in[IN_LWIN] + (size_t)mat * D * 2 * D, 2 * D, kb * 64, nb * 64, (bf16_t*)(F.ws + WS_WIN) + (size_t)mat * 2 * D * D, D, nb * 64, scr, F.lane); continue; } r -= I2;
        if (r < I3) { const int mat = r >> 4, q = r & 15, kb = q >> 2, nb = q & 3;
            const int layer = mat >> 3, ax = (mat >> 2) & 1, g = mat & 3, n0 = nb * 64;
            const float* src = (ax ? a.in[IN_LWX] : a.in[IN_LWA]) + (size_t)(layer * 4 + g) * 256 * 256;
            const int dr = (g * 2 + (n0 >> 7)) * 256 + ax * 128 + (n0 & 127);
            cvt_tile(src, 256, kb * 64, n0, (bf16_t*)(F.ws + WS_WG) + (size_t)layer * 2048 * 256, 256, dr, scr, F.lane); continue; } r -= I3;
        if (r < I4) { const int mat = r >> 8, q = r & 255, kb = q >> 4, nb = q & 15;
            cvt_tile(a.in[IN_LWOUT] + (size_t)mat * D * D, D, kb * 64, nb * 64, (bf16_t*)(F.ws + WS_WLO) + (size_t)mat * D * D, D, nb * 64, scr, F.lane); continue; } r -= I4;
        if (r < I5) { const int mat = r / 768, q = r % 768, kb = q / 48, nb = q % 48;
            cvt_tile(a.in[IN_AQKV] + (size_t)mat * D * 3 * D, 3 * D, kb * 64, nb * 64, (bf16_t*)(F.ws + WS_WQKV) + (size_t)mat * 3 * D * D, D, nb * 64, scr, F.lane); continue; } r -= I5;
        { const int mat = r >> 8, q = r & 255, kb = q >> 4, nb = q & 15;
            cvt_tile(a.in[IN_AWOUT] + (size_t)mat * D * D, D, kb * 64, nb * 64, (bf16_t*)(F.ws + WS_WAO) + (size_t)mat * D * D, D, nb * 64, scr, F.lane); }
    }
}

__device__ __forceinline__ void phase_norm(Frame& F, const float* xin, float* out, int layer, bool final_) {
    const float* PAR = (const float*)(F.ws + WS_PAR);
    const int gw = F.vcu * NWAVES + F.wave; const int m0 = gw * 8; const int b = m0 / SEQ;
    const float* MOD = (const float*)(F.ws + WS_MOD);
    const bool first = (layer == 0);
    f32x4 gain[4], sc[4], sh[4], g2[4];
#pragma unroll
    for (int j = 0; j < 4; ++j) { const int c = 4 * F.lane + 256 * j;
        if (!final_) { gain[j] = *(const f32x4*)(PAR + PAR_NMG + (size_t)layer * D + c);
            sh[j] = *(const f32x4*)(MOD + ((size_t)layer * BATCH + b) * 6 * D + c); sc[j] = *(const f32x4*)(MOD + ((size_t)layer * BATCH + b) * 6 * D + D + c); }
        if (!first) g2[j] = *(const f32x4*)(MOD + ((size_t)(layer - 1) * BATCH + b) * 6 * D + 5 * D + c); }
    const float* XB = (const float*)(F.ws + WS_XB);
    const bf16_t* YK = (const bf16_t*)(F.ws + WS_YK); bf16_t* H = (bf16_t*)(F.ws + WS_H);
    for (int r = 0; r < 8; ++r) { const int m = m0 + r;
        f32x4 x[4];
#pragma unroll
        for (int j = 0; j < 4; ++j) { const int c = 4 * F.lane + 256 * j;
            if (first) x[j] = *(const f32x4*)(xin + (size_t)m * D + c);
            else { const u32x2 w = *(const u32x2*)(YK + (size_t)m * D + c); const f32x4 s = (f32x4){bflo(w.x), bfhi(w.x), bflo(w.y), bfhi(w.y)};
                x[j] = *(const f32x4*)(XB + (size_t)m * D + c) + g2[j] * s;
                if (final_) *(f32x4*)(out + (size_t)m * D + c) = x[j]; } }
        if (final_) continue;
        float ss = 0.f;
#pragma unroll
        for (int j = 0; j < 4; ++j) ss += (x[j][0] * x[j][0] + x[j][1] * x[j][1]) + (x[j][2] * x[j][2] + x[j][3] * x[j][3]);
        const float rstd = __builtin_amdgcn_rsqf(wave_sum(ss) * (1.0f / D) + NORM_EPS);
#pragma unroll
        for (int j = 0; j < 4; ++j) { const int c = 4 * F.lane + 256 * j;
            const f32x4 h = x[j] * rstd * gain[j] * (1.0f + sc[j]) + sh[j];
            u32x2 o; o.x = cvt_pk_bf16(h[0], h[1]); o.y = cvt_pk_bf16(h[2], h[3]); *(u32x2*)(H + (size_t)m * D + c) = o; }
    }
}

constexpr int MOE_TOK = T / TOPK;
__device__ __forceinline__ void phase_router(Frame& F, int layer) {
    if (F.vcu >= MOE_TOK / 64) return;
    const float* PAR = (const float*)(F.ws + WS_PAR);
    LAS float* rw = (LAS float*)F.lds;
    LAS unsigned* lcnt = (LAS unsigned*)(F.lds + LDS_X);
    LAS unsigned* lbase = lcnt + 32;
    LAS unsigned* pend = lcnt + 64;
    { const float* RW = PAR + PAR_RW + (size_t)layer * D * NE;
      for (int i = F.tid; i < D * NE / 4; i += NTHR) { const int col = i >> 3, ch = i & 7; const f32x4 v = *(const f32x4*)(RW + (size_t)i * 4);
          *(LAS f32x4*)(rw + col * 32 + ((ch ^ ((col >> 2) & 7)) << 2)) = v; }
      if (F.tid < 32) lcnt[F.tid] = 0u; }
    __syncthreads();
    const int gw = F.vcu * NWAVES + F.wave; const int m0 = gw * 8; const int b = m0 / SEQ;
    const float* MOD = (const float*)(F.ws + WS_MOD);
    f32x4 gain[4], sc[4], sh[4];
#pragma unroll
    for (int j = 0; j < 4; ++j) { const int c = 4 * F.lane + 256 * j; gain[j] = *(const f32x4*)(PAR + PAR_NFG + (size_t)layer * D + c);
        sh[j] = *(const f32x4*)(MOD + ((size_t)layer * BATCH + b) * 6 * D + 3 * D + c); sc[j] = *(const f32x4*)(MOD + ((size_t)layer * BATCH + b) * 6 * D + 4 * D + c); }
    const float* XB = (const float*)(F.ws + WS_XB); bf16_t* H = (bf16_t*)(F.ws + WS_H);
    const float rbias = PAR[PAR_RB + layer * NE + (F.lane & 31)];
    const int sw = F.lane & 7;
    for (int rp = 0; rp < 4; ++rp) {
        f32x4 h[2][4];
#pragma unroll
        for (int q = 0; q < 2; ++q) { const int m = m0 + rp * 2 + q;
            f32x4 x[4]; float ss = 0.f;
#pragma unroll
            for (int j = 0; j < 4; ++j) { x[j] = *(const f32x4*)(XB + (size_t)m * D + 4 * F.lane + 256 * j); ss += (x[j][0] * x[j][0] + x[j][1] * x[j][1]) + (x[j][2] * x[j][2] + x[j][3] * x[j][3]); }
            const float rstd = __builtin_amdgcn_rsqf(wave_sum(ss) * (1.0f / D) + NORM_EPS);
#pragma unroll
            for (int j = 0; j < 4; ++j) { h[q][j] = x[j] * rstd * gain[j] * (1.0f + sc[j]) + sh[j];
                u32x2 o; o.x = cvt_pk_bf16(h[q][j][0], h[q][j][1]); o.y = cvt_pk_bf16(h[q][j][2], h[q][j][3]); *(u32x2*)(H + (size_t)m * D + 4 * F.lane + 256 * j) = o; } }
        float v[64];
#pragma unroll
        for (int i = 0; i < 64; ++i) v[i] = 0.f;
#pragma unroll
        for (int j = 0; j < 4; ++j)
#pragma unroll
            for (int cc = 0; cc < 4; ++cc) { const int col = 4 * F.lane + 256 * j + cc; const LAS float* rp_ = rw + col * 32;
#pragma unroll
                for (int eq = 0; eq < 8; ++eq) { const f32x4 w = *(const LAS f32x4*)(rp_ + ((eq ^ sw) << 2));
#pragma unroll
                    for (int k = 0; k < 4; ++k) { v[eq * 4 + k] = fmaf(h[0][j][cc], w[k], v[eq * 4 + k]); v[32 + eq * 4 + k] = fmaf(h[1][j][cc], w[k], v[32 + eq * 4 + k]); } } }
#pragma unroll
        for (int i = 0; i < 32; ++i) { const bool up = (F.lane & 32) != 0; const float send = up ? v[i] : v[32 + i]; const float recv = __shfl_xor(send, 32); v[i] = (up ? v[32 + i] : v[i]) + recv; }
#pragma unroll
        for (int i = 0; i < 16; ++i) { const bool up = (F.lane & 16) != 0; const float send = up ? v[i] : v[16 + i]; const float recv = __shfl_xor(send, 16); v[i] = (up ? v[16 + i] : v[i]) + recv; }
#pragma unroll
        for (int i = 0; i < 8; ++i) { const bool up = (F.lane & 8) != 0; const float send = up ? v[i] : v[8 + i]; const float recv = __shfl_xor(send, 8); v[i] = (up ? v[8 + i] : v[i]) + recv; }
#pragma unroll
        for (int i = 0; i < 4; ++i) { const bool up = (F.lane & 4) != 0; const float send = up ? v[i] : v[4 + i]; const float recv = __shfl_xor(send, 4); v[i] = (up ? v[4 + i] : v[i]) + recv; }
#pragma unroll
        for (int i = 0; i < 2; ++i) { const bool up = (F.lane & 2) != 0; const float send = up ? v[i] : v[2 + i]; const float recv = __shfl_xor(send, 2); v[i] = (up ? v[2 + i] : v[i]) + recv; }
        { const bool up = (F.lane & 1) != 0; const float send = up ? v[0] : v[1]; const float recv = __shfl_xor(send, 1); v[0] = (up ? v[1] : v[0]) + recv; }
        float logit = v[0] + rbias;
        float tv[4]; int te[4];
#pragma unroll
        for (int k = 0; k < 4; ++k) { float bv = logit; int be = F.lane & 31;
#pragma unroll
            for (int o = 1; o < 32; o <<= 1) { const float ov = __shfl_xor(bv, o); const int oe = __shfl_xor(be, o); if (ov > bv || (ov == bv && oe < be)) { bv = ov; be = oe; } }
            tv[k] = bv; te[k] = be; if ((F.lane & 31) == be) logit = -__builtin_inff(); }
        const float e1 = __expf(tv[1] - tv[0]), e2 = __expf(tv[2] - tv[0]), e3 = __expf(tv[3] - tv[0]); const float inv = 1.0f / (1.0f + e1 + e2 + e3);
        const int kk = F.lane & 31;
        if (kk < 4) { const int e = kk == 0 ? te[0] : (kk == 1 ? te[1] : (kk == 2 ? te[2] : te[3]));
            const float w = (kk == 0 ? 1.0f : (kk == 1 ? e1 : (kk == 2 ? e2 : e3))) * inv;
            const unsigned rank = __hip_atomic_fetch_add(&lcnt[e], 1u, __ATOMIC_RELAXED, __HIP_MEMORY_SCOPE_WORKGROUP);
            const int rl = F.wave * 8 + rp * 2 + (F.lane >> 5);
            pend[(rl * 4 + kk) * 2 + 0] = (unsigned)e | (rank << 8); pend[(rl * 4 + kk) * 2 + 1] = __float_as_uint(w); }
    }
    __syncthreads();
    unsigned* gcnt = (unsigned*)(F.ws + WS_CTL) + CW_CNT + 64 * layer;
    if (F.tid < 32) lbase[F.tid] = __hip_atomic_fetch_add(gcnt + F.tid, lcnt[F.tid], __ATOMIC_RELAXED, __HIP_MEMORY_SCOPE_AGENT);
    __syncthreads();
    if (F.tid < 256) { const int rl = F.tid >> 2, k = F.tid & 3; const unsigned p0 = pend[(rl * 4 + k) * 2], p1 = pend[(rl * 4 + k) * 2 + 1];
        const unsigned e = p0 & 255u, rank = p0 >> 8; const unsigned pos = lbase[e] + rank; const unsigned tok = (unsigned)(F.vcu * 64 + rl);
        ((unsigned*)(F.ws + WS_ROWLIST))[(size_t)e * CAP + pos] = tok * 4u + (unsigned)k;
        ((float*)(F.ws + WS_TOPW))[tok * 4u + k] = __uint_as_float(p1); }
}

__device__ __forceinline__ int moe_units(Frame& F, int layer, int npn) {
    LAS int* moe = (LAS int*)(F.lds + LDS_MOE);
    LAS int* units = (LAS int*)(F.lds + LDS_UNITS);
    if (F.wave == 0) {
        const unsigned* gcnt = (const unsigned*)(F.ws + WS_CTL) + CW_CNT + 64 * layer;
        const int e_ = F.lane & 31;
        const int cnt = (int)gcnt[e_]; const int ntl = (cnt + 255) >> 8;
        int incl = ntl;
#pragma unroll
        for (int o = 1; o < 32; o <<= 1) { const int t = __shfl_up(incl, o); if ((F.lane & 31) >= o) incl += t; }
        const int start = incl - ntl; const int ts = __shfl(incl, 31);
        const int c = blockIdx.x, xcd = c & 7, slot = c >> 3, rpx = 32 / npn;
        const int i = F.lane;
        const int rt = (i * 8 + xcd) * rpx + slot / npn, pn = slot % npn;
        int e = 0, st = 0, cn = 0;
        for (int q = 0; q < 32; ++q) { const int s_ = __shfl(start, q), n_ = __shfl(ntl, q), c_ = __shfl(cnt, q); if (rt >= s_ && rt < s_ + n_) { e = q; st = s_; cn = c_; } }
        const bool ok = (F.lane < 32) && (rt < ts);
        const unsigned long long bal = __ballot(ok);
        if (ok) { const int j = rt - st; int valid = cn - j * 256; valid = valid > 256 ? 256 : valid;
            units[i * 4 + 0] = rt; units[i * 4 + 1] = pn; units[i * 4 + 2] = e | (j << 8); units[i * 4 + 3] = valid; }
        if (F.lane == 0) moe[40] = __popcll(bal);
    }
    __syncthreads();
    return __builtin_amdgcn_readfirstlane(moe[40]);
}

__device__ __forceinline__ void phase_conv(Frame& F, int j) {
    const float* PAR = (const float*)(F.ws + WS_PAR);
    const int g = F.vcu * NTHR + F.tid; const int chunk = g & 127, seg = g >> 7; const int c0 = chunk * 8, m0 = seg * 16; const int s0 = m0 & (SEQ - 1);
    const bf16_t* RB = (const bf16_t*)(F.ws + WS_RB); bf16_t* XC = (bf16_t*)(F.ws + WS_XC);
    float w[4][8], bias[8];
#pragma unroll
    for (int k = 0; k < 4; ++k) { const f32x4 w0 = *(const f32x4*)(PAR + PAR_LCW + ((size_t)j * 4 + k) * D + c0), w1 = *(const f32x4*)(PAR + PAR_LCW + ((size_t)j * 4 + k) * D + c0 + 4);
#pragma unroll
        for (int i = 0; i < 4; ++i) { w[k][i] = w0[i]; w[k][4 + i] = w1[i]; } }
    { const f32x4 b0 = *(const f32x4*)(PAR + PAR_LCB + (size_t)j * D + c0), b1 = *(const f32x4*)(PAR + PAR_LCB + (size_t)j * D + c0 + 4);
#pragma unroll
      for (int i = 0; i < 4; ++i) { bias[i] = b0[i]; bias[4 + i] = b1[i]; } }
    float x0[8], x1[8], x2[8];
#pragma unroll
    for (int i = 0; i < 8; ++i) { x0[i] = 0.f; x1[i] = 0.f; x2[i] = 0.f; }
    if (s0 != 0) {
        const u32x4 r0 = *(const u32x4*)(RB + (size_t)(m0 - 3) * D + c0), r1 = *(const u32x4*)(RB + (size_t)(m0 - 2) * D + c0), r2 = *(const u32x4*)(RB + (size_t)(m0 - 1) * D + c0);
#pragma unroll
        for (int i = 0; i < 4; ++i) { x0[2 * i] = bflo(r0[i]); x0[2 * i + 1] = bfhi(r0[i]); x1[2 * i] = bflo(r1[i]); x1[2 * i + 1] = bfhi(r1[i]); x2[2 * i] = bflo(r2[i]); x2[2 * i + 1] = bfhi(r2[i]); }
    }
#pragma unroll 4
    for (int t = 0; t < 16; ++t) {
        const u32x4 rr = *(const u32x4*)(RB + (size_t)(m0 + t) * D + c0);
        float x3[8], y[8];
#pragma unroll
        for (int i = 0; i < 4; ++i) { x3[2 * i] = bflo(rr[i]); x3[2 * i + 1] = bfhi(rr[i]); }
#pragma unroll
        for (int i = 0; i < 8; ++i) { y[i] = bias[i] + w[0][i] * x0[i] + w[1][i] * x1[i] + w[2][i] * x2[i] + w[3][i] * x3[i]; x0[i] = x1[i]; x1[i] = x2[i]; x2[i] = x3[i]; }
        u32x4 o; o.x = cvt_pk_bf16(y[0], y[1]); o.y = cvt_pk_bf16(y[2], y[3]); o.z = cvt_pk_bf16(y[4], y[5]); o.w = cvt_pk_bf16(y[6], y[7]);
        *(u32x4*)(XC + (size_t)(m0 + t) * D + c0) = o;
    }
}
__device__ __forceinline__ void phase_scan1(Frame& F) {
    const int item = F.vcu; const int m0 = item * 64; const int ch = 2 * F.tid;
    const bf16_t* LA = (const bf16_t*)(F.ws + WS_AF); const bf16_t* UB = (const bf16_t*)(F.ws + WS_UF);
    float h0 = 0.f, h1 = 0.f, s0 = 0.f, s1 = 0.f;
#pragma unroll 16
    for (int t = 0; t < 64; ++t) { const unsigned lw = *(const unsigned*)(LA + (size_t)(m0 + t) * D + ch), uw = *(const unsigned*)(UB + (size_t)(m0 + t) * D + ch);
        const float l0 = bflo(lw), l1 = bfhi(lw);
        h0 = __builtin_amdgcn_exp2f(l0) * h0 + bflo(uw); h1 = __builtin_amdgcn_exp2f(l1) * h1 + bfhi(uw); s0 += l0; s1 += l1; }
    float* PS = (float*)(F.ws + WS_PS);
    *(f32x4*)(PS + ((size_t)item * D + ch) * 2) = (f32x4){__builtin_amdgcn_exp2f(s0), h0, __builtin_amdgcn_exp2f(s1), h1};
}
__device__ __forceinline__ void phase_scan2(Frame& F) {
    const int item = F.vcu; const int m0 = item * 64; const int ch = 2 * F.tid; const int c = item & 63, b = item >> 6;
    const bf16_t* LA = (const bf16_t*)(F.ws + WS_AF); const bf16_t* UB = (const bf16_t*)(F.ws + WS_UF);
    const float* PS = (const float*)(F.ws + WS_PS); const bf16_t* GB = (const bf16_t*)(F.ws + WS_GB); bf16_t* YB = (bf16_t*)(F.ws + WS_YB);
    float h0 = 0.f, h1 = 0.f;
#pragma unroll 8
    for (int jj = 0; jj < c; ++jj) { const f32x4 s = *(const f32x4*)(PS + ((size_t)(b * 64 + jj) * D + ch) * 2); h0 = s[0] * h0 + s[1]; h1 = s[2] * h1 + s[3]; }
#pragma unroll 16
    for (int t = 0; t < 64; ++t) { const unsigned lw = *(const unsigned*)(LA + (size_t)(m0 + t) * D + ch), uw = *(const unsigned*)(UB + (size_t)(m0 + t) * D + ch);
        const unsigned gw_ = *(const unsigned*)(GB + (size_t)(m0 + t) * D + ch);
        h0 = __builtin_amdgcn_exp2f(bflo(lw)) * h0 + bflo(uw); h1 = __builtin_amdgcn_exp2f(bfhi(lw)) * h1 + bfhi(uw);
        *(unsigned*)(YB + (size_t)(m0 + t) * D + ch) = cvt_pk_bf16(bflo(gw_) * h0, bfhi(gw_) * h1); }
}

__device__ __forceinline__ void phase_qknorm(Frame& F, int j) {
    const float* PAR = (const float*)(F.ws + WS_PAR);
    bf16_t* Q = (bf16_t*)(F.ws + WS_Q); bf16_t* Kb = (bf16_t*)(F.ws + WS_K); float* KM = (float*)(F.ws + WS_KMEAN);
    LAS float* red = (LAS float*)F.lds;
    const int rr = F.lane >> 4, cq = F.lane & 15;
    f32x4 qg0 = *(const f32x4*)(PAR + PAR_AQG + (size_t)j * HD + cq * 8), qg1 = *(const f32x4*)(PAR + PAR_AQG + (size_t)j * HD + cq * 8 + 4);
    f32x4 kg0 = *(const f32x4*)(PAR + PAR_AKG + (size_t)j * HD + cq * 8), kg1 = *(const f32x4*)(PAR + PAR_AKG + (size_t)j * HD + cq * 8 + 4);
    for (int it = F.vcu; it < BATCH * NBLK * NH; it += F.G) {
        const int h = it & 7, blk = (it >> 3) & 15, b = it >> 7;
        const size_t base = ((size_t)(b * SEQ + blk * MBLK + F.wave * 32)) * D + h * HD + cq * 8;
        float ks[8];
#pragma unroll
        for (int i = 0; i < 8; ++i) ks[i] = 0.f;
#pragma unroll 2
        for (int i = 0; i < 8; ++i) { const size_t off = base + (size_t)(i * 4 + rr) * D;
            const u32x4 qw = *(const u32x4*)(Q + off), kw = *(const u32x4*)(Kb + off);
            float qv[8], kv[8]; float sq = 0.f, sk = 0.f;
#pragma unroll
            for (int e = 0; e < 4; ++e) { qv[2 * e] = bflo(qw[e]); qv[2 * e + 1] = bfhi(qw[e]); kv[2 * e] = bflo(kw[e]); kv[2 * e + 1] = bfhi(kw[e]); }
#pragma unroll
            for (int e = 0; e < 8; ++e) { sq += qv[e] * qv[e]; sk += kv[e] * kv[e]; }
#pragma unroll
            for (int o = 1; o < 16; o <<= 1) { sq += __shfl_xor(sq, o); sk += __shfl_xor(sk, o); }
            const float rq = __builtin_amdgcn_rsqf(sq * (1.0f / HD) + NORM_EPS), rk = __builtin_amdgcn_rsqf(sk * (1.0f / HD) + NORM_EPS);
#pragma unroll
            for (int e = 0; e < 8; ++e) { qv[e] = qv[e] * rq * (e < 4 ? qg0[e & 3] : qg1[e & 3]); kv[e] = kv[e] * rk * (e < 4 ? kg0[e & 3] : kg1[e & 3]); ks[e] += kv[e]; }
            u32x4 qo, ko;
#pragma unroll
            for (int e = 0; e < 4; ++e) { qo[e] = cvt_pk_bf16(qv[2 * e], qv[2 * e + 1]); ko[e] = cvt_pk_bf16(kv[2 * e], kv[2 * e + 1]); }
            *(u32x4*)(Q + off) = qo; *(u32x4*)(Kb + off) = ko; }
#pragma unroll
        for (int e = 0; e < 8; ++e) { ks[e] += __shfl_xor(ks[e], 16); ks[e] += __shfl_xor(ks[e], 32); }
        __syncthreads();
        if (F.lane < 16) {
#pragma unroll
            for (int e = 0; e < 8; ++e) red[F.wave * 128 + cq * 8 + e] = ks[e]; }
        __syncthreads();
        if (F.tid < 128) { float s = 0.f;
#pragma unroll
            for (int w = 0; w < 8; ++w) s += red[w * 128 + F.tid];
            KM[(((size_t)b * NH + h) * NBLK + blk) * HD + F.tid] = s * (1.0f / MBLK); }
    }
}
__device__ __forceinline__ void phase_gate(Frame& F) {
    const bf16_t* Q = (const bf16_t*)(F.ws + WS_Q); const float* KM = (const float*)(F.ws + WS_KMEAN); unsigned* SEL = (unsigned*)(F.ws + WS_SEL);
    LAS float* km = (LAS float*)F.lds;
    const int it = F.vcu; const int s8 = it & 7, h = (it >> 3) & 7, b = it >> 6;
    for (int i = F.tid; i < NBLK * HD / 4; i += NTHR) *(LAS f32x4*)(km + 4 * i) = *(const f32x4*)(KM + ((size_t)b * NH + h) * NBLK * HD + 4 * i);
    __syncthreads();
    const int s = s8 * 512 + F.tid; const int qb = __builtin_amdgcn_readfirstlane(s >> 8);
    u32x4 qw[16];
    const bf16_t* qp = Q + ((size_t)(b * SEQ + s)) * D + h * HD;
#pragma unroll
    for (int i = 0; i < 16; ++i) qw[i] = *(const u32x4*)(qp + 8 * i);
    float v1 = -__builtin_inff(), v2 = v1, v3 = v1; int i1 = -1, i2 = -1, i3 = -1;
    for (int n = 0; n < qb; ++n) { float sc = 0.f;
#pragma unroll
        for (int i = 0; i < 16; ++i) { const f32x4 k0 = *(const LAS f32x4*)(km + n * HD + 8 * i), k1 = *(const LAS f32x4*)(km + n * HD + 8 * i + 4);
            sc += bflo(qw[i][0]) * k0[0] + bfhi(qw[i][0]) * k0[1] + bflo(qw[i][1]) * k0[2] + bfhi(qw[i][1]) * k0[3]
                + bflo(qw[i][2]) * k1[0] + bfhi(qw[i][2]) * k1[1] + bflo(qw[i][3]) * k1[2] + bfhi(qw[i][3]) * k1[3]; }
        if (sc > v1) { v3 = v2; i3 = i2; v2 = v1; i2 = i1; v1 = sc; i1 = n; }
        else if (sc > v2) { v3 = v2; i3 = i2; v2 = sc; i2 = n; }
        else if (sc > v3) { v3 = sc; i3 = n; } }
    unsigned m = 0u; if (i1 >= 0) m |= 1u << i1; if (i2 >= 0) m |= 1u << i2; if (i3 >= 0) m |= 1u << i3;
    SEL[((size_t)b * NH + h) * SEQ + s] = m;
}
__device__ __forceinline__ att::BlockRef att_ref(Frame& F, int L, int pass) {
    const int bh = L >> 3, x = L & 7; const int qb = pass ? 15 - x : x; const int b = bh >> 3, h = bh & 7;
    att::BlockRef r; const size_t ro = ((size_t)(b * SEQ + qb * MBLK)) * D + h * HD;
    r.Q = (const bf16_t*)(F.ws + WS_Q) + ro; r.O = (bf16_t*)(F.ws + WS_YB) + ro;
    r.K = (const bf16_t*)(F.ws + WS_K) + (size_t)(b * SEQ) * D + h * HD; r.V = (const bf16_t*)(F.ws + WS_V) + (size_t)(b * SEQ) * D + h * HD;
    r.qb = qb; return r;
}
__device__ __forceinline__ void phase_attn(Frame& F, char* lds) {
    const int total = BATCH * NH * 8, stride = F.G;
    int L = F.vcu; if (L >= total) return;
    int pass = 0;
    att::BlockRef cur = att_ref(F, L, 0);
    att::Seam S;
    att::moba_prime(cur, lds, S, F.tid);
    for (;;) {
        if (pass == 0) {
            const float* KM = (const float*)(F.ws + WS_KMEAN) + (size_t)(L >> 3) * NBLK * HD;
            *(f32x4*)(lds + att::KM_OFF + F.tid * 16) = *(const f32x4*)(KM + F.tid * 4);
            __syncthreads(); }
        const bool more_pass = pass == 0, more_item = L + stride < total, last = !more_pass && !more_item;
        int passn = pass + 1, Ln = L;
        if (!more_pass) { passn = 0; Ln = more_item ? L + stride : L; }
        const att::BlockRef nxt = last ? cur : att_ref(F, Ln, passn);
        att::moba_block(cur, nxt, lds, S, F.tid);
        if (last) break;
        cur = nxt; pass = passn; L = Ln;
    }
}

constexpr int NPH = 42;
__global__ void __launch_bounds__(NTHR, 2) fwd(Args args) {
    extern __shared__ __attribute__((aligned(16))) unsigned char lds_[];
    Frame F;
    F.lds = (LAS unsigned char*)lds_; F.ws = args.ws;
    F.tid = threadIdx.x; F.lane = F.tid & 63; F.wave = __builtin_amdgcn_readfirstlane(F.tid >> 6);
    F.G = gridDim.x; { const int bx = blockIdx.x; F.vcu = (F.G % 8 == 0) ? (bx % 8) * (F.G / 8) + bx / 8 : bx; }
    volatile LAS unsigned* MISC = (volatile LAS unsigned*)(F.lds + LDS_MISC);
    if (F.tid < 64) MISC[F.tid] = 0u;
    __syncthreads();
    const int lo = args.ph_lo, hi = args.ph_hi;
    unsigned* ctl = (unsigned*)(F.ws + WS_CTL);
    XcdBarrier bar; bar.bar = ctl + CW_BAR + args.li * XCD_BAR_WORDS; bar.x = 0; bar.st = nullptr;
    if (hi - lo > 1) bar = xcd_barrier_post(ctl + CW_BAR + args.li * XCD_BAR_WORDS, MISC + 8);
#ifdef ONLY
#define EN(code) ((code) == ONLY)
#else
#define EN(code) true
#endif
#define IN(k) (lo <= (k) && (k) < hi)
#define SEAM(k) do { if (IN(k) && IN((k) + 1)) xcd_barrier(bar); } while (0)
#ifdef PROBE_CODE
#define REPS(code) ((code) == PROBE_CODE ? 1 + PROBE_EXTRA : 1)
#else
#define REPS(code) 1
#endif
#define PF() Frame Fp = F; asm volatile("" : "+v"(Fp.tid)); Fp.lane = Fp.tid & 63
    LAS unsigned* tab = (LAS unsigned*)(F.lds + LDS_TAB);
    const float* xin = args.in[IN_X]; float* out = args.out; const float* PAR = (const float*)(F.ws + WS_PAR);

    if (EN(0) && IN(0)) { for (int rep_ = 0; rep_ < REPS(0); ++rep_) { if (rep_) __syncthreads(); PF(); phase_prologue(Fp, args); } } SEAM(0);

#pragma nounroll
    for (int l = 0; l < DEPTH; ++l) {
        const int pb = 1 + 10 * l; const int j = l >> 1; const bool lru = (l & 1) == 0;
        if (EN(10) && IN(pb + 0)) { for (int rep_ = 0; rep_ < REPS(10); ++rep_) { if (rep_) __syncthreads(); PF(); phase_norm(Fp, xin, out, l, false); } } SEAM(pb + 0);
        if (lru) {
            if (EN(21) && IN(pb + 1)) { for (int rep_ = 0; rep_ < REPS(21); ++rep_) { if (rep_) __syncthreads(); pg8::ProbPlain P; P.init((const bf16_t*)(F.ws + WS_H), (const bf16_t*)(F.ws + WS_WIN) + (size_t)j * 2 * D * D, T, 2 * D, D, D, -1, F.G, (int)blockIdx.x);
                pg8::EpiWin E{(bf16_t*)(F.ws + WS_GB), (bf16_t*)(F.ws + WS_RB)};
                pg8::gemm_phase<pg8::EpiWin, pg8::ProbPlain, true, true>(F.lds, tab, P, E); } } SEAM(pb + 1);
            if (EN(22) && IN(pb + 2)) { for (int rep_ = 0; rep_ < REPS(22); ++rep_) { if (rep_) __syncthreads(); PF(); phase_conv(Fp, j); } } SEAM(pb + 2);
            if (EN(23) && IN(pb + 3)) { for (int rep_ = 0; rep_ < REPS(23); ++rep_) { if (rep_) __syncthreads(); pg8::ProbPlain P; P.init((const bf16_t*)(F.ws + WS_XC), (const bf16_t*)(F.ws + WS_WG) + (size_t)j * 2048 * 256, T, 2 * D, 256, D, 1, F.G, (int)blockIdx.x);
                pg8::EpiGates E{(const bf16_t*)(F.ws + WS_XC), (bf16_t*)(F.ws + WS_AF), (bf16_t*)(F.ws + WS_UF), PAR + PAR_LBA + (size_t)j * D, PAR + PAR_LBX + (size_t)j * D, (const float*)(F.ws + WS_SP8) + (size_t)j * D};
                pg8::gemm_phase<pg8::EpiGates, pg8::ProbPlain, true, true>(F.lds, tab, P, E); } } SEAM(pb + 3);
            if (EN(24) && IN(pb + 4)) { for (int rep_ = 0; rep_ < REPS(24); ++rep_) { if (rep_) __syncthreads(); PF(); phase_scan1(Fp); } } SEAM(pb + 4);
            if (EN(25) && IN(pb + 5)) { for (int rep_ = 0; rep_ < REPS(25); ++rep_) { if (rep_) __syncthreads(); PF(); phase_scan2(Fp); } } SEAM(pb + 5);
        } else {
            if (EN(31) && IN(pb + 1)) { for (int rep_ = 0; rep_ < REPS(31); ++rep_) { if (rep_) __syncthreads(); pg8::ProbPlain P; P.init((const bf16_t*)(F.ws + WS_H), (const bf16_t*)(F.ws + WS_WQKV) + (size_t)j * 3 * D * D, T, 3 * D, D, D, -1, F.G, (int)blockIdx.x);
                pg8::EpiQKV E{(bf16_t*)(F.ws + WS_Q), PAR + PAR_AQG + (size_t)j * HD, PAR + PAR_AKG + (size_t)j * HD, (float*)(F.ws + WS_KMEAN), (LAS float*)(F.lds + LDS_X)};
                pg8::gemm_phase<pg8::EpiQKV, pg8::ProbPlain, true, true>(F.lds, tab, P, E); } } SEAM(pb + 1);
            if (EN(34) && IN(pb + 4)) { for (int rep_ = 0; rep_ < REPS(34); ++rep_) { if (rep_) __syncthreads(); PF(); phase_attn(Fp, (char*)lds_); } } SEAM(pb + 4);
        }
        if (EN(16) && IN(pb + 6)) { for (int rep_ = 0; rep_ < REPS(16); ++rep_) { if (rep_) __syncthreads(); pg8::ProbPlain P; P.init((const bf16_t*)(F.ws + WS_YB), (const bf16_t*)(F.ws + (lru ? WS_WLO : WS_WAO)) + (size_t)j * D * D, T, D, D, D, -1, F.G, (int)blockIdx.x);
            pg8::EpiResid E{l == 0 ? xin : (const float*)(F.ws + WS_XB), (float*)(F.ws + WS_XB), (const float*)(F.ws + WS_MOD) + (size_t)l * BATCH * 6 * D + 2 * D, (const bf16_t*)(F.ws + WS_YK), (const float*)(F.ws + WS_MOD) + (size_t)(l > 0 ? l - 1 : 0) * BATCH * 6 * D + 5 * D, l == 0};
            pg8::gemm_phase<pg8::EpiResid, pg8::ProbPlain, false, true>(F.lds, tab, P, E); } } SEAM(pb + 6);
        if (EN(17) && IN(pb + 7)) { PF(); phase_router(Fp, l); } SEAM(pb + 7);
        if (EN(18) && IN(pb + 8)) { for (int rep_ = 0; rep_ < REPS(18); ++rep_) { if (rep_) __syncthreads(); PF(); const int nu = moe_units(Fp, l, 8);
            pg8::ProbMoE<true> P; P.A = (const bf16_t*)(F.ws + WS_H); P.Bt = (const bf16_t*)(F.ws + WS_WGU) + (size_t)l * NE * 2 * D * D; P.K = D; P.lda = D; P.bstride = (size_t)2 * D * D;
            P.rowlist = (const unsigned*)(F.ws + WS_ROWLIST); P.units = (const LAS int*)(F.lds + LDS_UNITS); P.nunits = nu;
            pg8::EpiSwiglu E{(bf16_t*)(F.ws + WS_ACT), PAR + PAR_BGU + (size_t)l * NE * 2 * D};
            pg8::gemm_phase<pg8::EpiSwiglu, pg8::ProbMoE<true>, true, true>(F.lds, tab, P, E); } } SEAM(pb + 8);
        if (EN(19) && IN(pb + 9)) { for (int rep_ = 0; rep_ < REPS(19); ++rep_) { if (rep_) __syncthreads(); PF(); const int nu = moe_units(Fp, l, 4);
            pg8::ProbMoE<false> P; P.A = (const bf16_t*)(F.ws + WS_ACT); P.Bt = (const bf16_t*)(F.ws + WS_WDN) + (size_t)l * NE * D * D; P.K = D; P.lda = D; P.bstride = (size_t)D * D;
            P.rowlist = (const unsigned*)(F.ws + WS_ROWLIST); P.units = (const LAS int*)(F.lds + LDS_UNITS); P.nunits = nu;
            pg8::EpiDown E{(bf16_t*)(F.ws + WS_YK), PAR + PAR_BDN + (size_t)l * NE * D, (const unsigned*)(F.ws + WS_ROWLIST), (const float*)(F.ws + WS_TOPW)};
            pg8::gemm_phase<pg8::EpiDown, pg8::ProbMoE<false>, true, true>(F.lds, tab, P, E); } } SEAM(pb + 9);
    }
    if (EN(41) && IN(41)) { PF(); phase_norm(Fp, xin, out, DEPTH, true); }
#undef IN
#undef SEAM
#undef EN
}

#ifndef DEBUG_CHECKS
#define DEBUG_CHECKS 0
#endif
#ifndef CHK_FROM
#define CHK_FROM 0
#endif
#if DEBUG_CHECKS
constexpr int CW_CHK = 70000;
__device__ __forceinline__ unsigned hsh(unsigned x) { x ^= x >> 16; x *= 0x7feb352du; x ^= x >> 15; x *= 0x846ca68bu; x ^= x >> 16; return x; }
__device__ __forceinline__ bool cls(float got, float ref, float rt, float at) { return (fabsf(got - ref) <= rt * fabsf(ref) + at); }
__device__ __forceinline__ float bfq(const bf16_t* p, size_t i) { return __uint_as_float(((unsigned)p[i]) << 16); }
__device__ __forceinline__ float gelu_ref(float x) { return 0.5f * x * (1.0f + tanhf(0.7978845608028654f * (x + 0.044715f * x * x * x))); }
__global__ void __launch_bounds__(64) chk(Args a, int id, int l, int code) {
    const int j = l >> 1;
    unsigned char* ws = a.ws; unsigned* ctl = (unsigned*)(ws + WS_CTL); const int lane = threadIdx.x;
    const float* MOD = (const float*)(ws + WS_MOD); const float* PAR = (const float*)(ws + WS_PAR);
    const bf16_t* H = (const bf16_t*)(ws + WS_H);
    bool bad = false;
    for (int it = 0; it < 8; ++it) {
        const unsigned sd = hsh(blockIdx.x * 131u + it * 7919u + id * 104729u + 12345u);
        if (id == 1) {
            const int l = sd & 3, b = (sd >> 2) & 3, n = (sd >> 4) % (6 * D); float s = 0.f;
            for (int k = lane; k < D; k += 64) { const float c = a.in[IN_C][b * D + k]; s += (c / (1.0f + expf(-c))) * a.in[IN_WMOD][((size_t)l * D + k) * 6 * D + n]; }
            s = wave_sum(s) + a.in[IN_BMOD][l * 6 * D + n];
            if (!cls(MOD[((size_t)l * BATCH + b) * 6 * D + n], s, 1e-3f, 1e-3f)) bad = true;
        } else if (id == 2) {
            const int m = sd % T, b = m / SEQ; float ss = 0.f;
            for (int k = lane; k < D; k += 64) { const float x = a.in[IN_X][(size_t)m * D + k]; ss += x * x; }
            const float rstd = 1.0f / sqrtf(wave_sum(ss) / D + NORM_EPS);
            for (int k = lane; k < D; k += 64) { const float x = a.in[IN_X][(size_t)m * D + k];
                const float h = x * rstd * a.in[IN_NMG][k] * (1.0f + MOD[(size_t)b * 6 * D + D + k]) + MOD[(size_t)b * 6 * D + k];
                if (!cls(bfq(H, (size_t)m * D + k), h, 0.01f, 0.01f)) bad = true; }
        } else if (id == 3) {
            const int m = sd % T, n = (sd >> 14) % (2 * D); float s = 0.f;
            for (int k = lane; k < D; k += 64) s += bfq(H, (size_t)m * D + k) * a.in[IN_LWIN][((size_t)j * D + k) * 2 * D + n];
            s = wave_sum(s);
            const float got = n < D ? bfq((const bf16_t*)(ws + WS_GB), (size_t)m * D + n) : bfq((const bf16_t*)(ws + WS_RB), (size_t)m * D + n - D);
            const float ref = n < D ? gelu_ref(s) : s;
            if (!cls(got, ref, 0.02f, 0.02f)) bad = true;
        } else if (id == 4) {
            const int m = sd % T, c = (sd >> 14) % D, s0 = m % SEQ; const bf16_t* RB = (const bf16_t*)(ws + WS_RB);
            float y = a.in[IN_LCB][j * D + c];
            for (int k = 0; k < 4; ++k) { const int t = s0 - 3 + k; if (t >= 0) y += a.in[IN_LCW][(j * 4 + k) * D + c] * bfq(RB, (size_t)(m - 3 + k) * D + c); }
            if (!cls(bfq((const bf16_t*)(ws + WS_XC), (size_t)m * D + c), y, 0.01f, 0.01f)) bad = true;
        } else if (id == 5) {
            const int m = sd % T, ch = (sd >> 14) % D, g = ch >> 8, jc = ch & 255; const bf16_t* XC = (const bf16_t*)(ws + WS_XC);
            float sa = 0.f, sx = 0.f;
            for (int i = lane; i < 256; i += 64) { const float xv = bfq(XC, (size_t)m * D + g * 256 + i); sa += xv * a.in[IN_LWA][((size_t)(j * 4 + g) * 256 + i) * 256 + jc]; sx += xv * a.in[IN_LWX][((size_t)(j * 4 + g) * 256 + i) * 256 + jc]; }
            sa = wave_sum(sa) + a.in[IN_LBA][j * D + ch]; sx = wave_sum(sx) + a.in[IN_LBX][j * D + ch];
            const float r = 1.0f / (1.0f + expf(-sa)), ig = 1.0f / (1.0f + expf(-sx)); const float lam = a.in[IN_LLAM][j * D + ch];
            const float la = -8.0f * r * log1pf(expf(-lam)); const float av = expf(la), uv = sqrtf(-expm1f(2.0f * la)) * ig * bfq(XC, (size_t)m * D + ch);
            if (!cls(((const float*)(ws + WS_AF))[(size_t)m * D + ch], av, 2e-3f, 1e-4f)) bad = true;
            if (!cls(((const float*)(ws + WS_UF))[(size_t)m * D + ch], uv, 0.03f, 0.003f)) bad = true;
        } else if (id == 6) {
            const int b = sd & 3, ch = ((sd >> 2) + lane * 17) % D; const float* AF = (const float*)(ws + WS_AF); const float* UF = (const float*)(ws + WS_UF);
            const bf16_t* GB = (const bf16_t*)(ws + WS_GB); const bf16_t* YB = (const bf16_t*)(ws + WS_YB);
            float h = 0.f;
            for (int t = 0; t < SEQ; ++t) { const size_t o = ((size_t)b * SEQ + t) * D + ch; h = AF[o] * h + UF[o];
                if ((t & 127) == 77 || t == SEQ - 1 || t == 0 || t == 64) { if (!cls(bfq(YB, o), bfq(GB, o) * h, 0.02f, 0.01f)) bad = true; } }
        } else if (id == 7) {
            const int m = sd % T, n = (sd >> 14) % D, b = m / SEQ; float s = 0.f; const bf16_t* YB = (const bf16_t*)(ws + WS_YB);
            for (int k = lane; k < D; k += 64) s += bfq(YB, (size_t)m * D + k) * a.in[IN_LWOUT][((size_t)j * D + k) * D + n];
            s = wave_sum(s);
            const float ref = (l == 0 ? a.in[IN_X][(size_t)m * D + n] : ((const float*)(ws + WS_XA))[(size_t)m * D + n]) + MOD[((size_t)l * BATCH + b) * 6 * D + 2 * D + n] * s;
            if (!cls(((const float*)(ws + WS_XB))[(size_t)m * D + n], ref, 0.01f, 0.01f)) bad = true;
        } else if (id == 8) {
            __shared__ float hrow[D];
            const int m = sd % MOE_TOK, b = m / SEQ; const float* XB = (const float*)(ws + WS_XB); float ss = 0.f;
            for (int k = lane; k < D; k += 64) { const float x = XB[(size_t)m * D + k]; ss += x * x; }
            const float rstd = 1.0f / sqrtf(wave_sum(ss) / D + NORM_EPS);
            __syncthreads();
            for (int k = lane; k < D; k += 64) { const float x = XB[(size_t)m * D + k];
                const float h = x * rstd * a.in[IN_NFG][l * D + k] * (1.0f + MOD[((size_t)l * BATCH + b) * 6 * D + 4 * D + k]) + MOD[((size_t)l * BATCH + b) * 6 * D + 3 * D + k]; hrow[k] = h;
                if (!cls(bfq(H, (size_t)m * D + k), h, 0.01f, 0.01f)) bad = true; }
            __syncthreads();
            const int e = lane & 31; float lg = a.in[IN_RB][l * NE + e];
            for (int k = 0; k < D; ++k) lg += hrow[k] * a.in[IN_RW][((size_t)l * D + k) * NE + e];
            int rank = 0; float mx = -1e30f;
            for (int q = 0; q < 32; ++q) { const float o = __shfl(lg, q); if (o > lg || (o == lg && q < e)) ++rank; mx = fmaxf(mx, o); }
            const bool sel = rank < 4; float den = 0.f;
            for (int q = 0; q < 32; ++q) { const float o = __shfl(lg, q); const int rk = __shfl(rank, q); if (rk < 4) den += expf(o - mx); }
            const float wref = expf(lg - mx) / den;
            float v4 = 0.f, v5 = 0.f; for (int q = 0; q < 32; ++q) { const float o = __shfl(lg, q); const int rk = __shfl(rank, q); if (rk == 3) v4 = o; if (rk == 4) v5 = o; }
            const unsigned* gcnt = ctl + CW_CNT + 64 * l; const unsigned* RL = (const unsigned*)(ws + WS_ROWLIST); const float* TW = (const float*)(ws + WS_TOPW);
            if (v4 - v5 > 1e-3f && lane < 32) {
                const int cnt = (int)gcnt[e]; int found = -1;
                for (int p = 0; p < cnt; ++p) { const unsigned r = RL[(size_t)e * CAP + p]; if ((int)(r >> 2) == m) found = (int)r; }
                if (sel) { if (found < 0) bad = true; else if (!cls(TW[found], wref, 0.01f, 1e-3f)) bad = true; }
                else if (found >= 0) bad = true;
            }
            unsigned tot = 0; for (int q = 0; q < 32; ++q) tot += gcnt[q]; if (tot != (unsigned)T) bad = true;
        } else if (id == 9 || id == 10) {
            const unsigned* gcnt = ctl + CW_CNT + 64 * l; const unsigned* RL = (const unsigned*)(ws + WS_ROWLIST); const float* TW = (const float*)(ws + WS_TOPW);
            const int e = sd & 31; int ts = 0; for (int q = 0; q < e; ++q) ts += ((int)gcnt[q] + 255) >> 8;
            const int cnt = (int)gcnt[e]; if (cnt == 0) continue;
            const int pos = (sd >> 5) % cnt; const unsigned dest = RL[(size_t)e * CAP + pos]; const int tok = dest >> 2; const size_t arow = (size_t)ts * 256 + pos;
            const int col = (sd >> 17) % D; const bf16_t* ACT = (const bf16_t*)(ws + WS_ACT);
            if (id == 9) { float sg = 0.f, su = 0.f;
                for (int k = lane; k < D; k += 64) { const float hv = bfq(H, (size_t)tok * D + k); sg += hv * a.in[IN_WGU][((size_t)(l * NE + e) * D + k) * 2 * D + col]; su += hv * a.in[IN_WGU][((size_t)(l * NE + e) * D + k) * 2 * D + D + col]; }
                sg = wave_sum(sg) + a.in[IN_BGU][(size_t)(l * NE + e) * 2 * D + col]; su = wave_sum(su) + a.in[IN_BGU][(size_t)(l * NE + e) * 2 * D + D + col];
                const float gv = fminf(sg, 7.f), uv = fminf(fmaxf(su, -7.f), 7.f); const float ref = gv / (1.0f + expf(-1.702f * gv)) * (uv + 1.0f);
                if (!cls(bfq(ACT, arow * D + col), ref, 0.03f, 0.02f)) bad = true;
            } else { float s = 0.f;
                for (int k = lane; k < D; k += 64) s += bfq(ACT, arow * D + k) * a.in[IN_WDN][((size_t)(l * NE + e) * D + k) * D + col];
                s = (wave_sum(s) + a.in[IN_BDN][(size_t)(l * NE + e) * D + col]) * TW[dest];
                if (!cls(bfq((const bf16_t*)(ws + WS_YK), (size_t)dest * D + col), s, 0.03f, 0.01f)) bad = true; }
        } else if (id == 11) {
            const int m = sd % T, h = (sd >> 14) & 7, which = (sd >> 17) % 3; float r0 = 0.f, r1 = 0.f;
            for (int k = 0; k < D; ++k) { const float hv = bfq(H, (size_t)m * D + k); const float* w = a.in[IN_AQKV] + ((size_t)j * D + k) * 3 * D + which * D + h * HD; r0 += hv * w[lane]; r1 += hv * w[lane + 64]; }
            const bf16_t* buf = (const bf16_t*)(ws + (which == 0 ? WS_Q : (which == 1 ? WS_K : WS_V)));
            const float g0 = bfq(buf, (size_t)m * D + h * HD + lane), g1 = bfq(buf, (size_t)m * D + h * HD + lane + 64);
            if (which == 2) { if (!cls(g0, r0, 0.02f, 0.02f) || !cls(g1, r1, 0.02f, 0.02f)) bad = true; }
            else { const float rs = 1.0f / sqrtf(wave_sum(r0 * r0 + r1 * r1) / HD + NORM_EPS); const float* gg = a.in[which == 0 ? IN_AQG : IN_AKG] + j * HD;
                if (!cls(g0, r0 * rs * gg[lane], 0.03f, 0.03f) || !cls(g1, r1 * rs * gg[lane + 64], 0.03f, 0.03f)) bad = true; }
        } else if (id == 12) {
            const int b = sd & 3, h = (sd >> 2) & 7, blk = (sd >> 5) & 15; const bf16_t* Kb = (const bf16_t*)(ws + WS_K); const float* KM = (const float*)(ws + WS_KMEAN);
            float s0 = 0.f, s1 = 0.f;
            for (int r = 0; r < MBLK; ++r) { const size_t o = ((size_t)b * SEQ + blk * MBLK + r) * D + h * HD; s0 += bfq(Kb, o + lane); s1 += bfq(Kb, o + lane + 64); }
            const float* km = KM + (((size_t)b * NH + h) * NBLK + blk) * HD;
            if (!cls(km[lane], s0 / MBLK, 0.03f, 0.003f) || !cls(km[lane + 64], s1 / MBLK, 0.03f, 0.003f)) bad = true;
            const int s = (sd >> 9) % SEQ, qb = s >> 8; const bf16_t* Q = (const bf16_t*)(ws + WS_Q); const unsigned msk = ((const unsigned*)(ws + WS_SEL))[((size_t)b * NH + h) * SEQ + s];
            float sc[16]; const size_t qo = ((size_t)b * SEQ + s) * D + h * HD;
#pragma unroll
            for (int n = 0; n < 16; ++n) { const float* kk = KM + (((size_t)b * NH + h) * NBLK + n) * HD; sc[n] = wave_sum(bfq(Q, qo + lane) * kk[lane] + bfq(Q, qo + lane + 64) * kk[lane + 64]); }
            int cntb = 0; float minsel = 1e30f;
#pragma unroll
            for (int n = 0; n < 16; ++n) if ((msk >> n) & 1u) { ++cntb; if (n >= qb) bad = true; minsel = fminf(minsel, sc[n]); }
            if (cntb != (qb < 3 ? qb : 3) || (msk >> 16)) bad = true;
            int better = 0;
#pragma unroll
            for (int n = 0; n < 16; ++n) if (n < qb && !((msk >> n) & 1u) && sc[n] > minsel + 1e-3f) ++better;
            if (better) bad = true;
        } else if (id == 13) {
            const int b = sd & 3, h = (sd >> 2) & 7, s = (sd >> 5) % SEQ, qb = s >> 8;
            const bf16_t* Q = (const bf16_t*)(ws + WS_Q); const bf16_t* Kb = (const bf16_t*)(ws + WS_K); const bf16_t* V = (const bf16_t*)(ws + WS_V); const bf16_t* O = (const bf16_t*)(ws + WS_YB);
            const unsigned msk = ((const unsigned*)(ws + WS_SEL))[((size_t)b * NH + h) * SEQ + s] | (1u << qb);
            const size_t qo = ((size_t)b * SEQ + s) * D + h * HD;
            float mx = -1e30f;
            for (int pass = 0; pass < 2; ++pass) {
                float den = 0.f, o0 = 0.f, o1 = 0.f;
                for (int blk = 0; blk <= qb; ++blk) if ((msk >> blk) & 1u) {
                    const int kend = blk == qb ? (s & 255) + 1 : 256;
                    for (int kk = 0; kk < kend; ++kk) { const size_t ko = ((size_t)b * SEQ + blk * MBLK + kk) * D + h * HD;
                        const float sc = wave_sum(bfq(Q, qo + lane) * bfq(Kb, ko + lane) + bfq(Q, qo + lane + 64) * bfq(Kb, ko + lane + 64)) * 0.08838834764831845f;
                        if (pass == 0) mx = fmaxf(mx, sc); else { const float p = expf(sc - mx); den += p; o0 += p * bfq(V, ko + lane); o1 += p * bfq(V, ko + lane + 64); } } }
                if (pass == 1) { if (!cls(bfq(O, qo + lane), o0 / den, 0.03f, 0.01f) || !cls(bfq(O, qo + lane + 64), o1 / den, 0.03f, 0.01f)) bad = true; }
            }
        } else if (id == 14) {
            const int m = sd % T, n = (sd >> 14) % D, b = m / SEQ; float s = 0.f; const bf16_t* YB = (const bf16_t*)(ws + WS_YB);
            for (int k = lane; k < D; k += 64) s += bfq(YB, (size_t)m * D + k) * a.in[IN_AWOUT][((size_t)j * D + k) * D + n];
            s = wave_sum(s);
            const float ref = ((const float*)(ws + WS_XA))[(size_t)m * D + n] + MOD[((size_t)l * BATCH + b) * 6 * D + 2 * D + n] * s;
            if (!cls(((const float*)(ws + WS_XB))[(size_t)m * D + n], ref, 0.01f, 0.01f)) bad = true;
        } else if (id == 15) {
            const int m = sd % T, b = m / SEQ; float ss = 0.f; const float* XA = (const float*)(ws + WS_XA); const bf16_t* YK = (const bf16_t*)(ws + WS_YK);
            for (int k = lane; k < D; k += 64) { const float x = XA[(size_t)m * D + k]; ss += x * x;
                const float sy = bfq(YK, (size_t)m * D + k);
                if (!cls(x, ((const float*)(ws + WS_XB))[(size_t)m * D + k] + MOD[((size_t)(l - 1) * BATCH + b) * 6 * D + 5 * D + k] * sy, 1e-3f, 1e-3f)) bad = true; }
            const float rstd = 1.0f / sqrtf(wave_sum(ss) / D + NORM_EPS);
            for (int k = lane; k < D; k += 64) { const float x = XA[(size_t)m * D + k];
                const float hh = x * rstd * a.in[IN_NMG][l * D + k] * (1.0f + MOD[((size_t)l * BATCH + b) * 6 * D + D + k]) + MOD[((size_t)l * BATCH + b) * 6 * D + k];
                if (!cls(bfq(H, (size_t)m * D + k), hh, 0.01f, 0.01f)) bad = true; }
        }
    }
    if (id == 16) {
        for (int it = 0; it < 8; ++it) { const unsigned sd = hsh(blockIdx.x * 131u + it * 7919u + 777u); const int m = sd % T, b = m / SEQ; const bf16_t* YK = (const bf16_t*)(ws + WS_YK);
            for (int k = lane; k < D; k += 64) { const float sy = bfq(YK, (size_t)m * D + k);
                if (!cls(a.out[(size_t)m * D + k], ((const float*)(ws + WS_XB))[(size_t)m * D + k] + MOD[((size_t)3 * BATCH + b) * 6 * D + 5 * D + k] * sy, 1e-3f, 1e-3f)) bad = true; } } }
    if (id == 99) bad = true;
    if (__any(bad) && lane == 0) atomicMax(ctl + CW_CHK, (unsigned)(100 - code));
    (void)PAR;
}
__global__ void chk_encode(Args a) {
    const unsigned v = ((const unsigned*)(a.ws + WS_CTL))[CW_CHK]; if (v == 0u) return;
    const float f = 1.0f + (float)(100 - (int)v);
    for (size_t i = (size_t)blockIdx.x * blockDim.x + threadIdx.x; i < (size_t)T * D; i += (size_t)gridDim.x * blockDim.x) a.out[i] = a.in[IN_X][i] * f;
}
#endif

#ifndef N_LAUNCH_MODE
#define N_LAUNCH_MODE 1
#endif
extern "C" void kernel_launch(void* const* d_in, const int* in_sizes, int n_in, void* d_out, int out_size, void* d_ws, size_t ws_size, hipStream_t stream) {
    static int grid = 0;
    if (grid == 0) {
        if (n_in != 25 || out_size != T * D || ws_size < WS_END) { fprintf(stderr, "kernel_launch: unexpected shapes (n_in %d out %d ws %zu)\n", n_in, out_size, ws_size); grid = -1; return; }
        int dev = 0, cus = 0;
        if (hipGetDevice(&dev) != hipSuccess || hipDeviceGetAttribute(&cus, hipDeviceAttributeMultiprocessorCount, dev) != hipSuccess) { grid = -1; return; }
        if (hipFuncSetAttribute((const void*)fwd, hipFuncAttributeMaxDynamicSharedMemorySize, LDS_BYTES) != hipSuccess) { fprintf(stderr, "kernel_launch: hipFuncSetAttribute failed\n"); grid = -1; return; }
        int per_cu = 0;
        if (hipOccupancyMaxActiveBlocksPerMultiprocessor(&per_cu, (const void*)fwd, NTHR, LDS_BYTES) != hipSuccess || per_cu < 1) fprintf(stderr, "kernel_launch: occupancy query says %d\n", per_cu);
        (void)hipGetLastError();
        if (cus < 256) { fprintf(stderr, "kernel_launch: %d CUs < 256\n", cus); grid = -1; return; }
        grid = 256;
    }
    if (grid < 0) return;
    (void)hipMemsetAsync((char*)d_ws + WS_CTL, 0, CTL_ZERO_BYTES, stream);
    Args a{};
    for (int i = 0; i < 25; ++i) a.in[i] = (const float*)d_in[i];
    a.out = (float*)d_out; a.ws = (unsigned char*)d_ws; a.pad = 0;
#if N_LAUNCH_MODE == 1
    a.ph_lo = 0; a.ph_hi = NPH; a.li = 0;
    hipLaunchKernelGGL(fwd, dim3(grid), dim3(NTHR), LDS_BYTES, stream, a);
#else
    int ordinal = 0; (void)ordinal;
    for (int p = 0; p < NPH; ++p) {
        const int l = (p - 1) / 10, o = (p - 1) % 10;
        if (p >= 1 && p <= 40 && (l & 1) == 1 && o == 5) continue;
        a.ph_lo = p; a.ph_hi = p + 1; a.li = 0;
        hipLaunchKernelGGL(fwd, dim3(grid), dim3(NTHR), LDS_BYTES, stream, a);
#if DEBUG_CHECKS
        {
            const int lch = (p - 1) / 10, och = (p - 1) % 10; int cid = 0;
            if (p == 0) cid = 1;
            else if (p == 41) cid = 16;
            else if ((lch & 1) == 0) { const int t[10] = {lch == 0 ? 2 : 15, 3, 4, 5, 0, 6, 7, 8, 9, 10}; cid = t[och]; }
            else { const int t[10] = {15, 0, 11, 12, 13, 0, 14, 8, 9, 10}; cid = t[och]; }
            if (cid && p >= CHK_FROM) { ++ordinal; hipLaunchKernelGGL(chk, dim3(64), dim3(64), 0, stream, a, cid, lch < 0 ? 0 : (p == 41 ? 3 : lch), ordinal); }
            if (p == 41) { ++ordinal; hipLaunchKernelGGL(chk, dim3(64), dim3(64), 0, stream, a, 99, 0, ordinal); }
        }
#endif
    }
#if DEBUG_CHECKS
    hipLaunchKernelGGL(chk_encode, dim3(1024), dim3(256), 0, stream, a);
#endif
#endif
}
```

```cpp
#include <hip/hip_runtime.h>
#include <stdint.h>
#include <stdio.h>

#define LAS __attribute__((address_space(3)))
#define GAS __attribute__((address_space(1)))
typedef unsigned short bf16_t;
typedef short bf16x8 __attribute__((ext_vector_type(8)));
typedef float f32x4 __attribute__((ext_vector_type(4)));
typedef float f32x2 __attribute__((ext_vector_type(2)));
typedef unsigned u32x4 __attribute__((ext_vector_type(4)));
typedef unsigned u32x2 __attribute__((ext_vector_type(2)));

constexpr int BATCH = 4, SEQ = 4096, D = 1024, T = BATCH * SEQ, DEPTH = 4;
constexpr int NE = 32, TOPK = 4, NH = 8, HD = 128, NBLK = 16, MBLK = 256;
constexpr float NORM_EPS = 1e-6f;
constexpr int NWAVES = 8, NTHR = 512;
constexpr int CAP = T;
constexpr int MAXTILES = T * TOPK / 256 + NE;

constexpr size_t MiB = 1u << 20;
constexpr size_t WS_CTL = 0, CTL_ZERO_BYTES = 1 * MiB;
constexpr size_t WS_MOD = 1 * MiB;
constexpr size_t WS_SP8 = 2 * MiB;
constexpr size_t WS_KMEAN = 3 * MiB;
constexpr size_t WS_SEL = 4 * MiB;
constexpr size_t WS_ROWLIST = 5 * MiB;
constexpr size_t WS_TOPW = 7 * MiB;
constexpr size_t WS_PS = 8 * MiB;
constexpr size_t WS_PAR = 10 * MiB;
constexpr int PAR_NMG = 0, PAR_NFG = PAR_NMG + 4 * 1024, PAR_LCW = PAR_NFG + 4 * 1024, PAR_LCB = PAR_LCW + 2 * 4 * 1024, PAR_LBA = PAR_LCB + 2 * 1024, PAR_LBX = PAR_LBA + 2 * 1024,
              PAR_AQG = PAR_LBX + 2 * 1024, PAR_AKG = PAR_AQG + 256, PAR_RW = PAR_AKG + 256, PAR_RB = PAR_RW + 4 * 1024 * 32, PAR_BGU = PAR_RB + 128, PAR_BDN = PAR_BGU + 4 * 32 * 2048, PAR_END = PAR_BDN + 4 * 32 * 1024;
static_assert((size_t)PAR_END * 4 <= 6 * MiB, "param region");
constexpr size_t WS_WIN = 16 * MiB;
constexpr size_t WS_WG = 24 * MiB;
constexpr size_t WS_WLO = 26 * MiB;
constexpr size_t WS_WQKV = 30 * MiB;
constexpr size_t WS_WAO = 42 * MiB;
constexpr size_t WS_WGU = 64 * MiB;
constexpr size_t WS_WDN = 576 * MiB;
constexpr size_t WS_XA = 832 * MiB;
constexpr size_t WS_XB = 896 * MiB;
constexpr size_t WS_H = 960 * MiB;
constexpr size_t WS_GB = 992 * MiB;
constexpr size_t WS_RB = 1024 * MiB;
constexpr size_t WS_XC = 1056 * MiB;
constexpr size_t WS_AF = 1088 * MiB;
constexpr size_t WS_UF = 1152 * MiB;
constexpr size_t WS_YB = 1216 * MiB;
constexpr size_t WS_Q = 1248 * MiB, WS_K = 1280 * MiB, WS_V = 1312 * MiB;
constexpr size_t WS_ACT = 1344 * MiB;
constexpr size_t WS_YK = 1488 * MiB;
constexpr size_t WS_END = 1616 * MiB;

constexpr int CW_BAR = 4096;
constexpr int CW_CNT = 65536;

constexpr int RING_BYTES = 131072;
constexpr int LDS_TAB = RING_BYTES;
constexpr int LDS_UNITS = LDS_TAB + 1024;
constexpr int LDS_MOE = LDS_UNITS + 512;
constexpr int LDS_MISC = LDS_MOE + 512;
constexpr int LDS_X = LDS_MISC + 256;
constexpr int LDS_BYTES = 147456;

__device__ __forceinline__ float bf2f(unsigned h) { return __uint_as_float(h << 16); }
__device__ __forceinline__ float bflo(unsigned u) { return __uint_as_float(u << 16); }
__device__ __forceinline__ float bfhi(unsigned u) { return __uint_as_float(u & 0xffff0000u); }
__device__ __forceinline__ unsigned cvt_pk_bf16(float lo, float hi) { unsigned r; asm("v_cvt_pk_bf16_f32 %0, %1, %2" : "=v"(r) : "v"(lo), "v"(hi)); return r; }
__device__ __forceinline__ float wave_sum(float v) {
#pragma unroll
    for (int o = 1; o < 64; o <<= 1) v += __shfl_xor(v, o);
    return v;
}
__device__ __forceinline__ float fast_exp(float x) { return __builtin_amdgcn_exp2f(x * 1.4426950408889634f); }
__device__ __forceinline__ float sigmoidf_(float x) { return __builtin_amdgcn_rcpf(1.0f + fast_exp(-x)); }
#define LDS_WAIT() asm volatile("s_waitcnt lgkmcnt(0)" ::: "memory")
#define VM_WAIT() asm volatile("s_waitcnt vmcnt(0)" ::: "memory")

#define XB_TMO      128
#define XB_XCNT(j)  (256  + 64 * (j))
#define XB_XSUB(j)  (1280 + 64 * (j))
#define XB_XGEN(j)  (2304 + 64 * (j))
#define XB_TOP      3328
#define XB_TOPGEN   3392
#define XCD_BAR_WORDS 3456
#define XB_SPIN_CAP (1u << 18)
__device__ __forceinline__ unsigned xb_ld(unsigned* p)              { return __hip_atomic_load(p, __ATOMIC_RELAXED, __HIP_MEMORY_SCOPE_AGENT); }
__device__ __forceinline__ unsigned xb_add(unsigned* p, unsigned v) { return __hip_atomic_fetch_add(p, v, __ATOMIC_RELAXED, __HIP_MEMORY_SCOPE_AGENT); }
__device__ __forceinline__ unsigned xb_xcc_id() { return (unsigned)__builtin_amdgcn_s_getreg((3 << 11) | 20) & 0xFu; }
#define XB_SPIN(cond, bar) do { unsigned _sp = 0; while (cond) { __builtin_amdgcn_s_sleep(1); \
    if ((++_sp & 255u) == 0u) { if (xb_ld(&(bar)[XB_TMO])) break; if (_sp > XB_SPIN_CAP) { atomicAdd(&(bar)[XB_TMO], 1u); break; } } } } while (0)
struct XcdBarrier { unsigned* bar; unsigned x; volatile LAS unsigned* st; };
__device__ __forceinline__ XcdBarrier xcd_barrier_post(unsigned* bar, volatile LAS unsigned* st) {
    XcdBarrier b; b.bar = bar; b.x = xb_xcc_id(); b.st = st;
    if (threadIdx.x == 0) (void)xb_add(&bar[XB_XCNT(b.x)], 1u);
    return b;
}
__device__ __forceinline__ void xcd_barrier_complete(unsigned* bar, unsigned x, unsigned& nloc, unsigned& nx) {
    const unsigned G = gridDim.x * gridDim.y * gridDim.z;
    unsigned sum, cnt, mine, sp = 0u;
    for (;;) {
        sum = 0u; cnt = 0u; mine = 0u;
#pragma unroll
        for (unsigned j = 0; j < 16; ++j) { const unsigned c = xb_ld(&bar[XB_XCNT(j)]); sum += c; cnt += (c > 0u) ? 1u : 0u; mine = (j == x) ? c : mine; }
        if (sum == G) break;
        __builtin_amdgcn_s_sleep(1);
        if ((++sp & 255u) == 0u) { if (xb_ld(&bar[XB_TMO])) break; if (sp > XB_SPIN_CAP) { atomicAdd(&bar[XB_TMO], 1u); break; } }
    }
    nloc = mine > 0u ? mine : 1u; nx = cnt > 0u ? cnt : 1u;
}
__device__ __forceinline__ void xcd_barrier(const XcdBarrier& b) {
    asm volatile("s_waitcnt vmcnt(0)" ::: "memory");
    __syncthreads();
    if (threadIdx.x == 0) {
        unsigned* bar = b.bar;
        __builtin_amdgcn_s_waitcnt(0);
        unsigned nloc = b.st[0], nx = b.st[1];
        if (nloc == 0u) { xcd_barrier_complete(bar, b.x, nloc, nx); b.st[0] = nloc; b.st[1] = nx; }
        const unsigned old = xb_add(&bar[XB_XSUB(b.x)], 1u);
        const unsigned gen = old / nloc;
        if (old + 1u == (gen + 1u) * nloc) {
            __builtin_amdgcn_fence(__ATOMIC_RELEASE, "agent");
            asm volatile("s_waitcnt vmcnt(0)" ::: "memory");
            const unsigned og = xb_add(&bar[XB_TOP], 1u);
            const unsigned tg = og / nx;
            if (og + 1u == (tg + 1u) * nx) xb_add(&bar[XB_TOPGEN], 1u);
            else XB_SPIN(xb_ld(&bar[XB_TOPGEN]) == tg, bar);
            __builtin_amdgcn_fence(__ATOMIC_ACQUIRE, "agent");
            xb_add(&bar[XB_XGEN(b.x)], 1u);
            asm volatile("s_waitcnt vmcnt(0)" ::: "memory");
        } else {
            XB_SPIN(xb_ld(&bar[XB_XGEN(b.x)]) == gen, bar);
            __builtin_amdgcn_fence(__ATOMIC_ACQUIRE, "agent");
            asm volatile("s_waitcnt vmcnt(0)" ::: "memory");
        }
    }
    __syncthreads();
}

namespace pg8 {
constexpr int BM = 256, BK = 64, HALF = 128, HTB = HALF * BK * 2, STAGE_BYTES = 8 * HTB, NXCD = 8, WGM = 8;
__host__ __device__ __forceinline__ int lds_byte(int r, int c) { const int st = (r >> 4) * 2 + (c >> 5), rr = r & 15, cc = c & 31, ob = rr * 64 + cc * 2; return st * 1024 + (ob ^ (((ob >> 9) & 1) << 5)); }
__host__ __device__ __forceinline__ void stage_rc(int b, int& R, int& C) { const int st = b / 1024, sb = b % 1024, swz = sb ^ (((sb >> 9) & 1) << 5); R = (st >> 1) * 16 + swz / 64; C = (st & 1) * 32 + (swz % 64) / 2; }
__host__ __device__ __forceinline__ int perm32(int rho) { const int n = rho >> 4, i = rho & 15; return 8 * (i >> 2) + 4 * n + (i & 3); }

struct Unit { int pm, pn, e, valid, j; };

struct ProbPlain {
    static constexpr bool GATHER = false, TAILS = false;
    const bf16_t* A; const bf16_t* Bt; int M, N, K, lda; int acol_sh;
    int nM, nN, nwg, G, c;
    __device__ __forceinline__ void init(const bf16_t* A_, const bf16_t* Bt_, int M_, int N_, int K_, int lda_, int acol_sh_, int G_, int c_) {
        A = A_; Bt = Bt_; M = M_; N = N_; K = K_; lda = lda_; acol_sh = acol_sh_; nM = M / BM; nN = N / BM; nwg = nM * nN; G = G_; c = c_; }
    __device__ __forceinline__ bool next(int i, Unit& u) const {
        const long L = (long)i * G + c; if (L >= nwg) return false;
        int wgid = (int)L; { const int q = nwg / NXCD, r = nwg % NXCD, xcd = wgid % NXCD, off = wgid / NXCD; wgid = (xcd < r ? xcd * (q + 1) : r * (q + 1) + (xcd - r) * q) + off; }
        const int nig = WGM * nN, gid = wgid / nig, fm = gid * WGM, gsz = (nM - fm) < WGM ? (nM - fm) : WGM;
        u.pm = fm + ((wgid % nig) % gsz); u.pn = (wgid % nig) / gsz; u.e = 0; u.valid = 256; u.j = 0; return true;
    }
    __device__ __forceinline__ const char* a_base(const Unit& u) const { const int ac = acol_sh >= 0 ? (u.pn >> acol_sh) * 256 : 0; return (const char*)(A + (size_t)u.pm * BM * lda + ac); }
    __device__ __forceinline__ const char* b_base(const Unit& u) const { return (const char*)(Bt + (size_t)u.pn * BM * K); }
    __device__ __forceinline__ void fill_tab(const Unit&, LAS unsigned*) const {}
    __device__ __forceinline__ void a_off(const Unit&, const int (&R)[2], const int (&C)[2], unsigned (&v)[2][2], const LAS unsigned*) const {
#pragma unroll
        for (int h = 0; h < 2; ++h)
#pragma unroll
            for (int i = 0; i < 2; ++i) v[h][i] = (unsigned)((h * HALF + R[i]) * lda + C[i]) * 2u;
    }
};
template <bool GATHER_> struct ProbMoE {
    static constexpr bool GATHER = GATHER_, TAILS = true;
    const bf16_t* A; const bf16_t* Bt; int K, lda; size_t bstride;
    const unsigned* rowlist; const LAS int* units; int nunits;
    __device__ __forceinline__ bool next(int i, Unit& u) const {
        if (i >= nunits) return false;
        u.pm = __builtin_amdgcn_readfirstlane(units[i * 4 + 0]); u.pn = __builtin_amdgcn_readfirstlane(units[i * 4 + 1]);
        const int ej = __builtin_amdgcn_readfirstlane(units[i * 4 + 2]); u.e = ej & 255; u.j = ej >> 8; u.valid = __builtin_amdgcn_readfirstlane(units[i * 4 + 3]); return true;
    }
    __device__ __forceinline__ const char* a_base(const Unit& u) const { return GATHER ? (const char*)A : (const char*)(A + (size_t)u.pm * BM * lda); }
    __device__ __forceinline__ const char* b_base(const Unit& u) const { return (const char*)(Bt + (size_t)u.e * bstride + (size_t)u.pn * BM * K); }
    __device__ __forceinline__ void fill_tab(const Unit& u, LAS unsigned* tab) const {
        if (GATHER && threadIdx.x < 256) {
            const unsigned* rl = rowlist + (size_t)u.e * CAP + u.j * 256;
            const int r = (int)threadIdx.x < u.valid ? (int)threadIdx.x : 0;
            tab[threadIdx.x] = rl[r] >> 2;
        }
    }
    __device__ __forceinline__ void a_off(const Unit&, const int (&R)[2], const int (&C)[2], unsigned (&v)[2][2], const LAS unsigned* tab) const {
#pragma unroll
        for (int h = 0; h < 2; ++h)
#pragma unroll
            for (int i = 0; i < 2; ++i) {
                if (GATHER) v[h][i] = (tab[h * HALF + R[i]] * (unsigned)lda + (unsigned)C[i]) * 2u;
                else v[h][i] = (unsigned)((h * HALF + R[i]) * lda + C[i]) * 2u;
            }
    }
};

template <class Epi, class Prob, bool ALIGN_EPI, bool SP2>
__device__ __forceinline__ void gemm_phase(LAS unsigned char* lds, LAS unsigned* tab, const Prob& P, const Epi& E) {
    int tid = threadIdx.x; asm volatile("" : "+v"(tid));
    const int wid = __builtin_amdgcn_readfirstlane(tid >> 6), lane = tid & 63, wr = wid >> 2, wc = wid & 3, fr = lane & 15, fq = lane >> 4;
    const int K = P.K, nt = K / BK;
    int Rr[2], Cc[2]; unsigned voffB[2];
#pragma unroll
    for (int i = 0; i < 2; ++i) { int R, C; stage_rc(tid * 16 + i * 8192, R, C); Rr[i] = R; Cc[i] = C; const int Rb = Epi::PERM ? ((R & ~31) + perm32(R & 31)) : R; voffB[i] = (unsigned)(Rb * K + C) * 2u; }
    const size_t kstep = (size_t)(BK * 2);
    const size_t hstepB = (size_t)HALF * K * 2;
    const size_t hstepA = Prob::GATHER ? (size_t)0 : (size_t)HALF * P.lda * 2;
#define PG8_V1 (Prob::GATHER ? vcur[1] : vcur[0])
    const unsigned ldsw = (unsigned)wid * 1024u;
    const int aoff = lds_byte(wr * 64 + fr, fq * 8), boff = lds_byte(wc * 32 + fr, fq * 8);
#define PG8_SA(b, h) (((b) * 2 + (h)) * HTB)
#define PG8_SB(b, h) ((4 + (b) * 2 + (h)) * HTB)
#define PG8_STAGE(bufoff, gbase, voff) do { _Pragma("unroll") for (int _i = 0; _i < 2; ++_i) \
        __builtin_amdgcn_global_load_lds((const unsigned*)((const char*)(gbase) + (voff)[_i]), (LAS unsigned*)(lds + (bufoff) + ldsw + _i * 8192), 16, 0, 0); } while (0)
#define PG8_LDA(dst, b, h) do { _Pragma("unroll") for (int m = 0; m < 4; ++m) _Pragma("unroll") for (int k = 0; k < 2; ++k) dst[m][k] = *(const LAS bf16x8*)(lds + PG8_SA(b, h) + aoff + m * 2048 + k * 1024); } while (0)
#define PG8_LDB(dst, b, h) do { _Pragma("unroll") for (int n = 0; n < 2; ++n) _Pragma("unroll") for (int k = 0; k < 2; ++k) dst[n][k] = *(const LAS bf16x8*)(lds + PG8_SB(b, h) + boff + n * 2048 + k * 1024); } while (0)
#define PG8_MMA(ai, bj, At, Bt) do { __builtin_amdgcn_s_setprio(1); _Pragma("unroll") for (int m = 0; m < 4; ++m) _Pragma("unroll") for (int n = 0; n < 2; ++n) _Pragma("unroll") for (int k = 0; k < 2; ++k) \
        acc[ai][bj][m][n] = __builtin_amdgcn_mfma_f32_16x16x32_bf16(Bt[n][k], At[m][k], acc[ai][bj][m][n], 0, 0, 0); __builtin_amdgcn_s_setprio(0); } while (0)
#define PG8_WAIT_V(n) asm volatile("s_waitcnt vmcnt(" #n ")" ::: "memory")
#define PG8_WAIT_L(n) asm volatile("s_waitcnt lgkmcnt(" #n ")" ::: "memory")
#define PG8_BAR __builtin_amdgcn_s_barrier()
#define PG8_SCHED __builtin_amdgcn_sched_barrier(0)
    Unit cur, nxt; int ui = 0;
    if (!P.next(0, cur)) return;
    unsigned vcur[2][2];
    if constexpr (Prob::GATHER) { P.fill_tab(cur, tab); asm volatile("s_waitcnt vmcnt(0) lgkmcnt(0)" ::: "memory"); PG8_BAR; asm volatile("" ::: "memory"); }
    P.a_off(cur, Rr, Cc, vcur, tab);
    if constexpr (Prob::GATHER) { asm volatile("s_waitcnt lgkmcnt(0)" ::: "memory"); }
    f32x4 acc[2][2][4][2];
#pragma unroll
    for (int a = 0; a < 2; ++a)
#pragma unroll
        for (int b = 0; b < 2; ++b)
#pragma unroll
            for (int m = 0; m < 4; ++m)
#pragma unroll
                for (int n = 0; n < 2; ++n) acc[a][b][m][n] = (f32x4){0.f, 0.f, 0.f, 0.f};
    bf16x8 At[4][2], B0[2][2], B1[2][2];
    const char* cA = P.a_base(cur); const char* cB = P.b_base(cur);
    static_assert(SP2, "only the two-MFMA-blocks-per-barrier-pair loop is kept");
    PG8_STAGE(PG8_SB(0, 0), cB, voffB); PG8_STAGE(PG8_SB(0, 1), cB + hstepB, voffB); PG8_STAGE(PG8_SA(0, 0), cA, vcur[0]); PG8_STAGE(PG8_SA(0, 1), cA + hstepA, PG8_V1);
    if (wr == 1) PG8_BAR;
    PG8_WAIT_V(2); PG8_BAR;
    PG8_STAGE(PG8_SB(1, 0), cB + kstep, voffB); PG8_STAGE(PG8_SA(1, 0), cA + kstep, vcur[0]); PG8_STAGE(PG8_SB(1, 1), cB + hstepB + kstep, voffB);
    PG8_WAIT_V(6); PG8_BAR;
    for (;;) {
        const bool has_next = P.next(ui + 1, nxt);
        const char* nA = has_next ? P.a_base(nxt) : cA; const char* nB = has_next ? P.b_base(nxt) : cB;
        if constexpr (Prob::GATHER) { if (has_next) P.fill_tab(nxt, tab); }
        const bool full = !Prob::TAILS || cur.valid > HALF;
        for (int t = 0; t < nt; t += 2) {
            const bool last = (t == nt - 2);
            const char* a1 = cA + (size_t)(t + 1) * kstep;
            const char* a2 = last ? nA : cA + (size_t)(t + 2) * kstep; const char* b2 = last ? nB : cB + (size_t)(t + 2) * kstep;
            const char* a3 = a2 + kstep; const char* b3 = b2 + kstep;
            PG8_LDB(B0, 0, 0); PG8_LDB(B1, 0, 1); PG8_SCHED; PG8_LDA(At, 0, 0); PG8_STAGE(PG8_SA(1, 1), a1 + hstepA, PG8_V1);
            if constexpr (Prob::GATHER) { if (last && has_next) P.a_off(nxt, Rr, Cc, vcur, tab); }
            PG8_WAIT_V(8); PG8_WAIT_L(0); PG8_BAR; PG8_MMA(0, 0, At, B0); PG8_MMA(0, 1, At, B1); PG8_BAR; PG8_SCHED;
            if (full) { PG8_LDA(At, 0, 1); } PG8_STAGE(PG8_SB(0, 0), b2, voffB); PG8_STAGE(PG8_SB(0, 1), b2 + hstepB, voffB); PG8_STAGE(PG8_SA(0, 0), a2, vcur[0]);
            PG8_WAIT_V(8); PG8_WAIT_L(0); PG8_BAR; if (full) { PG8_MMA(1, 0, At, B0); PG8_MMA(1, 1, At, B1); } PG8_BAR; PG8_SCHED;
            PG8_LDB(B0, 1, 0); PG8_LDB(B1, 1, 1); PG8_SCHED; PG8_LDA(At, 1, 0); PG8_STAGE(PG8_SA(0, 1), a2 + hstepA, PG8_V1);
            PG8_WAIT_V(8); PG8_WAIT_L(0); PG8_BAR; PG8_MMA(0, 0, At, B0); PG8_MMA(0, 1, At, B1); PG8_BAR; PG8_SCHED;
            if (full) { PG8_LDA(At, 1, 1); } PG8_STAGE(PG8_SB(1, 0), b3, voffB); PG8_STAGE(PG8_SB(1, 1), b3 + hstepB, voffB); PG8_STAGE(PG8_SA(1, 0), a3, vcur[0]);
            PG8_WAIT_V(8); PG8_WAIT_L(0); PG8_BAR; if (full) { PG8_MMA(1, 0, At, B0); PG8_MMA(1, 1, At, B1); } PG8_BAR; PG8_SCHED;
        }
        if constexpr (ALIGN_EPI) { if (wr == 0) PG8_BAR; }
        E(acc, cur, wr, wc, fr, fq);
        if (!has_next) break;
#pragma unroll
        for (int a = 0; a < 2; ++a)
#pragma unroll
            for (int b = 0; b < 2; ++b)
#pragma unroll
                for (int m = 0; m < 4; ++m)
#pragma unroll
                    for (int n = 0; n < 2; ++n) acc[a][b][m][n] = (f32x4){0.f, 0.f, 0.f, 0.f};
        cur = nxt; cA = nA; cB = nB; ++ui;
        if constexpr (ALIGN_EPI) { if (wr == 1) PG8_BAR; }
    }
    PG8_WAIT_V(0);
    if constexpr (!ALIGN_EPI) { if (wr == 0) PG8_BAR; }
    PG8_BAR;
#undef PG8_V1
#undef PG8_SA
#undef PG8_SB
#undef PG8_STAGE
#undef PG8_LDA
#undef PG8_LDB
#undef PG8_MMA
#undef PG8_WAIT_V
#undef PG8_WAIT_L
#undef PG8_BAR
#undef PG8_SCHED
}

typedef f32x4 AccT[2][2][4][2];
__device__ __forceinline__ float gelu_tanh(float x) {
    const float z = 1.5957691216057308f * (x + 0.044715f * x * x * x);
    return x * __builtin_amdgcn_rcpf(1.0f + __builtin_amdgcn_exp2f(-1.4426950408889634f * z));
}
struct EpiWin {
    static constexpr bool PERM = true;
    bf16_t* GB; bf16_t* RB;
    __device__ __forceinline__ void operator()(const AccT& acc, const Unit& u, int wr, int wc, int fr, int fq) const {
        const int row0 = u.pm * BM + wr * 64 + fr; const bool gate = u.pn < 4;
        bf16_t* base = GB + (size_t)(u.pn >> 2) * ((WS_RB - WS_GB) / 2); const int col0 = (u.pn & 3) * BM + wc * 32 + 8 * fq;
#pragma unroll
        for (int ai = 0; ai < 2; ++ai)
#pragma unroll
            for (int m = 0; m < 4; ++m) { bf16_t* rowp = base + (size_t)(row0 + ai * HALF + m * 16) * D + col0;
#pragma unroll
                for (int bj = 0; bj < 2; ++bj) { f32x4 v0 = acc[ai][bj][m][0], v1 = acc[ai][bj][m][1];
                    if (gate) {
#pragma unroll
                        for (int j = 0; j < 4; ++j) { v0[j] = gelu_tanh(v0[j]); v1[j] = gelu_tanh(v1[j]); } }
                    u32x4 w; w.x = cvt_pk_bf16(v0[0], v0[1]); w.y = cvt_pk_bf16(v0[2], v0[3]); w.z = cvt_pk_bf16(v1[0], v1[1]); w.w = cvt_pk_bf16(v1[2], v1[3]);
                    *(u32x4*)(rowp + bj * HALF) = w; } }
    }
};
struct EpiQKV {
    static constexpr bool PERM = true;
    bf16_t* Q; const float* qg; const float* kg; float* KM; LAS float* xl;
    __device__ __forceinline__ void operator()(const AccT& acc, const Unit& u, int wr, int wc, int fr, int fq) const {
        const int row0 = u.pm * BM + wr * 64 + fr; const int t = u.pn >> 2;
        bf16_t* base = Q + (size_t)t * ((WS_K - WS_Q) / 2); const int col0 = (u.pn & 3) * BM + wc * 32 + 8 * fq;
        LAS float* SS = xl; LAS float* KS = xl + 2048;
#pragma unroll
        for (int ai = 0; ai < 2; ++ai)
#pragma unroll
            for (int m = 0; m < 4; ++m)
#pragma unroll
                for (int bj = 0; bj < 2; ++bj) { const f32x4 v0 = acc[ai][bj][m][0], v1 = acc[ai][bj][m][1];
                    float ss = (v0[0] * v0[0] + v0[1] * v0[1]) + (v0[2] * v0[2] + v0[3] * v0[3]) + (v1[0] * v1[0] + v1[1] * v1[1]) + (v1[2] * v1[2] + v1[3] * v1[3]);
                    ss += __shfl_xor(ss, 16); ss += __shfl_xor(ss, 32);
                    if (fq == 0) SS[((ai * HALF + wr * 64 + m * 16 + fr) * 2 + bj) * 4 + wc] = ss; __builtin_amdgcn_sched_barrier(0); }
        asm volatile("s_waitcnt lgkmcnt(0)" ::: "memory"); __builtin_amdgcn_s_barrier(); asm volatile("" ::: "memory");
        const bool isv = (t == 2);
        const float* gp = (t == 0 ? qg : kg) + wc * 32 + 8 * fq;
        f32x4 g0 = *(const f32x4*)gp, g1 = *(const f32x4*)(gp + 4);
        if (isv) { g0 = (f32x4){1.f, 1.f, 1.f, 1.f}; g1 = g0; }
        {
#pragma unroll
            for (int bj = 0; bj < 2; ++bj) {
                float cs[8];
#pragma unroll
                for (int q = 0; q < 8; ++q) cs[q] = 0.f;
#pragma unroll
                for (int ai = 0; ai < 2; ++ai)
#pragma unroll
                    for (int m = 0; m < 4; ++m) { const int r = ai * HALF + wr * 64 + m * 16 + fr; bf16_t* rowp = base + (size_t)(u.pm * BM + r) * D + col0;
                        const f32x4 p = *(const LAS f32x4*)(SS + (r * 2 + bj) * 4);
                        const float rstd = isv ? 1.0f : __builtin_amdgcn_rsqf(((p[0] + p[1]) + (p[2] + p[3])) * (1.0f / HD) + NORM_EPS);
                        const f32x4 v0 = acc[ai][bj][m][0] * rstd * g0, v1 = acc[ai][bj][m][1] * rstd * g1;
#pragma unroll
                        for (int q = 0; q < 4; ++q) { cs[q] += v0[q]; cs[4 + q] += v1[q]; }
                        u32x4 w; w.x = cvt_pk_bf16(v0[0], v0[1]); w.y = cvt_pk_bf16(v0[2], v0[3]); w.z = cvt_pk_bf16(v1[0], v1[1]); w.w = cvt_pk_bf16(v1[2], v1[3]);
                        *(u32x4*)(rowp + bj * HALF) = w; __builtin_amdgcn_sched_barrier(0); }
#pragma unroll
                for (int q = 0; q < 8; ++q) { float v = cs[q]; v += __shfl_xor(v, 1); v += __shfl_xor(v, 2); v += __shfl_xor(v, 4); v += __shfl_xor(v, 8);
                    if (fr == 0) KS[wr * 256 + bj * HALF + wc * 32 + 8 * fq + q] = v; }
            }
            asm volatile("s_waitcnt lgkmcnt(0)" ::: "memory"); __builtin_amdgcn_s_barrier(); asm volatile("" ::: "memory");
            int tid = threadIdx.x; asm volatile("" : "+v"(tid));
            if (tid < 256 && t == 1) { const int b = u.pm >> 4, blk = u.pm & 15, h = 2 * (u.pn & 3) + (tid >> 7);
                KM[(((size_t)b * NH + h) * NBLK + blk) * HD + (tid & 127)] = (KS[tid] + KS[256 + tid]) * (1.0f / MBLK); }
        }
    }
};
struct EpiGates {
    static constexpr bool PERM = true;
    const bf16_t* XC; bf16_t* LA; bf16_t* UB; const float* ba; const float* bx; const float* sp8;
    __device__ __forceinline__ void operator()(const AccT& acc, const Unit& u, int wr, int wc, int fr, int fq) const {
        const int row0 = u.pm * BM + wr * 64 + fr; const int ch0 = (u.pn >> 1) * 256 + (u.pn & 1) * 128 + wc * 32 + 8 * fq;
        f32x4 bav[2], bxv[2], spv[2];
#pragma unroll
        for (int n = 0; n < 2; ++n) { bav[n] = *(const f32x4*)(ba + ch0 + n * 4); bxv[n] = *(const f32x4*)(bx + ch0 + n * 4); spv[n] = *(const f32x4*)(sp8 + ch0 + n * 4) * 1.4426950408889634f; }
#pragma unroll
        for (int ai = 0; ai < 2; ++ai)
#pragma unroll
            for (int m = 0; m < 4; ++m) { const size_t ro = (size_t)(row0 + ai * HALF + m * 16) * D + ch0;
                const u32x4 xw = *(const u32x4*)(XC + ro);
                float lo[8], uo[8];
#pragma unroll
                for (int n = 0; n < 2; ++n)
#pragma unroll
                    for (int j = 0; j < 4; ++j) { const int q = n * 4 + j; const float xcv = (q & 1) ? bfhi(xw[q >> 1]) : bflo(xw[q >> 1]);
                        const float r = sigmoidf_(acc[ai][0][m][n][j] + bav[n][j]), ig = sigmoidf_(acc[ai][1][m][n][j] + bxv[n][j]);
                        const float l2 = -spv[n][j] * r;
                        const float a2 = __builtin_amdgcn_exp2f(2.0f * l2);
                        lo[q] = l2; uo[q] = __builtin_amdgcn_sqrtf(1.0f - a2) * ig * xcv; }
                u32x4 lw, uw;
#pragma unroll
                for (int q = 0; q < 4; ++q) { lw[q] = cvt_pk_bf16(lo[2 * q], lo[2 * q + 1]); uw[q] = cvt_pk_bf16(uo[2 * q], uo[2 * q + 1]); }
                *(u32x4*)(LA + ro) = lw; *(u32x4*)(UB + ro) = uw; }
    }
};
struct EpiResid {
    static constexpr bool PERM = false;
    const float* X; float* XB; const float* g1; const bf16_t* YK; const float* g2p; bool first;
    __device__ __forceinline__ void operator()(const AccT& acc, const Unit& u, int wr, int wc, int fr, int fq) const {
        const int row0 = u.pm * BM + wr * 64 + fr, col0 = u.pn * BM + wc * 32 + 4 * fq; const int b = (u.pm * BM) / SEQ;
        f32x4 gv[2][2], g2v[2][2];
#pragma unroll
        for (int bj = 0; bj < 2; ++bj)
#pragma unroll
            for (int n = 0; n < 2; ++n) { gv[bj][n] = *(const f32x4*)(g1 + (size_t)b * 6 * D + col0 + bj * HALF + n * 16);
                g2v[bj][n] = first ? (f32x4){0.f, 0.f, 0.f, 0.f} : *(const f32x4*)(g2p + (size_t)b * 6 * D + col0 + bj * HALF + n * 16); }
#pragma unroll
        for (int ai = 0; ai < 2; ++ai)
#pragma unroll
            for (int m = 0; m < 4; ++m) { const size_t ro = (size_t)(row0 + ai * HALF + m * 16) * D + col0;
#pragma unroll
                for (int bj = 0; bj < 2; ++bj)
#pragma unroll
                    for (int n = 0; n < 2; ++n) { f32x4 xv = *(const f32x4*)(X + ro + bj * HALF + n * 16);
                        if (!first) { const u32x2 w = *(const u32x2*)(YK + ro + bj * HALF + n * 16); xv += g2v[bj][n] * (f32x4){bflo(w.x), bfhi(w.x), bflo(w.y), bfhi(w.y)}; }
                        *(f32x4*)(XB + ro + bj * HALF + n * 16) = xv + gv[bj][n] * acc[ai][bj][m][n]; }
                asm volatile("" ::: "memory"); }
    }
};
struct EpiSwiglu {
    static constexpr bool PERM = true;
    bf16_t* ACT; const float* bgu;
    __device__ __forceinline__ void operator()(const AccT& acc, const Unit& u, int wr, int wc, int fr, int fq) const {
        const int row0 = u.pm * BM + wr * 64 + fr; const int j0 = u.pn * HALF + wc * 32 + 8 * fq;
        const float* bp = bgu + (size_t)u.e * 2 * D + j0;
        const f32x4 bg0 = *(const f32x4*)(bp), bg1 = *(const f32x4*)(bp + 4), bu0 = *(const f32x4*)(bp + D), bu1 = *(const f32x4*)(bp + D + 4);
#pragma unroll
        for (int ai = 0; ai < 2; ++ai)
#pragma unroll
            for (int m = 0; m < 4; ++m) {
                float o[8];
#pragma unroll
                for (int n = 0; n < 2; ++n)
#pragma unroll
                    for (int j = 0; j < 4; ++j) { const float g = acc[ai][0][m][n][j] + (n ? bg1[j] : bg0[j]), up = acc[ai][1][m][n][j] + (n ? bu1[j] : bu0[j]);
                        const float gv = fminf(g, 7.0f), uv = fminf(fmaxf(up, -7.0f), 7.0f);
                        o[n * 4 + j] = gv * sigmoidf_(1.702f * gv) * (uv + 1.0f); }
                u32x4 w; w.x = cvt_pk_bf16(o[0], o[1]); w.y = cvt_pk_bf16(o[2], o[3]); w.z = cvt_pk_bf16(o[4], o[5]); w.w = cvt_pk_bf16(o[6], o[7]);
                *(u32x4*)(ACT + (size_t)(row0 + ai * HALF + m * 16) * D + j0) = w; }
    }
};
struct EpiDown {
    static constexpr bool PERM = true;
    bf16_t* YK; const float* bdn; const unsigned* rowlist; const float* topw;
    __device__ __forceinline__ void operator()(const AccT& acc, const Unit& u, int wr, int wc, int fr, int fq) const {
        const int c0 = u.pn * BM + wc * 32 + 8 * fq;
        const float* bp = bdn + (size_t)u.e * D + c0;
        f32x4 bv[2][2];
#pragma unroll
        for (int bj = 0; bj < 2; ++bj) { bv[bj][0] = *(const f32x4*)(bp + bj * HALF); bv[bj][1] = *(const f32x4*)(bp + bj * HALF + 4); }
        const unsigned* rl = rowlist + (size_t)u.e * CAP + u.j * 256;
#pragma unroll
        for (int ai = 0; ai < 2; ++ai)
#pragma unroll
            for (int m = 0; m < 4; ++m) { const int r = ai * HALF + wr * 64 + m * 16 + fr;
                if (r < u.valid) { const unsigned dest = rl[r]; const float w = topw[dest];
                    bf16_t* rowp = YK + (size_t)dest * D + c0;
#pragma unroll
                    for (int bj = 0; bj < 2; ++bj) { const f32x4 v0 = (acc[ai][bj][m][0] + bv[bj][0]) * w, v1 = (acc[ai][bj][m][1] + bv[bj][1]) * w;
                        u32x4 o; o.x = cvt_pk_bf16(v0[0], v0[1]); o.y = cvt_pk_bf16(v0[2], v0[3]); o.z = cvt_pk_bf16(v1[0], v1[1]); o.w = cvt_pk_bf16(v1[2], v1[3]);
                        *(u32x4*)(rowp + bj * HALF) = o; } } }
    }
};
}

namespace att {
typedef short s16x4 __attribute__((ext_vector_type(4)));
typedef float f32x16 __attribute__((ext_vector_type(16)));
constexpr int NW = 8, QBLK = 32, KVBLK = 64, QB = NW * QBLK, DH = 128, LD = 1024;
constexpr int SHM_V = KVBLK * DH * 2, SHM_K = KVBLK * DH * 2;
constexpr int ATT_LDS_BYTES = 2 * SHM_V + 2 * SHM_K + NW * 64 * 4;
constexpr float SCALE = 0.08838834764831845f;
constexpr float THR = 8.f;
#define KSWZ(row, colB) ((row) * 256 + ((colB) ^ (((row) & 7) << 4)))
#define SBAR() __builtin_amdgcn_sched_barrier(0)
__device__ __forceinline__ int v_st(int k, int c) { const int kk = (k & ~0xC) | ((k & 4) << 1) | ((k & 8) >> 1); return ((kk >> 3) * 4 + (c >> 5)) * 512 + ((kk & 7) * 32 + (c & 31)) * 2; }
__device__ __forceinline__ int v_rd_base(int lane) { return ((lane & 3) << 3) | (((lane >> 2) & 3) << 6) | (((lane >> 4) & 1) << 5) | (((lane >> 5) & 1) << 8); }
constexpr int v_rd_off(int d0, int ks, int half) { return d0 * 512 + ks * 4096 + half * 2048; }
__device__ __forceinline__ int crow(int r, int hi) { return (r & 3) + 8 * (r >> 2) + 4 * hi; }
__device__ __forceinline__ unsigned cvtpk(float lo, float hi) { unsigned r; asm volatile("v_cvt_pk_bf16_f32 %0, %1, %2" : "=v"(r) : "v"(lo), "v"(hi)); return r; }
__device__ __forceinline__ bf16x8 ld8(const bf16_t* p) { return *reinterpret_cast<const bf16x8*>(p); }
__device__ __forceinline__ void mask_causal(f32x16& p0, f32x16& p1, int dq) {
    const float NEG = -__builtin_inff();
#pragma unroll
    for (int r = 0; r < 16; ++r) {
        const int c = (r & 3) + 8 * (r >> 2);
        if (dq - c < 0) p0[r] = NEG;
        if (dq - c - 32 < 0) p1[r] = NEG;
    }
}
__device__ __forceinline__ void mask_all(f32x16& p0, f32x16& p1, bool keep) {
    const float NEG = -__builtin_inff();
#pragma unroll
    for (int r = 0; r < 16; ++r) { p0[r] = keep ? p0[r] : NEG; p1[r] = keep ? p1[r] : NEG; }
}
__device__ __forceinline__ void partialSM(f32x16& p0, f32x16& p1, float& m_reg, float& mn, float& alpha) {
    float pmax = p0[0]; for (int r = 1; r < 16; ++r) pmax = fmaxf(pmax, p0[r]); for (int r = 0; r < 16; ++r) pmax = fmaxf(pmax, p1[r]);
    { auto rr = __builtin_amdgcn_permlane32_swap(__float_as_uint(pmax), __float_as_uint(pmax), false, false);
      pmax = fmaxf(__uint_as_float(rr[0]), __uint_as_float(rr[1])); }
    constexpr float C2 = 1.4426950408889634f * SCALE;
    if (__builtin_expect(__all((pmax - m_reg) * SCALE <= THR), 1)) { mn = m_reg; alpha = 1.f; }
    else { mn = fmaxf(m_reg, pmax); alpha = __builtin_amdgcn_exp2f((m_reg - mn) * C2); m_reg = mn; }
    const float mnL = -mn * C2;
    for (int r = 0; r < 16; ++r) p0[r] = fmaf(p0[r], C2, mnL); for (int r = 0; r < 16; ++r) p1[r] = fmaf(p1[r], C2, mnL);
    for (int r = 0; r < 16; ++r) p0[r] = __builtin_amdgcn_exp2f(p0[r]);
}
__device__ __forceinline__ void finishSM(f32x16& p0, f32x16& p1, float alpha, float& l_reg, bf16x8& pa0, bf16x8& pa1, bf16x8& pa2, bf16x8& pa3) {
    for (int r = 0; r < 16; ++r) p1[r] = __builtin_amdgcn_exp2f(p1[r]);
    float ps = 0; for (int r = 0; r < 16; ++r) ps += p0[r]; for (int r = 0; r < 16; ++r) ps += p1[r];
    { auto rr = __builtin_amdgcn_permlane32_swap(__float_as_uint(ps), __float_as_uint(ps), false, false);
      ps = __uint_as_float(rr[0]) + __uint_as_float(rr[1]); }
    l_reg = l_reg * alpha + ps;
#define PK4(P, B_, OUT) do { unsigned a0 = cvtpk(P[B_+0], P[B_+1]), a1 = cvtpk(P[B_+2], P[B_+3]);                          \
        unsigned b0 = cvtpk(P[B_+4], P[B_+5]), b1 = cvtpk(P[B_+6], P[B_+7]);                                             \
        auto r0 = __builtin_amdgcn_permlane32_swap(a0, b0, false, false); auto r1 = __builtin_amdgcn_permlane32_swap(a1, b1, false, false); \
        u32x4 w = {r0[0], r1[0], r0[1], r1[1]}; OUT = *reinterpret_cast<bf16x8*>(&w); } while (0)
    PK4(p0, 0, pa0); PK4(p0, 8, pa1); PK4(p1, 0, pa2); PK4(p1, 8, pa3);
#undef PK4
}
template <int KB>
__device__ __forceinline__ void qkt(f32x16& p0, f32x16& p1, const char* K_lds, int r32, int hi, const bf16x8* qr) {
    p0 = f32x16{}; p1 = f32x16{};
    const char* kb[4];
#pragma unroll
    for (int dd = 0; dd < 4; ++dd) kb[dd] = K_lds + KB * SHM_K + KSWZ(r32, (dd * 16 + hi * 8) * 2);
#pragma unroll
    for (int d0 = 0; d0 < 8; ++d0) { const char* a = kb[d0 & 3] + (d0 >> 2) * 128;
        bf16x8 b0 = *reinterpret_cast<const bf16x8*>(a);
        bf16x8 b1 = *reinterpret_cast<const bf16x8*>(a + 32 * 256);
        p0 = __builtin_amdgcn_mfma_f32_32x32x16_bf16(b0, qr[d0], p0, 0, 0, 0);
        p1 = __builtin_amdgcn_mfma_f32_32x32x16_bf16(b1, qr[d0], p1, 0, 0, 0); }
}
template <int VB>
__device__ __forceinline__ void pv_tile(f32x16* o, int vb0, bf16x8 pa0, bf16x8 pa1, bf16x8 pa2, bf16x8 pa3) {
#define TRRD(dst, off) asm volatile("ds_read_b64_tr_b16 %0, %1 offset:%2" : "=&v"(dst) : "v"(vb0), "i"(off) : "memory")
#define PV_D0(d0) do { s16x4 l0, l1, l2, l3, h0, h1, h2, h3; constexpr int b_ = VB * SHM_V + v_rd_off(d0, 0, 0); \
        TRRD(l0, b_); TRRD(h0, b_ + 2048); TRRD(l1, b_ + 4096); TRRD(h1, b_ + 6144); TRRD(l2, b_ + 8192); TRRD(h2, b_ + 10240); TRRD(l3, b_ + 12288); TRRD(h3, b_ + 14336); \
        asm volatile("s_waitcnt lgkmcnt(0)" ::: "memory"); SBAR();   \
        o[d0] = __builtin_amdgcn_mfma_f32_32x32x16_bf16(pa0, (bf16x8){l0[0], l0[1], l0[2], l0[3], h0[0], h0[1], h0[2], h0[3]}, o[d0], 0, 0, 0);   \
        o[d0] = __builtin_amdgcn_mfma_f32_32x32x16_bf16(pa1, (bf16x8){l1[0], l1[1], l1[2], l1[3], h1[0], h1[1], h1[2], h1[3]}, o[d0], 0, 0, 0);   \
        o[d0] = __builtin_amdgcn_mfma_f32_32x32x16_bf16(pa2, (bf16x8){l2[0], l2[1], l2[2], l2[3], h2[0], h2[1], h2[2], h2[3]}, o[d0], 0, 0, 0);   \
        o[d0] = __builtin_amdgcn_mfma_f32_32x32x16_bf16(pa3, (bf16x8){l3[0], l3[1], l3[2], l3[3], h3[0], h3[1], h3[2], h3[3]}, o[d0], 0, 0, 0); } while (0)
    PV_D0(0); PV_D0(1); PV_D0(2); PV_D0(3);
#undef PV_D0
#undef TRRD
}
constexpr int KM_OFF = 69632;
__device__ __forceinline__ unsigned moba_gate(const bf16x8* qr, const float* km, int qb, int hi) {
    float v1 = -__builtin_inff(), v2 = v1, v3 = v1; int i1 = -1, i2 = -1, i3 = -1;
    for (int n = 0; n < qb; ++n) { const float* kp = km + n * DH + hi * 8; float sc = 0.f;
#pragma unroll
        for (int d0 = 0; d0 < 8; ++d0) { const f32x4 k0 = *(const f32x4*)(kp + d0 * 16), k1 = *(const f32x4*)(kp + d0 * 16 + 4); const bf16x8 q = qr[d0];
#pragma unroll
            for (int e = 0; e < 4; ++e) { sc += __uint_as_float(((unsigned)(unsigned short)q[e]) << 16) * k0[e]; sc += __uint_as_float(((unsigned)(unsigned short)q[4 + e]) << 16) * k1[e]; } }
        sc += __shfl_xor(sc, 32);
        if (sc > v1) { v3 = v2; i3 = i2; v2 = v1; i2 = i1; v1 = sc; i1 = n; }
        else if (sc > v2) { v3 = v2; i3 = i2; v2 = sc; i2 = n; }
        else if (sc > v3) { v3 = sc; i3 = n; } }
    unsigned m = 0u; if (i1 >= 0) m |= 1u << i1; if (i2 >= 0) m |= 1u << i2; if (i3 >= 0) m |= 1u << i3;
    return m;
}
struct BlockRef { const bf16_t* Q; const bf16_t* K; const bf16_t* V; bf16_t* O; int qb; };
struct Seam { bf16x8 qr[8]; bf16x8 st_v0, st_v1, st_k0, st_k1; };
#define VMW() asm volatile("s_waitcnt vmcnt(0)" ::: "memory")
#define VMWN(n) asm volatile("s_waitcnt vmcnt(%0)" :: "i"(n) : "memory")
#define GLD8(ubase) (*reinterpret_cast<const bf16x8*>((ubase) + toff))
#define SLOAD_H(Kp, Vp, k0) do { const char* kb__ = (const char*)(Kp) + (size_t)(k0) * (LD * 2); const char* vb__ = (const char*)(Vp) + (size_t)(k0) * (LD * 2); \
                         S.st_v0 = GLD8(vb__); S.st_v1 = GLD8(vb__ + 32 * LD * 2); S.st_k0 = GLD8(kb__); S.st_k1 = GLD8(kb__ + 32 * LD * 2); } while (0)
#define SWRITE_HK(bf) do { *(bf16x8*)(K_lds + (bf) * SHM_K + kws) = S.st_k0; *(bf16x8*)(K_lds + (bf) * SHM_K + kws + 32 * 256) = S.st_k1; } while (0)
#define SWRITE_HV(bf) do { *(bf16x8*)(V_lds + (bf) * SHM_V + vst0) = S.st_v0; *(bf16x8*)(V_lds + (bf) * SHM_V + vst1) = S.st_v1; } while (0)
#define SWRITE_H(bf) do { SWRITE_HV(bf); SWRITE_HK(bf); } while (0)
__device__ __forceinline__ void moba_prime(const BlockRef& cur, char* lds, Seam& S, int tid) {
    const int wid = __builtin_amdgcn_readfirstlane(tid >> 6), lane = tid & 63, r32 = lane & 31, hi = lane >> 5;
    const int sr = tid >> 4, sc = (tid & 15) * 8, kws = KSWZ(sr, sc * 2); char* K_lds = lds + 2 * SHM_V;
    const unsigned toff = (unsigned)(sr * LD + sc) * 2u, qoff = (unsigned)(r32 * LD + hi * 8) * 2u;
    { const char* qb_ = (const char*)cur.Q + (size_t)(wid * QBLK) * (LD * 2);
#pragma unroll
      for (int d0 = 0; d0 < 8; ++d0) S.qr[d0] = *reinterpret_cast<const bf16x8*>(qb_ + d0 * 32 + qoff); }
    SLOAD_H(cur.K, cur.V, 0); VMW(); SWRITE_HK(0);
    __syncthreads();
}
__device__ __forceinline__ void moba_block(const BlockRef& cur, const BlockRef& nxt, char* lds, Seam& S, int tid) {
    const int wid = __builtin_amdgcn_readfirstlane(tid >> 6), lane = tid & 63, r32 = lane & 31, hi = lane >> 5;
    const int NT = 4 * (cur.qb + 1);
    const int P0 = cur.qb * QB;
    const int qlo = P0 + wid * QBLK, qm = qlo + r32 - 4 * hi;
    const unsigned msk = moba_gate(S.qr, (const float*)(lds + KM_OFF), cur.qb, hi);
    char* V_lds = lds; char* K_lds = lds + 2 * SHM_V;
    float* ws = (float*)(lds + 2 * SHM_V + 2 * SHM_K) + wid * 64; float* li_l = ws, * al_l = ws + 32;
    float m_reg = -1e30f, l_reg = 0; f32x16 o[4] = {};
    const int sr = tid >> 4, sc = (tid & 15) * 8, vst0 = v_st(sr, sc), vst1 = v_st(32 + sr, sc), kws = KSWZ(sr, sc * 2);
    const unsigned toff = (unsigned)(sr * LD + sc) * 2u, qoff = (unsigned)(r32 * LD + hi * 8) * 2u;
    const int vb0 = (int)(uintptr_t)V_lds + v_rd_base(lane);
    const bf16_t* Kh = cur.K; const bf16_t* Vh = cur.V;
#define RESC(a) do { if (__any((a) < 1.f)) { if (hi == 0) al_l[r32] = (a); asm volatile("s_waitcnt lgkmcnt(0)" ::: "memory");              \
                     for (int d_ = 0; d_ < 4; ++d_) for (int r = 0; r < 16; ++r) o[d_][r] *= al_l[crow(r, hi)]; } } while (0)
#define KBASE(t) ((t) * KVBLK)
#define MASKT(P0_, P1_, t) do { const int kb_ = KBASE(t); const int jb_ = (t) >> 2; \
        if (jb_ < cur.qb) { mask_all(P0_, P1_, ((msk >> jb_) & 1u) != 0u); } \
        else if (kb_ + KVBLK - 1 > qlo) mask_causal(P0_, P1_, qm - kb_); } while (0)
    constexpr int NQL = 8;
#define SEAM_K0() do { VMWN(NQL); SWRITE_HK(0); SBAR(); } while (0)
    f32x16 pA0, pA1, pB0, pB1; float mnA, mnB, alA, alB; bf16x8 pa0, pa1, pa2, pa3;
    SWRITE_HV(0); SBAR();
    if (NT > 1) { SLOAD_H(Kh, Vh, KBASE(1)); }
    SBAR(); qkt<0>(pA0, pA1, K_lds, r32, hi, S.qr);
    MASKT(pA0, pA1, 0); partialSM(pA0, pA1, m_reg, mnA, alA);
    if (NT > 1) { VMW(); SWRITE_H(1); }
    __syncthreads();
#define HALF_STEP(PX0, PX1, mnX, alX, PY0, PY1, alY, t, KB, VB, SB) do {                                                      \
        SBAR(); qkt<KB>(PX0, PX1, K_lds, r32, hi, S.qr);                                             \
        finishSM(PY0, PY1, alY, l_reg, pa0, pa1, pa2, pa3); SBAR();                                                           \
        if ((t) + 1 < NT) { SLOAD_H(Kh, Vh, KBASE((t) + 1)); SBAR(); }                                               \
        pv_tile<VB>(o, vb0, pa0, pa1, pa2, pa3); MASKT(PX0, PX1, (t)); partialSM(PX0, PX1, m_reg, mnX, alX);                                        \
        __syncthreads();                                                                                                      \
        if ((t) + 1 < NT) { VMW(); SWRITE_H(SB); }                                                                          \
        RESC(alX); __syncthreads(); } while (0)
    for (int t = 1; t + 1 < NT; t += 2) {
        HALF_STEP(pB0, pB1, mnB, alB, pA0, pA1, alA, t, 1, 0, 0);
        HALF_STEP(pA0, pA1, mnA, alA, pB0, pB1, alB, t + 1, 0, 1, 1);
    }
    const bool even = (NT & 1) == 0;
    if (even) { SBAR(); qkt<1>(pB0, pB1, K_lds, r32, hi, S.qr); SBAR(); }
    SLOAD_H(nxt.K, nxt.V, 0); SBAR();
    { const char* qb_ = (const char*)nxt.Q + (size_t)(wid * QBLK) * (LD * 2);
#pragma unroll
      for (int d0 = 0; d0 < 8; ++d0) S.qr[d0] = *reinterpret_cast<const bf16x8*>(qb_ + d0 * 32 + qoff); }
    SBAR();
    finishSM(pA0, pA1, alA, l_reg, pa0, pa1, pa2, pa3); SBAR();
    pv_tile<0>(o, vb0, pa0, pa1, pa2, pa3);
    if (even) { MASKT(pB0, pB1, NT - 1); partialSM(pB0, pB1, m_reg, mnB, alB); __syncthreads(); RESC(alB);
        finishSM(pB0, pB1, alB, l_reg, pa0, pa1, pa2, pa3); SBAR(); pv_tile<1>(o, vb0, pa0, pa1, pa2, pa3); }
    SBAR(); SEAM_K0();
    if (hi == 0) li_l[r32] = l_reg; asm volatile("s_waitcnt lgkmcnt(0)" ::: "memory");
    float rli[16];
#pragma unroll
    for (int r = 0; r < 16; ++r) rli[r] = __builtin_amdgcn_rcpf(li_l[crow(r, hi)]);
    char* Ow = (char*)cur.O + (size_t)(wid * QBLK) * (LD * 2);
    const unsigned ooff = (unsigned)(4 * hi * LD + r32) * 2u;
#pragma unroll
    for (int r = 0; r < 16; ++r) { char* Or = Ow + (size_t)((r & 3) + 8 * (r >> 2)) * (LD * 2);
#pragma unroll
        for (int d0 = 0; d0 < 4; ++d0) { const float v = o[d0][r] * rli[r];
            const float vn = __shfl_xor(v, 1);
            if ((r32 & 1) == 0) *(unsigned*)(Or + d0 * 64 + ooff) = cvtpk(v, vn); } }
    __syncthreads();
#undef RESC
#undef KBASE
#undef MASKT
#undef SEAM_K0
#undef HALF_STEP
}
#undef VMW
#undef VMWN
#undef SLOAD_H
#undef GLD8
#undef SWRITE_HK
#undef SWRITE_HV
#undef SWRITE_H
}

struct Args { const float* in[25]; float* out; unsigned char* ws; int ph_lo, ph_hi, li, pad; };
enum { IN_X = 0, IN_C, IN_NMG, IN_NFG, IN_WMOD, IN_BMOD, IN_LWIN, IN_LCW, IN_LCB, IN_LWA, IN_LBA, IN_LWX, IN_LBX, IN_LLAM, IN_LWOUT,
       IN_AQKV, IN_AQG, IN_AKG, IN_AWOUT, IN_RW, IN_RB, IN_WGU, IN_BGU, IN_WDN, IN_BDN };
struct Frame {
    LAS unsigned char* lds;
    unsigned char* ws;
    int tid, lane, wave, vcu, G;
};

__device__ __forceinline__ void cvt_tile(const float* W, int ldw, int k0, int n0, bf16_t* WT, int ldt, int drow0, LAS float* scr, int lane) {
    const int q = lane & 15, rr = lane >> 4;
    f32x4 v[16];
#pragma unroll
    for (int i = 0; i < 16; ++i) v[i] = *(const f32x4*)(W + (size_t)(k0 + 4 * i + rr) * ldw + n0 + 4 * q);
#pragma unroll
    for (int i = 0; i < 16; ++i) { LAS float* s = scr + (4 * i + rr) * 65 + 4 * q; s[0] = v[i][0]; s[1] = v[i][1]; s[2] = v[i][2]; s[3] = v[i][3]; }
    LDS_WAIT();
    const int c = lane & 7;
#pragma unroll
    for (int jj = 0; jj < 8; ++jj) { const int n = (lane >> 3) + 8 * jj; const LAS float* s = scr + (8 * c) * 65 + n;
        u32x4 o; o.x = cvt_pk_bf16(s[0 * 65], s[1 * 65]); o.y = cvt_pk_bf16(s[2 * 65], s[3 * 65]); o.z = cvt_pk_bf16(s[4 * 65], s[5 * 65]); o.w = cvt_pk_bf16(s[6 * 65], s[7 * 65]);
        *(u32x4*)(WT + (size_t)(drow0 + n) * ldt + k0 + 8 * c) = o; }
    LDS_WAIT();
}
__device__ __forceinline__ void phase_prologue(Frame& F, const Args& a) {
    if (blockIdx.x < 96) {
        LAS float* cond = (LAS float*)F.lds;
        LAS float* red = (LAS float*)(F.lds + 16384);
        const float* c = a.in[IN_C];
        for (int i = F.tid; i < BATCH * D; i += NTHR) { const float x = c[i]; cond[i] = x * sigmoidf_(x); }
        __syncthreads();
        const int l = blockIdx.x / 24, n0 = (blockIdx.x % 24) * 256;
        const float* W = a.in[IN_WMOD] + (size_t)l * D * 6 * D + n0 + 4 * F.lane;
        f32x4 acc[4];
#pragma unroll
        for (int b = 0; b < 4; ++b) acc[b] = (f32x4){0.f, 0.f, 0.f, 0.f};
        const int kb = F.wave * 128;
#pragma unroll 8
        for (int k = 0; k < 128; ++k) { const f32x4 w = *(const f32x4*)(W + (size_t)(kb + k) * 6 * D);
#pragma unroll
            for (int b = 0; b < 4; ++b) acc[b] += w * cond[b * D + kb + k]; }
#pragma unroll
        for (int b = 0; b < 4; ++b) *(LAS f32x4*)(red + (F.wave * 4 + b) * 256 + 4 * F.lane) = acc[b];
        __syncthreads();
        float* MOD = (float*)(F.ws + WS_MOD);
        for (int o = F.tid; o < 1024; o += NTHR) { const int b = o >> 8, n = o & 255; float s = 0.f;
#pragma unroll
            for (int w = 0; w < 8; ++w) s += red[(w * 4 + b) * 256 + n];
            MOD[((size_t)l * BATCH + b) * 6 * D + n0 + n] = s + a.in[IN_BMOD][(size_t)l * 6 * D + n0 + n]; }
        __syncthreads();
    }
    { const int g = blockIdx.x * NTHR + F.tid; if (g < 2 * D) { const float lam = a.in[IN_LLAM][g]; const float z = -lam;
        const float sp = z > 20.f ? z : log1pf(__expf(z)); ((float*)(F.ws + WS_SP8))[g] = 8.0f * sp; } }
    { float* PAR = (float*)(F.ws + WS_PAR); const int g = blockIdx.x * NTHR + F.tid, GS = F.G * NTHR;
#define CPY(dst, src, n) for (int i = g; i < (n) / 4; i += GS) *(f32x4*)(PAR + (dst) + 4 * i) = *(const f32x4*)(a.in[src] + 4 * i)
      CPY(PAR_NMG, IN_NMG, 4 * 1024); CPY(PAR_NFG, IN_NFG, 4 * 1024); CPY(PAR_LCW, IN_LCW, 2 * 4 * 1024); CPY(PAR_LCB, IN_LCB, 2 * 1024); CPY(PAR_LBA, IN_LBA, 2 * 1024); CPY(PAR_LBX, IN_LBX, 2 * 1024);
      CPY(PAR_AQG, IN_AQG, 256); CPY(PAR_AKG, IN_AKG, 256); CPY(PAR_RW, IN_RW, 4 * 1024 * 32); CPY(PAR_RB, IN_RB, 128); CPY(PAR_BGU, IN_BGU, 4 * 32 * 2048); CPY(PAR_BDN, IN_BDN, 4 * 32 * 1024);
#undef CPY
    }
    LAS float* scr = (LAS float*)(F.lds + F.wave * 16640);
    const int gw = F.vcu * NWAVES + F.wave, NGW = F.G * NWAVES;
    constexpr int I0 = 128 * 512, I1 = 128 * 256, I2 = 2 * 512, I3 = 16 * 16, I4 = 2 * 256, I5 = 2 * 768, I6 = 2 * 256;
    constexpr int NITEMS = I0 + I1 + I2 + I3 + I4 + I5 + I6;
    for (int it = gw; it < NITEMS; it += NGW) {
        int r = it;
        if (r < I0) { const int mat = r >> 9, q = r & 511, kb = q >> 5, nb = q & 31, n0 = nb * 64;
            const int dr = n0 < D ? (n0 >> 7) * 256 + (n0 & 127) : ((n0 - D) >> 7) * 256 + 128 + ((n0 - D) & 127);
            cvt_tile(a.in[IN_WGU] + (size_t)mat * D * 2 * D, 2 * D, kb * 64, n0, (bf16_t*)(F.ws + WS_WGU) + (size_t)mat * 2 * D * D, D, dr, scr, F.lane); continue; } r -= I0;
        if (r < I1) { const int mat = r >> 8, q = r & 255, kb = q >> 4, nb = q & 15;
            cvt_tile(a.in[IN_WDN] + (size_t)mat * D * D, D, kb * 64, nb * 64, (bf16_t*)(F.ws + WS_WDN) + (size_t)mat * D * D, D, nb * 64, scr, F.lane); continue; } r -= I1;
        if (r < I2) { const int mat = r >> 9, q = r & 511, kb = q >> 5, nb = q & 31;
            cvt_tile(a.in[IN_LWIN] + (size_t)mat * D * 2 * D, 2 * D, kb * 64, nb * 64, (bf16_t*)(F.ws + WS_WIN) + (size_t)mat * 2 * D * D, D, nb * 64, scr, F.lane); continue; } r -= I2;
        if (r < I3) { const int mat = r >> 4, q = r & 15, kb = q >> 2, nb = q & 3;
            const int layer = mat >> 3, ax = (mat >> 2) & 1, g = mat & 3, n0 = nb * 64;
            const float* src = (ax ? a.in[IN_LWX] : a.in[IN_LWA]) + (size_t)(layer * 4 + g) * 256 * 256;
            const int dr = (g * 2 + (n0 >> 7)) * 256 + ax * 128 + (n0 & 127);
            cvt_tile(src, 256, kb * 64, n0, (bf16_t*)(F.ws + WS_WG) + (size_t)layer * 2048 * 256, 256, dr, scr, F.lane); continue; } r -= I3;
        if (r < I4) { const int mat = r >> 8, q = r & 255, kb = q >> 4, nb = q & 15;
            cvt_tile(a.in[IN_LWOUT] + (size_t)mat * D * D, D, kb * 64, nb * 64, (bf16_t*)(F.ws + WS_WLO) + (size_t)mat * D * D, D, nb * 64, scr, F.lane); continue; } r -= I4;
        if (r < I5) { const int mat = r / 768, q = r % 768, kb = q / 48, nb = q % 48;
            cvt_tile(a.in[IN_AQKV] + (size_t)mat * D * 3 * D, 3 * D, kb * 64, nb * 64, (bf16_t*)(F.ws + WS_WQKV) + (size_t)mat * 3 * D * D, D, nb * 64, scr, F.lane); continue; } r -= I5;
        { const int mat = r >> 8, q = r & 255, kb = q >> 4, nb = q & 15;
            cvt_tile(a.in[IN_AWOUT] + (size_t)mat * D * D, D, kb * 64, nb * 64, (bf16_t*)(F.ws + WS_WAO) + (size_t)mat * D * D, D, nb * 64, scr, F.lane); }
    }
}

__device__ __forceinline__ void phase_norm(Frame& F, const float* xin, float* out, int layer, bool final_) {
    const float* PAR = (const float*)(F.ws + WS_PAR);
    const int gw = F.vcu * NWAVES + F.wave; const int m0 = gw * 8; const int b = m0 / SEQ;
    const float* MOD = (const float*)(F.ws + WS_MOD);
    const bool first = (layer == 0);
    f32x4 gain[4], sc[4], sh[4], g2[4];
#pragma unroll
    for (int j = 0; j < 4; ++j) { const int c = 4 * F.lane + 256 * j;
        if (!final_) { gain[j] = *(const f32x4*)(PAR + PAR_NMG + (size_t)layer * D + c);
            sh[j] = *(const f32x4*)(MOD + ((size_t)layer * BATCH + b) * 6 * D + c); sc[j] = *(const f32x4*)(MOD + ((size_t)layer * BATCH + b) * 6 * D + D + c); }
        if (!first) g2[j] = *(const f32x4*)(MOD + ((size_t)(layer - 1) * BATCH + b) * 6 * D + 5 * D + c); }
    const float* XB = (const float*)(F.ws + WS_XB);
    const bf16_t* YK = (const bf16_t*)(F.ws + WS_YK); bf16_t* H = (bf16_t*)(F.ws + WS_H);
    for (int r = 0; r < 8; ++r) { const int m = m0 + r;
        f32x4 x[4];
#pragma unroll
        for (int j = 0; j < 4; ++j) { const int c = 4 * F.lane + 256 * j;
            if (first) x[j] = *(const f32x4*)(xin + (size_t)m * D + c);
            else { const u32x2 w = *(const u32x2*)(YK + (size_t)m * D + c); const f32x4 s = (f32x4){bflo(w.x), bfhi(w.x), bflo(w.y), bfhi(w.y)};
                x[j] = *(const f32x4*)(XB + (size_t)m * D + c) + g2[j] * s;
                if (final_) *(f32x4*)(out + (size_t)m * D + c) = x[j]; } }
        if (final_) continue;
        float ss = 0.f;
#pragma unroll
        for (int j = 0; j < 4; ++j) ss += (x[j][0] * x[j][0] + x[j][1] * x[j][1]) + (x[j][2] * x[j][2] + x[j][3] * x[j][3]);
        const float rstd = __builtin_amdgcn_rsqf(wave_sum(ss) * (1.0f / D) + NORM_EPS);
#pragma unroll
        for (int j = 0; j < 4; ++j) { const int c = 4 * F.lane + 256 * j;
            const f32x4 h = x[j] * rstd * gain[j] * (1.0f + sc[j]) + sh[j];
            u32x2 o; o.x = cvt_pk_bf16(h[0], h[1]); o.y = cvt_pk_bf16(h[2], h[3]); *(u32x2*)(H + (size_t)m * D + c) = o; }
    }
}

constexpr int MOE_TOK = T / TOPK;
__device__ __forceinline__ void phase_router(Frame& F, int layer) {
    constexpr int RPW = MOE_TOK / (256 * NWAVES * 2);
    const float* PAR = (const float*)(F.ws + WS_PAR);
    LAS float* rw = (LAS float*)F.lds;
    LAS unsigned* lcnt = (LAS unsigned*)(F.lds + LDS_X);
    LAS unsigned* lbase = lcnt + 32;
    LAS unsigned* pend = lcnt + 64;
    { const float* RW = PAR + PAR_RW + (size_t)layer * D * NE;
      for (int i = F.tid; i < D * NE / 4; i += NTHR) { const int col = i >> 3, ch = i & 7; const f32x4 v = *(const f32x4*)(RW + (size_t)i * 4);
          *(LAS f32x4*)(rw + col * 32 + ((ch ^ ((col >> 2) & 7)) << 2)) = v; }
      if (F.tid < 32) lcnt[F.tid] = 0u; }
    __syncthreads();
    const int gw = F.vcu * NWAVES + F.wave; const int m0 = gw * 2 * RPW; const int b = m0 / SEQ;
    const float* MOD = (const float*)(F.ws + WS_MOD);
    f32x4 gain[4], sc[4], sh[4];
#pragma unroll
    for (int j = 0; j < 4; ++j) { const int c = 4 * F.lane + 256 * j; gain[j] = *(const f32x4*)(PAR + PAR_NFG + (size_t)layer * D + c);
        sh[j] = *(const f32x4*)(MOD + ((size_t)layer * BATCH + b) * 6 * D + 3 * D + c); sc[j] = *(const f32x4*)(MOD + ((size_t)layer * BATCH + b) * 6 * D + 4 * D + c); }
    const float* XB = (const float*)(F.ws + WS_XB); bf16_t* H = (bf16_t*)(F.ws + WS_H);
    const float rbias = PAR[PAR_RB + layer * NE + (F.lane & 31)];
    const int sw = F.lane & 7;
    for (int rp = 0; rp < RPW; ++rp) {
        f32x4 h[2][4];
#pragma unroll
        for (int q = 0; q < 2; ++q) { const int m = m0 + rp * 2 + q;
            f32x4 x[4]; float ss = 0.f;
#pragma unroll
            for (int j = 0; j < 4; ++j) { x[j] = *(const f32x4*)(XB + (size_t)m * D + 4 * F.lane + 256 * j); ss += (x[j][0] * x[j][0] + x[j][1] * x[j][1]) + (x[j][2] * x[j][2] + x[j][3] * x[j][3]); }
            const float rstd = __builtin_amdgcn_rsqf(wave_sum(ss) * (1.0f / D) + NORM_EPS);
#pragma unroll
            for (int j = 0; j < 4; ++j) { h[q][j] = x[j] * rstd * gain[j] * (1.0f + sc[j]) + sh[j];
                u32x2 o; o.x = cvt_pk_bf16(h[q][j][0], h[q][j][1]); o.y = cvt_pk_bf16(h[q][j][2], h[q][j][3]); *(u32x2*)(H + (size_t)m * D + 4 * F.lane + 256 * j) = o; } }
        float v[64];
#pragma unroll
        for (int i = 0; i < 64; ++i) v[i] = 0.f;
#pragma unroll
        for (int j = 0; j < 4; ++j)
#pragma unroll
            for (int cc = 0; cc < 4; ++cc) { const int col = 4 * F.lane + 256 * j + cc; const LAS float* rp_ = rw + col * 32;
#pragma unroll
                for (int eq = 0; eq < 8; ++eq) { const f32x4 w = *(const LAS f32x4*)(rp_ + ((eq ^ sw) << 2));
#pragma unroll
                    for (int k = 0; k < 4; ++k) { v[eq * 4 + k] = fmaf(h[0][j][cc], w[k], v[eq * 4 + k]); v[32 + eq * 4 + k] = fmaf(h[1][j][cc], w[k], v[32 + eq * 4 + k]); } } }
#pragma unroll
        for (int i = 0; i < 32; ++i) { const bool up = (F.lane & 32) != 0; const float send = up ? v[i] : v[32 + i]; const float recv = __shfl_xor(send, 32); v[i] = (up ? v[32 + i] : v[i]) + recv; }
#pragma unroll
        for (int i = 0; i < 16; ++i) { const bool up = (F.lane & 16) != 0; const float send = up ? v[i] : v[16 + i]; const float recv = __shfl_xor(send, 16); v[i] = (up ? v[16 + i] : v[i]) + recv; }
#pragma unroll
        for (int i = 0; i < 8; ++i) { const bool up = (F.lane & 8) != 0; const float send = up ? v[i] : v[8 + i]; const float recv = __shfl_xor(send, 8); v[i] = (up ? v[8 + i] : v[i]) + recv; }
#pragma unroll
        for (int i = 0; i < 4; ++i) { const bool up = (F.lane & 4) != 0; const float send = up ? v[i] : v[4 + i]; const float recv = __shfl_xor(send, 4); v[i] = (up ? v[4 + i] : v[i]) + recv; }
#pragma unroll
        for (int i = 0; i < 2; ++i) { const bool up = (F.lane & 2) != 0; const float send = up ? v[i] : v[2 + i]; const float recv = __shfl_xor(send, 2); v[i] = (up ? v[2 + i] : v[i]) + recv; }
        { const bool up = (F.lane & 1) != 0; const float send = up ? v[0] : v[1]; const float recv = __shfl_xor(send, 1); v[0] = (up ? v[1] : v[0]) + recv; }
        float logit = v[0] + rbias;
        float tv[4]; int te[4];
#pragma unroll
        for (int k = 0; k < 4; ++k) { float bv = logit; int be = F.lane & 31;
#pragma unroll
            for (int o = 1; o < 32; o <<= 1) { const float ov = __shfl_xor(bv, o); const int oe = __shfl_xor(be, o); if (ov > bv || (ov == bv && oe < be)) { bv = ov; be = oe; } }
            tv[k] = bv; te[k] = be; if ((F.lane & 31) == be) logit = -__builtin_inff(); }
        const float e1 = __expf(tv[1] - tv[0]), e2 = __expf(tv[2] - tv[0]), e3 = __expf(tv[3] - tv[0]); const float inv = 1.0f / (1.0f + e1 + e2 + e3);
        const int kk = F.lane & 31;
        if (kk < 4) { const int e = kk == 0 ? te[0] : (kk == 1 ? te[1] : (kk == 2 ? te[2] : te[3]));
            const float w = (kk == 0 ? 1.0f : (kk == 1 ? e1 : (kk == 2 ? e2 : e3))) * inv;
            const unsigned rank = __hip_atomic_fetch_add(&lcnt[e], 1u, __ATOMIC_RELAXED, __HIP_MEMORY_SCOPE_WORKGROUP);
            const int rl = F.wave * 2 * RPW + rp * 2 + (F.lane >> 5);
            pend[(rl * 4 + kk) * 2 + 0] = (unsigned)e | (rank << 8); pend[(rl * 4 + kk) * 2 + 1] = __float_as_uint(w); }
    }
    __syncthreads();
    unsigned* gcnt = (unsigned*)(F.ws + WS_CTL) + CW_CNT + 64 * layer;
    if (F.tid < 32) lbase[F.tid] = __hip_atomic_fetch_add(gcnt + F.tid, lcnt[F.tid], __ATOMIC_RELAXED, __HIP_MEMORY_SCOPE_AGENT);
    __syncthreads();
    if (F.tid < NWAVES * 2 * RPW * 4) { const int rl = F.tid >> 2, k = F.tid & 3; const unsigned p0 = pend[(rl * 4 + k) * 2], p1 = pend[(rl * 4 + k) * 2 + 1];
        const unsigned e = p0 & 255u, rank = p0 >> 8; const unsigned pos = lbase[e] + rank; const unsigned tok = (unsigned)(F.vcu * NWAVES * 2 * RPW + rl);
        ((unsigned*)(F.ws + WS_ROWLIST))[(size_t)e * CAP + pos] = tok * 4u + (unsigned)k;
        ((float*)(F.ws + WS_TOPW))[tok * 4u + k] = __uint_as_float(p1); }
}

__device__ __forceinline__ int moe_units(Frame& F, int layer, int npn) {
    LAS int* moe = (LAS int*)(F.lds + LDS_MOE);
    LAS int* units = (LAS int*)(F.lds + LDS_UNITS);
    if (F.wave == 0) {
        const unsigned* gcnt = (const unsigned*)(F.ws + WS_CTL) + CW_CNT + 64 * layer;
        const int e_ = F.lane & 31;
        const int cnt = (int)gcnt[e_]; const int ntl = (cnt + 255) >> 8;
        const int lastv = cnt - (ntl - 1) * 256;
        const int ntail = (ntl > 0 && lastv <= 128) ? 1 : 0, nfull = ntl - ntail;
        int incl = ntl, fincl = nfull, tincl = ntail;
#pragma unroll
        for (int o = 1; o < 32; o <<= 1) { const int t0 = __shfl_up(incl, o), t1 = __shfl_up(fincl, o), t2 = __shfl_up(tincl, o); if ((F.lane & 31) >= o) { incl += t0; fincl += t1; tincl += t2; } }
        const int start = incl - ntl, fstart = fincl - nfull, tstart = tincl - ntail; const int ts = __shfl(incl, 31), nf = __shfl(fincl, 31);
        const int c = blockIdx.x, xcd = c & 7, slot = c >> 3, rpx = 32 / npn;
        const int i = F.lane;
        const int p = (i * 8 + xcd) * rpx + slot / npn, pn = slot % npn;
        int e = 0, j = 0, st = 0, cn = 0;
        for (int q = 0; q < 32; ++q) { const int s_ = __shfl(start, q), c_ = __shfl(cnt, q), fs_ = __shfl(fstart, q), nf_ = __shfl(nfull, q), ts_ = __shfl(tstart, q), nt_ = __shfl(ntail, q), nl_ = __shfl(ntl, q);
            if (p < nf) { if (p >= fs_ && p < fs_ + nf_) { e = q; j = p - fs_; st = s_; cn = c_; } }
            else { const int pt = p - nf; if (pt >= ts_ && pt < ts_ + nt_) { e = q; j = nl_ - 1; st = s_; cn = c_; } } }
        const bool ok = (F.lane < 32) && (p < ts);
        const unsigned long long bal = __ballot(ok);
        if (ok) { int valid = cn - j * 256; valid = valid > 256 ? 256 : valid;
            units[i * 4 + 0] = st + j; units[i * 4 + 1] = pn; units[i * 4 + 2] = e | (j << 8); units[i * 4 + 3] = valid; }
        if (F.lane == 0) moe[40] = __popcll(bal);
    }
    __syncthreads();
    return __builtin_amdgcn_readfirstlane(moe[40]);
}

__device__ __forceinline__ void phase_conv(Frame& F, int j) {
    const float* PAR = (const float*)(F.ws + WS_PAR);
    const int g = F.vcu * NTHR + F.tid; const int chunk = g & 127, seg = g >> 7; const int c0 = chunk * 8, m0 = seg * 16; const int s0 = m0 & (SEQ - 1);
    const bf16_t* RB = (const bf16_t*)(F.ws + WS_RB); bf16_t* XC = (bf16_t*)(F.ws + WS_XC);
    float w[4][8], bias[8];
#pragma unroll
    for (int k = 0; k < 4; ++k) { const f32x4 w0 = *(const f32x4*)(PAR + PAR_LCW + ((size_t)j * 4 + k) * D + c0), w1 = *(const f32x4*)(PAR + PAR_LCW + ((size_t)j * 4 + k) * D + c0 + 4);
#pragma unroll
        for (int i = 0; i < 4; ++i) { w[k][i] = w0[i]; w[k][4 + i] = w1[i]; } }
    { const f32x4 b0 = *(const f32x4*)(PAR + PAR_LCB + (size_t)j * D + c0), b1 = *(const f32x4*)(PAR + PAR_LCB + (size_t)j * D + c0 + 4);
#pragma unroll
      for (int i = 0; i < 4; ++i) { bias[i] = b0[i]; bias[4 + i] = b1[i]; } }
    float x0[8], x1[8], x2[8];
#pragma unroll
    for (int i = 0; i < 8; ++i) { x0[i] = 0.f; x1[i] = 0.f; x2[i] = 0.f; }
    if (s0 != 0) {
        const u32x4 r0 = *(const u32x4*)(RB + (size_t)(m0 - 3) * D + c0), r1 = *(const u32x4*)(RB + (size_t)(m0 - 2) * D + c0), r2 = *(const u32x4*)(RB + (size_t)(m0 - 1) * D + c0);
#pragma unroll
        for (int i = 0; i < 4; ++i) { x0[2 * i] = bflo(r0[i]); x0[2 * i + 1] = bfhi(r0[i]); x1[2 * i] = bflo(r1[i]); x1[2 * i + 1] = bfhi(r1[i]); x2[2 * i] = bflo(r2[i]); x2[2 * i + 1] = bfhi(r2[i]); }
    }
#pragma unroll 4
    for (int t = 0; t < 16; ++t) {
        const u32x4 rr = *(const u32x4*)(RB + (size_t)(m0 + t) * D + c0);
        float x3[8], y[8];
#pragma unroll
        for (int i = 0; i < 4; ++i) { x3[2 * i] = bflo(rr[i]); x3[2 * i + 1] = bfhi(rr[i]); }
#pragma unroll
        for (int i = 0; i < 8; ++i) { y[i] = bias[i] + w[0][i] * x0[i] + w[1][i] * x1[i] + w[2][i] * x2[i] + w[3][i] * x3[i]; x0[i] = x1[i]; x1[i] = x2[i]; x2[i] = x3[i]; }
        u32x4 o; o.x = cvt_pk_bf16(y[0], y[1]); o.y = cvt_pk_bf16(y[2], y[3]); o.z = cvt_pk_bf16(y[4], y[5]); o.w = cvt_pk_bf16(y[6], y[7]);
        *(u32x4*)(XC + (size_t)(m0 + t) * D + c0) = o;
    }
}
__device__ __forceinline__ void phase_scan1(Frame& F) {
    const int item = F.vcu; const int m0 = item * 64; const int ch = 2 * F.tid;
    const bf16_t* LA = (const bf16_t*)(F.ws + WS_AF); const bf16_t* UB = (const bf16_t*)(F.ws + WS_UF);
    float h0 = 0.f, h1 = 0.f, s0 = 0.f, s1 = 0.f;
#pragma unroll 16
    for (int t = 0; t < 64; ++t) { const unsigned lw = *(const unsigned*)(LA + (size_t)(m0 + t) * D + ch), uw = *(const unsigned*)(UB + (size_t)(m0 + t) * D + ch);
        const float l0 = bflo(lw), l1 = bfhi(lw);
        h0 = __builtin_amdgcn_exp2f(l0) * h0 + bflo(uw); h1 = __builtin_amdgcn_exp2f(l1) * h1 + bfhi(uw); s0 += l0; s1 += l1; }
    float* PS = (float*)(F.ws + WS_PS);
    *(f32x4*)(PS + ((size_t)item * D + ch) * 2) = (f32x4){__builtin_amdgcn_exp2f(s0), h0, __builtin_amdgcn_exp2f(s1), h1};
}
__device__ __forceinline__ void phase_scan2(Frame& F) {
    const int item = F.vcu; const int m0 = item * 64; const int ch = 2 * F.tid; const int c = item & 63, b = item >> 6;
    const bf16_t* LA = (const bf16_t*)(F.ws + WS_AF); const bf16_t* UB = (const bf16_t*)(F.ws + WS_UF);
    const float* PS = (const float*)(F.ws + WS_PS); const bf16_t* GB = (const bf16_t*)(F.ws + WS_GB); bf16_t* YB = (bf16_t*)(F.ws + WS_YB);
    float h0 = 0.f, h1 = 0.f;
#pragma unroll 8
    for (int jj = 0; jj < c; ++jj) { const f32x4 s = *(const f32x4*)(PS + ((size_t)(b * 64 + jj) * D + ch) * 2); h0 = s[0] * h0 + s[1]; h1 = s[2] * h1 + s[3]; }
#pragma unroll 16
    for (int t = 0; t < 64; ++t) { const unsigned lw = *(const unsigned*)(LA + (size_t)(m0 + t) * D + ch), uw = *(const unsigned*)(UB + (size_t)(m0 + t) * D + ch);
        const unsigned gw_ = *(const unsigned*)(GB + (size_t)(m0 + t) * D + ch);
        h0 = __builtin_amdgcn_exp2f(bflo(lw)) * h0 + bflo(uw); h1 = __builtin_amdgcn_exp2f(bfhi(lw)) * h1 + bfhi(uw);
        *(unsigned*)(YB + (size_t)(m0 + t) * D + ch) = cvt_pk_bf16(bflo(gw_) * h0, bfhi(gw_) * h1); }
}

__device__ __forceinline__ void phase_qknorm(Frame& F, int j) {
    const float* PAR = (const float*)(F.ws + WS_PAR);
    bf16_t* Q = (bf16_t*)(F.ws + WS_Q); bf16_t* Kb = (bf16_t*)(F.ws + WS_K); float* KM = (float*)(F.ws + WS_KMEAN);
    LAS float* red = (LAS float*)F.lds;
    const int rr = F.lane >> 4, cq = F.lane & 15;
    f32x4 qg0 = *(const f32x4*)(PAR + PAR_AQG + (size_t)j * HD + cq * 8), qg1 = *(const f32x4*)(PAR + PAR_AQG + (size_t)j * HD + cq * 8 + 4);
    f32x4 kg0 = *(const f32x4*)(PAR + PAR_AKG + (size_t)j * HD + cq * 8), kg1 = *(const f32x4*)(PAR + PAR_AKG + (size_t)j * HD + cq * 8 + 4);
    for (int it = F.vcu; it < BATCH * NBLK * NH; it += F.G) {
        const int h = it & 7, blk = (it >> 3) & 15, b = it >> 7;
        const size_t base = ((size_t)(b * SEQ + blk * MBLK + F.wave * 32)) * D + h * HD + cq * 8;
        float ks[8];
#pragma unroll
        for (int i = 0; i < 8; ++i) ks[i] = 0.f;
#pragma unroll 2
        for (int i = 0; i < 8; ++i) { const size_t off = base + (size_t)(i * 4 + rr) * D;
            const u32x4 qw = *(const u32x4*)(Q + off), kw = *(const u32x4*)(Kb + off);
            float qv[8], kv[8]; float sq = 0.f, sk = 0.f;
#pragma unroll
            for (int e = 0; e < 4; ++e) { qv[2 * e] = bflo(qw[e]); qv[2 * e + 1] = bfhi(qw[e]); kv[2 * e] = bflo(kw[e]); kv[2 * e + 1] = bfhi(kw[e]); }
#pragma unroll
            for (int e = 0; e < 8; ++e) { sq += qv[e] * qv[e]; sk += kv[e] * kv[e]; }
#pragma unroll
            for (int o = 1; o < 16; o <<= 1) { sq += __shfl_xor(sq, o); sk += __shfl_xor(sk, o); }
            const float rq = __builtin_amdgcn_rsqf(sq * (1.0f / HD) + NORM_EPS), rk = __builtin_amdgcn_rsqf(sk * (1.0f / HD) + NORM_EPS);
#pragma unroll
            for (int e = 0; e < 8; ++e) { qv[e] = qv[e] * rq * (e < 4 ? qg0[e & 3] : qg1[e & 3]); kv[e] = kv[e] * rk * (e < 4 ? kg0[e & 3] : kg1[e & 3]); ks[e] += kv[e]; }
            u32x4 qo, ko;
#pragma unroll
            for (int e = 0; e < 4; ++e) { qo[e] = cvt_pk_bf16(qv[2 * e], qv[2 * e + 1]); ko[e] = cvt_pk_bf16(kv[2 * e], kv[2 * e + 1]); }
            *(u32x4*)(Q + off) = qo; *(u32x4*)(Kb + off) = ko; }
#pragma unroll
        for (int e = 0; e < 8; ++e) { ks[e] += __shfl_xor(ks[e], 16); ks[e] += __shfl_xor(ks[e], 32); }
        __syncthreads();
        if (F.lane < 16) {
#pragma unroll
            for (int e = 0; e < 8; ++e) red[F.wave * 128 + cq * 8 + e] = ks[e]; }
        __syncthreads();
        if (F.tid < 128) { float s = 0.f;
#pragma unroll
            for (int w = 0; w < 8; ++w) s += red[w * 128 + F.tid];
            KM[(((size_t)b * NH + h) * NBLK + blk) * HD + F.tid] = s * (1.0f / MBLK); }
    }
}
__device__ __forceinline__ void phase_gate(Frame& F) {
    const bf16_t* Q = (const bf16_t*)(F.ws + WS_Q); const float* KM = (const float*)(F.ws + WS_KMEAN); unsigned* SEL = (unsigned*)(F.ws + WS_SEL);
    LAS float* km = (LAS float*)F.lds;
    const int it = F.vcu; const int s8 = it & 7, h = (it >> 3) & 7, b = it >> 6;
    for (int i = F.tid; i < NBLK * HD / 4; i += NTHR) *(LAS f32x4*)(km + 4 * i) = *(const f32x4*)(KM + ((size_t)b * NH + h) * NBLK * HD + 4 * i);
    __syncthreads();
    const int s = s8 * 512 + F.tid; const int qb = __builtin_amdgcn_readfirstlane(s >> 8);
    u32x4 qw[16];
    const bf16_t* qp = Q + ((size_t)(b * SEQ + s)) * D + h * HD;
#pragma unroll
    for (int i = 0; i < 16; ++i) qw[i] = *(const u32x4*)(qp + 8 * i);
    float v1 = -__builtin_inff(), v2 = v1, v3 = v1; int i1 = -1, i2 = -1, i3 = -1;
    for (int n = 0; n < qb; ++n) { float sc = 0.f;
#pragma unroll
        for (int i = 0; i < 16; ++i) { const f32x4 k0 = *(const LAS f32x4*)(km + n * HD + 8 * i), k1 = *(const LAS f32x4*)(km + n * HD + 8 * i + 4);
            sc += bflo(qw[i][0]) * k0[0] + bfhi(qw[i][0]) * k0[1] + bflo(qw[i][1]) * k0[2] + bfhi(qw[i][1]) * k0[3]
                + bflo(qw[i][2]) * k1[0] + bfhi(qw[i][2]) * k1[1] + bflo(qw[i][3]) * k1[2] + bfhi(qw[i][3]) * k1[3]; }
        if (sc > v1) { v3 = v2; i3 = i2; v2 = v1; i2 = i1; v1 = sc; i1 = n; }
        else if (sc > v2) { v3 = v2; i3 = i2; v2 = sc; i2 = n; }
        else if (sc > v3) { v3 = sc; i3 = n; } }
    unsigned m = 0u; if (i1 >= 0) m |= 1u << i1; if (i2 >= 0) m |= 1u << i2; if (i3 >= 0) m |= 1u << i3;
    SEL[((size_t)b * NH + h) * SEQ + s] = m;
}
__device__ __forceinline__ att::BlockRef att_ref(Frame& F, int L, int pass) {
    const int bh = L >> 3, x = L & 7; const int qb = pass ? 15 - x : x; const int b = bh >> 3, h = bh & 7;
    att::BlockRef r; const size_t ro = ((size_t)(b * SEQ + qb * MBLK)) * D + h * HD;
    r.Q = (const bf16_t*)(F.ws + WS_Q) + ro; r.O = (bf16_t*)(F.ws + WS_YB) + ro;
    r.K = (const bf16_t*)(F.ws + WS_K) + (size_t)(b * SEQ) * D + h * HD; r.V = (const bf16_t*)(F.ws + WS_V) + (size_t)(b * SEQ) * D + h * HD;
    r.qb = qb; return r;
}
__device__ __forceinline__ void phase_attn(Frame& F, char* lds) {
    const int total = BATCH * NH * 8, stride = F.G;
    int L = F.vcu; if (L >= total) return;
    int pass = 0;
    att::BlockRef cur = att_ref(F, L, 0);
    att::Seam S;
    att::moba_prime(cur, lds, S, F.tid);
    for (;;) {
        if (pass == 0) {
            const float* KM = (const float*)(F.ws + WS_KMEAN) + (size_t)(L >> 3) * NBLK * HD;
            *(f32x4*)(lds + att::KM_OFF + F.tid * 16) = *(const f32x4*)(KM + F.tid * 4);
            __syncthreads(); }
        const bool more_pass = pass == 0, more_item = L + stride < total, last = !more_pass && !more_item;
        int passn = pass + 1, Ln = L;
        if (!more_pass) { passn = 0; Ln = more_item ? L + stride : L; }
        const att::BlockRef nxt = last ? cur : att_ref(F, Ln, passn);
        att::moba_block(cur, nxt, lds, S, F.tid);
        if (last) break;
        cur = nxt; pass = passn; L = Ln;
    }
}

constexpr int NPH = 42;
__global__ void __launch_bounds__(NTHR, 2) fwd(Args args) {
    extern __shared__ __attribute__((aligned(16))) unsigned char lds_[];
    Frame F;
    F.lds = (LAS unsigned char*)lds_; F.ws = args.ws;
    F.tid = threadIdx.x; F.lane = F.tid & 63; F.wave = __builtin_amdgcn_readfirstlane(F.tid >> 6);
    F.G = gridDim.x; { const int bx = blockIdx.x; F.vcu = (F.G % 8 == 0) ? (bx % 8) * (F.G / 8) + bx / 8 : bx; }
    volatile LAS unsigned* MISC = (volatile LAS unsigned*)(F.lds + LDS_MISC);
    if (F.tid < 64) MISC[F.tid] = 0u;
    __syncthreads();
    const int lo = args.ph_lo, hi = args.ph_hi;
    unsigned* ctl = (unsigned*)(F.ws + WS_CTL);
    XcdBarrier bar; bar.bar = ctl + CW_BAR + args.li * XCD_BAR_WORDS; bar.x = 0; bar.st = nullptr;
    if (hi - lo > 1) bar = xcd_barrier_post(ctl + CW_BAR + args.li * XCD_BAR_WORDS, MISC + 8);
#ifdef ONLY
#define EN(code) ((code) == ONLY)
#else
#define EN(code) true
#endif
#define IN(k) (lo <= (k) && (k) < hi)
#define SEAM(k) do { if (IN(k) && IN((k) + 1)) xcd_barrier(bar); } while (0)
#ifdef PROBE_CODE
#define REPS(code) ((code) == PROBE_CODE ? 1 + PROBE_EXTRA : 1)
#else
#define REPS(code) 1
#endif
#define PF() Frame Fp = F; asm volatile("" : "+v"(Fp.tid)); Fp.lane = Fp.tid & 63
    LAS unsigned* tab = (LAS unsigned*)(F.lds + LDS_TAB);
    const float* xin = args.in[IN_X]; float* out = args.out; const float* PAR = (const float*)(F.ws + WS_PAR);

    if (EN(0) && IN(0)) { for (int rep_ = 0; rep_ < REPS(0); ++rep_) { if (rep_) __syncthreads(); PF(); phase_prologue(Fp, args); } } SEAM(0);

#pragma nounroll
    for (int l = 0; l < DEPTH; ++l) {
        const int pb = 1 + 10 * l; const int j = l >> 1; const bool lru = (l & 1) == 0;
        if (EN(10) && IN(pb + 0)) { for (int rep_ = 0; rep_ < REPS(10); ++rep_) { if (rep_) __syncthreads(); PF(); phase_norm(Fp, xin, out, l, false); } } SEAM(pb + 0);
        if (lru) {
            if (EN(21) && IN(pb + 1)) { for (int rep_ = 0; rep_ < REPS(21); ++rep_) { if (rep_) __syncthreads(); pg8::ProbPlain P; P.init((const bf16_t*)(F.ws + WS_H), (const bf16_t*)(F.ws + WS_WIN) + (size_t)j * 2 * D * D, T, 2 * D, D, D, -1, F.G, (int)blockIdx.x);
                pg8::EpiWin E{(bf16_t*)(F.ws + WS_GB), (bf16_t*)(F.ws + WS_RB)};
                pg8::gemm_phase<pg8::EpiWin, pg8::ProbPlain, true, true>(F.lds, tab, P, E); } } SEAM(pb + 1);
            if (EN(22) && IN(pb + 2)) { for (int rep_ = 0; rep_ < REPS(22); ++rep_) { if (rep_) __syncthreads(); PF(); phase_conv(Fp, j); } } SEAM(pb + 2);
            if (EN(23) && IN(pb + 3)) { for (int rep_ = 0; rep_ < REPS(23); ++rep_) { if (rep_) __syncthreads(); pg8::ProbPlain P; P.init((const bf16_t*)(F.ws + WS_XC), (const bf16_t*)(F.ws + WS_WG) + (size_t)j * 2048 * 256, T, 2 * D, 256, D, 1, F.G, (int)blockIdx.x);
                pg8::EpiGates E{(const bf16_t*)(F.ws + WS_XC), (bf16_t*)(F.ws + WS_AF), (bf16_t*)(F.ws + WS_UF), PAR + PAR_LBA + (size_t)j * D, PAR + PAR_LBX + (size_t)j * D, (const float*)(F.ws + WS_SP8) + (size_t)j * D};
                pg8::gemm_phase<pg8::EpiGates, pg8::ProbPlain, true, true>(F.lds, tab, P, E); } } SEAM(pb + 3);
            if (EN(24) && IN(pb + 4)) { for (int rep_ = 0; rep_ < REPS(24); ++rep_) { if (rep_) __syncthreads(); PF(); phase_scan1(Fp); } } SEAM(pb + 4);
            if (EN(25) && IN(pb + 5)) { for (int rep_ = 0; rep_ < REPS(25); ++rep_) { if (rep_) __syncthreads(); PF(); phase_scan2(Fp); } } SEAM(pb + 5);
        } else {
            if (EN(31) && IN(pb + 1)) { for (int rep_ = 0; rep_ < REPS(31); ++rep_) { if (rep_) __syncthreads(); pg8::ProbPlain P; P.init((const bf16_t*)(F.ws + WS_H), (const bf16_t*)(F.ws + WS_WQKV) + (size_t)j * 3 * D * D, T, 3 * D, D, D, -1, F.G, (int)blockIdx.x);
                pg8::EpiQKV E{(bf16_t*)(F.ws + WS_Q), PAR + PAR_AQG + (size_t)j * HD, PAR + PAR_AKG + (size_t)j * HD, (float*)(F.ws + WS_KMEAN), (LAS float*)(F.lds + LDS_X)};
                pg8::gemm_phase<pg8::EpiQKV, pg8::ProbPlain, true, true>(F.lds, tab, P, E); } } SEAM(pb + 1);
            if (EN(34) && IN(pb + 4)) { for (int rep_ = 0; rep_ < REPS(34); ++rep_) { if (rep_) __syncthreads(); PF(); phase_attn(Fp, (char*)lds_); } } SEAM(pb + 4);
        }
        if (EN(16) && IN(pb + 6)) { for (int rep_ = 0; rep_ < REPS(16); ++rep_) { if (rep_) __syncthreads(); pg8::ProbPlain P; P.init((const bf16_t*)(F.ws + WS_YB), (const bf16_t*)(F.ws + (lru ? WS_WLO : WS_WAO)) + (size_t)j * D * D, T, D, D, D, -1, F.G, (int)blockIdx.x);
            pg8::EpiResid E{l == 0 ? xin : (const float*)(F.ws + WS_XB), (float*)(F.ws + WS_XB), (const float*)(F.ws + WS_MOD) + (size_t)l * BATCH * 6 * D + 2 * D, (const bf16_t*)(F.ws + WS_YK), (const float*)(F.ws + WS_MOD) + (size_t)(l > 0 ? l - 1 : 0) * BATCH * 6 * D + 5 * D, l == 0};
            pg8::gemm_phase<pg8::EpiResid, pg8::ProbPlain, false, true>(F.lds, tab, P, E); } } SEAM(pb + 6);
        if (EN(17) && IN(pb + 7)) { PF(); phase_router(Fp, l); } SEAM(pb + 7);
        if (EN(18) && IN(pb + 8)) { for (int rep_ = 0; rep_ < REPS(18); ++rep_) { if (rep_) __syncthreads(); PF(); const int nu = moe_units(Fp, l, 8);
            pg8::ProbMoE<true> P; P.A = (const bf16_t*)(F.ws + WS_H); P.Bt = (const bf16_t*)(F.ws + WS_WGU) + (size_t)l * NE * 2 * D * D; P.K = D; P.lda = D; P.bstride = (size_t)2 * D * D;
            P.rowlist = (const unsigned*)(F.ws + WS_ROWLIST); P.units = (const LAS int*)(F.lds + LDS_UNITS); P.nunits = nu;
            pg8::EpiSwiglu E{(bf16_t*)(F.ws + WS_ACT), PAR + PAR_BGU + (size_t)l * NE * 2 * D};
            pg8::gemm_phase<pg8::EpiSwiglu, pg8::ProbMoE<true>, true, true>(F.lds, tab, P, E); } } SEAM(pb + 8);
        if (EN(19) && IN(pb + 9)) { for (int rep_ = 0; rep_ < REPS(19); ++rep_) { if (rep_) __syncthreads(); PF(); const int nu = moe_units(Fp, l, 4);
            pg8::ProbMoE<false> P; P.A = (const bf16_t*)(F.ws + WS_ACT); P.Bt = (const bf16_t*)(F.ws + WS_WDN) + (size_t)l * NE * D * D; P.K = D; P.lda = D; P.bstride = (size_t)D * D;
            P.rowlist = (const unsigned*)(F.ws + WS_ROWLIST); P.units = (const LAS int*)(F.lds + LDS_UNITS); P.nunits = nu;
            pg8::EpiDown E{(bf16_t*)(F.ws + WS_YK), PAR + PAR_BDN + (size_t)l * NE * D, (const unsigned*)(F.ws + WS_ROWLIST), (const float*)(F.ws + WS_TOPW)};
            pg8::gemm_phase<pg8::EpiDown, pg8::ProbMoE<false>, true, true>(F.lds, tab, P, E); } } SEAM(pb + 9);
    }
    if (EN(41) && IN(41)) { PF(); phase_norm(Fp, xin, out, DEPTH, true); }
#undef IN
#undef SEAM
#undef EN
}

#ifndef DEBUG_CHECKS
#define DEBUG_CHECKS 0
#endif
#ifndef CHK_FROM
#define CHK_FROM 0
#endif
#if DEBUG_CHECKS
constexpr int CW_CHK = 70000;
__device__ __forceinline__ unsigned hsh(unsigned x) { x ^= x >> 16; x *= 0x7feb352du; x ^= x >> 15; x *= 0x846ca68bu; x ^= x >> 16; return x; }
__device__ __forceinline__ bool cls(float got, float ref, float rt, float at) { return (fabsf(got - ref) <= rt * fabsf(ref) + at); }
__device__ __forceinline__ float bfq(const bf16_t* p, size_t i) { return __uint_as_float(((unsigned)p[i]) << 16); }
__device__ __forceinline__ float gelu_ref(float x) { return 0.5f * x * (1.0f + tanhf(0.7978845608028654f * (x + 0.044715f * x * x * x))); }
__global__ void __launch_bounds__(64) chk(Args a, int id, int l, int code) {
    const int j = l >> 1;
    unsigned char* ws = a.ws; unsigned* ctl = (unsigned*)(ws + WS_CTL); const int lane = threadIdx.x;
    const float* MOD = (const float*)(ws + WS_MOD); const float* PAR = (const float*)(ws + WS_PAR);
    const bf16_t* H = (const bf16_t*)(ws + WS_H);
    bool bad = false;
    for (int it = 0; it < 8; ++it) {
        const unsigned sd = hsh(blockIdx.x * 131u + it * 7919u + id * 104729u + 12345u);
        if (id == 1) {
            const int l = sd & 3, b = (sd >> 2) & 3, n = (sd >> 4) % (6 * D); float s = 0.f;
            for (int k = lane; k < D; k += 64) { const float c = a.in[IN_C][b * D + k]; s += (c / (1.0f + expf(-c))) * a.in[IN_WMOD][((size_t)l * D + k) * 6 * D + n]; }
            s = wave_sum(s) + a.in[IN_BMOD][l * 6 * D + n];
            if (!cls(MOD[((size_t)l * BATCH + b) * 6 * D + n], s, 1e-3f, 1e-3f)) bad = true;
        } else if (id == 2) {
            const int m = sd % T, b = m / SEQ; float ss = 0.f;
            for (int k = lane; k < D; k += 64) { const float x = a.in[IN_X][(size_t)m * D + k]; ss += x * x; }
            const float rstd = 1.0f / sqrtf(wave_sum(ss) / D + NORM_EPS);
            for (int k = lane; k < D; k += 64) { const float x = a.in[IN_X][(size_t)m * D + k];
                const float h = x * rstd * a.in[IN_NMG][k] * (1.0f + MOD[(size_t)b * 6 * D + D + k]) + MOD[(size_t)b * 6 * D + k];
                if (!cls(bfq(H, (size_t)m * D + k), h, 0.01f, 0.01f)) bad = true; }
        } else if (id == 3) {
            const int m = sd % T, n = (sd >> 14) % (2 * D); float s = 0.f;
            for (int k = lane; k < D; k += 64) s += bfq(H, (size_t)m * D + k) * a.in[IN_LWIN][((size_t)j * D + k) * 2 * D + n];
            s = wave_sum(s);
            const float got = n < D ? bfq((const bf16_t*)(ws + WS_GB), (size_t)m * D + n) : bfq((const bf16_t*)(ws + WS_RB), (size_t)m * D + n - D);
            const float ref = n < D ? gelu_ref(s) : s;
            if (!cls(got, ref, 0.02f, 0.02f)) bad = true;
        } else if (id == 4) {
            const int m = sd % T, c = (sd >> 14) % D, s0 = m % SEQ; const bf16_t* RB = (const bf16_t*)(ws + WS_RB);
            float y = a.in[IN_LCB][j * D + c];
            for (int k = 0; k < 4; ++k) { const int t = s0 - 3 + k; if (t >= 0) y += a.in[IN_LCW][(j * 4 + k) * D + c] * bfq(RB, (size_t)(m - 3 + k) * D + c); }
            if (!cls(bfq((const bf16_t*)(ws + WS_XC), (size_t)m * D + c), y, 0.01f, 0.01f)) bad = true;
        } else if (id == 5) {
            const int m = sd % T, ch = (sd >> 14) % D, g = ch >> 8, jc = ch & 255; const bf16_t* XC = (const bf16_t*)(ws + WS_XC);
            float sa = 0.f, sx = 0.f;
            for (int i = lane; i < 256; i += 64) { const float xv = bfq(XC, (size_t)m * D + g * 256 + i); sa += xv * a.in[IN_LWA][((size_t)(j * 4 + g) * 256 + i) * 256 + jc]; sx += xv * a.in[IN_LWX][((size_t)(j * 4 + g) * 256 + i) * 256 + jc]; }
            sa = wave_sum(sa) + a.in[IN_LBA][j * D + ch]; sx = wave_sum(sx) + a.in[IN_LBX][j * D + ch];
            const float r = 1.0f / (1.0f + expf(-sa)), ig = 1.0f / (1.0f + expf(-sx)); const float lam = a.in[IN_LLAM][j * D + ch];
            const float la = -8.0f * r * log1pf(expf(-lam)); const float av = expf(la), uv = sqrtf(-expm1f(2.0f * la)) * ig * bfq(XC, (size_t)m * D + ch);
            if (!cls(((const float*)(ws + WS_AF))[(size_t)m * D + ch], av, 2e-3f, 1e-4f)) bad = true;
            if (!cls(((const float*)(ws + WS_UF))[(size_t)m * D + ch], uv, 0.03f, 0.003f)) bad = true;
        } else if (id == 6) {
            const int b = sd & 3, ch = ((sd >> 2) + lane * 17) % D; const float* AF = (const float*)(ws + WS_AF); const float* UF = (const float*)(ws + WS_UF);
            const bf16_t* GB = (const bf16_t*)(ws + WS_GB); const bf16_t* YB = (const bf16_t*)(ws + WS_YB);
            float h = 0.f;
            for (int t = 0; t < SEQ; ++t) { const size_t o = ((size_t)b * SEQ + t) * D + ch; h = AF[o] * h + UF[o];
                if ((t & 127) == 77 || t == SEQ - 1 || t == 0 || t == 64) { if (!cls(bfq(YB, o), bfq(GB, o) * h, 0.02f, 0.01f)) bad = true; } }
        } else if (id == 7) {
            const int m = sd % T, n = (sd >> 14) % D, b = m / SEQ; float s = 0.f; const bf16_t* YB = (const bf16_t*)(ws + WS_YB);
            for (int k = lane; k < D; k += 64) s += bfq(YB, (size_t)m * D + k) * a.in[IN_LWOUT][((size_t)j * D + k) * D + n];
            s = wave_sum(s);
            const float ref = (l == 0 ? a.in[IN_X][(size_t)m * D + n] : ((const float*)(ws + WS_XA))[(size_t)m * D + n]) + MOD[((size_t)l * BATCH + b) * 6 * D + 2 * D + n] * s;
            if (!cls(((const float*)(ws + WS_XB))[(size_t)m * D + n], ref, 0.01f, 0.01f)) bad = true;
        } else if (id == 8) {
            __shared__ float hrow[D];
            const int m = sd % MOE_TOK, b = m / SEQ; const float* XB = (const float*)(ws + WS_XB); float ss = 0.f;
            for (int k = lane; k < D; k += 64) { const float x = XB[(size_t)m * D + k]; ss += x * x; }
            const float rstd = 1.0f / sqrtf(wave_sum(ss) / D + NORM_EPS);
            __syncthreads();
            for (int k = lane; k < D; k += 64) { const float x = XB[(size_t)m * D + k];
                const float h = x * rstd * a.in[IN_NFG][l * D + k] * (1.0f + MOD[((size_t)l * BATCH + b) * 6 * D + 4 * D + k]) + MOD[((size_t)l * BATCH + b) * 6 * D + 3 * D + k]; hrow[k] = h;
                if (!cls(bfq(H, (size_t)m * D + k), h, 0.01f, 0.01f)) bad = true; }
            __syncthreads();
            const int e = lane & 31; float lg = a.in[IN_RB][l * NE + e];
            for (int k = 0; k < D; ++k) lg += hrow[k] * a.in[IN_RW][((size_t)l * D + k) * NE + e];
            int rank = 0; float mx = -1e30f;
            for (int q = 0; q < 32; ++q) { const float o = __shfl(lg, q); if (o > lg || (o == lg && q < e)) ++rank; mx = fmaxf(mx, o); }
            const bool sel = rank < 4; float den = 0.f;
            for (int q = 0; q < 32; ++q) { const float o = __shfl(lg, q); const int rk = __shfl(rank, q); if (rk < 4) den += expf(o - mx); }
            const float wref = expf(lg - mx) / den;
            float v4 = 0.f, v5 = 0.f; for (int q = 0; q < 32; ++q) { const float o = __shfl(lg, q); const int rk = __shfl(rank, q); if (rk == 3) v4 = o; if (rk == 4) v5 = o; }
            const unsigned* gcnt = ctl + CW_CNT + 64 * l; const unsigned* RL = (const unsigned*)(ws + WS_ROWLIST); const float* TW = (const float*)(ws + WS_TOPW);
            if (v4 - v5 > 1e-3f && lane < 32) {
                const int cnt = (int)gcnt[e]; int found = -1;
                for (int p = 0; p < cnt; ++p) { const unsigned r = RL[(size_t)e * CAP + p]; if ((int)(r >> 2) == m) found = (int)r; }
                if (sel) { if (found < 0) bad = true; else if (!cls(TW[found], wref, 0.01f, 1e-3f)) bad = true; }
                else if (found >= 0) bad = true;
            }
            unsigned tot = 0; for (int q = 0; q < 32; ++q) tot += gcnt[q]; if (tot != (unsigned)T) bad = true;
        } else if (id == 9 || id == 10) {
            const unsigned* gcnt = ctl + CW_CNT + 64 * l; const unsigned* RL = (const unsigned*)(ws + WS_ROWLIST); const float* TW = (const float*)(ws + WS_TOPW);
            const int e = sd & 31; int ts = 0; for (int q = 0; q < e; ++q) ts += ((int)gcnt[q] + 255) >> 8;
            const int cnt = (int)gcnt[e]; if (cnt == 0) continue;
            const int pos = (sd >> 5) % cnt; const unsigned dest = RL[(size_t)e * CAP + pos]; const int tok = dest >> 2; const size_t arow = (size_t)ts * 256 + pos;
            const int col = (sd >> 17) % D; const bf16_t* ACT = (const bf16_t*)(ws + WS_ACT);
            if (id == 9) { float sg = 0.f, su = 0.f;
                for (int k = lane; k < D; k += 64) { const float hv = bfq(H, (size_t)tok * D + k); sg += hv * a.in[IN_WGU][((size_t)(l * NE + e) * D + k) * 2 * D + col]; su += hv * a.in[IN_WGU][((size_t)(l * NE + e) * D + k) * 2 * D + D + col]; }
                sg = wave_sum(sg) + a.in[IN_BGU][(size_t)(l * NE + e) * 2 * D + col]; su = wave_sum(su) + a.in[IN_BGU][(size_t)(l * NE + e) * 2 * D + D + col];
                const float gv = fminf(sg, 7.f), uv = fminf(fmaxf(su, -7.f), 7.f); const float ref = gv / (1.0f + expf(-1.702f * gv)) * (uv + 1.0f);
                if (!cls(bfq(ACT, arow * D + col), ref, 0.03f, 0.02f)) bad = true;
            } else { float s = 0.f;
                for (int k = lane; k < D; k += 64) s += bfq(ACT, arow * D + k) * a.in[IN_WDN][((size_t)(l * NE + e) * D + k) * D + col];
                s = (wave_sum(s) + a.in[IN_BDN][(size_t)(l * NE + e) * D + col]) * TW[dest];
                if (!cls(bfq((const bf16_t*)(ws + WS_YK), (size_t)dest * D + col), s, 0.03f, 0.01f)) bad = true; }
        } else if (id == 11) {
            const int m = sd % T, h = (sd >> 14) & 7, which = (sd >> 17) % 3; float r0 = 0.f, r1 = 0.f;
            for (int k = 0; k < D; ++k) { const float hv = bfq(H, (size_t)m * D + k); const float* w = a.in[IN_AQKV] + ((size_t)j * D + k) * 3 * D + which * D + h * HD; r0 += hv * w[lane]; r1 += hv * w[lane + 64]; }
            const bf16_t* buf = (const bf16_t*)(ws + (which == 0 ? WS_Q : (which == 1 ? WS_K : WS_V)));
            const float g0 = bfq(buf, (size_t)m * D + h * HD + lane), g1 = bfq(buf, (size_t)m * D + h * HD + lane + 64);
            if (which == 2) { if (!cls(g0, r0, 0.02f, 0.02f) || !cls(g1, r1, 0.02f, 0.02f)) bad = true; }
            else { const float rs = 1.0f / sqrtf(wave_sum(r0 * r0 + r1 * r1) / HD + NORM_EPS); const float* gg = a.in[which == 0 ? IN_AQG : IN_AKG] + j * HD;
                if (!cls(g0, r0 * rs * gg[lane], 0.03f, 0.03f) || !cls(g1, r1 * rs * gg[lane + 64], 0.03f, 0.03f)) bad = true; }
        } else if (id == 12) {
            const int b = sd & 3, h = (sd >> 2) & 7, blk = (sd >> 5) & 15; const bf16_t* Kb = (const bf16_t*)(ws + WS_K); const float* KM = (const float*)(ws + WS_KMEAN);
            float s0 = 0.f, s1 = 0.f;
            for (int r = 0; r < MBLK; ++r) { const size_t o = ((size_t)b * SEQ + blk * MBLK + r) * D + h * HD; s0 += bfq(Kb, o + lane); s1 += bfq(Kb, o + lane + 64); }
            const float* km = KM + (((size_t)b * NH + h) * NBLK + blk) * HD;
            if (!cls(km[lane], s0 / MBLK, 0.03f, 0.003f) || !cls(km[lane + 64], s1 / MBLK, 0.03f, 0.003f)) bad = true;
            const int s = (sd >> 9) % SEQ, qb = s >> 8; const bf16_t* Q = (const bf16_t*)(ws + WS_Q); const unsigned msk = ((const unsigned*)(ws + WS_SEL))[((size_t)b * NH + h) * SEQ + s];
            float sc[16]; const size_t qo = ((size_t)b * SEQ + s) * D + h * HD;
#pragma unroll
            for (int n = 0; n < 16; ++n) { const float* kk = KM + (((size_t)b * NH + h) * NBLK + n) * HD; sc[n] = wave_sum(bfq(Q, qo + lane) * kk[lane] + bfq(Q, qo + lane + 64) * kk[lane + 64]); }
            int cntb = 0; float minsel = 1e30f;
#pragma unroll
            for (int n = 0; n < 16; ++n) if ((msk >> n) & 1u) { ++cntb; if (n >= qb) bad = true; minsel = fminf(minsel, sc[n]); }
            if (cntb != (qb < 3 ? qb : 3) || (msk >> 16)) bad = true;
            int better = 0;
#pragma unroll
            for (int n = 0; n < 16; ++n) if (n < qb && !((msk >> n) & 1u) && sc[n] > minsel + 1e-3f) ++better;
            if (better) bad = true;
        } else if (id == 13) {
            const int b = sd & 3, h = (sd >> 2) & 7, s = (sd >> 5) % SEQ, qb = s >> 8;
            const bf16_t* Q = (const bf16_t*)(ws + WS_Q); const bf16_t* Kb = (const bf16_t*)(ws + WS_K); const bf16_t* V = (const bf16_t*)(ws + WS_V); const bf16_t* O = (const bf16_t*)(ws + WS_YB);
            const unsigned msk = ((const unsigned*)(ws + WS_SEL))[((size_t)b * NH + h) * SEQ + s] | (1u << qb);
            const size_t qo = ((size_t)b * SEQ + s) * D + h * HD;
            float mx = -1e30f;
            for (int pass = 0; pass < 2; ++pass) {
                float den = 0.f, o0 = 0.f, o1 = 0.f;
                for (int blk = 0; blk <= qb; ++blk) if ((msk >> blk) & 1u) {
                    const int kend = blk == qb ? (s & 255) + 1 : 256;
                    for (int kk = 0; kk < kend; ++kk) { const size_t ko = ((size_t)b * SEQ + blk * MBLK + kk) * D + h * HD;
                        const float sc = wave_sum(bfq(Q, qo + lane) * bfq(Kb, ko + lane) + bfq(Q, qo + lane + 64) * bfq(Kb, ko + lane + 64)) * 0.08838834764831845f;
                        if (pass == 0) mx = fmaxf(mx, sc); else { const float p = expf(sc - mx); den += p; o0 += p * bfq(V, ko + lane); o1 += p * bfq(V, ko + lane + 64); } } }
                if (pass == 1) { if (!cls(bfq(O, qo + lane), o0 / den, 0.03f, 0.01f) || !cls(bfq(O, qo + lane + 64), o1 / den, 0.03f, 0.01f)) bad = true; }
            }
        } else if (id == 14) {
            const int m = sd % T, n = (sd >> 14) % D, b = m / SEQ; float s = 0.f; const bf16_t* YB = (const bf16_t*)(ws + WS_YB);
            for (int k = lane; k < D; k += 64) s += bfq(YB, (size_t)m * D + k) * a.in[IN_AWOUT][((size_t)j * D + k) * D + n];
            s = wave_sum(s);
            const float ref = ((const float*)(ws + WS_XA))[(size_t)m * D + n] + MOD[((size_t)l * BATCH + b) * 6 * D + 2 * D + n] * s;
            if (!cls(((const float*)(ws + WS_XB))[(size_t)m * D + n], ref, 0.01f, 0.01f)) bad = true;
        } else if (id == 15) {
            const int m = sd % T, b = m / SEQ; float ss = 0.f; const float* XA = (const float*)(ws + WS_XA); const bf16_t* YK = (const bf16_t*)(ws + WS_YK);
            for (int k = lane; k < D; k += 64) { const float x = XA[(size_t)m * D + k]; ss += x * x;
                const float sy = bfq(YK, (size_t)m * D + k);
                if (!cls(x, ((const float*)(ws + WS_XB))[(size_t)m * D + k] + MOD[((size_t)(l - 1) * BATCH + b) * 6 * D + 5 * D + k] * sy, 1e-3f, 1e-3f)) bad = true; }
            const float rstd = 1.0f / sqrtf(wave_sum(ss) / D + NORM_EPS);
            for (int k = lane; k < D; k += 64) { const float x = XA[(size_t)m * D + k];
                const float hh = x * rstd * a.in[IN_NMG][l * D + k] * (1.0f + MOD[((size_t)l * BATCH + b) * 6 * D + D + k]) + MOD[((size_t)l * BATCH + b) * 6 * D + k];
                if (!cls(bfq(H, (size_t)m * D + k), hh, 0.01f, 0.01f)) bad = true; }
        }
    }
    if (id == 16) {
        for (int it = 0; it < 8; ++it) { const unsigned sd = hsh(blockIdx.x * 131u + it * 7919u + 777u); const int m = sd % T, b = m / SEQ; const bf16_t* YK = (const bf16_t*)(ws + WS_YK);
            for (int k = lane; k < D; k += 64) { const float sy = bfq(YK, (size_t)m * D + k);
                if (!cls(a.out[(size_t)m * D + k], ((const float*)(ws + WS_XB))[(size_t)m * D + k] + MOD[((size_t)3 * BATCH + b) * 6 * D + 5 * D + k] * sy, 1e-3f, 1e-3f)) bad = true; } } }
    if (id == 99) bad = true;
    if (__any(bad) && lane == 0) atomicMax(ctl + CW_CHK, (unsigned)(100 - code));
    (void)PAR;
}
__global__ void chk_encode(Args a) {
    const unsigned v = ((const unsigned*)(a.ws + WS_CTL))[CW_CHK]; if (v == 0u) return;
    const float f = 1.0f + (float)(100 - (int)v);
    for (size_t i = (size_t)blockIdx.x * blockDim.x + threadIdx.x; i < (size_t)T * D; i += (size_t)gridDim.x * blockDim.x) a.out[i] = a.in[IN_X][i] * f;
}
#endif

#ifndef N_LAUNCH_MODE
#define N_LAUNCH_MODE 1
#endif
extern "C" void kernel_launch(void* const* d_in, const int* in_sizes, int n_in, void* d_out, int out_size, void* d_ws, size_t ws_size, hipStream_t stream) {
    static int grid = 0;
    if (grid == 0) {
        if (n_in != 25 || out_size != T * D || ws_size < WS_END) { fprintf(stderr, "kernel_launch: unexpected shapes (n_in %d out %d ws %zu)\n", n_in, out_size, ws_size); grid = -1; return; }
        int dev = 0, cus = 0;
        if (hipGetDevice(&dev) != hipSuccess || hipDeviceGetAttribute(&cus, hipDeviceAttributeMultiprocessorCount, dev) != hipSuccess) { grid = -1; return; }
        if (hipFuncSetAttribute((const void*)fwd, hipFuncAttributeMaxDynamicSharedMemorySize, LDS_BYTES) != hipSuccess) { fprintf(stderr, "kernel_launch: hipFuncSetAttribute failed\n"); grid = -1; return; }
        int per_cu = 0;
        if (hipOccupancyMaxActiveBlocksPerMultiprocessor(&per_cu, (const void*)fwd, NTHR, LDS_BYTES) != hipSuccess || per_cu < 1) fprintf(stderr, "kernel_launch: occupancy query says %d\n", per_cu);
        (void)hipGetLastError();
        if (cus < 256) { fprintf(stderr, "kernel_launch: %d CUs < 256\n", cus); grid = -1; return; }
        grid = 256;
    }
    if (grid < 0) return;
    (void)hipMemsetAsync((char*)d_ws + WS_CTL, 0, CTL_ZERO_BYTES, stream);
    Args a{};
    for (int i = 0; i < 25; ++i) a.in[i] = (const float*)d_in[i];
    a.out = (float*)d_out; a.ws = (unsigned char*)d_ws; a.pad = 0;
#if N_LAUNCH_MODE == 1
    a.ph_lo = 0; a.ph_hi = NPH; a.li = 0;
    hipLaunchKernelGGL(fwd, dim3(grid), dim3(NTHR), LDS_BYTES, stream, a);
#else
    int ordinal = 0; (void)ordinal;
    for (int p = 0; p < NPH; ++p) {
        const int l = (p - 1) / 10, o = (p - 1) % 10;
        if (p >= 1 && p <= 40 && (l & 1) == 1 && o == 5) continue;
        a.ph_lo = p; a.ph_hi = p + 1; a.li = 0;
        hipLaunchKernelGGL(fwd, dim3(grid), dim3(NTHR), LDS_BYTES, stream, a);
#if DEBUG_CHECKS
        {
            const int lch = (p - 1) / 10, och = (p - 1) % 10; int cid = 0;
            if (p == 0) cid = 1;
            else if (p == 41) cid = 16;
            else if ((lch & 1) == 0) { const int t[10] = {lch == 0 ? 2 : 15, 3, 4, 5, 0, 6, 7, 8, 9, 10}; cid = t[och]; }
            else { const int t[10] = {15, 0, 11, 12, 13, 0, 14, 8, 9, 10}; cid = t[och]; }
            if (cid && p >= CHK_FROM) { ++ordinal; hipLaunchKernelGGL(chk, dim3(64), dim3(64), 0, stream, a, cid, lch < 0 ? 0 : (p == 41 ? 3 : lch), ordinal); }
            if (p == 41) { ++ordinal; hipLaunchKernelGGL(chk, dim3(64), dim3(64), 0, stream, a, 99, 0, ordinal); }
        }
#endif
    }
#if DEBUG_CHECKS
    hipLaunchKernelGGL(chk_encode, dim3(1024), dim3(256), 0, stream, a);
#endif
#endif
}
```

```cpp
#include <hip/hip_runtime.h>
#include <stdint.h>
#include <stdio.h>

#define LAS __attribute__((address_space(3)))
#define GAS __attribute__((address_space(1)))
typedef unsigned short bf16_t;
typedef short bf16x8 __attribute__((ext_vector_type(8)));
typedef float f32x4 __attribute__((ext_vector_type(4)));
typedef float f32x2 __attribute__((ext_vector_type(2)));
typedef unsigned u32x4 __attribute__((ext_vector_type(4)));
typedef unsigned u32x2 __attribute__((ext_vector_type(2)));

constexpr int BATCH = 4, SEQ = 4096, D = 1024, T = BATCH * SEQ, DEPTH = 4;
constexpr int NE = 32, TOPK = 4, NH = 8, HD = 128, NBLK = 16, MBLK = 256;
constexpr float NORM_EPS = 1e-6f;
constexpr int NWAVES = 8, NTHR = 512;
constexpr int CAP = T;
constexpr int MAXTILES = T * TOPK / 256 + NE;

constexpr size_t MiB = 1u << 20;
constexpr size_t WS_CTL = 0, CTL_ZERO_BYTES = 1 * MiB;
constexpr size_t WS_MOD = 1 * MiB;
constexpr size_t WS_SP8 = 2 * MiB;
constexpr size_t WS_KMEAN = 3 * MiB;
constexpr size_t WS_SEL = 4 * MiB;
constexpr size_t WS_ROWLIST = 5 * MiB;
constexpr size_t WS_TOPW = 7 * MiB;
constexpr size_t WS_PS = 8 * MiB;
constexpr size_t WS_PAR = 10 * MiB;
constexpr int PAR_NMG = 0, PAR_NFG = PAR_NMG + 4 * 1024, PAR_LCW = PAR_NFG + 4 * 1024, PAR_LCB = PAR_LCW + 2 * 4 * 1024, PAR_LBA = PAR_LCB + 2 * 1024, PAR_LBX = PAR_LBA + 2 * 1024,
              PAR_AQG = PAR_LBX + 2 * 1024, PAR_AKG = PAR_AQG + 256, PAR_RW = PAR_AKG + 256, PAR_RB = PAR_RW + 4 * 1024 * 32, PAR_BGU = PAR_RB + 128, PAR_BDN = PAR_BGU + 4 * 32 * 2048, PAR_END = PAR_BDN + 4 * 32 * 1024;
static_assert((size_t)PAR_END * 4 <= 6 * MiB, "param region");
constexpr size_t WS_WIN = 16 * MiB;
constexpr size_t WS_WG = 24 * MiB;
constexpr size_t WS_WLO = 26 * MiB;
constexpr size_t WS_WQKV = 30 * MiB;
constexpr size_t WS_WAO = 42 * MiB;
constexpr size_t WS_WGU = 64 * MiB;
constexpr size_t WS_WDN = 576 * MiB;
constexpr size_t WS_XA = 832 * MiB;
constexpr size_t WS_XB = 896 * MiB;
constexpr size_t WS_H = 960 * MiB;
constexpr size_t WS_GB = 992 * MiB;
constexpr size_t WS_RB = 1024 * MiB;
constexpr size_t WS_XC = 1056 * MiB;
constexpr size_t WS_AF = 1088 * MiB;
constexpr size_t WS_UF = 1152 * MiB;
constexpr size_t WS_YB = 1216 * MiB;
constexpr size_t WS_Q = 1248 * MiB, WS_K = 1280 * MiB, WS_V = 1312 * MiB;
constexpr size_t WS_ACT = 1344 * MiB;
constexpr size_t WS_YK = 1488 * MiB;
constexpr size_t WS_END = 1616 * MiB;

constexpr int CW_BAR = 4096;
constexpr int CW_CNT = 65536;

constexpr int RING_BYTES = 131072;
constexpr int LDS_TAB = RING_BYTES;
constexpr int LDS_UNITS = LDS_TAB + 1024;
constexpr int LDS_MOE = LDS_UNITS + 512;
constexpr int LDS_MISC = LDS_MOE + 512;
constexpr int LDS_X = LDS_MISC + 256;
constexpr int LDS_BYTES = 147456;

__device__ __forceinline__ float bf2f(unsigned h) { return __uint_as_float(h << 16); }
__device__ __forceinline__ float bflo(unsigned u) { return __uint_as_float(u << 16); }
__device__ __forceinline__ float bfhi(unsigned u) { return __uint_as_float(u & 0xffff0000u); }
__device__ __forceinline__ unsigned cvt_pk_bf16(float lo, float hi) { unsigned r; asm("v_cvt_pk_bf16_f32 %0, %1, %2" : "=v"(r) : "v"(lo), "v"(hi)); return r; }
__device__ __forceinline__ float wave_sum(float v) {
#pragma unroll
    for (int o = 1; o < 64; o <<= 1) v += __shfl_xor(v, o);
    return v;
}
__device__ __forceinline__ float fast_exp(float x) { return __builtin_amdgcn_exp2f(x * 1.4426950408889634f); }
__device__ __forceinline__ float sigmoidf_(float x) { return __builtin_amdgcn_rcpf(1.0f + fast_exp(-x)); }
#define LDS_WAIT() asm volatile("s_waitcnt lgkmcnt(0)" ::: "memory")
#define VM_WAIT() asm volatile("s_waitcnt vmcnt(0)" ::: "memory")

#define XB_TMO      128
#define XB_XCNT(j)  (256  + 64 * (j))
#define XB_XSUB(j)  (1280 + 64 * (j))
#define XB_XGEN(j)  (2304 + 64 * (j))
#define XB_TOP      3328
#define XB_TOPGEN   3392
#define XCD_BAR_WORDS 3456
#define XB_SPIN_CAP (1u << 18)
__device__ __forceinline__ unsigned xb_ld(unsigned* p)              { return __hip_atomic_load(p, __ATOMIC_RELAXED, __HIP_MEMORY_SCOPE_AGENT); }
__device__ __forceinline__ unsigned xb_add(unsigned* p, unsigned v) { return __hip_atomic_fetch_add(p, v, __ATOMIC_RELAXED, __HIP_MEMORY_SCOPE_AGENT); }
__device__ __forceinline__ unsigned xb_xcc_id() { return (unsigned)__builtin_amdgcn_s_getreg((3 << 11) | 20) & 0xFu; }
#define XB_SPIN(cond, bar) do { unsigned _sp = 0; while (cond) { __builtin_amdgcn_s_sleep(1); \
    if ((++_sp & 255u) == 0u) { if (xb_ld(&(bar)[XB_TMO])) break; if (_sp > XB_SPIN_CAP) { atomicAdd(&(bar)[XB_TMO], 1u); break; } } } } while (0)
struct XcdBarrier { unsigned* bar; unsigned x; volatile LAS unsigned* st; };
__device__ __forceinline__ XcdBarrier xcd_barrier_post(unsigned* bar, volatile LAS unsigned* st) {
    XcdBarrier b; b.bar = bar; b.x = xb_xcc_id(); b.st = st;
    if (threadIdx.x == 0) (void)xb_add(&bar[XB_XCNT(b.x)], 1u);
    return b;
}
__device__ __forceinline__ void xcd_barrier_complete(unsigned* bar, unsigned x, unsigned& nloc, unsigned& nx) {
    const unsigned G = gridDim.x * gridDim.y * gridDim.z;
    unsigned sum, cnt, mine, sp = 0u;
    for (;;) {
        sum = 0u; cnt = 0u; mine = 0u;
#pragma unroll
        for (unsigned j = 0; j < 16; ++j) { const unsigned c = xb_ld(&bar[XB_XCNT(j)]); sum += c; cnt += (c > 0u) ? 1u : 0u; mine = (j == x) ? c : mine; }
        if (sum == G) break;
        __builtin_amdgcn_s_sleep(1);
        if ((++sp & 255u) == 0u) { if (xb_ld(&bar[XB_TMO])) break; if (sp > XB_SPIN_CAP) { atomicAdd(&bar[XB_TMO], 1u); break; } }
    }
    nloc = mine > 0u ? mine : 1u; nx = cnt > 0u ? cnt : 1u;
}
__device__ __forceinline__ void xcd_barrier(const XcdBarrier& b) {
    asm volatile("s_waitcnt vmcnt(0)" ::: "memory");
    __syncthreads();
    if (threadIdx.x == 0) {
        unsigned* bar = b.bar;
        __builtin_amdgcn_s_waitcnt(0);
        unsigned nloc = b.st[0], nx = b.st[1];
        if (nloc == 0u) { xcd_barrier_complete(bar, b.x, nloc, nx); b.st[0] = nloc; b.st[1] = nx; }
        const unsigned old = xb_add(&bar[XB_XSUB(b.x)], 1u);
        const unsigned gen = old / nloc;
        if (old + 1u == (gen + 1u) * nloc) {
            __builtin_amdgcn_fence(__ATOMIC_RELEASE, "agent");
            asm volatile("s_waitcnt vmcnt(0)" ::: "memory");
            const unsigned og = xb_add(&bar[XB_TOP], 1u);
            const unsigned tg = og / nx;
            if (og + 1u == (tg + 1u) * nx) xb_add(&bar[XB_TOPGEN], 1u);
            else XB_SPIN(xb_ld(&bar[XB_TOPGEN]) == tg, bar);
            __builtin_amdgcn_fence(__ATOMIC_ACQUIRE, "agent");
            xb_add(&bar[XB_XGEN(b.x)], 1u);
            asm volatile("s_waitcnt vmcnt(0)" ::: "memory");
        } else {
            XB_SPIN(xb_ld(&bar[XB_XGEN(b.x)]) == gen, bar);
            __builtin_amdgcn_fence(__ATOMIC_ACQUIRE, "agent");
            asm volatile("s_waitcnt vmcnt(0)" ::: "memory");
        }
    }
    __syncthreads();
}

namespace pg8 {
constexpr int BM = 256, BK = 64, HALF = 128, HTB = HALF * BK * 2, STAGE_BYTES = 8 * HTB, NXCD = 8, WGM = 8;
__host__ __device__ __forceinline__ int lds_byte(int r, int c) { const int st = (r >> 4) * 2 + (c >> 5), rr = r & 15, cc = c & 31, ob = rr * 64 + cc * 2; return st * 1024 + (ob ^ (((ob >> 9) & 1) << 5)); }
__host__ __device__ __forceinline__ void stage_rc(int b, int& R, int& C) { const int st = b / 1024, sb = b % 1024, swz = sb ^ (((sb >> 9) & 1) << 5); R = (st >> 1) * 16 + swz / 64; C = (st & 1) * 32 + (swz % 64) / 2; }
__host__ __device__ __forceinline__ int perm32(int rho) { const int n = rho >> 4, i = rho & 15; return 8 * (i >> 2) + 4 * n + (i & 3); }

struct Unit { int pm, pn, e, valid, j; };

struct ProbPlain {
    static constexpr bool GATHER = false, TAILS = false, ATILED = false;
    const bf16_t* A; const bf16_t* Bt; int M, N, K, lda; int acol_sh;
    int nM, nN, nwg, G, c;
    __device__ __forceinline__ void init(const bf16_t* A_, const bf16_t* Bt_, int M_, int N_, int K_, int lda_, int acol_sh_, int G_, int c_) {
        A = A_; Bt = Bt_; M = M_; N = N_; K = K_; lda = lda_; acol_sh = acol_sh_; nM = M / BM; nN = N / BM; nwg = nM * nN; G = G_; c = c_; }
    __device__ __forceinline__ bool next(int i, Unit& u) const {
        const long L = (long)i * G + c; if (L >= nwg) return false;
        int wgid = (int)L; { const int q = nwg / NXCD, r = nwg % NXCD, xcd = wgid % NXCD, off = wgid / NXCD; wgid = (xcd < r ? xcd * (q + 1) : r * (q + 1) + (xcd - r) * q) + off; }
        const int nig = WGM * nN, gid = wgid / nig, fm = gid * WGM, gsz = (nM - fm) < WGM ? (nM - fm) : WGM;
        u.pm = fm + ((wgid % nig) % gsz); u.pn = (wgid % nig) / gsz; u.e = 0; u.valid = 256; u.j = 0; return true;
    }
    __device__ __forceinline__ const char* a_base(const Unit& u) const { const int ac = acol_sh >= 0 ? (u.pn >> acol_sh) * 256 : 0; return (const char*)(A + (size_t)u.pm * BM * lda + ac); }
    __device__ __forceinline__ const char* b_base(const Unit& u) const { return (const char*)(Bt + (size_t)u.pn * BM * K); }
    __device__ __forceinline__ void fill_tab(const Unit&, LAS unsigned*) const {}
    __device__ __forceinline__ void a_off(const Unit&, const int (&R)[2], const int (&C)[2], unsigned (&v)[2][2], const LAS unsigned*) const {
#pragma unroll
        for (int h = 0; h < 2; ++h)
#pragma unroll
            for (int i = 0; i < 2; ++i) v[h][i] = (unsigned)((h * HALF + R[i]) * lda + C[i]) * 2u;
    }
};
template <bool GATHER_> struct ProbMoE {
    static constexpr bool GATHER = GATHER_, TAILS = true, ATILED = !GATHER_;
    const bf16_t* A; const bf16_t* Bt; int K, lda; size_t bstride;
    const unsigned* rowlist; const LAS int* units; int nunits;
    __device__ __forceinline__ bool next(int i, Unit& u) const {
        if (i >= nunits) return false;
        u.pm = __builtin_amdgcn_readfirstlane(units[i * 4 + 0]); u.pn = __builtin_amdgcn_readfirstlane(units[i * 4 + 1]);
        const int ej = __builtin_amdgcn_readfirstlane(units[i * 4 + 2]); u.e = ej & 255; u.j = ej >> 8; u.valid = __builtin_amdgcn_readfirstlane(units[i * 4 + 3]); return true;
    }
    __device__ __forceinline__ const char* a_base(const Unit& u) const { return GATHER ? (const char*)A : (const char*)(A + (size_t)u.pm * BM * lda); }
    __device__ __forceinline__ const char* b_base(const Unit& u) const { return (const char*)(Bt + (size_t)u.e * bstride + (size_t)u.pn * BM * K); }
    __device__ __forceinline__ void fill_tab(const Unit& u, LAS unsigned* tab) const {
        if (GATHER && threadIdx.x < 256) {
            const unsigned* rl = rowlist + (size_t)u.e * CAP + u.j * 256;
            const int r = (int)threadIdx.x < u.valid ? (int)threadIdx.x : 0;
            tab[threadIdx.x] = rl[r] >> 2;
        }
    }
    __device__ __forceinline__ void a_off(const Unit&, const int (&R)[2], const int (&C)[2], unsigned (&v)[2][2], const LAS unsigned* tab) const {
#pragma unroll
        for (int h = 0; h < 2; ++h)
#pragma unroll
            for (int i = 0; i < 2; ++i) {
                if (GATHER) v[h][i] = (tab[h * HALF + R[i]] * (unsigned)lda + (unsigned)C[i]) * 2u;
                else v[h][i] = (unsigned)((h * HALF + R[i]) * BK + C[i]) * 2u;
            }
    }
};

template <class Epi, class Prob, bool ALIGN_EPI, bool SP2>
__device__ __forceinline__ void gemm_phase(LAS unsigned char* lds, LAS unsigned* tab, const Prob& P, const Epi& E) {
    int tid = threadIdx.x; asm volatile("" : "+v"(tid));
    const int wid = __builtin_amdgcn_readfirstlane(tid >> 6), lane = tid & 63, wr = wid >> 2, wc = wid & 3, fr = lane & 15, fq = lane >> 4;
    const int K = P.K, nt = K / BK;
    int Rr[2], Cc[2]; unsigned voffB[2];
#pragma unroll
    for (int i = 0; i < 2; ++i) { int R, C; stage_rc(tid * 16 + i * 8192, R, C); Rr[i] = R; Cc[i] = C; const int Rb = Epi::PERM ? ((R & ~31) + perm32(R & 31)) : R; voffB[i] = (unsigned)(Rb * BK + C) * 2u; }
    const size_t kstepB = (size_t)BM * BK * 2;
    const size_t hstepB = (size_t)HALF * BK * 2;
    const size_t kstep = Prob::ATILED ? (size_t)BM * BK * 2 : (size_t)(BK * 2);
    const size_t hstepA = Prob::GATHER ? (size_t)0 : (Prob::ATILED ? (size_t)HALF * BK * 2 : (size_t)HALF * P.lda * 2);
#define PG8_V1 (Prob::GATHER ? vcur[1] : vcur[0])
    const unsigned ldsw = (unsigned)wid * 1024u;
    const int aoff = lds_byte(wr * 64 + fr, fq * 8), boff = lds_byte(wc * 32 + fr, fq * 8);
#define PG8_SA(b, h) (((b) * 2 + (h)) * HTB)
#define PG8_SB(b, h) ((4 + (b) * 2 + (h)) * HTB)
#define PG8_STAGE(bufoff, gbase, voff) do { _Pragma("unroll") for (int _i = 0; _i < 2; ++_i) \
        __builtin_amdgcn_global_load_lds((const unsigned*)((const char*)(gbase) + (voff)[_i]), (LAS unsigned*)(lds + (bufoff) + ldsw + _i * 8192), 16, 0, 0); } while (0)
#define PG8_LDA(dst, b, h) do { _Pragma("unroll") for (int m = 0; m < 4; ++m) _Pragma("unroll") for (int k = 0; k < 2; ++k) dst[m][k] = *(const LAS bf16x8*)(lds + PG8_SA(b, h) + aoff + m * 2048 + k * 1024); } while (0)
#define PG8_LDB(dst, b, h) do { _Pragma("unroll") for (int n = 0; n < 2; ++n) _Pragma("unroll") for (int k = 0; k < 2; ++k) dst[n][k] = *(const LAS bf16x8*)(lds + PG8_SB(b, h) + boff + n * 2048 + k * 1024); } while (0)
#define PG8_MMA(ai, bj, At, Bt) do { __builtin_amdgcn_s_setprio(1); _Pragma("unroll") for (int m = 0; m < 4; ++m) _Pragma("unroll") for (int n = 0; n < 2; ++n) _Pragma("unroll") for (int k = 0; k < 2; ++k) \
        acc[ai][bj][m][n] = __builtin_amdgcn_mfma_f32_16x16x32_bf16(Bt[n][k], At[m][k], acc[ai][bj][m][n], 0, 0, 0); __builtin_amdgcn_s_setprio(0); } while (0)
#define PG8_WAIT_V(n) asm volatile("s_waitcnt vmcnt(" #n ")" ::: "memory")
#define PG8_WAIT_L(n) asm volatile("s_waitcnt lgkmcnt(" #n ")" ::: "memory")
#define PG8_BAR __builtin_amdgcn_s_barrier()
#define PG8_SCHED __builtin_amdgcn_sched_barrier(0)
    Unit cur, nxt; int ui = 0;
    if (!P.next(0, cur)) return;
    unsigned vcur[2][2];
    if constexpr (Prob::GATHER) { P.fill_tab(cur, tab); asm volatile("s_waitcnt vmcnt(0) lgkmcnt(0)" ::: "memory"); PG8_BAR; asm volatile("" ::: "memory"); }
    P.a_off(cur, Rr, Cc, vcur, tab);
    if constexpr (Prob::GATHER) { asm volatile("s_waitcnt lgkmcnt(0)" ::: "memory"); }
    f32x4 acc[2][2][4][2];
#pragma unroll
    for (int a = 0; a < 2; ++a)
#pragma unroll
        for (int b = 0; b < 2; ++b)
#pragma unroll
            for (int m = 0; m < 4; ++m)
#pragma unroll
                for (int n = 0; n < 2; ++n) acc[a][b][m][n] = (f32x4){0.f, 0.f, 0.f, 0.f};
    bf16x8 At[4][2], B0[2][2], B1[2][2];
    const char* cA = P.a_base(cur); const char* cB = P.b_base(cur);
    static_assert(SP2, "only the two-MFMA-blocks-per-barrier-pair loop is kept");
    PG8_STAGE(PG8_SB(0, 0), cB, voffB); PG8_STAGE(PG8_SB(0, 1), cB + hstepB, voffB); PG8_STAGE(PG8_SA(0, 0), cA, vcur[0]); PG8_STAGE(PG8_SA(0, 1), cA + hstepA, PG8_V1);
    if (wr == 1) PG8_BAR;
    PG8_WAIT_V(2); PG8_BAR;
    PG8_STAGE(PG8_SB(1, 0), cB + kstepB, voffB); PG8_STAGE(PG8_SA(1, 0), cA + kstep, vcur[0]); PG8_STAGE(PG8_SB(1, 1), cB + hstepB + kstepB, voffB);
    PG8_WAIT_V(6); PG8_BAR;
    for (;;) {
        const bool has_next = P.next(ui + 1, nxt);
        const char* nA = has_next ? P.a_base(nxt) : cA; const char* nB = has_next ? P.b_base(nxt) : cB;
        if constexpr (Prob::GATHER) { if (has_next) P.fill_tab(nxt, tab); }
        const bool full = !Prob::TAILS || cur.valid > HALF;
        for (int t = 0; t < nt; t += 2) {
            const bool last = (t == nt - 2);
            const char* a1 = cA + (size_t)(t + 1) * kstep;
            const char* a2 = last ? nA : cA + (size_t)(t + 2) * kstep; const char* b2 = last ? nB : cB + (size_t)(t + 2) * kstepB;
            const char* a3 = a2 + kstep; const char* b3 = b2 + kstepB;
            PG8_LDB(B0, 0, 0); PG8_LDB(B1, 0, 1); PG8_SCHED; PG8_LDA(At, 0, 0); PG8_STAGE(PG8_SA(1, 1), a1 + hstepA, PG8_V1);
            if constexpr (Prob::GATHER) { if (last && has_next) P.a_off(nxt, Rr, Cc, vcur, tab); }
            PG8_WAIT_V(8); PG8_WAIT_L(0); PG8_BAR; PG8_MMA(0, 0, At, B0); PG8_MMA(0, 1, At, B1); PG8_BAR; PG8_SCHED;
            if (full) { PG8_LDA(At, 0, 1); } PG8_STAGE(PG8_SB(0, 0), b2, voffB); PG8_STAGE(PG8_SB(0, 1), b2 + hstepB, voffB); PG8_STAGE(PG8_SA(0, 0), a2, vcur[0]);
            PG8_WAIT_V(8); PG8_WAIT_L(0); PG8_BAR; if (full) { PG8_MMA(1, 0, At, B0); PG8_MMA(1, 1, At, B1); } PG8_BAR; PG8_SCHED;
            PG8_LDB(B0, 1, 0); PG8_LDB(B1, 1, 1); PG8_SCHED; PG8_LDA(At, 1, 0); PG8_STAGE(PG8_SA(0, 1), a2 + hstepA, PG8_V1);
            PG8_WAIT_V(8); PG8_WAIT_L(0); PG8_BAR; PG8_MMA(0, 0, At, B0); PG8_MMA(0, 1, At, B1); PG8_BAR; PG8_SCHED;
            if (full) { PG8_LDA(At, 1, 1); } PG8_STAGE(PG8_SB(1, 0), b3, voffB); PG8_STAGE(PG8_SB(1, 1), b3 + hstepB, voffB); PG8_STAGE(PG8_SA(1, 0), a3, vcur[0]);
            PG8_WAIT_V(8); PG8_WAIT_L(0); PG8_BAR; if (full) { PG8_MMA(1, 0, At, B0); PG8_MMA(1, 1, At, B1); } PG8_BAR; PG8_SCHED;
        }
        if constexpr (ALIGN_EPI) { if (wr == 0) PG8_BAR; }
        E(acc, cur, wr, wc, fr, fq);
        if (!has_next) break;
#pragma unroll
        for (int a = 0; a < 2; ++a)
#pragma unroll
            for (int b = 0; b < 2; ++b)
#pragma unroll
                for (int m = 0; m < 4; ++m)
#pragma unroll
                    for (int n = 0; n < 2; ++n) acc[a][b][m][n] = (f32x4){0.f, 0.f, 0.f, 0.f};
        cur = nxt; cA = nA; cB = nB; ++ui;
        if constexpr (ALIGN_EPI) { if (wr == 1) PG8_BAR; }
    }
    PG8_WAIT_V(0);
    if constexpr (!ALIGN_EPI) { if (wr == 0) PG8_BAR; }
    PG8_BAR;
#undef PG8_V1
#undef PG8_SA
#undef PG8_SB
#undef PG8_STAGE
#undef PG8_LDA
#undef PG8_LDB
#undef PG8_MMA
#undef PG8_WAIT_V
#undef PG8_WAIT_L
#undef PG8_BAR
#undef PG8_SCHED
}

typedef f32x4 AccT[2][2][4][2];
__device__ __forceinline__ float gelu_tanh(float x) {
    const float z = 1.5957691216057308f * (x + 0.044715f * x * x * x);
    return x * __builtin_amdgcn_rcpf(1.0f + __builtin_amdgcn_exp2f(-1.4426950408889634f * z));
}
struct EpiWin {
    static constexpr bool PERM = true;
    bf16_t* GB; bf16_t* RB;
    __device__ __forceinline__ void operator()(const AccT& acc, const Unit& u, int wr, int wc, int fr, int fq) const {
        const int row0 = u.pm * BM + wr * 64 + fr; const bool gate = u.pn < 4;
        bf16_t* base = GB + (size_t)(u.pn >> 2) * ((WS_RB - WS_GB) / 2); const int col0 = (u.pn & 3) * BM + wc * 32 + 8 * fq;
#pragma unroll
        for (int ai = 0; ai < 2; ++ai)
#pragma unroll
            for (int m = 0; m < 4; ++m) { bf16_t* rowp = base + (size_t)(row0 + ai * HALF + m * 16) * D + col0;
#pragma unroll
                for (int bj = 0; bj < 2; ++bj) { f32x4 v0 = acc[ai][bj][m][0], v1 = acc[ai][bj][m][1];
                    if (gate) {
#pragma unroll
                        for (int j = 0; j < 4; ++j) { v0[j] = gelu_tanh(v0[j]); v1[j] = gelu_tanh(v1[j]); } }
                    u32x4 w; w.x = cvt_pk_bf16(v0[0], v0[1]); w.y = cvt_pk_bf16(v0[2], v0[3]); w.z = cvt_pk_bf16(v1[0], v1[1]); w.w = cvt_pk_bf16(v1[2], v1[3]);
                    *(u32x4*)(rowp + bj * HALF) = w; } }
    }
};
struct EpiQKV {
    static constexpr bool PERM = true;
    bf16_t* Q; const float* qg; const float* kg; float* KM; LAS float* xl;
    __device__ __forceinline__ void operator()(const AccT& acc, const Unit& u, int wr, int wc, int fr, int fq) const {
        const int row0 = u.pm * BM + wr * 64 + fr; const int t = u.pn >> 2;
        bf16_t* base = Q + (size_t)t * ((WS_K - WS_Q) / 2); const int col0 = (u.pn & 3) * BM + wc * 32 + 8 * fq;
        LAS float* SS = xl; LAS float* KS = xl + 2048;
#pragma unroll
        for (int ai = 0; ai < 2; ++ai)
#pragma unroll
            for (int m = 0; m < 4; ++m)
#pragma unroll
                for (int bj = 0; bj < 2; ++bj) { const f32x4 v0 = acc[ai][bj][m][0], v1 = acc[ai][bj][m][1];
                    float ss = (v0[0] * v0[0] + v0[1] * v0[1]) + (v0[2] * v0[2] + v0[3] * v0[3]) + (v1[0] * v1[0] + v1[1] * v1[1]) + (v1[2] * v1[2] + v1[3] * v1[3]);
                    ss += __shfl_xor(ss, 16); ss += __shfl_xor(ss, 32);
                    if (fq == 0) SS[((ai * HALF + wr * 64 + m * 16 + fr) * 2 + bj) * 4 + wc] = ss; __builtin_amdgcn_sched_barrier(0); }
        asm volatile("s_waitcnt lgkmcnt(0)" ::: "memory"); __builtin_amdgcn_s_barrier(); asm volatile("" ::: "memory");
        const bool isv = (t == 2);
        const float* gp = (t == 0 ? qg : kg) + wc * 32 + 8 * fq;
        f32x4 g0 = *(const f32x4*)gp, g1 = *(const f32x4*)(gp + 4);
        if (isv) { g0 = (f32x4){1.f, 1.f, 1.f, 1.f}; g1 = g0; }
        {
#pragma unroll
            for (int bj = 0; bj < 2; ++bj) {
                float cs[8];
#pragma unroll
                for (int q = 0; q < 8; ++q) cs[q] = 0.f;
#pragma unroll
                for (int ai = 0; ai < 2; ++ai)
#pragma unroll
                    for (int m = 0; m < 4; ++m) { const int r = ai * HALF + wr * 64 + m * 16 + fr; bf16_t* rowp = base + (size_t)(u.pm * BM + r) * D + col0;
                        const f32x4 p = *(const LAS f32x4*)(SS + (r * 2 + bj) * 4);
                        const float rstd = isv ? 1.0f : __builtin_amdgcn_rsqf(((p[0] + p[1]) + (p[2] + p[3])) * (1.0f / HD) + NORM_EPS);
                        const f32x4 v0 = acc[ai][bj][m][0] * rstd * g0, v1 = acc[ai][bj][m][1] * rstd * g1;
#pragma unroll
                        for (int q = 0; q < 4; ++q) { cs[q] += v0[q]; cs[4 + q] += v1[q]; }
                        u32x4 w; w.x = cvt_pk_bf16(v0[0], v0[1]); w.y = cvt_pk_bf16(v0[2], v0[3]); w.z = cvt_pk_bf16(v1[0], v1[1]); w.w = cvt_pk_bf16(v1[2], v1[3]);
                        *(u32x4*)(rowp + bj * HALF) = w; __builtin_amdgcn_sched_barrier(0); }
#pragma unroll
                for (int q = 0; q < 8; ++q) { float v = cs[q]; v += __shfl_xor(v, 1); v += __shfl_xor(v, 2); v += __shfl_xor(v, 4); v += __shfl_xor(v, 8);
                    if (fr == 0) KS[wr * 256 + bj * HALF + wc * 32 + 8 * fq + q] = v; }
            }
            asm volatile("s_waitcnt lgkmcnt(0)" ::: "memory"); __builtin_amdgcn_s_barrier(); asm volatile("" ::: "memory");
            int tid = threadIdx.x; asm volatile("" : "+v"(tid));
            if (tid < 256 && t == 1) { const int b = u.pm >> 4, blk = u.pm & 15, h = 2 * (u.pn & 3) + (tid >> 7);
                KM[(((size_t)b * NH + h) * NBLK + blk) * HD + (tid & 127)] = (KS[tid] + KS[256 + tid]) * (1.0f / MBLK); }
        }
    }
};
struct EpiGates {
    static constexpr bool PERM = true;
    const bf16_t* XC; bf16_t* LA; bf16_t* UB; const float* ba; const float* bx; const float* sp8;
    __device__ __forceinline__ void operator()(const AccT& acc, const Unit& u, int wr, int wc, int fr, int fq) const {
        const int row0 = u.pm * BM + wr * 64 + fr; const int ch0 = (u.pn >> 1) * 256 + (u.pn & 1) * 128 + wc * 32 + 8 * fq;
        f32x4 bav[2], bxv[2], spv[2];
#pragma unroll
        for (int n = 0; n < 2; ++n) { bav[n] = *(const f32x4*)(ba + ch0 + n * 4); bxv[n] = *(const f32x4*)(bx + ch0 + n * 4); spv[n] = *(const f32x4*)(sp8 + ch0 + n * 4) * 1.4426950408889634f; }
#pragma unroll
        for (int ai = 0; ai < 2; ++ai)
#pragma unroll
            for (int m = 0; m < 4; ++m) { const size_t ro = (size_t)(row0 + ai * HALF + m * 16) * D + ch0;
                const u32x4 xw = *(const u32x4*)(XC + ro);
                float lo[8], uo[8];
#pragma unroll
                for (int n = 0; n < 2; ++n)
#pragma unroll
                    for (int j = 0; j < 4; ++j) { const int q = n * 4 + j; const float xcv = (q & 1) ? bfhi(xw[q >> 1]) : bflo(xw[q >> 1]);
                        const float r = sigmoidf_(acc[ai][0][m][n][j] + bav[n][j]), ig = sigmoidf_(acc[ai][1][m][n][j] + bxv[n][j]);
                        const float l2 = -spv[n][j] * r;
                        const float a2 = __builtin_amdgcn_exp2f(2.0f * l2);
                        lo[q] = l2; uo[q] = __builtin_amdgcn_sqrtf(1.0f - a2) * ig * xcv; }
                u32x4 lw, uw;
#pragma unroll
                for (int q = 0; q < 4; ++q) { lw[q] = cvt_pk_bf16(lo[2 * q], lo[2 * q + 1]); uw[q] = cvt_pk_bf16(uo[2 * q], uo[2 * q + 1]); }
                *(u32x4*)(LA + ro) = lw; *(u32x4*)(UB + ro) = uw; }
    }
};
struct EpiResid {
    static constexpr bool PERM = false;
    const float* X; float* XB; const float* g1;
    __device__ __forceinline__ void operator()(const AccT& acc, const Unit& u, int wr, int wc, int fr, int fq) const {
        const int row0 = u.pm * BM + wr * 64 + fr, col0 = u.pn * BM + wc * 32 + 4 * fq; const int b = (u.pm * BM) / SEQ;
        f32x4 gv[2][2];
#pragma unroll
        for (int bj = 0; bj < 2; ++bj)
#pragma unroll
            for (int n = 0; n < 2; ++n) gv[bj][n] = *(const f32x4*)(g1 + (size_t)b * 6 * D + col0 + bj * HALF + n * 16);
#pragma unroll
        for (int ai = 0; ai < 2; ++ai)
#pragma unroll
            for (int m = 0; m < 4; ++m) { const size_t ro = (size_t)(row0 + ai * HALF + m * 16) * D + col0;
#pragma unroll
                for (int bj = 0; bj < 2; ++bj)
#pragma unroll
                    for (int n = 0; n < 2; ++n) { const f32x4 xv = *(const f32x4*)(X + ro + bj * HALF + n * 16);
                        *(f32x4*)(XB + ro + bj * HALF + n * 16) = xv + gv[bj][n] * acc[ai][bj][m][n]; }
                asm volatile("" ::: "memory"); }
    }
};
struct EpiSwiglu {
    static constexpr bool PERM = true;
    bf16_t* ACT; const float* bgu;
    __device__ __forceinline__ void operator()(const AccT& acc, const Unit& u, int wr, int wc, int fr, int fq) const {
        const int row0 = u.pm * BM + wr * 64 + fr; const int j0 = u.pn * HALF + wc * 32 + 8 * fq;
        const float* bp = bgu + (size_t)u.e * 2 * D + j0;
        const f32x4 bg0 = *(const f32x4*)(bp), bg1 = *(const f32x4*)(bp + 4), bu0 = *(const f32x4*)(bp + D), bu1 = *(const f32x4*)(bp + D + 4);
#pragma unroll
        for (int ai = 0; ai < 2; ++ai)
#pragma unroll
            for (int m = 0; m < 4; ++m) {
                float o[8];
#pragma unroll
                for (int n = 0; n < 2; ++n)
#pragma unroll
                    for (int j = 0; j < 4; ++j) { const float g = acc[ai][0][m][n][j] + (n ? bg1[j] : bg0[j]), up = acc[ai][1][m][n][j] + (n ? bu1[j] : bu0[j]);
                        const float gv = fminf(g, 7.0f), uv = fminf(fmaxf(up, -7.0f), 7.0f);
                        o[n * 4 + j] = gv * sigmoidf_(1.702f * gv) * (uv + 1.0f); }
                u32x4 w; w.x = cvt_pk_bf16(o[0], o[1]); w.y = cvt_pk_bf16(o[2], o[3]); w.z = cvt_pk_bf16(o[4], o[5]); w.w = cvt_pk_bf16(o[6], o[7]);
                *(u32x4*)(ACT + (size_t)u.pm * BM * D + (size_t)(j0 >> 6) * (BM * BK) + (size_t)(wr * 64 + fr + ai * HALF + m * 16) * BK + (j0 & 63)) = w; }
    }
};
struct EpiDown {
    static constexpr bool PERM = false;
    const float* XB; float* XO; const float* g2; const float* bdn; const unsigned* rowlist; const float* topw;
    __device__ __forceinline__ void operator()(const AccT& acc, const Unit& u, int wr, int wc, int fr, int fq) const {
        const int c0 = u.pn * BM + wc * 32 + 4 * fq;
        const float* bp = bdn + (size_t)u.e * D + c0;
        f32x4 bv[2][2];
#pragma unroll
        for (int bj = 0; bj < 2; ++bj) { bv[bj][0] = *(const f32x4*)(bp + bj * HALF); bv[bj][1] = *(const f32x4*)(bp + bj * HALF + 16); }
        const unsigned* rl = rowlist + (size_t)u.e * CAP + u.j * 256;
#pragma unroll
        for (int ai = 0; ai < 2; ++ai)
#pragma unroll
            for (int m = 0; m < 4; ++m) { const int r = ai * HALF + wr * 64 + m * 16 + fr;
                if (r < u.valid) { const unsigned dest = rl[r]; const float w = topw[dest];
                    const size_t ro = (size_t)dest * D + c0; const float* gp = g2 + (size_t)(dest / SEQ) * 6 * D + c0;
#pragma unroll
                    for (int bj = 0; bj < 2; ++bj)
#pragma unroll
                        for (int n = 0; n < 2; ++n) { const f32x4 xv = *(const f32x4*)(XB + ro + bj * HALF + n * 16), gv = *(const f32x4*)(gp + bj * HALF + n * 16);
                            *(f32x4*)(XO + ro + bj * HALF + n * 16) = xv + gv * ((acc[ai][bj][m][n] + bv[bj][n]) * w); } }
                asm volatile("" ::: "memory"); }
    }
};
}

namespace att {
typedef short s16x4 __attribute__((ext_vector_type(4)));
typedef float f32x16 __attribute__((ext_vector_type(16)));
constexpr int NW = 8, QBLK = 32, KVBLK = 64, QB = NW * QBLK, DH = 128, LD = 1024;
constexpr int SHM_V = KVBLK * DH * 2, SHM_K = KVBLK * DH * 2;
constexpr int ATT_LDS_BYTES = 2 * SHM_V + 2 * SHM_K + NW * 64 * 4;
constexpr float SCALE = 0.08838834764831845f;
constexpr float THR = 8.f;
#define KSWZ(row, colB) ((row) * 256 + ((colB) ^ (((row) & 7) << 4)))
#define SBAR() __builtin_amdgcn_sched_barrier(0)
__device__ __forceinline__ int v_st(int k, int c) { const int kk = (k & ~0xC) | ((k & 4) << 1) | ((k & 8) >> 1); return ((kk >> 3) * 4 + (c >> 5)) * 512 + ((kk & 7) * 32 + (c & 31)) * 2; }
__device__ __forceinline__ int v_rd_base(int lane) { return ((lane & 3) << 3) | (((lane >> 2) & 3) << 6) | (((lane >> 4) & 1) << 5) | (((lane >> 5) & 1) << 8); }
constexpr int v_rd_off(int d0, int ks, int half) { return d0 * 512 + ks * 4096 + half * 2048; }
__device__ __forceinline__ int crow(int r, int hi) { return (r & 3) + 8 * (r >> 2) + 4 * hi; }
__device__ __forceinline__ unsigned cvtpk(float lo, float hi) { unsigned r; asm volatile("v_cvt_pk_bf16_f32 %0, %1, %2" : "=v"(r) : "v"(lo), "v"(hi)); return r; }
__device__ __forceinline__ bf16x8 ld8(const bf16_t* p) { return *reinterpret_cast<const bf16x8*>(p); }
__device__ __forceinline__ void mask_causal(f32x16& p0, f32x16& p1, int dq) {
    const float NEG = -__builtin_inff();
#pragma unroll
    for (int r = 0; r < 16; ++r) {
        const int c = (r & 3) + 8 * (r >> 2);
        if (dq - c < 0) p0[r] = NEG;
        if (dq - c - 32 < 0) p1[r] = NEG;
    }
}
__device__ __forceinline__ void mask_all(f32x16& p0, f32x16& p1, bool keep) {
    const float NEG = -__builtin_inff();
#pragma unroll
    for (int r = 0; r < 16; ++r) { p0[r] = keep ? p0[r] : NEG; p1[r] = keep ? p1[r] : NEG; }
}
__device__ __forceinline__ void partialSM(f32x16& p0, f32x16& p1, float& m_reg, float& mn, float& alpha) {
    float pmax = p0[0]; for (int r = 1; r < 16; ++r) pmax = fmaxf(pmax, p0[r]); for (int r = 0; r < 16; ++r) pmax = fmaxf(pmax, p1[r]);
    { auto rr = __builtin_amdgcn_permlane32_swap(__float_as_uint(pmax), __float_as_uint(pmax), false, false);
      pmax = fmaxf(__uint_as_float(rr[0]), __uint_as_float(rr[1])); }
    constexpr float C2 = 1.4426950408889634f * SCALE;
    if (__builtin_expect(__all((pmax - m_reg) * SCALE <= THR), 1)) { mn = m_reg; alpha = 1.f; }
    else { mn = fmaxf(m_reg, pmax); alpha = __builtin_amdgcn_exp2f((m_reg - mn) * C2); m_reg = mn; }
    const float mnL = -mn * C2;
    for (int r = 0; r < 16; ++r) p0[r] = fmaf(p0[r], C2, mnL); for (int r = 0; r < 16; ++r) p1[r] = fmaf(p1[r], C2, mnL);
    for (int r = 0; r < 16; ++r) p0[r] = __builtin_amdgcn_exp2f(p0[r]);
}
__device__ __forceinline__ void finishSM(f32x16& p0, f32x16& p1, float alpha, float& l_reg, bf16x8& pa0, bf16x8& pa1, bf16x8& pa2, bf16x8& pa3) {
    for (int r = 0; r < 16; ++r) p1[r] = __builtin_amdgcn_exp2f(p1[r]);
    float ps = 0; for (int r = 0; r < 16; ++r) ps += p0[r]; for (int r = 0; r < 16; ++r) ps += p1[r];
    { auto rr = __builtin_amdgcn_permlane32_swap(__float_as_uint(ps), __float_as_uint(ps), false, false);
      ps = __uint_as_float(rr[0]) + __uint_as_float(rr[1]); }
    l_reg = l_reg * alpha + ps;
#define PK4(P, B_, OUT) do { unsigned a0 = cvtpk(P[B_+0], P[B_+1]), a1 = cvtpk(P[B_+2], P[B_+3]);                          \
        unsigned b0 = cvtpk(P[B_+4], P[B_+5]), b1 = cvtpk(P[B_+6], P[B_+7]);                                             \
        auto r0 = __builtin_amdgcn_permlane32_swap(a0, b0, false, false); auto r1 = __builtin_amdgcn_permlane32_swap(a1, b1, false, false); \
        u32x4 w = {r0[0], r1[0], r0[1], r1[1]}; OUT = *reinterpret_cast<bf16x8*>(&w); } while (0)
    PK4(p0, 0, pa0); PK4(p0, 8, pa1); PK4(p1, 0, pa2); PK4(p1, 8, pa3);
#undef PK4
}
template <int KB>
__device__ __forceinline__ void qkt(f32x16& p0, f32x16& p1, const char* K_lds, int r32, int hi, const bf16x8* qr) {
    p0 = f32x16{}; p1 = f32x16{};
    const char* kb[4];
#pragma unroll
    for (int dd = 0; dd < 4; ++dd) kb[dd] = K_lds + KB * SHM_K + KSWZ(r32, (dd * 16 + hi * 8) * 2);
#pragma unroll
    for (int d0 = 0; d0 < 8; ++d0) { const char* a = kb[d0 & 3] + (d0 >> 2) * 128;
        bf16x8 b0 = *reinterpret_cast<const bf16x8*>(a);
        bf16x8 b1 = *reinterpret_cast<const bf16x8*>(a + 32 * 256);
        p0 = __builtin_amdgcn_mfma_f32_32x32x16_bf16(b0, qr[d0], p0, 0, 0, 0);
        p1 = __builtin_amdgcn_mfma_f32_32x32x16_bf16(b1, qr[d0], p1, 0, 0, 0); }
}
template <int VB>
__device__ __forceinline__ void pv_tile(f32x16* o, int vb0, bf16x8 pa0, bf16x8 pa1, bf16x8 pa2, bf16x8 pa3) {
#define TRRD(dst, off) asm volatile("ds_read_b64_tr_b16 %0, %1 offset:%2" : "=&v"(dst) : "v"(vb0), "i"(off) : "memory")
#define PV_D0(d0) do { s16x4 l0, l1, l2, l3, h0, h1, h2, h3; constexpr int b_ = VB * SHM_V + v_rd_off(d0, 0, 0); \
        TRRD(l0, b_); TRRD(h0, b_ + 2048); TRRD(l1, b_ + 4096); TRRD(h1, b_ + 6144); TRRD(l2, b_ + 8192); TRRD(h2, b_ + 10240); TRRD(l3, b_ + 12288); TRRD(h3, b_ + 14336); \
        asm volatile("s_waitcnt lgkmcnt(0)" ::: "memory"); SBAR();   \
        o[d0] = __builtin_amdgcn_mfma_f32_32x32x16_bf16(pa0, (bf16x8){l0[0], l0[1], l0[2], l0[3], h0[0], h0[1], h0[2], h0[3]}, o[d0], 0, 0, 0);   \
        o[d0] = __builtin_amdgcn_mfma_f32_32x32x16_bf16(pa1, (bf16x8){l1[0], l1[1], l1[2], l1[3], h1[0], h1[1], h1[2], h1[3]}, o[d0], 0, 0, 0);   \
        o[d0] = __builtin_amdgcn_mfma_f32_32x32x16_bf16(pa2, (bf16x8){l2[0], l2[1], l2[2], l2[3], h2[0], h2[1], h2[2], h2[3]}, o[d0], 0, 0, 0);   \
        o[d0] = __builtin_amdgcn_mfma_f32_32x32x16_bf16(pa3, (bf16x8){l3[0], l3[1], l3[2], l3[3], h3[0], h3[1], h3[2], h3[3]}, o[d0], 0, 0, 0); } while (0)
    PV_D0(0); PV_D0(1); PV_D0(2); PV_D0(3);
#undef PV_D0
#undef TRRD
}
constexpr int KM_OFF = 69632;
__device__ __forceinline__ unsigned moba_gate(const bf16x8* qr, const float* km, int qb, int hi) {
    float v1 = -__builtin_inff(), v2 = v1, v3 = v1; int i1 = -1, i2 = -1, i3 = -1;
    for (int n = 0; n < qb; ++n) { const float* kp = km + n * DH + hi * 8; float sc = 0.f;
#pragma unroll
        for (int d0 = 0; d0 < 8; ++d0) { const f32x4 k0 = *(const f32x4*)(kp + d0 * 16), k1 = *(const f32x4*)(kp + d0 * 16 + 4); const bf16x8 q = qr[d0];
#pragma unroll
            for (int e = 0; e < 4; ++e) { sc += __uint_as_float(((unsigned)(unsigned short)q[e]) << 16) * k0[e]; sc += __uint_as_float(((unsigned)(unsigned short)q[4 + e]) << 16) * k1[e]; } }
        sc += __shfl_xor(sc, 32);
        if (sc > v1) { v3 = v2; i3 = i2; v2 = v1; i2 = i1; v1 = sc; i1 = n; }
        else if (sc > v2) { v3 = v2; i3 = i2; v2 = sc; i2 = n; }
        else if (sc > v3) { v3 = sc; i3 = n; } }
    unsigned m = 0u; if (i1 >= 0) m |= 1u << i1; if (i2 >= 0) m |= 1u << i2; if (i3 >= 0) m |= 1u << i3;
    return m;
}
struct BlockRef { const bf16_t* Q; const bf16_t* K; const bf16_t* V; bf16_t* O; int qb; };
struct Seam { bf16x8 qr[8]; bf16x8 st_v0, st_v1, st_k0, st_k1; };
#define VMW() asm volatile("s_waitcnt vmcnt(0)" ::: "memory")
#define VMWN(n) asm volatile("s_waitcnt vmcnt(%0)" :: "i"(n) : "memory")
#define GLD8(ubase) (*reinterpret_cast<const bf16x8*>((ubase) + toff))
#define SLOAD_H(Kp, Vp, k0) do { const char* kb__ = (const char*)(Kp) + (size_t)(k0) * (LD * 2); const char* vb__ = (const char*)(Vp) + (size_t)(k0) * (LD * 2); \
                         S.st_v0 = GLD8(vb__); S.st_v1 = GLD8(vb__ + 32 * LD * 2); S.st_k0 = GLD8(kb__); S.st_k1 = GLD8(kb__ + 32 * LD * 2); } while (0)
#define SWRITE_HK(bf) do { *(bf16x8*)(K_lds + (bf) * SHM_K + kws) = S.st_k0; *(bf16x8*)(K_lds + (bf) * SHM_K + kws + 32 * 256) = S.st_k1; } while (0)
#define SWRITE_HV(bf) do { *(bf16x8*)(V_lds + (bf) * SHM_V + vst0) = S.st_v0; *(bf16x8*)(V_lds + (bf) * SHM_V + vst1) = S.st_v1; } while (0)
#define SWRITE_H(bf) do { SWRITE_HV(bf); SWRITE_HK(bf); } while (0)
__device__ __forceinline__ void moba_prime(const BlockRef& cur, char* lds, Seam& S, int tid) {
    const int wid = __builtin_amdgcn_readfirstlane(tid >> 6), lane = tid & 63, r32 = lane & 31, hi = lane >> 5;
    const int sr = tid >> 4, sc = (tid & 15) * 8, kws = KSWZ(sr, sc * 2); char* K_lds = lds + 2 * SHM_V;
    const unsigned toff = (unsigned)(sr * LD + sc) * 2u, qoff = (unsigned)(r32 * LD + hi * 8) * 2u;
    { const char* qb_ = (const char*)cur.Q + (size_t)(wid * QBLK) * (LD * 2);
#pragma unroll
      for (int d0 = 0; d0 < 8; ++d0) S.qr[d0] = *reinterpret_cast<const bf16x8*>(qb_ + d0 * 32 + qoff); }
    SLOAD_H(cur.K, cur.V, 0); VMW(); SWRITE_HK(0);
    __syncthreads();
}
__device__ __forceinline__ void moba_block(const BlockRef& cur, const BlockRef& nxt, char* lds, Seam& S, int tid) {
    const int wid = __builtin_amdgcn_readfirstlane(tid >> 6), lane = tid & 63, r32 = lane & 31, hi = lane >> 5;
    const int NT = 4 * (cur.qb + 1);
    const int P0 = cur.qb * QB;
    const int qlo = P0 + wid * QBLK, qm = qlo + r32 - 4 * hi;
    const unsigned msk = moba_gate(S.qr, (const float*)(lds + KM_OFF), cur.qb, hi);
    char* V_lds = lds; char* K_lds = lds + 2 * SHM_V;
    float* ws = (float*)(lds + 2 * SHM_V + 2 * SHM_K) + wid * 64; float* li_l = ws, * al_l = ws + 32;
    float m_reg = -1e30f, l_reg = 0; f32x16 o[4] = {};
    const int sr = tid >> 4, sc = (tid & 15) * 8, vst0 = v_st(sr, sc), vst1 = v_st(32 + sr, sc), kws = KSWZ(sr, sc * 2);
    const unsigned toff = (unsigned)(sr * LD + sc) * 2u, qoff = (unsigned)(r32 * LD + hi * 8) * 2u;
    const int vb0 = (int)(uintptr_t)V_lds + v_rd_base(lane);
    const bf16_t* Kh = cur.K; const bf16_t* Vh = cur.V;
#define RESC(a) do { if (__any((a) < 1.f)) { if (hi == 0) al_l[r32] = (a); asm volatile("s_waitcnt lgkmcnt(0)" ::: "memory");              \
                     for (int d_ = 0; d_ < 4; ++d_) for (int r = 0; r < 16; ++r) o[d_][r] *= al_l[crow(r, hi)]; } } while (0)
#define KBASE(t) ((t) * KVBLK)
#define MASKT(P0_, P1_, t) do { const int kb_ = KBASE(t); const int jb_ = (t) >> 2; \
        if (jb_ < cur.qb) { mask_all(P0_, P1_, ((msk >> jb_) & 1u) != 0u); } \
        else if (kb_ + KVBLK - 1 > qlo) mask_causal(P0_, P1_, qm - kb_); } while (0)
    constexpr int NQL = 8;
#define SEAM_K0() do { VMWN(NQL); SWRITE_HK(0); SBAR(); } while (0)
    f32x16 pA0, pA1, pB0, pB1; float mnA, mnB, alA, alB; bf16x8 pa0, pa1, pa2, pa3;
    SWRITE_HV(0); SBAR();
    if (NT > 1) { SLOAD_H(Kh, Vh, KBASE(1)); }
    SBAR(); qkt<0>(pA0, pA1, K_lds, r32, hi, S.qr);
    MASKT(pA0, pA1, 0); partialSM(pA0, pA1, m_reg, mnA, alA);
    if (NT > 1) { VMW(); SWRITE_H(1); }
    __syncthreads();
#define HALF_STEP(PX0, PX1, mnX, alX, PY0, PY1, alY, t, KB, VB, SB) do {                                                      \
        SBAR(); qkt<KB>(PX0, PX1, K_lds, r32, hi, S.qr);                                             \
        finishSM(PY0, PY1, alY, l_reg, pa0, pa1, pa2, pa3); SBAR();                                                           \
        if ((t) + 1 < NT) { SLOAD_H(Kh, Vh, KBASE((t) + 1)); SBAR(); }                                               \
        pv_tile<VB>(o, vb0, pa0, pa1, pa2, pa3); MASKT(PX0, PX1, (t)); partialSM(PX0, PX1, m_reg, mnX, alX);                                        \
        __syncthreads();                                                                                                      \
        if ((t) + 1 < NT) { VMW(); SWRITE_H(SB); }                                                                          \
        RESC(alX); __syncthreads(); } while (0)
    for (int t = 1; t + 1 < NT; t += 2) {
        HALF_STEP(pB0, pB1, mnB, alB, pA0, pA1, alA, t, 1, 0, 0);
        HALF_STEP(pA0, pA1, mnA, alA, pB0, pB1, alB, t + 1, 0, 1, 1);
    }
    const bool even = (NT & 1) == 0;
    if (even) { SBAR(); qkt<1>(pB0, pB1, K_lds, r32, hi, S.qr); SBAR(); }
    SLOAD_H(nxt.K, nxt.V, 0); SBAR();
    { const char* qb_ = (const char*)nxt.Q + (size_t)(wid * QBLK) * (LD * 2);
#pragma unroll
      for (int d0 = 0; d0 < 8; ++d0) S.qr[d0] = *reinterpret_cast<const bf16x8*>(qb_ + d0 * 32 + qoff); }
    SBAR();
    finishSM(pA0, pA1, alA, l_reg, pa0, pa1, pa2, pa3); SBAR();
    pv_tile<0>(o, vb0, pa0, pa1, pa2, pa3);
    if (even) { MASKT(pB0, pB1, NT - 1); partialSM(pB0, pB1, m_reg, mnB, alB); __syncthreads(); RESC(alB);
        finishSM(pB0, pB1, alB, l_reg, pa0, pa1, pa2, pa3); SBAR(); pv_tile<1>(o, vb0, pa0, pa1, pa2, pa3); }
    SBAR(); SEAM_K0();
    if (hi == 0) li_l[r32] = l_reg; asm volatile("s_waitcnt lgkmcnt(0)" ::: "memory");
    float rli[16];
#pragma unroll
    for (int r = 0; r < 16; ++r) rli[r] = __builtin_amdgcn_rcpf(li_l[crow(r, hi)]);
    char* Ow = (char*)cur.O + (size_t)(wid * QBLK) * (LD * 2);
    const unsigned ooff = (unsigned)(4 * hi * LD + r32) * 2u;
#pragma unroll
    for (int r = 0; r < 16; ++r) { char* Or = Ow + (size_t)((r & 3) + 8 * (r >> 2)) * (LD * 2);
#pragma unroll
        for (int d0 = 0; d0 < 4; ++d0) { const float v = o[d0][r] * rli[r];
            const float vn = __shfl_xor(v, 1);
            if ((r32 & 1) == 0) *(unsigned*)(Or + d0 * 64 + ooff) = cvtpk(v, vn); } }
    __syncthreads();
#undef RESC
#undef KBASE
#undef MASKT
#undef SEAM_K0
#undef HALF_STEP
}
#undef VMW
#undef VMWN
#undef SLOAD_H
#undef GLD8
#undef SWRITE_HK
#undef SWRITE_HV
#undef SWRITE_H
}

struct Args { const float* in[25]; float* out; unsigned char* ws; int ph_lo, ph_hi, li, pad; };
enum { IN_X = 0, IN_C, IN_NMG, IN_NFG, IN_WMOD, IN_BMOD, IN_LWIN, IN_LCW, IN_LCB, IN_LWA, IN_LBA, IN_LWX, IN_LBX, IN_LLAM, IN_LWOUT,
       IN_AQKV, IN_AQG, IN_AKG, IN_AWOUT, IN_RW, IN_RB, IN_WGU, IN_BGU, IN_WDN, IN_BDN };
struct Frame {
    LAS unsigned char* lds;
    unsigned char* ws;
    int tid, lane, wave, vcu, G;
};

__device__ __forceinline__ void cvt_tile(const float* W, int ldw, int k0, int n0, bf16_t* WT, int ldt, int drow0, LAS float* scr, int lane) {
    const int q = lane & 15, rr = lane >> 4;
    f32x4 v[16];
#pragma unroll
    for (int i = 0; i < 16; ++i) v[i] = __builtin_nontemporal_load((const f32x4*)(W + (size_t)(k0 + 4 * i + rr) * ldw + n0 + 4 * q));
#pragma unroll
    for (int i = 0; i < 16; ++i) { LAS float* s = scr + (4 * i + rr) * 65 + 4 * q; s[0] = v[i][0]; s[1] = v[i][1]; s[2] = v[i][2]; s[3] = v[i][3]; }
    LDS_WAIT();
    const int c = lane & 7;
#pragma unroll
    for (int jj = 0; jj < 8; ++jj) { const int n = (lane >> 3) + 8 * jj; const LAS float* s = scr + (8 * c) * 65 + n;
        u32x4 o; o.x = cvt_pk_bf16(s[0 * 65], s[1 * 65]); o.y = cvt_pk_bf16(s[2 * 65], s[3 * 65]); o.z = cvt_pk_bf16(s[4 * 65], s[5 * 65]); o.w = cvt_pk_bf16(s[6 * 65], s[7 * 65]);
        const int dr = drow0 + n;
        __builtin_nontemporal_store(o, (u32x4*)(WT + ((size_t)(dr >> 8) * (ldt >> 6) + (k0 >> 6)) * (256 * 64) + (size_t)(dr & 255) * 64 + 8 * c)); }
    LDS_WAIT();
}
__device__ __forceinline__ void phase_prologue(Frame& F, const Args& a) {
    if (blockIdx.x < 96) {
        LAS float* cond = (LAS float*)F.lds;
        LAS float* red = (LAS float*)(F.lds + 16384);
        const float* c = a.in[IN_C];
        for (int i = F.tid; i < BATCH * D; i += NTHR) { const float x = c[i]; cond[i] = x * sigmoidf_(x); }
        __syncthreads();
        const int l = blockIdx.x / 24, n0 = (blockIdx.x % 24) * 256;
        const float* W = a.in[IN_WMOD] + (size_t)l * D * 6 * D + n0 + 4 * F.lane;
        f32x4 acc[4];
#pragma unroll
        for (int b = 0; b < 4; ++b) acc[b] = (f32x4){0.f, 0.f, 0.f, 0.f};
        const int kb = F.wave * 128;
#pragma unroll 8
        for (int k = 0; k < 128; ++k) { const f32x4 w = *(const f32x4*)(W + (size_t)(kb + k) * 6 * D);
#pragma unroll
            for (int b = 0; b < 4; ++b) acc[b] += w * cond[b * D + kb + k]; }
#pragma unroll
        for (int b = 0; b < 4; ++b) *(LAS f32x4*)(red + (F.wave * 4 + b) * 256 + 4 * F.lane) = acc[b];
        __syncthreads();
        float* MOD = (float*)(F.ws + WS_MOD);
        for (int o = F.tid; o < 1024; o += NTHR) { const int b = o >> 8, n = o & 255; float s = 0.f;
#pragma unroll
            for (int w = 0; w < 8; ++w) s += red[(w * 4 + b) * 256 + n];
            MOD[((size_t)l * BATCH + b) * 6 * D + n0 + n] = s + a.in[IN_BMOD][(size_t)l * 6 * D + n0 + n]; }
        __syncthreads();
    }
    { const int g = blockIdx.x * NTHR + F.tid; if (g < 2 * D) { const float lam = a.in[IN_LLAM][g]; const float z = -lam;
        const float sp = z > 20.f ? z : log1pf(__expf(z)); ((float*)(F.ws + WS_SP8))[g] = 8.0f * sp; } }
    { float* PAR = (float*)(F.ws + WS_PAR); const int g = blockIdx.x * NTHR + F.tid, GS = F.G * NTHR;
#define CPY(dst, src, n) for (int i = g; i < (n) / 4; i += GS) *(f32x4*)(PAR + (dst) + 4 * i) = *(const f32x4*)(a.in[src] + 4 * i)
      CPY(PAR_NMG, IN_NMG, 4 * 1024); CPY(PAR_NFG, IN_NFG, 4 * 1024); CPY(PAR_LCW, IN_LCW, 2 * 4 * 1024); CPY(PAR_LCB, IN_LCB, 2 * 1024); CPY(PAR_LBA, IN_LBA, 2 * 1024); CPY(PAR_LBX, IN_LBX, 2 * 1024);
      CPY(PAR_AQG, IN_AQG, 256); CPY(PAR_AKG, IN_AKG, 256); CPY(PAR_RW, IN_RW, 4 * 1024 * 32); CPY(PAR_RB, IN_RB, 128); CPY(PAR_BGU, IN_BGU, 4 * 32 * 2048); CPY(PAR_BDN, IN_BDN, 4 * 32 * 1024);
#undef CPY
    }
    LAS float* scr = (LAS float*)(F.lds + F.wave * 16640);
    const int gw = F.vcu * NWAVES + F.wave, NGW = F.G * NWAVES;
    constexpr int I0 = 128 * 512, I1 = 128 * 256, I2 = 2 * 512, I3 = 16 * 16, I4 = 2 * 256, I5 = 2 * 768, I6 = 2 * 256;
    constexpr int NITEMS = I0 + I1 + I2 + I3 + I4 + I5 + I6;
    for (int it = gw; it < NITEMS; it += NGW) {
        int r = it;
        if (r < I0) { const int mat = r >> 9, q = r & 511, kb = q >> 5, nb = q & 31, n0 = nb * 64;
            const int dr = n0 < D ? (n0 >> 7) * 256 + (n0 & 127) : ((n0 - D) >> 7) * 256 + 128 + ((n0 - D) & 127);
            cvt_tile(a.in[IN_WGU] + (size_t)mat * D * 2 * D, 2 * D, kb * 64, n0, (bf16_t*)(F.ws + WS_WGU) + (size_t)mat * 2 * D * D, D, dr, scr, F.lane); continue; } r -= I0;
        if (r < I1) { const int mat = r >> 8, q = r & 255, kb = q >> 4, nb = q & 15;
            cvt_tile(a.in[IN_WDN] + (size_t)mat * D * D, D, kb * 64, nb * 64, (bf16_t*)(F.ws + WS_WDN) + (size_t)mat * D * D, D, nb * 64, scr, F.lane); continue; } r -= I1;
        if (r < I2) { const int mat = r >> 9, q = r & 511, kb = q >> 5, nb = q & 31;
            cvt_tile(a.in[IN_LWIN] + (size_t)mat * D * 2 * D, 2 * D, kb * 64, nb * 64, (bf16_t*)(F.ws + WS_WIN) + (size_t)mat * 2 * D * D, D, nb * 64, scr, F.lane); continue; } r -= I2;
        if (r < I3) { const int mat = r >> 4, q = r & 15, kb = q >> 2, nb = q & 3;
            const int layer = mat >> 3, ax = (mat >> 2) & 1, g = mat & 3, n0 = nb * 64;
            const float* src = (ax ? a.in[IN_LWX] : a.in[IN_LWA]) + (size_t)(layer * 4 + g) * 256 * 256;
            const int dr = (g * 2 + (n0 >> 7)) * 256 + ax * 128 + (n0 & 127);
            cvt_tile(src, 256, kb * 64, n0, (bf16_t*)(F.ws + WS_WG) + (size_t)layer * 2048 * 256, 256, dr, scr, F.lane); continue; } r -= I3;
        if (r < I4) { const int mat = r >> 8, q = r & 255, kb = q >> 4, nb = q & 15;
            cvt_tile(a.in[IN_LWOUT] + (size_t)mat * D * D, D, kb * 64, nb * 64, (bf16_t*)(F.ws + WS_WLO) + (size_t)mat * D * D, D, nb * 64, scr, F.lane); continue; } r -= I4;
        if (r < I5) { const int mat = r / 768, q = r % 768, kb = q / 48, nb = q % 48;
            cvt_tile(a.in[IN_AQKV] + (size_t)mat * D * 3 * D, 3 * D, kb * 64, nb * 64, (bf16_t*)(F.ws + WS_WQKV) + (size_t)mat * 3 * D * D, D, nb * 64, scr, F.lane); continue; } r -= I5;
        { const int mat = r >> 8, q = r & 255, kb = q >> 4, nb = q & 15;
            cvt_tile(a.in[IN_AWOUT] + (size_t)mat * D * D, D, kb * 64, nb * 64, (bf16_t*)(F.ws + WS_WAO) + (size_t)mat * D * D, D, nb * 64, scr, F.lane); }
    }
}

__device__ __forceinline__ void phase_norm(Frame& F, const float* xin, int layer) {
    const float* PAR = (const float*)(F.ws + WS_PAR);
    const int gw = F.vcu * NWAVES + F.wave; const int m0 = gw * 8; const int b = m0 / SEQ;
    const float* MOD = (const float*)(F.ws + WS_MOD);
    const float* X = (layer == 0) ? xin : (const float*)(F.ws + WS_XB);
    f32x4 gain[4], sc[4], sh[4];
#pragma unroll
    for (int j = 0; j < 4; ++j) { const int c = 4 * F.lane + 256 * j;
        gain[j] = *(const f32x4*)(PAR + PAR_NMG + (size_t)layer * D + c);
        sh[j] = *(const f32x4*)(MOD + ((size_t)layer * BATCH + b) * 6 * D + c); sc[j] = *(const f32x4*)(MOD + ((size_t)layer * BATCH + b) * 6 * D + D + c);
        gain[j] = gain[j] * (1.0f + sc[j]); }
    bf16_t* H = (bf16_t*)(F.ws + WS_H);
#pragma unroll 2
    for (int r = 0; r < 8; ++r) { const int m = m0 + r;
        f32x4 x[4];
#pragma unroll
        for (int j = 0; j < 4; ++j) x[j] = *(const f32x4*)(X + (size_t)m * D + 4 * F.lane + 256 * j);
        float ss = 0.f;
#pragma unroll
        for (int j = 0; j < 4; ++j) ss += (x[j][0] * x[j][0] + x[j][1] * x[j][1]) + (x[j][2] * x[j][2] + x[j][3] * x[j][3]);
        const float rstd = __builtin_amdgcn_rsqf(wave_sum(ss) * (1.0f / D) + NORM_EPS);
#pragma unroll
        for (int j = 0; j < 4; ++j) { const int c = 4 * F.lane + 256 * j;
            const f32x4 h = x[j] * rstd * gain[j] + sh[j];
            u32x2 o; o.x = cvt_pk_bf16(h[0], h[1]); o.y = cvt_pk_bf16(h[2], h[3]); *(u32x2*)(H + (size_t)m * D + c) = o; }
    }
}

constexpr int MOE_TOK = T / TOPK;
__device__ __forceinline__ void phase_router(Frame& F, int layer) {
    constexpr int RPW = MOE_TOK / (256 * NWAVES * 2);
    const float* PAR = (const float*)(F.ws + WS_PAR);
    LAS float* rw = (LAS float*)F.lds;
    LAS unsigned* lcnt = (LAS unsigned*)(F.lds + LDS_X);
    LAS unsigned* lbase = lcnt + 32;
    LAS unsigned* pend = lcnt + 64;
    { const float* RW = PAR + PAR_RW + (size_t)layer * D * NE;
      for (int i = F.tid; i < D * NE / 4; i += NTHR) { const int col = i >> 3, ch = i & 7; const f32x4 v = *(const f32x4*)(RW + (size_t)i * 4);
          *(LAS f32x4*)(rw + col * 32 + ((ch ^ ((col >> 2) & 7)) << 2)) = v; }
      if (F.tid < 32) lcnt[F.tid] = 0u; }
    __syncthreads();
    const int gw = F.vcu * NWAVES + F.wave; const int m0 = gw * 2 * RPW; const int b = m0 / SEQ;
    const float* MOD = (const float*)(F.ws + WS_MOD);
    f32x4 gain[4], sc[4], sh[4];
#pragma unroll
    for (int j = 0; j < 4; ++j) { const int c = 4 * F.lane + 256 * j; gain[j] = *(const f32x4*)(PAR + PAR_NFG + (size_t)layer * D + c);
        sh[j] = *(const f32x4*)(MOD + ((size_t)layer * BATCH + b) * 6 * D + 3 * D + c); sc[j] = *(const f32x4*)(MOD + ((size_t)layer * BATCH + b) * 6 * D + 4 * D + c); }
    const float* XB = (const float*)(F.ws + WS_XB); bf16_t* H = (bf16_t*)(F.ws + WS_H);
    const float rbias = PAR[PAR_RB + layer * NE + (F.lane & 31)];
    const int sw = F.lane & 7;
    for (int rp = 0; rp < RPW; ++rp) {
        f32x4 h[2][4];
#pragma unroll
        for (int q = 0; q < 2; ++q) { const int m = m0 + rp * 2 + q;
            f32x4 x[4]; float ss = 0.f;
#pragma unroll
            for (int j = 0; j < 4; ++j) { x[j] = *(const f32x4*)(XB + (size_t)m * D + 4 * F.lane + 256 * j); ss += (x[j][0] * x[j][0] + x[j][1] * x[j][1]) + (x[j][2] * x[j][2] + x[j][3] * x[j][3]); }
            const float rstd = __builtin_amdgcn_rsqf(wave_sum(ss) * (1.0f / D) + NORM_EPS);
#pragma unroll
            for (int j = 0; j < 4; ++j) { h[q][j] = x[j] * rstd * gain[j] * (1.0f + sc[j]) + sh[j];
                u32x2 o; o.x = cvt_pk_bf16(h[q][j][0], h[q][j][1]); o.y = cvt_pk_bf16(h[q][j][2], h[q][j][3]); *(u32x2*)(H + (size_t)m * D + 4 * F.lane + 256 * j) = o; } }
        float v[64];
#pragma unroll
        for (int i = 0; i < 64; ++i) v[i] = 0.f;
#pragma unroll
        for (int j = 0; j < 4; ++j)
#pragma unroll
            for (int cc = 0; cc < 4; ++cc) { const int col = 4 * F.lane + 256 * j + cc; const LAS float* rp_ = rw + col * 32;
#pragma unroll
                for (int eq = 0; eq < 8; ++eq) { const f32x4 w = *(const LAS f32x4*)(rp_ + ((eq ^ sw) << 2));
#pragma unroll
                    for (int k = 0; k < 4; ++k) { v[eq * 4 + k] = fmaf(h[0][j][cc], w[k], v[eq * 4 + k]); v[32 + eq * 4 + k] = fmaf(h[1][j][cc], w[k], v[32 + eq * 4 + k]); } } }
#pragma unroll
        for (int i = 0; i < 32; ++i) { const bool up = (F.lane & 32) != 0; const float send = up ? v[i] : v[32 + i]; const float recv = __shfl_xor(send, 32); v[i] = (up ? v[32 + i] : v[i]) + recv; }
#pragma unroll
        for (int i = 0; i < 16; ++i) { const bool up = (F.lane & 16) != 0; const float send = up ? v[i] : v[16 + i]; const float recv = __shfl_xor(send, 16); v[i] = (up ? v[16 + i] : v[i]) + recv; }
#pragma unroll
        for (int i = 0; i < 8; ++i) { const bool up = (F.lane & 8) != 0; const float send = up ? v[i] : v[8 + i]; const float recv = __shfl_xor(send, 8); v[i] = (up ? v[8 + i] : v[i]) + recv; }
#pragma unroll
        for (int i = 0; i < 4; ++i) { const bool up = (F.lane & 4) != 0; const float send = up ? v[i] : v[4 + i]; const float recv = __shfl_xor(send, 4); v[i] = (up ? v[4 + i] : v[i]) + recv; }
#pragma unroll
        for (int i = 0; i < 2; ++i) { const bool up = (F.lane & 2) != 0; const float send = up ? v[i] : v[2 + i]; const float recv = __shfl_xor(send, 2); v[i] = (up ? v[2 + i] : v[i]) + recv; }
        { const bool up = (F.lane & 1) != 0; const float send = up ? v[0] : v[1]; const float recv = __shfl_xor(send, 1); v[0] = (up ? v[1] : v[0]) + recv; }
        float logit = v[0] + rbias;
        float tv[4]; int te[4];
#pragma unroll
        for (int k = 0; k < 4; ++k) { float bv = logit; int be = F.lane & 31;
#pragma unroll
            for (int o = 1; o < 32; o <<= 1) { const float ov = __shfl_xor(bv, o); const int oe = __shfl_xor(be, o); if (ov > bv || (ov == bv && oe < be)) { bv = ov; be = oe; } }
            tv[k] = bv; te[k] = be; if ((F.lane & 31) == be) logit = -__builtin_inff(); }
        const float e1 = __expf(tv[1] - tv[0]), e2 = __expf(tv[2] - tv[0]), e3 = __expf(tv[3] - tv[0]); const float inv = 1.0f / (1.0f + e1 + e2 + e3);
        const int kk = F.lane & 31;
        if (kk < 4) { const int e = kk == 0 ? te[0] : (kk == 1 ? te[1] : (kk == 2 ? te[2] : te[3]));
            const float w = (kk == 0 ? 1.0f : (kk == 1 ? e1 : (kk == 2 ? e2 : e3))) * inv;
            const unsigned rank = __hip_atomic_fetch_add(&lcnt[e], 1u, __ATOMIC_RELAXED, __HIP_MEMORY_SCOPE_WORKGROUP);
            const int rl = F.wave * 2 * RPW + rp * 2 + (F.lane >> 5);
            pend[(rl * 4 + kk) * 2 + 0] = (unsigned)e | (rank << 8); pend[(rl * 4 + kk) * 2 + 1] = __float_as_uint(w); }
    }
    __syncthreads();
    unsigned* gcnt = (unsigned*)(F.ws + WS_CTL) + CW_CNT + 64 * layer;
    if (F.tid < 32) lbase[F.tid] = __hip_atomic_fetch_add(gcnt + F.tid, lcnt[F.tid], __ATOMIC_RELAXED, __HIP_MEMORY_SCOPE_AGENT);
    __syncthreads();
    if (F.tid < NWAVES * 2 * RPW * 4) { const int rl = F.tid >> 2, k = F.tid & 3; const unsigned p0 = pend[(rl * 4 + k) * 2], p1 = pend[(rl * 4 + k) * 2 + 1];
        const unsigned e = p0 & 255u, rank = p0 >> 8; const unsigned pos = lbase[e] + rank; const unsigned tok = (unsigned)(F.vcu * NWAVES * 2 * RPW + rl);
        ((unsigned*)(F.ws + WS_ROWLIST))[(size_t)e * CAP + pos] = tok * 4u + (unsigned)k;
        ((float*)(F.ws + WS_TOPW))[tok * 4u + k] = __uint_as_float(p1); }
}

__device__ __forceinline__ int moe_units(Frame& F, int layer, int npn) {
    LAS int* moe = (LAS int*)(F.lds + LDS_MOE);
    LAS int* units = (LAS int*)(F.lds + LDS_UNITS);
    if (F.wave == 0) {
        const unsigned* gcnt = (const unsigned*)(F.ws + WS_CTL) + CW_CNT + 64 * layer;
        const int e_ = F.lane & 31;
        const int cnt = (int)gcnt[e_]; const int ntl = (cnt + 255) >> 8;
        const int lastv = cnt - (ntl - 1) * 256;
        const int ntail = (ntl > 0 && lastv <= 128) ? 1 : 0, nfull = ntl - ntail;
        int incl = ntl, fincl = nfull, tincl = ntail;
#pragma unroll
        for (int o = 1; o < 32; o <<= 1) { const int t0 = __shfl_up(incl, o), t1 = __shfl_up(fincl, o), t2 = __shfl_up(tincl, o); if ((F.lane & 31) >= o) { incl += t0; fincl += t1; tincl += t2; } }
        const int start = incl - ntl, fstart = fincl - nfull, tstart = tincl - ntail; const int ts = __shfl(incl, 31), nf = __shfl(fincl, 31);
        const int c = blockIdx.x, xcd = c & 7, slot = c >> 3, rpx = 32 / npn;
        const int i = F.lane;
        const int p = (i * 8 + xcd) * rpx + slot / npn, pn = slot % npn;
        int e = 0, j = 0, st = 0, cn = 0;
        for (int q = 0; q < 32; ++q) { const int s_ = __shfl(start, q), c_ = __shfl(cnt, q), fs_ = __shfl(fstart, q), nf_ = __shfl(nfull, q), ts_ = __shfl(tstart, q), nt_ = __shfl(ntail, q), nl_ = __shfl(ntl, q);
            if (p < nf) { if (p >= fs_ && p < fs_ + nf_) { e = q; j = p - fs_; st = s_; cn = c_; } }
            else { const int pt = p - nf; if (pt >= ts_ && pt < ts_ + nt_) { e = q; j = nl_ - 1; st = s_; cn = c_; } } }
        const bool ok = (F.lane < 32) && (p < ts);
        const unsigned long long bal = __ballot(ok);
        if (ok) { int valid = cn - j * 256; valid = valid > 256 ? 256 : valid;
            units[i * 4 + 0] = st + j; units[i * 4 + 1] = pn; units[i * 4 + 2] = e | (j << 8); units[i * 4 + 3] = valid; }
        if (F.lane == 0) moe[40] = __popcll(bal);
    }
    __syncthreads();
    return __builtin_amdgcn_readfirstlane(moe[40]);
}

__device__ __forceinline__ void phase_conv(Frame& F, int j) {
    const float* PAR = (const float*)(F.ws + WS_PAR);
    const int g = F.vcu * NTHR + F.tid; const int chunk = g & 127, seg = g >> 7; const int c0 = chunk * 8, m0 = seg * 16; const int s0 = m0 & (SEQ - 1);
    const bf16_t* RB = (const bf16_t*)(F.ws + WS_RB); bf16_t* XC = (bf16_t*)(F.ws + WS_XC);
    float w[4][8], bias[8];
#pragma unroll
    for (int k = 0; k < 4; ++k) { const f32x4 w0 = *(const f32x4*)(PAR + PAR_LCW + ((size_t)j * 4 + k) * D + c0), w1 = *(const f32x4*)(PAR + PAR_LCW + ((size_t)j * 4 + k) * D + c0 + 4);
#pragma unroll
        for (int i = 0; i < 4; ++i) { w[k][i] = w0[i]; w[k][4 + i] = w1[i]; } }
    { const f32x4 b0 = *(const f32x4*)(PAR + PAR_LCB + (size_t)j * D + c0), b1 = *(const f32x4*)(PAR + PAR_LCB + (size_t)j * D + c0 + 4);
#pragma unroll
      for (int i = 0; i < 4; ++i) { bias[i] = b0[i]; bias[4 + i] = b1[i]; } }
    float x0[8], x1[8], x2[8];
#pragma unroll
    for (int i = 0; i < 8; ++i) { x0[i] = 0.f; x1[i] = 0.f; x2[i] = 0.f; }
    if (s0 != 0) {
        const u32x4 r0 = *(const u32x4*)(RB + (size_t)(m0 - 3) * D + c0), r1 = *(const u32x4*)(RB + (size_t)(m0 - 2) * D + c0), r2 = *(const u32x4*)(RB + (size_t)(m0 - 1) * D + c0);
#pragma unroll
        for (int i = 0; i < 4; ++i) { x0[2 * i] = bflo(r0[i]); x0[2 * i + 1] = bfhi(r0[i]); x1[2 * i] = bflo(r1[i]); x1[2 * i + 1] = bfhi(r1[i]); x2[2 * i] = bflo(r2[i]); x2[2 * i + 1] = bfhi(r2[i]); }
    }
#pragma unroll 4
    for (int t = 0; t < 16; ++t) {
        const u32x4 rr = *(const u32x4*)(RB + (size_t)(m0 + t) * D + c0);
        float x3[8], y[8];
#pragma unroll
        for (int i = 0; i < 4; ++i) { x3[2 * i] = bflo(rr[i]); x3[2 * i + 1] = bfhi(rr[i]); }
#pragma unroll
        for (int i = 0; i < 8; ++i) { y[i] = bias[i] + w[0][i] * x0[i] + w[1][i] * x1[i] + w[2][i] * x2[i] + w[3][i] * x3[i]; x0[i] = x1[i]; x1[i] = x2[i]; x2[i] = x3[i]; }
        u32x4 o; o.x = cvt_pk_bf16(y[0], y[1]); o.y = cvt_pk_bf16(y[2], y[3]); o.z = cvt_pk_bf16(y[4], y[5]); o.w = cvt_pk_bf16(y[6], y[7]);
        *(u32x4*)(XC + (size_t)(m0 + t) * D + c0) = o;
    }
}
__device__ __forceinline__ void phase_scan1(Frame& F) {
    const int item = F.vcu; const int m0 = item * 64; const int ch = 2 * F.tid;
    const bf16_t* LA = (const bf16_t*)(F.ws + WS_AF); const bf16_t* UB = (const bf16_t*)(F.ws + WS_UF);
    float h0 = 0.f, h1 = 0.f, s0 = 0.f, s1 = 0.f;
#pragma unroll 16
    for (int t = 0; t < 64; ++t) { const unsigned lw = *(const unsigned*)(LA + (size_t)(m0 + t) * D + ch), uw = *(const unsigned*)(UB + (size_t)(m0 + t) * D + ch);
        const float l0 = bflo(lw), l1 = bfhi(lw);
        h0 = __builtin_amdgcn_exp2f(l0) * h0 + bflo(uw); h1 = __builtin_amdgcn_exp2f(l1) * h1 + bfhi(uw); s0 += l0; s1 += l1; }
    float* PS = (float*)(F.ws + WS_PS);
    *(f32x4*)(PS + ((size_t)item * D + ch) * 2) = (f32x4){__builtin_amdgcn_exp2f(s0), h0, __builtin_amdgcn_exp2f(s1), h1};
}
__device__ __forceinline__ void phase_scan2(Frame& F) {
    const int item = F.vcu; const int m0 = item * 64; const int ch = 2 * F.tid; const int c = item & 63, b = item >> 6;
    const bf16_t* LA = (const bf16_t*)(F.ws + WS_AF); const bf16_t* UB = (const bf16_t*)(F.ws + WS_UF);
    const float* PS = (const float*)(F.ws + WS_PS); const bf16_t* GB = (const bf16_t*)(F.ws + WS_GB); bf16_t* YB = (bf16_t*)(F.ws + WS_YB);
    float h0 = 0.f, h1 = 0.f;
#pragma unroll 8
    for (int jj = 0; jj < c; ++jj) { const f32x4 s = *(const f32x4*)(PS + ((size_t)(b * 64 + jj) * D + ch) * 2); h0 = s[0] * h0 + s[1]; h1 = s[2] * h1 + s[3]; }
#pragma unroll 16
    for (int t = 0; t < 64; ++t) { const unsigned lw = *(const unsigned*)(LA + (size_t)(m0 + t) * D + ch), uw = *(const unsigned*)(UB + (size_t)(m0 + t) * D + ch);
        const unsigned gw_ = *(const unsigned*)(GB + (size_t)(m0 + t) * D + ch);
        h0 = __builtin_amdgcn_exp2f(bflo(lw)) * h0 + bflo(uw); h1 = __builtin_amdgcn_exp2f(bfhi(lw)) * h1 + bfhi(uw);
        *(unsigned*)(YB + (size_t)(m0 + t) * D + ch) = cvt_pk_bf16(bflo(gw_) * h0, bfhi(gw_) * h1); }
}

__device__ __forceinline__ void phase_qknorm(Frame& F, int j) {
    const float* PAR = (const float*)(F.ws + WS_PAR);
    bf16_t* Q = (bf16_t*)(F.ws + WS_Q); bf16_t* Kb = (bf16_t*)(F.ws + WS_K); float* KM = (float*)(F.ws + WS_KMEAN);
    LAS float* red = (LAS float*)F.lds;
    const int rr = F.lane >> 4, cq = F.lane & 15;
    f32x4 qg0 = *(const f32x4*)(PAR + PAR_AQG + (size_t)j * HD + cq * 8), qg1 = *(const f32x4*)(PAR + PAR_AQG + (size_t)j * HD + cq * 8 + 4);
    f32x4 kg0 = *(const f32x4*)(PAR + PAR_AKG + (size_t)j * HD + cq * 8), kg1 = *(const f32x4*)(PAR + PAR_AKG + (size_t)j * HD + cq * 8 + 4);
    for (int it = F.vcu; it < BATCH * NBLK * NH; it += F.G) {
        const int h = it & 7, blk = (it >> 3) & 15, b = it >> 7;
        const size_t base = ((size_t)(b * SEQ + blk * MBLK + F.wave * 32)) * D + h * HD + cq * 8;
        float ks[8];
#pragma unroll
        for (int i = 0; i < 8; ++i) ks[i] = 0.f;
#pragma unroll 2
        for (int i = 0; i < 8; ++i) { const size_t off = base + (size_t)(i * 4 + rr) * D;
            const u32x4 qw = *(const u32x4*)(Q + off), kw = *(const u32x4*)(Kb + off);
            float qv[8], kv[8]; float sq = 0.f, sk = 0.f;
#pragma unroll
            for (int e = 0; e < 4; ++e) { qv[2 * e] = bflo(qw[e]); qv[2 * e + 1] = bfhi(qw[e]); kv[2 * e] = bflo(kw[e]); kv[2 * e + 1] = bfhi(kw[e]); }
#pragma unroll
            for (int e = 0; e < 8; ++e) { sq += qv[e] * qv[e]; sk += kv[e] * kv[e]; }
#pragma unroll
            for (int o = 1; o < 16; o <<= 1) { sq += __shfl_xor(sq, o); sk += __shfl_xor(sk, o); }
            const float rq = __builtin_amdgcn_rsqf(sq * (1.0f / HD) + NORM_EPS), rk = __builtin_amdgcn_rsqf(sk * (1.0f / HD) + NORM_EPS);
#pragma unroll
            for (int e = 0; e < 8; ++e) { qv[e] = qv[e] * rq * (e < 4 ? qg0[e & 3] : qg1[e & 3]); kv[e] = kv[e] * rk * (e < 4 ? kg0[e & 3] : kg1[e & 3]); ks[e] += kv[e]; }
            u32x4 qo, ko;
#pragma unroll
            for (int e = 0; e < 4; ++e) { qo[e] = cvt_pk_bf16(qv[2 * e], qv[2 * e + 1]); ko[e] = cvt_pk_bf16(kv[2 * e], kv[2 * e + 1]); }
            *(u32x4*)(Q + off) = qo; *(u32x4*)(Kb + off) = ko; }
#pragma unroll
        for (int e = 0; e < 8; ++e) { ks[e] += __shfl_xor(ks[e], 16); ks[e] += __shfl_xor(ks[e], 32); }
        __syncthreads();
        if (F.lane < 16) {
#pragma unroll
            for (int e = 0; e < 8; ++e) red[F.wave * 128 + cq * 8 + e] = ks[e]; }
        __syncthreads();
        if (F.tid < 128) { float s = 0.f;
#pragma unroll
            for (int w = 0; w < 8; ++w) s += red[w * 128 + F.tid];
            KM[(((size_t)b * NH + h) * NBLK + blk) * HD + F.tid] = s * (1.0f / MBLK); }
    }
}
__device__ __forceinline__ void phase_gate(Frame& F) {
    const bf16_t* Q = (const bf16_t*)(F.ws + WS_Q); const float* KM = (const float*)(F.ws + WS_KMEAN); unsigned* SEL = (unsigned*)(F.ws + WS_SEL);
    LAS float* km = (LAS float*)F.lds;
    const int it = F.vcu; const int s8 = it & 7, h = (it >> 3) & 7, b = it >> 6;
    for (int i = F.tid; i < NBLK * HD / 4; i += NTHR) *(LAS f32x4*)(km + 4 * i) = *(const f32x4*)(KM + ((size_t)b * NH + h) * NBLK * HD + 4 * i);
    __syncthreads();
    const int s = s8 * 512 + F.tid; const int qb = __builtin_amdgcn_readfirstlane(s >> 8);
    u32x4 qw[16];
    const bf16_t* qp = Q + ((size_t)(b * SEQ + s)) * D + h * HD;
#pragma unroll
    for (int i = 0; i < 16; ++i) qw[i] = *(const u32x4*)(qp + 8 * i);
    float v1 = -__builtin_inff(), v2 = v1, v3 = v1; int i1 = -1, i2 = -1, i3 = -1;
    for (int n = 0; n < qb; ++n) { float sc = 0.f;
#pragma unroll
        for (int i = 0; i < 16; ++i) { const f32x4 k0 = *(const LAS f32x4*)(km + n * HD + 8 * i), k1 = *(const LAS f32x4*)(km + n * HD + 8 * i + 4);
            sc += bflo(qw[i][0]) * k0[0] + bfhi(qw[i][0]) * k0[1] + bflo(qw[i][1]) * k0[2] + bfhi(qw[i][1]) * k0[3]
                + bflo(qw[i][2]) * k1[0] + bfhi(qw[i][2]) * k1[1] + bflo(qw[i][3]) * k1[2] + bfhi(qw[i][3]) * k1[3]; }
        if (sc > v1) { v3 = v2; i3 = i2; v2 = v1; i2 = i1; v1 = sc; i1 = n; }
        else if (sc > v2) { v3 = v2; i3 = i2; v2 = sc; i2 = n; }
        else if (sc > v3) { v3 = sc; i3 = n; } }
    unsigned m = 0u; if (i1 >= 0) m |= 1u << i1; if (i2 >= 0) m |= 1u << i2; if (i3 >= 0) m |= 1u << i3;
    SEL[((size_t)b * NH + h) * SEQ + s] = m;
}
__device__ __forceinline__ att::BlockRef att_ref(Frame& F, int L, int pass) {
    const int bh = L >> 3, x = L & 7; const int qb = pass ? 15 - x : x; const int b = bh >> 3, h = bh & 7;
    att::BlockRef r; const size_t ro = ((size_t)(b * SEQ + qb * MBLK)) * D + h * HD;
    r.Q = (const bf16_t*)(F.ws + WS_Q) + ro; r.O = (bf16_t*)(F.ws + WS_YB) + ro;
    r.K = (const bf16_t*)(F.ws + WS_K) + (size_t)(b * SEQ) * D + h * HD; r.V = (const bf16_t*)(F.ws + WS_V) + (size_t)(b * SEQ) * D + h * HD;
    r.qb = qb; return r;
}
__device__ __forceinline__ void phase_attn(Frame& F, char* lds) {
    const int total = BATCH * NH * 8, stride = F.G;
    int L = F.vcu; if (L >= total) return;
    int pass = 0;
    att::BlockRef cur = att_ref(F, L, 0);
    att::Seam S;
    att::moba_prime(cur, lds, S, F.tid);
    for (;;) {
        if (pass == 0) {
            const float* KM = (const float*)(F.ws + WS_KMEAN) + (size_t)(L >> 3) * NBLK * HD;
            int t2 = F.tid; asm volatile("" : "+v"(t2));
            *(f32x4*)(lds + att::KM_OFF + t2 * 16) = *(const f32x4*)(KM + t2 * 4);
            __syncthreads(); }
        const bool more_pass = pass == 0, more_item = L + stride < total, last = !more_pass && !more_item;
        int passn = pass + 1, Ln = L;
        if (!more_pass) { passn = 0; Ln = more_item ? L + stride : L; }
        const att::BlockRef nxt = last ? cur : att_ref(F, Ln, passn);
        att::moba_block(cur, nxt, lds, S, F.tid);
        if (last) break;
        cur = nxt; pass = passn; L = Ln;
    }
}

constexpr int NPH = 42;
__global__ void __launch_bounds__(NTHR, 2) fwd(Args args) {
    extern __shared__ __attribute__((aligned(16))) unsigned char lds_[];
    Frame F;
    F.lds = (LAS unsigned char*)lds_; F.ws = args.ws;
    F.tid = threadIdx.x; F.lane = F.tid & 63; F.wave = __builtin_amdgcn_readfirstlane(F.tid >> 6);
    F.G = gridDim.x; { const int bx = blockIdx.x; F.vcu = (F.G % 8 == 0) ? (bx % 8) * (F.G / 8) + bx / 8 : bx; }
    volatile LAS unsigned* MISC = (volatile LAS unsigned*)(F.lds + LDS_MISC);
    if (F.tid < 64) MISC[F.tid] = 0u;
    __syncthreads();
#ifdef PROBE_ORD
    if (F.tid == 0) *(volatile LAS unsigned long long*)(MISC + 14) = __builtin_amdgcn_s_memrealtime();
    __syncthreads();
#endif
    const int lo = args.ph_lo, hi = args.ph_hi;
    unsigned* ctl = (unsigned*)(F.ws + WS_CTL);
    XcdBarrier bar; bar.bar = ctl + CW_BAR + args.li * XCD_BAR_WORDS; bar.x = 0; bar.st = nullptr;
    if (hi - lo > 1) bar = xcd_barrier_post(ctl + CW_BAR + args.li * XCD_BAR_WORDS, MISC + 8);
#ifdef ONLY
#define EN(code) ((code) == ONLY)
#else
#define EN(code) true
#endif
#define IN(k) (lo <= (k) && (k) < hi)
#ifdef PROBE_ORD
#define SEAM(k) do { if (IN(k) && IN((k) + 1)) { xcd_barrier(bar); if (threadIdx.x == 0) { const unsigned n_ = MISC[12] + 1u; MISC[12] = n_; if (n_ == PROBE_ORD) { while (__builtin_amdgcn_s_memrealtime() - *(volatile LAS unsigned long long*)(MISC + 14) < (unsigned long long)(PROBE_US) * 100ull) __builtin_amdgcn_s_sleep(20); } } __syncthreads(); } } while (0)
#else
#define SEAM(k) do { if (IN(k) && IN((k) + 1)) xcd_barrier(bar); } while (0)
#endif
#ifdef PROBE_CODE
#define REPS(code) ((code) == PROBE_CODE ? 1 + PROBE_EXTRA : 1)
#else
#define REPS(code) 1
#endif
#define PF() Frame Fp = F; asm volatile("" : "+v"(Fp.tid)); Fp.lane = Fp.tid & 63
    LAS unsigned* tab = (LAS unsigned*)(F.lds + LDS_TAB);
    const float* xin = args.in[IN_X]; float* out = args.out; const float* PAR = (const float*)(F.ws + WS_PAR);

    if (EN(0) && IN(0)) { for (int rep_ = 0; rep_ < REPS(0); ++rep_) { if (rep_) __syncthreads(); PF(); phase_prologue(Fp, args); } } SEAM(0);

#pragma nounroll
    for (int l = 0; l < DEPTH; ++l) {
        const int pb = 1 + 10 * l; const int j = l >> 1; const bool lru = (l & 1) == 0;
        if (EN(10) && IN(pb + 0)) { for (int rep_ = 0; rep_ < REPS(10); ++rep_) { if (rep_) __syncthreads(); PF(); phase_norm(Fp, xin, l); } } SEAM(pb + 0);
        if (lru) {
            if (EN(21) && IN(pb + 1)) { for (int rep_ = 0; rep_ < REPS(21); ++rep_) { if (rep_) __syncthreads(); pg8::ProbPlain P; P.init((const bf16_t*)(F.ws + WS_H), (const bf16_t*)(F.ws + WS_WIN) + (size_t)j * 2 * D * D, T, 2 * D, D, D, -1, F.G, (int)blockIdx.x);
                pg8::EpiWin E{(bf16_t*)(F.ws + WS_GB), (bf16_t*)(F.ws + WS_RB)};
                pg8::gemm_phase<pg8::EpiWin, pg8::ProbPlain, true, true>(F.lds, tab, P, E); } } SEAM(pb + 1);
            if (EN(22) && IN(pb + 2)) { for (int rep_ = 0; rep_ < REPS(22); ++rep_) { if (rep_) __syncthreads(); PF(); phase_conv(Fp, j); } } SEAM(pb + 2);
            if (EN(23) && IN(pb + 3)) { for (int rep_ = 0; rep_ < REPS(23); ++rep_) { if (rep_) __syncthreads(); pg8::ProbPlain P; P.init((const bf16_t*)(F.ws + WS_XC), (const bf16_t*)(F.ws + WS_WG) + (size_t)j * 2048 * 256, T, 2 * D, 256, D, 1, F.G, (int)blockIdx.x);
                pg8::EpiGates E{(const bf16_t*)(F.ws + WS_XC), (bf16_t*)(F.ws + WS_AF), (bf16_t*)(F.ws + WS_UF), PAR + PAR_LBA + (size_t)j * D, PAR + PAR_LBX + (size_t)j * D, (const float*)(F.ws + WS_SP8) + (size_t)j * D};
                pg8::gemm_phase<pg8::EpiGates, pg8::ProbPlain, true, true>(F.lds, tab, P, E); } } SEAM(pb + 3);
            if (EN(24) && IN(pb + 4)) { for (int rep_ = 0; rep_ < REPS(24); ++rep_) { if (rep_) __syncthreads(); PF(); phase_scan1(Fp); } } SEAM(pb + 4);
            if (EN(25) && IN(pb + 5)) { for (int rep_ = 0; rep_ < REPS(25); ++rep_) { if (rep_) __syncthreads(); PF(); phase_scan2(Fp); } } SEAM(pb + 5);
        } else {
            if (EN(31) && IN(pb + 1)) { for (int rep_ = 0; rep_ < REPS(31); ++rep_) { if (rep_) __syncthreads(); pg8::ProbPlain P; P.init((const bf16_t*)(F.ws + WS_H), (const bf16_t*)(F.ws + WS_WQKV) + (size_t)j * 3 * D * D, T, 3 * D, D, D, -1, F.G, (int)blockIdx.x);
                pg8::EpiQKV E{(bf16_t*)(F.ws + WS_Q), PAR + PAR_AQG + (size_t)j * HD, PAR + PAR_AKG + (size_t)j * HD, (float*)(F.ws + WS_KMEAN), (LAS float*)(F.lds + LDS_X)};
                pg8::gemm_phase<pg8::EpiQKV, pg8::ProbPlain, true, true>(F.lds, tab, P, E); } } SEAM(pb + 1);
            if (EN(34) && IN(pb + 4)) { for (int rep_ = 0; rep_ < REPS(34); ++rep_) { if (rep_) __syncthreads(); PF(); phase_attn(Fp, (char*)lds_); } } SEAM(pb + 4);
        }
        if (EN(16) && IN(pb + 6)) { for (int rep_ = 0; rep_ < REPS(16); ++rep_) { if (rep_) __syncthreads(); pg8::ProbPlain P; P.init((const bf16_t*)(F.ws + WS_YB), (const bf16_t*)(F.ws + (lru ? WS_WLO : WS_WAO)) + (size_t)j * D * D, T, D, D, D, -1, F.G, (int)blockIdx.x);
            pg8::EpiResid E{l == 0 ? xin : (const float*)(F.ws + WS_XB), (float*)(F.ws + WS_XB), (const float*)(F.ws + WS_MOD) + (size_t)l * BATCH * 6 * D + 2 * D};
            pg8::gemm_phase<pg8::EpiResid, pg8::ProbPlain, false, true>(F.lds, tab, P, E); } } SEAM(pb + 6);
        if (EN(17) && IN(pb + 7)) { PF(); phase_router(Fp, l); } SEAM(pb + 7);
        if (EN(18) && IN(pb + 8)) { for (int rep_ = 0; rep_ < REPS(18); ++rep_) { if (rep_) __syncthreads(); PF(); const int nu = moe_units(Fp, l, 8);
            pg8::ProbMoE<true> P; P.A = (const bf16_t*)(F.ws + WS_H); P.Bt = (const bf16_t*)(F.ws + WS_WGU) + (size_t)l * NE * 2 * D * D; P.K = D; P.lda = D; P.bstride = (size_t)2 * D * D;
            P.rowlist = (const unsigned*)(F.ws + WS_ROWLIST); P.units = (const LAS int*)(F.lds + LDS_UNITS); P.nunits = nu;
            pg8::EpiSwiglu E{(bf16_t*)(F.ws + WS_ACT), PAR + PAR_BGU + (size_t)l * NE * 2 * D};
            pg8::gemm_phase<pg8::EpiSwiglu, pg8::ProbMoE<true>, true, true>(F.lds, tab, P, E); } } SEAM(pb + 8);
        if (EN(19) && IN(pb + 9)) { for (int rep_ = 0; rep_ < REPS(19); ++rep_) { if (rep_) __syncthreads(); PF(); const int nu = moe_units(Fp, l, 4);
            pg8::ProbMoE<false> P; P.A = (const bf16_t*)(F.ws + WS_ACT); P.Bt = (const bf16_t*)(F.ws + WS_WDN) + (size_t)l * NE * D * D; P.K = D; P.lda = D; P.bstride = (size_t)D * D;
            P.rowlist = (const unsigned*)(F.ws + WS_ROWLIST); P.units = (const LAS int*)(F.lds + LDS_UNITS); P.nunits = nu;
            pg8::EpiDown E{(const float*)(F.ws + WS_XB), l == DEPTH - 1 ? out : (float*)(F.ws + WS_XB), (const float*)(F.ws + WS_MOD) + (size_t)l * BATCH * 6 * D + 5 * D, PAR + PAR_BDN + (size_t)l * NE * D, (const unsigned*)(F.ws + WS_ROWLIST), (const float*)(F.ws + WS_TOPW)};
            pg8::gemm_phase<pg8::EpiDown, pg8::ProbMoE<false>, true, true>(F.lds, tab, P, E); } } SEAM(pb + 9);
    }
#undef IN
#undef SEAM
#undef EN
}

#ifndef DEBUG_CHECKS
#define DEBUG_CHECKS 0
#endif
#ifndef CHK_FROM
#define CHK_FROM 0
#endif
#if DEBUG_CHECKS
constexpr int CW_CHK = 70000;
__device__ __forceinline__ unsigned hsh(unsigned x) { x ^= x >> 16; x *= 0x7feb352du; x ^= x >> 15; x *= 0x846ca68bu; x ^= x >> 16; return x; }
__device__ __forceinline__ bool cls(float got, float ref, float rt, float at) { return (fabsf(got - ref) <= rt * fabsf(ref) + at); }
__device__ __forceinline__ float bfq(const bf16_t* p, size_t i) { return __uint_as_float(((unsigned)p[i]) << 16); }
__device__ __forceinline__ float gelu_ref(float x) { return 0.5f * x * (1.0f + tanhf(0.7978845608028654f * (x + 0.044715f * x * x * x))); }
__global__ void __launch_bounds__(64) chk(Args a, int id, int l, int code) {
    const int j = l >> 1;
    unsigned char* ws = a.ws; unsigned* ctl = (unsigned*)(ws + WS_CTL); const int lane = threadIdx.x;
    const float* MOD = (const float*)(ws + WS_MOD); const float* PAR = (const float*)(ws + WS_PAR);
    const bf16_t* H = (const bf16_t*)(ws + WS_H);
    bool bad = false;
    for (int it = 0; it < 8; ++it) {
        const unsigned sd = hsh(blockIdx.x * 131u + it * 7919u + id * 104729u + 12345u);
        if (id == 1) {
            const int l = sd & 3, b = (sd >> 2) & 3, n = (sd >> 4) % (6 * D); float s = 0.f;
            for (int k = lane; k < D; k += 64) { const float c = a.in[IN_C][b * D + k]; s += (c / (1.0f + expf(-c))) * a.in[IN_WMOD][((size_t)l * D + k) * 6 * D + n]; }
            s = wave_sum(s) + a.in[IN_BMOD][l * 6 * D + n];
            if (!cls(MOD[((size_t)l * BATCH + b) * 6 * D + n], s, 1e-3f, 1e-3f)) bad = true;
        } else if (id == 2) {
            const int m = sd % T, b = m / SEQ; float ss = 0.f;
            for (int k = lane; k < D; k += 64) { const float x = a.in[IN_X][(size_t)m * D + k]; ss += x * x; }
            const float rstd = 1.0f / sqrtf(wave_sum(ss) / D + NORM_EPS);
            for (int k = lane; k < D; k += 64) { const float x = a.in[IN_X][(size_t)m * D + k];
                const float h = x * rstd * a.in[IN_NMG][k] * (1.0f + MOD[(size_t)b * 6 * D + D + k]) + MOD[(size_t)b * 6 * D + k];
                if (!cls(bfq(H, (size_t)m * D + k), h, 0.01f, 0.01f)) bad = true; }
        } else if (id == 3) {
            const int m = sd % T, n = (sd >> 14) % (2 * D); float s = 0.f;
            for (int k = lane; k < D; k += 64) s += bfq(H, (size_t)m * D + k) * a.in[IN_LWIN][((size_t)j * D + k) * 2 * D + n];
            s = wave_sum(s);
            const float got = n < D ? bfq((const bf16_t*)(ws + WS_GB), (size_t)m * D + n) : bfq((const bf16_t*)(ws + WS_RB), (size_t)m * D + n - D);
            const float ref = n < D ? gelu_ref(s) : s;
            if (!cls(got, ref, 0.02f, 0.02f)) bad = true;
        } else if (id == 4) {
            const int m = sd % T, c = (sd >> 14) % D, s0 = m % SEQ; const bf16_t* RB = (const bf16_t*)(ws + WS_RB);
            float y = a.in[IN_LCB][j * D + c];
            for (int k = 0; k < 4; ++k) { const int t = s0 - 3 + k; if (t >= 0) y += a.in[IN_LCW][(j * 4 + k) * D + c] * bfq(RB, (size_t)(m - 3 + k) * D + c); }
            if (!cls(bfq((const bf16_t*)(ws + WS_XC), (size_t)m * D + c), y, 0.01f, 0.01f)) bad = true;
        } else if (id == 5) {
            const int m = sd % T, ch = (sd >> 14) % D, g = ch >> 8, jc = ch & 255; const bf16_t* XC = (const bf16_t*)(ws + WS_XC);
            float sa = 0.f, sx = 0.f;
            for (int i = lane; i < 256; i += 64) { const float xv = bfq(XC, (size_t)m * D + g * 256 + i); sa += xv * a.in[IN_LWA][((size_t)(j * 4 + g) * 256 + i) * 256 + jc]; sx += xv * a.in[IN_LWX][((size_t)(j * 4 + g) * 256 + i) * 256 + jc]; }
            sa = wave_sum(sa) + a.in[IN_LBA][j * D + ch]; sx = wave_sum(sx) + a.in[IN_LBX][j * D + ch];
            const float r = 1.0f / (1.0f + expf(-sa)), ig = 1.0f / (1.0f + expf(-sx)); const float lam = a.in[IN_LLAM][j * D + ch];
            const float la = -8.0f * r * log1pf(expf(-lam)); const float av = expf(la), uv = sqrtf(-expm1f(2.0f * la)) * ig * bfq(XC, (size_t)m * D + ch);
            if (!cls(((const float*)(ws + WS_AF))[(size_t)m * D + ch], av, 2e-3f, 1e-4f)) bad = true;
            if (!cls(((const float*)(ws + WS_UF))[(size_t)m * D + ch], uv, 0.03f, 0.003f)) bad = true;
        } else if (id == 6) {
            const int b = sd & 3, ch = ((sd >> 2) + lane * 17) % D; const float* AF = (const float*)(ws + WS_AF); const float* UF = (const float*)(ws + WS_UF);
            const bf16_t* GB = (const bf16_t*)(ws + WS_GB); const bf16_t* YB = (const bf16_t*)(ws + WS_YB);
            float h = 0.f;
            for (int t = 0; t < SEQ; ++t) { const size_t o = ((size_t)b * SEQ + t) * D + ch; h = AF[o] * h + UF[o];
                if ((t & 127) == 77 || t == SEQ - 1 || t == 0 || t == 64) { if (!cls(bfq(YB, o), bfq(GB, o) * h, 0.02f, 0.01f)) bad = true; } }
        } else if (id == 7) {
            const int m = sd % T, n = (sd >> 14) % D, b = m / SEQ; float s = 0.f; const bf16_t* YB = (const bf16_t*)(ws + WS_YB);
            for (int k = lane; k < D; k += 64) s += bfq(YB, (size_t)m * D + k) * a.in[IN_LWOUT][((size_t)j * D + k) * D + n];
            s = wave_sum(s);
            const float ref = (l == 0 ? a.in[IN_X][(size_t)m * D + n] : ((const float*)(ws + WS_XA))[(size_t)m * D + n]) + MOD[((size_t)l * BATCH + b) * 6 * D + 2 * D + n] * s;
            if (!cls(((const float*)(ws + WS_XB))[(size_t)m * D + n], ref, 0.01f, 0.01f)) bad = true;
        } else if (id == 8) {
            __shared__ float hrow[D];
            const int m = sd % MOE_TOK, b = m / SEQ; const float* XB = (const float*)(ws + WS_XB); float ss = 0.f;
            for (int k = lane; k < D; k += 64) { const float x = XB[(size_t)m * D + k]; ss += x * x; }
            const float rstd = 1.0f / sqrtf(wave_sum(ss) / D + NORM_EPS);
            __syncthreads();
            for (int k = lane; k < D; k += 64) { const float x = XB[(size_t)m * D + k];
                const float h = x * rstd * a.in[IN_NFG][l * D + k] * (1.0f + MOD[((size_t)l * BATCH + b) * 6 * D + 4 * D + k]) + MOD[((size_t)l * BATCH + b) * 6 * D + 3 * D + k]; hrow[k] = h;
                if (!cls(bfq(H, (size_t)m * D + k), h, 0.01f, 0.01f)) bad = true; }
            __syncthreads();
            const int e = lane & 31; float lg = a.in[IN_RB][l * NE + e];
            for (int k = 0; k < D; ++k) lg += hrow[k] * a.in[IN_RW][((size_t)l * D + k) * NE + e];
            int rank = 0; float mx = -1e30f;
            for (int q = 0; q < 32; ++q) { const float o = __shfl(lg, q); if (o > lg || (o == lg && q < e)) ++rank; mx = fmaxf(mx, o); }
            const bool sel = rank < 4; float den = 0.f;
            for (int q = 0; q < 32; ++q) { const float o = __shfl(lg, q); const int rk = __shfl(rank, q); if (rk < 4) den += expf(o - mx); }
            const float wref = expf(lg - mx) / den;
            float v4 = 0.f, v5 = 0.f; for (int q = 0; q < 32; ++q) { const float o = __shfl(lg, q); const int rk = __shfl(rank, q); if (rk == 3) v4 = o; if (rk == 4) v5 = o; }
            const unsigned* gcnt = ctl + CW_CNT + 64 * l; const unsigned* RL = (const unsigned*)(ws + WS_ROWLIST); const float* TW = (const float*)(ws + WS_TOPW);
            if (v4 - v5 > 1e-3f && lane < 32) {
                const int cnt = (int)gcnt[e]; int found = -1;
                for (int p = 0; p < cnt; ++p) { const unsigned r = RL[(size_t)e * CAP + p]; if ((int)(r >> 2) == m) found = (int)r; }
                if (sel) { if (found < 0) bad = true; else if (!cls(TW[found], wref, 0.01f, 1e-3f)) bad = true; }
                else if (found >= 0) bad = true;
            }
            unsigned tot = 0; for (int q = 0; q < 32; ++q) tot += gcnt[q]; if (tot != (unsigned)T) bad = true;
        } else if (id == 9 || id == 10) {
            const unsigned* gcnt = ctl + CW_CNT + 64 * l; const unsigned* RL = (const unsigned*)(ws + WS_ROWLIST); const float* TW = (const float*)(ws + WS_TOPW);
            const int e = sd & 31; int ts = 0; for (int q = 0; q < e; ++q) ts += ((int)gcnt[q] + 255) >> 8;
            const int cnt = (int)gcnt[e]; if (cnt == 0) continue;
            const int pos = (sd >> 5) % cnt; const unsigned dest = RL[(size_t)e * CAP + pos]; const int tok = dest >> 2; const size_t arow = (size_t)ts * 256 + pos;
            const int col = (sd >> 17) % D; const bf16_t* ACT = (const bf16_t*)(ws + WS_ACT);
            if (id == 9) { float sg = 0.f, su = 0.f;
                for (int k = lane; k < D; k += 64) { const float hv = bfq(H, (size_t)tok * D + k); sg += hv * a.in[IN_WGU][((size_t)(l * NE + e) * D + k) * 2 * D + col]; su += hv * a.in[IN_WGU][((size_t)(l * NE + e) * D + k) * 2 * D + D + col]; }
                sg = wave_sum(sg) + a.in[IN_BGU][(size_t)(l * NE + e) * 2 * D + col]; su = wave_sum(su) + a.in[IN_BGU][(size_t)(l * NE + e) * 2 * D + D + col];
                const float gv = fminf(sg, 7.f), uv = fminf(fmaxf(su, -7.f), 7.f); const float ref = gv / (1.0f + expf(-1.702f * gv)) * (uv + 1.0f);
                if (!cls(bfq(ACT, arow * D + col), ref, 0.03f, 0.02f)) bad = true;
            } else { float s = 0.f;
                for (int k = lane; k < D; k += 64) s += bfq(ACT, arow * D + k) * a.in[IN_WDN][((size_t)(l * NE + e) * D + k) * D + col];
                s = (wave_sum(s) + a.in[IN_BDN][(size_t)(l * NE + e) * D + col]) * TW[dest];
                if (!cls(bfq((const bf16_t*)(ws + WS_YK), (size_t)dest * D + col), s, 0.03f, 0.01f)) bad = true; }
        } else if (id == 11) {
            const int m = sd % T, h = (sd >> 14) & 7, which = (sd >> 17) % 3; float r0 = 0.f, r1 = 0.f;
            for (int k = 0; k < D; ++k) { const float hv = bfq(H, (size_t)m * D + k); const float* w = a.in[IN_AQKV] + ((size_t)j * D + k) * 3 * D + which * D + h * HD; r0 += hv * w[lane]; r1 += hv * w[lane + 64]; }
            const bf16_t* buf = (const bf16_t*)(ws + (which == 0 ? WS_Q : (which == 1 ? WS_K : WS_V)));
            const float g0 = bfq(buf, (size_t)m * D + h * HD + lane), g1 = bfq(buf, (size_t)m * D + h * HD + lane + 64);
            if (which == 2) { if (!cls(g0, r0, 0.02f, 0.02f) || !cls(g1, r1, 0.02f, 0.02f)) bad = true; }
            else { const float rs = 1.0f / sqrtf(wave_sum(r0 * r0 + r1 * r1) / HD + NORM_EPS); const float* gg = a.in[which == 0 ? IN_AQG : IN_AKG] + j * HD;
                if (!cls(g0, r0 * rs * gg[lane], 0.03f, 0.03f) || !cls(g1, r1 * rs * gg[lane + 64], 0.03f, 0.03f)) bad = true; }
        } else if (id == 12) {
            const int b = sd & 3, h = (sd >> 2) & 7, blk = (sd >> 5) & 15; const bf16_t* Kb = (const bf16_t*)(ws + WS_K); const float* KM = (const float*)(ws + WS_KMEAN);
            float s0 = 0.f, s1 = 0.f;
            for (int r = 0; r < MBLK; ++r) { const size_t o = ((size_t)b * SEQ + blk * MBLK + r) * D + h * HD; s0 += bfq(Kb, o + lane); s1 += bfq(Kb, o + lane + 64); }
            const float* km = KM + (((size_t)b * NH + h) * NBLK + blk) * HD;
            if (!cls(km[lane], s0 / MBLK, 0.03f, 0.003f) || !cls(km[lane + 64], s1 / MBLK, 0.03f, 0.003f)) bad = true;
            const int s = (sd >> 9) % SEQ, qb = s >> 8; const bf16_t* Q = (const bf16_t*)(ws + WS_Q); const unsigned msk = ((const unsigned*)(ws + WS_SEL))[((size_t)b * NH + h) * SEQ + s];
            float sc[16]; const size_t qo = ((size_t)b * SEQ + s) * D + h * HD;
#pragma unroll
            for (int n = 0; n < 16; ++n) { const float* kk = KM + (((size_t)b * NH + h) * NBLK + n) * HD; sc[n] = wave_sum(bfq(Q, qo + lane) * kk[lane] + bfq(Q, qo + lane + 64) * kk[lane + 64]); }
            int cntb = 0; float minsel = 1e30f;
#pragma unroll
            for (int n = 0; n < 16; ++n) if ((msk >> n) & 1u) { ++cntb; if (n >= qb) bad = true; minsel = fminf(minsel, sc[n]); }
            if (cntb != (qb < 3 ? qb : 3) || (msk >> 16)) bad = true;
            int better = 0;
#pragma unroll
            for (int n = 0; n < 16; ++n) if (n < qb && !((msk >> n) & 1u) && sc[n] > minsel + 1e-3f) ++better;
            if (better) bad = true;
        } else if (id == 13) {
            const int b = sd & 3, h = (sd >> 2) & 7, s = (sd >> 5) % SEQ, qb = s >> 8;
            const bf16_t* Q = (const bf16_t*)(ws + WS_Q); const bf16_t* Kb = (const bf16_t*)(ws + WS_K); const bf16_t* V = (const bf16_t*)(ws + WS_V); const bf16_t* O = (const bf16_t*)(ws + WS_YB);
            const unsigned msk = ((const unsigned*)(ws + WS_SEL))[((size_t)b * NH + h) * SEQ + s] | (1u << qb);
            const size_t qo = ((size_t)b * SEQ + s) * D + h * HD;
            float mx = -1e30f;
            for (int pass = 0; pass < 2; ++pass) {
                float den = 0.f, o0 = 0.f, o1 = 0.f;
                for (int blk = 0; blk <= qb; ++blk) if ((msk >> blk) & 1u) {
                    const int kend = blk == qb ? (s & 255) + 1 : 256;
                    for (int kk = 0; kk < kend; ++kk) { const size_t ko = ((size_t)b * SEQ + blk * MBLK + kk) * D + h * HD;
                        const float sc = wave_sum(bfq(Q, qo + lane) * bfq(Kb, ko + lane) + bfq(Q, qo + lane + 64) * bfq(Kb, ko + lane + 64)) * 0.08838834764831845f;
                        if (pass == 0) mx = fmaxf(mx, sc); else { const float p = expf(sc - mx); den += p; o0 += p * bfq(V, ko + lane); o1 += p * bfq(V, ko + lane + 64); } } }
                if (pass == 1) { if (!cls(bfq(O, qo + lane), o0 / den, 0.03f, 0.01f) || !cls(bfq(O, qo + lane + 64), o1 / den, 0.03f, 0.01f)) bad = true; }
            }
        } else if (id == 14) {
            const int m = sd % T, n = (sd >> 14) % D, b = m / SEQ; float s = 0.f; const bf16_t* YB = (const bf16_t*)(ws + WS_YB);
            for (int k = lane; k < D; k += 64) s += bfq(YB, (size_t)m * D + k) * a.in[IN_AWOUT][((size_t)j * D + k) * D + n];
            s = wave_sum(s);
            const float ref = ((const float*)(ws + WS_XA))[(size_t)m * D + n] + MOD[((size_t)l * BATCH + b) * 6 * D + 2 * D + n] * s;
            if (!cls(((const float*)(ws + WS_XB))[(size_t)m * D + n], ref, 0.01f, 0.01f)) bad = true;
        } else if (id == 15) {
            const int m = sd % T, b = m / SEQ; float ss = 0.f; const float* XA = (const float*)(ws + WS_XA); const bf16_t* YK = (const bf16_t*)(ws + WS_YK);
            for (int k = lane; k < D; k += 64) { const float x = XA[(size_t)m * D + k]; ss += x * x;
                const float sy = bfq(YK, (size_t)m * D + k);
                if (!cls(x, ((const float*)(ws + WS_XB))[(size_t)m * D + k] + MOD[((size_t)(l - 1) * BATCH + b) * 6 * D + 5 * D + k] * sy, 1e-3f, 1e-3f)) bad = true; }
            const float rstd = 1.0f / sqrtf(wave_sum(ss) / D + NORM_EPS);
            for (int k = lane; k < D; k += 64) { const float x = XA[(size_t)m * D + k];
                const float hh = x * rstd * a.in[IN_NMG][l * D + k] * (1.0f + MOD[((size_t)l * BATCH + b) * 6 * D + D + k]) + MOD[((size_t)l * BATCH + b) * 6 * D + k];
                if (!cls(bfq(H, (size_t)m * D + k), hh, 0.01f, 0.01f)) bad = true; }
        }
    }
    if (id == 16) {
        for (int it = 0; it < 8; ++it) { const unsigned sd = hsh(blockIdx.x * 131u + it * 7919u + 777u); const int m = sd % T, b = m / SEQ; const bf16_t* YK = (const bf16_t*)(ws + WS_YK);
            for (int k = lane; k < D; k += 64) { const float sy = bfq(YK, (size_t)m * D + k);
                if (!cls(a.out[(size_t)m * D + k], ((const float*)(ws + WS_XB))[(size_t)m * D + k] + MOD[((size_t)3 * BATCH + b) * 6 * D + 5 * D + k] * sy, 1e-3f, 1e-3f)) bad = true; } } }
    if (id == 99) bad = true;
    if (__any(bad) && lane == 0) atomicMax(ctl + CW_CHK, (unsigned)(100 - code));
    (void)PAR;
}
__global__ void chk_encode(Args a) {
    const unsigned v = ((const unsigned*)(a.ws + WS_CTL))[CW_CHK]; if (v == 0u) return;
    const float f = 1.0f + (float)(100 - (int)v);
    for (size_t i = (size_t)blockIdx.x * blockDim.x + threadIdx.x; i < (size_t)T * D; i += (size_t)gridDim.x * blockDim.x) a.out[i] = a.in[IN_X][i] * f;
}
#endif

#ifndef N_LAUNCH_MODE
#define N_LAUNCH_MODE 1
#endif
extern "C" void kernel_launch(void* const* d_in, const int* in_sizes, int n_in, void* d_out, int out_size, void* d_ws, size_t ws_size, hipStream_t stream) {
    static int grid = 0;
    if (grid == 0) {
        if (n_in != 25 || out_size != T * D || ws_size < WS_END) { fprintf(stderr, "kernel_launch: unexpected shapes (n_in %d out %d ws %zu)\n", n_in, out_size, ws_size); grid = -1; return; }
        int dev = 0, cus = 0;
        if (hipGetDevice(&dev) != hipSuccess || hipDeviceGetAttribute(&cus, hipDeviceAttributeMultiprocessorCount, dev) != hipSuccess) { grid = -1; return; }
        if (hipFuncSetAttribute((const void*)fwd, hipFuncAttributeMaxDynamicSharedMemorySize, LDS_BYTES) != hipSuccess) { fprintf(stderr, "kernel_launch: hipFuncSetAttribute failed\n"); grid = -1; return; }
        int per_cu = 0;
        if (hipOccupancyMaxActiveBlocksPerMultiprocessor(&per_cu, (const void*)fwd, NTHR, LDS_BYTES) != hipSuccess || per_cu < 1) fprintf(stderr, "kernel_launch: occupancy query says %d\n", per_cu);
        (void)hipGetLastError();
        if (cus < 256) { fprintf(stderr, "kernel_launch: %d CUs < 256\n", cus); grid = -1; return; }
        grid = 256;
    }
    if (grid < 0) return;
    (void)hipMemsetAsync((char*)d_ws + WS_CTL, 0, CTL_ZERO_BYTES, stream);
    Args a{};
    for (int i = 0; i < 25; ++i) a.in[i] = (const float*)d_in[i];
    a.out = (float*)d_out; a.ws = (unsigned char*)d_ws; a.pad = 0;
#if N_LAUNCH_MODE == 1
    a.ph_lo = 0; a.ph_hi = NPH - 1; a.li = 0;
    hipLaunchKernelGGL(fwd, dim3(grid), dim3(NTHR), LDS_BYTES, stream, a);
#else
    int ordinal = 0; (void)ordinal;
    for (int p = 0; p < NPH; ++p) {
        const int l = (p - 1) / 10, o = (p - 1) % 10;
        if (p >= 1 && p <= 40 && (l & 1) == 1 && o == 5) continue;
        a.ph_lo = p; a.ph_hi = p + 1; a.li = 0;
        hipLaunchKernelGGL(fwd, dim3(grid), dim3(NTHR), LDS_BYTES, stream, a);
#if DEBUG_CHECKS
        {
            const int lch = (p - 1) / 10, och = (p - 1) % 10; int cid = 0;
            if (p == 0) cid = 1;
            else if (p == 41) cid = 16;
            else if ((lch & 1) == 0) { const int t[10] = {lch == 0 ? 2 : 15, 3, 4, 5, 0, 6, 7, 8, 9, 10}; cid = t[och]; }
            else { const int t[10] = {15, 0, 11, 12, 13, 0, 14, 8, 9, 10}; cid = t[och]; }
            if (cid && p >= CHK_FROM) { ++ordinal; hipLaunchKernelGGL(chk, dim3(64), dim3(64), 0, stream, a, cid, lch < 0 ? 0 : (p == 41 ? 3 : lch), ordinal); }
            if (p == 41) { ++ordinal; hipLaunchKernelGGL(chk, dim3(64), dim3(64), 0, stream, a, 99, 0, ordinal); }
        }
#endif
    }
#if DEBUG_CHECKS
    hipLaunchKernelGGL(chk_encode, dim3(1024), dim3(256), 0, stream, a);
#endif
#endif
}
```

```cpp
#include <hip/hip_runtime.h>
#include <stdint.h>
#include <stdio.h>

#define LAS __attribute__((address_space(3)))
#define GAS __attribute__((address_space(1)))
typedef unsigned short bf16_t;
typedef short bf16x8 __attribute__((ext_vector_type(8)));
typedef float f32x4 __attribute__((ext_vector_type(4)));
typedef float f32x2 __attribute__((ext_vector_type(2)));
typedef unsigned u32x4 __attribute__((ext_vector_type(4)));
typedef unsigned u32x2 __attribute__((ext_vector_type(2)));

constexpr int BATCH = 4, SEQ = 4096, D = 1024, T = BATCH * SEQ, DEPTH = 4;
constexpr int NE = 32, TOPK = 4, NH = 8, HD = 128, NBLK = 16, MBLK = 256;
constexpr float NORM_EPS = 1e-6f;
constexpr int NWAVES = 8, NTHR = 512;
constexpr int CAP = T / TOPK;
constexpr int MAXTILES = T * TOPK / 256 + NE;

constexpr size_t MiB = 1u << 20;
constexpr size_t WS_CTL = 0, CTL_ZERO_BYTES = 1 * MiB;
constexpr size_t WS_MOD = 1 * MiB;
constexpr size_t WS_SP8 = 2 * MiB;
constexpr size_t WS_KMEAN = 3 * MiB;
constexpr size_t WS_SEL = 4 * MiB;
constexpr size_t WS_ROWLIST = 5 * MiB;
constexpr size_t WS_TOPW = 7 * MiB;
constexpr size_t WS_PS = 8 * MiB;
constexpr size_t WS_PAR = 10 * MiB;
constexpr int PAR_NMG = 0, PAR_NFG = PAR_NMG + 4 * 1024, PAR_LCW = PAR_NFG + 4 * 1024, PAR_LCB = PAR_LCW + 2 * 4 * 1024, PAR_LBA = PAR_LCB + 2 * 1024, PAR_LBX = PAR_LBA + 2 * 1024,
              PAR_AQG = PAR_LBX + 2 * 1024, PAR_AKG = PAR_AQG + 256, PAR_RW = PAR_AKG + 256, PAR_RB = PAR_RW + 4 * 1024 * 32, PAR_BGU = PAR_RB + 128, PAR_BDN = PAR_BGU + 4 * 32 * 2048, PAR_END = PAR_BDN + 4 * 32 * 1024;
static_assert((size_t)PAR_END * 4 <= 6 * MiB, "param region");
constexpr size_t WS_WIN = 16 * MiB;
constexpr size_t WS_WG = 24 * MiB;
constexpr size_t WS_WLO = 26 * MiB;
constexpr size_t WS_WQKV = 30 * MiB;
constexpr size_t WS_WAO = 42 * MiB;
constexpr size_t WS_WGU = 64 * MiB;
constexpr size_t WS_WDN = 576 * MiB;
constexpr size_t WS_XA = 832 * MiB;
constexpr size_t WS_XB = 896 * MiB;
constexpr size_t WS_H = 960 * MiB;
constexpr size_t WS_GB = 992 * MiB;
constexpr size_t WS_RB = 1024 * MiB;
constexpr size_t WS_XC = 1056 * MiB;
constexpr size_t WS_AF = 1088 * MiB;
constexpr size_t WS_UF = 1152 * MiB;
constexpr size_t WS_YB = 1216 * MiB;
constexpr size_t WS_Q = 1248 * MiB, WS_K = 1280 * MiB, WS_V = 1312 * MiB;
constexpr size_t WS_ACT = 1344 * MiB;
constexpr size_t WS_YK = 1488 * MiB;
constexpr size_t WS_END = 1616 * MiB;

constexpr int CW_BAR = 4096;
constexpr int CW_CNT = 65536;

constexpr int RING_BYTES = 131072;
constexpr int LDS_TAB = RING_BYTES;
constexpr int LDS_UNITS = LDS_TAB + 1024;
constexpr int LDS_MOE = LDS_UNITS + 512;
constexpr int LDS_MISC = LDS_MOE + 512;
constexpr int LDS_X = LDS_MISC + 256;
constexpr int LDS_BYTES = 147456;

__device__ __forceinline__ float bf2f(unsigned h) { return __uint_as_float(h << 16); }
__device__ __forceinline__ float bflo(unsigned u) { return __uint_as_float(u << 16); }
__device__ __forceinline__ float bfhi(unsigned u) { return __uint_as_float(u & 0xffff0000u); }
__device__ __forceinline__ unsigned cvt_pk_bf16(float lo, float hi) { unsigned r; asm("v_cvt_pk_bf16_f32 %0, %1, %2" : "=v"(r) : "v"(lo), "v"(hi)); return r; }
__device__ __forceinline__ float wave_sum(float v) {
#pragma unroll
    for (int o = 1; o < 64; o <<= 1) v += __shfl_xor(v, o);
    return v;
}
__device__ __forceinline__ float fast_exp(float x) { return __builtin_amdgcn_exp2f(x * 1.4426950408889634f); }
__device__ __forceinline__ float sigmoidf_(float x) { return __builtin_amdgcn_rcpf(1.0f + fast_exp(-x)); }
#define LDS_WAIT() asm volatile("s_waitcnt lgkmcnt(0)" ::: "memory")
#define VM_WAIT() asm volatile("s_waitcnt vmcnt(0)" ::: "memory")

#define XB_TMO      128
#define XB_XCNT(j)  (256  + 64 * (j))
#define XB_XSUB(j)  (1280 + 64 * (j))
#define XB_XGEN(j)  (2304 + 64 * (j))
#define XB_TOP      3328
#define XB_TOPGEN   3392
#define XCD_BAR_WORDS 3456
#define XB_SPIN_CAP (1u << 18)
__device__ __forceinline__ unsigned xb_ld(unsigned* p)              { return __hip_atomic_load(p, __ATOMIC_RELAXED, __HIP_MEMORY_SCOPE_AGENT); }
__device__ __forceinline__ unsigned xb_add(unsigned* p, unsigned v) { return __hip_atomic_fetch_add(p, v, __ATOMIC_RELAXED, __HIP_MEMORY_SCOPE_AGENT); }
__device__ __forceinline__ unsigned xb_xcc_id() { return (unsigned)__builtin_amdgcn_s_getreg((3 << 11) | 20) & 0xFu; }
#define XB_SPIN(cond, bar) do { unsigned _sp = 0; while (cond) { __builtin_amdgcn_s_sleep(1); \
    if ((++_sp & 255u) == 0u) { if (xb_ld(&(bar)[XB_TMO])) break; if (_sp > XB_SPIN_CAP) { atomicAdd(&(bar)[XB_TMO], 1u); break; } } } } while (0)
struct XcdBarrier { unsigned* bar; unsigned x; volatile LAS unsigned* st; };
__device__ __forceinline__ XcdBarrier xcd_barrier_post(unsigned* bar, volatile LAS unsigned* st) {
    XcdBarrier b; b.bar = bar; b.x = xb_xcc_id(); b.st = st;
    if (threadIdx.x == 0) (void)xb_add(&bar[XB_XCNT(b.x)], 1u);
    return b;
}
__device__ __forceinline__ void xcd_barrier_complete(unsigned* bar, unsigned x, unsigned& nloc, unsigned& nx) {
    const unsigned G = gridDim.x * gridDim.y * gridDim.z;
    unsigned sum, cnt, mine, sp = 0u;
    for (;;) {
        sum = 0u; cnt = 0u; mine = 0u;
#pragma unroll
        for (unsigned j = 0; j < 16; ++j) { const unsigned c = xb_ld(&bar[XB_XCNT(j)]); sum += c; cnt += (c > 0u) ? 1u : 0u; mine = (j == x) ? c : mine; }
        if (sum == G) break;
        __builtin_amdgcn_s_sleep(1);
        if ((++sp & 255u) == 0u) { if (xb_ld(&bar[XB_TMO])) break; if (sp > XB_SPIN_CAP) { atomicAdd(&bar[XB_TMO], 1u); break; } }
    }
    nloc = mine > 0u ? mine : 1u; nx = cnt > 0u ? cnt : 1u;
}
__device__ __forceinline__ void xcd_barrier(const XcdBarrier& b) {
    asm volatile("s_waitcnt vmcnt(0)" ::: "memory");
    __syncthreads();
    if (threadIdx.x == 0) {
        unsigned* bar = b.bar;
        __builtin_amdgcn_s_waitcnt(0);
        unsigned nloc = b.st[0], nx = b.st[1];
        if (nloc == 0u) { xcd_barrier_complete(bar, b.x, nloc, nx); b.st[0] = nloc; b.st[1] = nx; }
        const unsigned old = xb_add(&bar[XB_XSUB(b.x)], 1u);
        const unsigned gen = old / nloc;
        if (old + 1u == (gen + 1u) * nloc) {
            __builtin_amdgcn_fence(__ATOMIC_RELEASE, "agent");
            asm volatile("s_waitcnt vmcnt(0)" ::: "memory");
            const unsigned og = xb_add(&bar[XB_TOP], 1u);
            const unsigned tg = og / nx;
            if (og + 1u == (tg + 1u) * nx) xb_add(&bar[XB_TOPGEN], 1u);
            else XB_SPIN(xb_ld(&bar[XB_TOPGEN]) == tg, bar);
            __builtin_amdgcn_fence(__ATOMIC_ACQUIRE, "agent");
            xb_add(&bar[XB_XGEN(b.x)], 1u);
            asm volatile("s_waitcnt vmcnt(0)" ::: "memory");
        } else {
            XB_SPIN(xb_ld(&bar[XB_XGEN(b.x)]) == gen, bar);
            __builtin_amdgcn_fence(__ATOMIC_ACQUIRE, "agent");
            asm volatile("s_waitcnt vmcnt(0)" ::: "memory");
        }
    }
    __syncthreads();
}

namespace pg8 {
constexpr int BM = 256, BK = 64, HALF = 128, HTB = HALF * BK * 2, STAGE_BYTES = 8 * HTB, NXCD = 8, WGM = 8;
__host__ __device__ __forceinline__ int lds_byte(int r, int c) { const int st = (r >> 4) * 2 + (c >> 5), rr = r & 15, cc = c & 31, ob = rr * 64 + cc * 2; return st * 1024 + (ob ^ (((ob >> 9) & 1) << 5)); }
__host__ __device__ __forceinline__ void stage_rc(int b, int& R, int& C) { const int st = b / 1024, sb = b % 1024, swz = sb ^ (((sb >> 9) & 1) << 5); R = (st >> 1) * 16 + swz / 64; C = (st & 1) * 32 + (swz % 64) / 2; }
__host__ __device__ __forceinline__ int perm32(int rho) { const int n = rho >> 4, i = rho & 15; return 8 * (i >> 2) + 4 * n + (i & 3); }

struct Unit { int pm, pn, e, valid, j; };

struct ProbPlain {
    static constexpr bool GATHER = false, TAILS = false, ATILED = false;
    const bf16_t* A; const bf16_t* Bt; int M, N, K, lda; int acol_sh;
    int nM, nN, nwg, G, c;
    __device__ __forceinline__ void init(const bf16_t* A_, const bf16_t* Bt_, int M_, int N_, int K_, int lda_, int acol_sh_, int G_, int c_) {
        A = A_; Bt = Bt_; M = M_; N = N_; K = K_; lda = lda_; acol_sh = acol_sh_; nM = M / BM; nN = N / BM; nwg = nM * nN; G = G_; c = c_; }
    __device__ __forceinline__ bool next(int i, Unit& u) const {
        const long L = (long)i * G + c; if (L >= nwg) return false;
        int wgid = (int)L; { const int q = nwg / NXCD, r = nwg % NXCD, xcd = wgid % NXCD, off = wgid / NXCD; wgid = (xcd < r ? xcd * (q + 1) : r * (q + 1) + (xcd - r) * q) + off; }
        const int nig = WGM * nN, gid = wgid / nig, fm = gid * WGM, gsz = (nM - fm) < WGM ? (nM - fm) : WGM;
        u.pm = fm + ((wgid % nig) % gsz); u.pn = (wgid % nig) / gsz; u.e = 0; u.valid = 256; u.j = 0; return true;
    }
    __device__ __forceinline__ const char* a_base(const Unit& u) const { const int ac = acol_sh >= 0 ? (u.pn >> acol_sh) * 256 : 0; return (const char*)(A + (size_t)u.pm * BM * lda + ac); }
    __device__ __forceinline__ const char* b_base(const Unit& u) const { return (const char*)(Bt + (size_t)u.pn * BM * K); }
    __device__ __forceinline__ void fill_tab(const Unit&, LAS unsigned*) const {}
    __device__ __forceinline__ void a_off(const Unit&, const int (&R)[2], const int (&C)[2], unsigned (&v)[2][2], const LAS unsigned*) const {
#pragma unroll
        for (int h = 0; h < 2; ++h)
#pragma unroll
            for (int i = 0; i < 2; ++i) v[h][i] = (unsigned)((h * HALF + R[i]) * lda + C[i]) * 2u;
    }
};
template <bool GATHER_> struct ProbMoE {
    static constexpr bool GATHER = GATHER_, TAILS = true, ATILED = !GATHER_;
    const bf16_t* A; const bf16_t* Bt; int K, lda; size_t bstride;
    const unsigned* rowlist; const LAS int* units; int nunits;
    __device__ __forceinline__ bool next(int i, Unit& u) const {
        if (i >= nunits) return false;
        u.pm = __builtin_amdgcn_readfirstlane(units[i * 4 + 0]); u.pn = __builtin_amdgcn_readfirstlane(units[i * 4 + 1]);
        const int ej = __builtin_amdgcn_readfirstlane(units[i * 4 + 2]); u.e = ej & 255; u.j = ej >> 8; u.valid = __builtin_amdgcn_readfirstlane(units[i * 4 + 3]); return true;
    }
    __device__ __forceinline__ const char* a_base(const Unit& u) const { return GATHER ? (const char*)A : (const char*)(A + (size_t)u.pm * BM * lda); }
    __device__ __forceinline__ const char* b_base(const Unit& u) const { return (const char*)(Bt + (size_t)u.e * bstride + (size_t)u.pn * BM * K); }
    __device__ __forceinline__ void fill_tab(const Unit& u, LAS unsigned* tab) const {
        if (GATHER && threadIdx.x < 256) {
            const u32x2* rl = (const u32x2*)rowlist + (size_t)u.e * CAP + u.j * 256;
            const int r = (int)threadIdx.x < u.valid ? (int)threadIdx.x : 0;
            tab[threadIdx.x] = rl[r].x >> 2;
        }
    }
    __device__ __forceinline__ void a_off(const Unit&, const int (&R)[2], const int (&C)[2], unsigned (&v)[2][2], const LAS unsigned* tab) const {
#pragma unroll
        for (int h = 0; h < 2; ++h)
#pragma unroll
            for (int i = 0; i < 2; ++i) {
                if (GATHER) v[h][i] = (tab[h * HALF + R[i]] * (unsigned)lda + (unsigned)C[i]) * 2u;
                else v[h][i] = (unsigned)((h * HALF + R[i]) * BK + C[i]) * 2u;
            }
    }
};

template <class Epi, class Prob, bool ALIGN_EPI, bool SP2>
__device__ __forceinline__ void gemm_phase(LAS unsigned char* lds, LAS unsigned* tab, const Prob& P, const Epi& E) {
    int tid = threadIdx.x; asm volatile("" : "+v"(tid));
    const int wid = __builtin_amdgcn_readfirstlane(tid >> 6), lane = tid & 63, wr = wid >> 2, wc = wid & 3, fr = lane & 15, fq = lane >> 4;
    const int K = P.K, nt = K / BK;
    int Rr[2], Cc[2]; unsigned voffB[2];
#pragma unroll
    for (int i = 0; i < 2; ++i) { int R, C; stage_rc(tid * 16 + i * 8192, R, C); Rr[i] = R; Cc[i] = C; const int Rb = Epi::PERM ? ((R & ~31) + perm32(R & 31)) : R; voffB[i] = (unsigned)(Rb * BK + C) * 2u; }
    const size_t kstepB = (size_t)BM * BK * 2;
    const size_t hstepB = (size_t)HALF * BK * 2;
    const size_t kstep = Prob::ATILED ? (size_t)BM * BK * 2 : (size_t)(BK * 2);
    const size_t hstepA = Prob::GATHER ? (size_t)0 : (Prob::ATILED ? (size_t)HALF * BK * 2 : (size_t)HALF * P.lda * 2);
#define PG8_V1 (Prob::GATHER ? vcur[1] : vcur[0])
    const unsigned ldsw = (unsigned)wid * 1024u;
    const int aoff = lds_byte(wr * 64 + fr, fq * 8), boff = lds_byte(wc * 32 + fr, fq * 8);
#define PG8_SA(b, h) (((b) * 2 + (h)) * HTB)
#define PG8_SB(b, h) ((4 + (b) * 2 + (h)) * HTB)
#define PG8_STAGE(bufoff, gbase, voff) do { _Pragma("unroll") for (int _i = 0; _i < 2; ++_i) \
        __builtin_amdgcn_global_load_lds((const unsigned*)((const char*)(gbase) + (voff)[_i]), (LAS unsigned*)(lds + (bufoff) + ldsw + _i * 8192), 16, 0, 0); } while (0)
#define PG8_LDA(dst, b, h) do { _Pragma("unroll") for (int m = 0; m < 4; ++m) _Pragma("unroll") for (int k = 0; k < 2; ++k) dst[m][k] = *(const LAS bf16x8*)(lds + PG8_SA(b, h) + aoff + m * 2048 + k * 1024); } while (0)
#define PG8_LDB(dst, b, h) do { _Pragma("unroll") for (int n = 0; n < 2; ++n) _Pragma("unroll") for (int k = 0; k < 2; ++k) dst[n][k] = *(const LAS bf16x8*)(lds + PG8_SB(b, h) + boff + n * 2048 + k * 1024); } while (0)
#define PG8_MMA(ai, bj, At, Bt) do { __builtin_amdgcn_s_setprio(1); _Pragma("unroll") for (int m = 0; m < 4; ++m) _Pragma("unroll") for (int n = 0; n < 2; ++n) _Pragma("unroll") for (int k = 0; k < 2; ++k) \
        acc[ai][bj][m][n] = __builtin_amdgcn_mfma_f32_16x16x32_bf16(Bt[n][k], At[m][k], acc[ai][bj][m][n], 0, 0, 0); __builtin_amdgcn_s_setprio(0); } while (0)
#define PG8_WAIT_V(n) asm volatile("s_waitcnt vmcnt(" #n ")" ::: "memory")
#define PG8_WAIT_L(n) asm volatile("s_waitcnt lgkmcnt(" #n ")" ::: "memory")
#define PG8_BAR __builtin_amdgcn_s_barrier()
#define PG8_SCHED __builtin_amdgcn_sched_barrier(0)
    Unit cur, nxt; int ui = 0;
    if (!P.next(0, cur)) return;
    unsigned vcur[2][2];
    if constexpr (Prob::GATHER) { P.fill_tab(cur, tab); asm volatile("s_waitcnt vmcnt(0) lgkmcnt(0)" ::: "memory"); PG8_BAR; asm volatile("" ::: "memory"); }
    P.a_off(cur, Rr, Cc, vcur, tab);
    if constexpr (Prob::GATHER) { asm volatile("s_waitcnt lgkmcnt(0)" ::: "memory"); }
    f32x4 acc[2][2][4][2];
#pragma unroll
    for (int a = 0; a < 2; ++a)
#pragma unroll
        for (int b = 0; b < 2; ++b)
#pragma unroll
            for (int m = 0; m < 4; ++m)
#pragma unroll
                for (int n = 0; n < 2; ++n) acc[a][b][m][n] = (f32x4){0.f, 0.f, 0.f, 0.f};
    bf16x8 At[4][2], B0[2][2], B1[2][2];
    const char* cA = P.a_base(cur); const char* cB = P.b_base(cur);
    static_assert(SP2, "only the two-MFMA-blocks-per-barrier-pair loop is kept");
    PG8_STAGE(PG8_SB(0, 0), cB, voffB); PG8_STAGE(PG8_SB(0, 1), cB + hstepB, voffB); PG8_STAGE(PG8_SA(0, 0), cA, vcur[0]); PG8_STAGE(PG8_SA(0, 1), cA + hstepA, PG8_V1);
    if (wr == 1) PG8_BAR;
    PG8_WAIT_V(2); PG8_BAR;
    PG8_STAGE(PG8_SB(1, 0), cB + kstepB, voffB); PG8_STAGE(PG8_SA(1, 0), cA + kstep, vcur[0]); PG8_STAGE(PG8_SB(1, 1), cB + hstepB + kstepB, voffB);
    PG8_WAIT_V(6); PG8_BAR;
    for (;;) {
        const bool has_next = P.next(ui + 1, nxt);
        const char* nA = has_next ? P.a_base(nxt) : cA; const char* nB = has_next ? P.b_base(nxt) : cB;
        if constexpr (Prob::GATHER) { if (has_next) P.fill_tab(nxt, tab); }
        const bool full = !Prob::TAILS || cur.valid > HALF;
        for (int t = 0; t < nt; t += 2) {
            const bool last = (t == nt - 2);
            const char* a1 = cA + (size_t)(t + 1) * kstep;
            const char* a2 = last ? nA : cA + (size_t)(t + 2) * kstep; const char* b2 = last ? nB : cB + (size_t)(t + 2) * kstepB;
            const char* a3 = a2 + kstep; const char* b3 = b2 + kstepB;
            PG8_LDB(B0, 0, 0); PG8_LDB(B1, 0, 1); PG8_SCHED; PG8_LDA(At, 0, 0); PG8_STAGE(PG8_SA(1, 1), a1 + hstepA, PG8_V1);
            if constexpr (Prob::GATHER) { if (last && has_next) P.a_off(nxt, Rr, Cc, vcur, tab); }
            PG8_WAIT_V(8); PG8_WAIT_L(0); PG8_BAR; PG8_MMA(0, 0, At, B0); PG8_MMA(0, 1, At, B1); PG8_BAR; PG8_SCHED;
            if (full) { PG8_LDA(At, 0, 1); } PG8_STAGE(PG8_SB(0, 0), b2, voffB); PG8_STAGE(PG8_SB(0, 1), b2 + hstepB, voffB); PG8_STAGE(PG8_SA(0, 0), a2, vcur[0]);
            PG8_WAIT_V(8); PG8_WAIT_L(0); PG8_BAR; if (full) { PG8_MMA(1, 0, At, B0); PG8_MMA(1, 1, At, B1); } PG8_BAR; PG8_SCHED;
            PG8_LDB(B0, 1, 0); PG8_LDB(B1, 1, 1); PG8_SCHED; PG8_LDA(At, 1, 0); PG8_STAGE(PG8_SA(0, 1), a2 + hstepA, PG8_V1);
            PG8_WAIT_V(8); PG8_WAIT_L(0); PG8_BAR; PG8_MMA(0, 0, At, B0); PG8_MMA(0, 1, At, B1); PG8_BAR; PG8_SCHED;
            if (full) { PG8_LDA(At, 1, 1); } PG8_STAGE(PG8_SB(1, 0), b3, voffB); PG8_STAGE(PG8_SB(1, 1), b3 + hstepB, voffB); PG8_STAGE(PG8_SA(1, 0), a3, vcur[0]);
            PG8_WAIT_V(8); PG8_WAIT_L(0); PG8_BAR; if (full) { PG8_MMA(1, 0, At, B0); PG8_MMA(1, 1, At, B1); } PG8_BAR; PG8_SCHED;
        }
        if constexpr (ALIGN_EPI) { if (wr == 0) PG8_BAR; }
        E(acc, cur, wr, wc, fr, fq);
        if (!has_next) break;
#pragma unroll
        for (int a = 0; a < 2; ++a)
#pragma unroll
            for (int b = 0; b < 2; ++b)
#pragma unroll
                for (int m = 0; m < 4; ++m)
#pragma unroll
                    for (int n = 0; n < 2; ++n) acc[a][b][m][n] = (f32x4){0.f, 0.f, 0.f, 0.f};
        cur = nxt; cA = nA; cB = nB; ++ui;
        if constexpr (ALIGN_EPI) { if (wr == 1) PG8_BAR; }
    }
    PG8_WAIT_V(0);
    if constexpr (!ALIGN_EPI) { if (wr == 0) PG8_BAR; }
    PG8_BAR;
#undef PG8_V1
#undef PG8_SA
#undef PG8_SB
#undef PG8_STAGE
#undef PG8_LDA
#undef PG8_LDB
#undef PG8_MMA
#undef PG8_WAIT_V
#undef PG8_WAIT_L
#undef PG8_BAR
#undef PG8_SCHED
}

typedef f32x4 AccT[2][2][4][2];
__device__ __forceinline__ float gelu_tanh(float x) {
    const float z = 1.5957691216057308f * (x + 0.044715f * x * x * x);
    return x * __builtin_amdgcn_rcpf(1.0f + __builtin_amdgcn_exp2f(-1.4426950408889634f * z));
}
struct EpiWin {
    static constexpr bool PERM = true;
    bf16_t* GB; bf16_t* RB;
    __device__ __forceinline__ void operator()(const AccT& acc, const Unit& u, int wr, int wc, int fr, int fq) const {
        const int row0 = u.pm * BM + wr * 64 + fr; const bool gate = u.pn < 4;
        bf16_t* base = GB + (size_t)(u.pn >> 2) * ((WS_RB - WS_GB) / 2); const int col0 = (u.pn & 3) * BM + wc * 32 + 8 * fq;
#pragma unroll
        for (int ai = 0; ai < 2; ++ai)
#pragma unroll
            for (int m = 0; m < 4; ++m) { bf16_t* rowp = base + (size_t)(row0 + ai * HALF + m * 16) * D + col0;
#pragma unroll
                for (int bj = 0; bj < 2; ++bj) { f32x4 v0 = acc[ai][bj][m][0], v1 = acc[ai][bj][m][1];
                    if (gate) {
#pragma unroll
                        for (int j = 0; j < 4; ++j) { v0[j] = gelu_tanh(v0[j]); v1[j] = gelu_tanh(v1[j]); } }
                    u32x4 w; w.x = cvt_pk_bf16(v0[0], v0[1]); w.y = cvt_pk_bf16(v0[2], v0[3]); w.z = cvt_pk_bf16(v1[0], v1[1]); w.w = cvt_pk_bf16(v1[2], v1[3]);
                    *(u32x4*)(rowp + bj * HALF) = w; } }
    }
};
struct EpiQKV {
    static constexpr bool PERM = true;
    bf16_t* Q; const float* qg; const float* kg; float* KM; LAS float* xl;
    __device__ __forceinline__ void operator()(const AccT& acc, const Unit& u, int wr, int wc, int fr, int fq) const {
        const int row0 = u.pm * BM + wr * 64 + fr; const int t = u.pn >> 2;
        bf16_t* base = Q + (size_t)t * ((WS_K - WS_Q) / 2); const int col0 = (u.pn & 3) * BM + wc * 32 + 8 * fq;
        LAS float* SS = xl; LAS float* KS = xl + 2048;
#pragma unroll
        for (int ai = 0; ai < 2; ++ai)
#pragma unroll
            for (int m = 0; m < 4; ++m)
#pragma unroll
                for (int bj = 0; bj < 2; ++bj) { const f32x4 v0 = acc[ai][bj][m][0], v1 = acc[ai][bj][m][1];
                    float ss = (v0[0] * v0[0] + v0[1] * v0[1]) + (v0[2] * v0[2] + v0[3] * v0[3]) + (v1[0] * v1[0] + v1[1] * v1[1]) + (v1[2] * v1[2] + v1[3] * v1[3]);
                    ss += __shfl_xor(ss, 16); ss += __shfl_xor(ss, 32);
                    if (fq == 0) SS[((ai * HALF + wr * 64 + m * 16 + fr) * 2 + bj) * 4 + wc] = ss; __builtin_amdgcn_sched_barrier(0); }
        asm volatile("s_waitcnt lgkmcnt(0)" ::: "memory"); __builtin_amdgcn_s_barrier(); asm volatile("" ::: "memory");
        const bool isv = (t == 2);
        const float* gp = (t == 0 ? qg : kg) + wc * 32 + 8 * fq;
        f32x4 g0 = *(const f32x4*)gp, g1 = *(const f32x4*)(gp + 4);
        if (isv) { g0 = (f32x4){1.f, 1.f, 1.f, 1.f}; g1 = g0; }
        {
#pragma unroll
            for (int bj = 0; bj < 2; ++bj) {
                float cs[8];
#pragma unroll
                for (int q = 0; q < 8; ++q) cs[q] = 0.f;
#pragma unroll
                for (int ai = 0; ai < 2; ++ai)
#pragma unroll
                    for (int m = 0; m < 4; ++m) { const int r = ai * HALF + wr * 64 + m * 16 + fr; bf16_t* rowp = base + (size_t)(u.pm * BM + r) * D + col0;
                        const f32x4 p = *(const LAS f32x4*)(SS + (r * 2 + bj) * 4);
                        const float rstd = isv ? 1.0f : __builtin_amdgcn_rsqf(((p[0] + p[1]) + (p[2] + p[3])) * (1.0f / HD) + NORM_EPS);
                        const f32x4 v0 = acc[ai][bj][m][0] * rstd * g0, v1 = acc[ai][bj][m][1] * rstd * g1;
#pragma unroll
                        for (int q = 0; q < 4; ++q) { cs[q] += v0[q]; cs[4 + q] += v1[q]; }
                        u32x4 w; w.x = cvt_pk_bf16(v0[0], v0[1]); w.y = cvt_pk_bf16(v0[2], v0[3]); w.z = cvt_pk_bf16(v1[0], v1[1]); w.w = cvt_pk_bf16(v1[2], v1[3]);
                        *(u32x4*)(rowp + bj * HALF) = w; __builtin_amdgcn_sched_barrier(0); }
#pragma unroll
                for (int q = 0; q < 8; ++q) { float v = cs[q]; v += __shfl_xor(v, 1); v += __shfl_xor(v, 2); v += __shfl_xor(v, 4); v += __shfl_xor(v, 8);
                    if (fr == 0) KS[wr * 256 + bj * HALF + wc * 32 + 8 * fq + q] = v; }
            }
            asm volatile("s_waitcnt lgkmcnt(0)" ::: "memory"); __builtin_amdgcn_s_barrier(); asm volatile("" ::: "memory");
            int tid = threadIdx.x; asm volatile("" : "+v"(tid));
            if (tid < 256 && t == 1) { const int b = u.pm >> 4, blk = u.pm & 15, h = 2 * (u.pn & 3) + (tid >> 7);
                KM[(((size_t)b * NH + h) * NBLK + blk) * HD + (tid & 127)] = (KS[tid] + KS[256 + tid]) * (1.0f / MBLK); }
        }
    }
};
struct EpiGates {
    static constexpr bool PERM = true;
    const bf16_t* XC; bf16_t* LA; bf16_t* UB; const float* ba; const float* bx; const float* sp8;
    __device__ __forceinline__ void operator()(const AccT& acc, const Unit& u, int wr, int wc, int fr, int fq) const {
        const int row0 = u.pm * BM + wr * 64 + fr; const int ch0 = (u.pn >> 1) * 256 + (u.pn & 1) * 128 + wc * 32 + 8 * fq;
        f32x4 bav[2], bxv[2], spv[2];
#pragma unroll
        for (int n = 0; n < 2; ++n) { bav[n] = *(const f32x4*)(ba + ch0 + n * 4); bxv[n] = *(const f32x4*)(bx + ch0 + n * 4); spv[n] = *(const f32x4*)(sp8 + ch0 + n * 4) * 1.4426950408889634f; }
#pragma unroll
        for (int ai = 0; ai < 2; ++ai)
#pragma unroll
            for (int m = 0; m < 4; ++m) { const size_t ro = (size_t)(row0 + ai * HALF + m * 16) * D + ch0;
                const u32x4 xw = *(const u32x4*)(XC + ro);
                float lo[8], uo[8];
#pragma unroll
                for (int n = 0; n < 2; ++n)
#pragma unroll
                    for (int j = 0; j < 4; ++j) { const int q = n * 4 + j; const float xcv = (q & 1) ? bfhi(xw[q >> 1]) : bflo(xw[q >> 1]);
                        const float r = sigmoidf_(acc[ai][0][m][n][j] + bav[n][j]), ig = sigmoidf_(acc[ai][1][m][n][j] + bxv[n][j]);
                        const float l2 = -spv[n][j] * r;
                        const float a2 = __builtin_amdgcn_exp2f(2.0f * l2);
                        lo[q] = l2; uo[q] = __builtin_amdgcn_sqrtf(1.0f - a2) * ig * xcv; }
                u32x4 lw, uw;
#pragma unroll
                for (int q = 0; q < 4; ++q) { lw[q] = cvt_pk_bf16(lo[2 * q], lo[2 * q + 1]); uw[q] = cvt_pk_bf16(uo[2 * q], uo[2 * q + 1]); }
                *(u32x4*)(LA + ro) = lw; *(u32x4*)(UB + ro) = uw; }
    }
};
struct EpiResid {
    static constexpr bool PERM = false;
    const float* X; float* XB; const float* g1;
    __device__ __forceinline__ void operator()(const AccT& acc, const Unit& u, int wr, int wc, int fr, int fq) const {
        const int row0 = u.pm * BM + wr * 64 + fr, col0 = u.pn * BM + wc * 32 + 4 * fq; const int b = (u.pm * BM) / SEQ;
        f32x4 gv[2][2];
#pragma unroll
        for (int bj = 0; bj < 2; ++bj)
#pragma unroll
            for (int n = 0; n < 2; ++n) gv[bj][n] = *(const f32x4*)(g1 + (size_t)b * 6 * D + col0 + bj * HALF + n * 16);
#pragma unroll
        for (int ai = 0; ai < 2; ++ai) {
            f32x4 xv[4][2][2];
#pragma unroll
            for (int m = 0; m < 4; ++m) { const size_t ro = (size_t)(row0 + ai * HALF + m * 16) * D + col0;
#pragma unroll
                for (int bj = 0; bj < 2; ++bj)
#pragma unroll
                    for (int n = 0; n < 2; ++n) xv[m][bj][n] = *(const f32x4*)(X + ro + bj * HALF + n * 16); }
#pragma unroll
            for (int m = 0; m < 4; ++m) { const size_t ro = (size_t)(row0 + ai * HALF + m * 16) * D + col0;
#pragma unroll
                for (int bj = 0; bj < 2; ++bj)
#pragma unroll
                    for (int n = 0; n < 2; ++n) *(f32x4*)(XB + ro + bj * HALF + n * 16) = xv[m][bj][n] + gv[bj][n] * acc[ai][bj][m][n]; }
            asm volatile("" ::: "memory"); }
    }
};
struct EpiSwiglu {
    static constexpr bool PERM = true;
    bf16_t* ACT; const float* bgu;
    __device__ __forceinline__ void operator()(const AccT& acc, const Unit& u, int wr, int wc, int fr, int fq) const {
        const int row0 = u.pm * BM + wr * 64 + fr; const int j0 = u.pn * HALF + wc * 32 + 8 * fq;
        const float* bp = bgu + (size_t)u.e * 2 * D + j0;
        const f32x4 bg0 = *(const f32x4*)(bp), bg1 = *(const f32x4*)(bp + 4), bu0 = *(const f32x4*)(bp + D), bu1 = *(const f32x4*)(bp + D + 4);
#pragma unroll
        for (int ai = 0; ai < 2; ++ai)
#pragma unroll
            for (int m = 0; m < 4; ++m) {
                float o[8];
#pragma unroll
                for (int n = 0; n < 2; ++n)
#pragma unroll
                    for (int j = 0; j < 4; ++j) { const float g = acc[ai][0][m][n][j] + (n ? bg1[j] : bg0[j]), up = acc[ai][1][m][n][j] + (n ? bu1[j] : bu0[j]);
                        const float gv = fminf(g, 7.0f), uv = fminf(fmaxf(up, -7.0f), 7.0f);
                        o[n * 4 + j] = gv * sigmoidf_(1.702f * gv) * (uv + 1.0f); }
                u32x4 w; w.x = cvt_pk_bf16(o[0], o[1]); w.y = cvt_pk_bf16(o[2], o[3]); w.z = cvt_pk_bf16(o[4], o[5]); w.w = cvt_pk_bf16(o[6], o[7]);
                *(u32x4*)(ACT + (size_t)u.pm * BM * D + (size_t)(j0 >> 6) * (BM * BK) + (size_t)(wr * 64 + fr + ai * HALF + m * 16) * BK + (j0 & 63)) = w; }
    }
};
struct EpiDown {
    static constexpr bool PERM = false;
    const float* XB; float* XO; const float* __restrict__ g2; const float* __restrict__ bdn; const unsigned* __restrict__ rowlist;
    __device__ __forceinline__ void operator()(const AccT& acc, const Unit& u, int wr, int wc, int fr, int fq) const {
        const int c0 = u.pn * BM + wc * 32 + 4 * fq;
        const float* bp = bdn + (size_t)u.e * D + c0;
        f32x4 bv[2][2];
#pragma unroll
        for (int bj = 0; bj < 2; ++bj) { bv[bj][0] = *(const f32x4*)(bp + bj * HALF); bv[bj][1] = *(const f32x4*)(bp + bj * HALF + 16); }
        const u32x2* rl = (const u32x2*)rowlist + (size_t)u.e * CAP + u.j * 256;
        u32x2 ri[2][4];
#pragma unroll
        for (int ai = 0; ai < 2; ++ai)
#pragma unroll
            for (int m = 0; m < 4; ++m) { const int r = ai * HALF + wr * 64 + m * 16 + fr; ri[ai][m] = rl[r < u.valid ? r : 0]; }
#pragma unroll
        for (int ai = 0; ai < 2; ++ai)
#pragma unroll
            for (int mp = 0; mp < 2; ++mp) {
                f32x4 xv[2][2][2];
#pragma unroll
                for (int q = 0; q < 2; ++q) { const size_t ro = (size_t)ri[ai][2 * mp + q].x * D + c0;
#pragma unroll
                    for (int bj = 0; bj < 2; ++bj)
#pragma unroll
                        for (int n = 0; n < 2; ++n) xv[q][bj][n] = *(const f32x4*)(XB + ro + bj * HALF + n * 16); }
#pragma unroll
                for (int q = 0; q < 2; ++q) { const int m = 2 * mp + q; const int r = ai * HALF + wr * 64 + m * 16 + fr; const unsigned dest = ri[ai][m].x; const float w = __uint_as_float(ri[ai][m].y);
                    const size_t ro = (size_t)dest * D + c0; const float* gp = g2 + (size_t)(dest / SEQ) * 6 * D + c0;
                    if (r < u.valid) {
#pragma unroll
                        for (int bj = 0; bj < 2; ++bj)
#pragma unroll
                            for (int n = 0; n < 2; ++n) { const f32x4 gv = *(const f32x4*)(gp + bj * HALF + n * 16);
                                *(f32x4*)(XO + ro + bj * HALF + n * 16) = xv[q][bj][n] + gv * ((acc[ai][bj][m][n] + bv[bj][n]) * w); } } }
            }
    }
};
}

namespace att {
typedef short s16x4 __attribute__((ext_vector_type(4)));
typedef float f32x16 __attribute__((ext_vector_type(16)));
constexpr int NW = 8, QBLK = 32, KVBLK = 64, QB = NW * QBLK, DH = 128, LD = 1024;
constexpr int SHM_V = KVBLK * DH * 2, SHM_K = KVBLK * DH * 2;
constexpr int ATT_LDS_BYTES = 2 * SHM_V + 2 * SHM_K + NW * 64 * 4;
constexpr float SCALE = 0.08838834764831845f;
constexpr float THR = 8.f;
#define KSWZ(row, colB) ((row) * 256 + ((colB) ^ (((row) & 7) << 4)))
#define SBAR() __builtin_amdgcn_sched_barrier(0)
__device__ __forceinline__ int v_st(int k, int c) { const int kk = (k & ~0xC) | ((k & 4) << 1) | ((k & 8) >> 1); return ((kk >> 3) * 4 + (c >> 5)) * 512 + ((kk & 7) * 32 + (c & 31)) * 2; }
__device__ __forceinline__ int v_rd_base(int lane) { return ((lane & 3) << 3) | (((lane >> 2) & 3) << 6) | (((lane >> 4) & 1) << 5) | (((lane >> 5) & 1) << 8); }
constexpr int v_rd_off(int d0, int ks, int half) { return d0 * 512 + ks * 4096 + half * 2048; }
__device__ __forceinline__ int crow(int r, int hi) { return (r & 3) + 8 * (r >> 2) + 4 * hi; }
__device__ __forceinline__ unsigned cvtpk(float lo, float hi) { unsigned r; asm volatile("v_cvt_pk_bf16_f32 %0, %1, %2" : "=v"(r) : "v"(lo), "v"(hi)); return r; }
__device__ __forceinline__ bf16x8 ld8(const bf16_t* p) { return *reinterpret_cast<const bf16x8*>(p); }
__device__ __forceinline__ void mask_causal(f32x16& p0, f32x16& p1, int dq) {
    const float NEG = -__builtin_inff();
#pragma unroll
    for (int r = 0; r < 16; ++r) {
        const int c = (r & 3) + 8 * (r >> 2);
        if (dq - c < 0) p0[r] = NEG;
        if (dq - c - 32 < 0) p1[r] = NEG;
    }
}
__device__ __forceinline__ void mask_all(f32x16& p0, f32x16& p1, bool keep) {
    const float NEG = -__builtin_inff();
#pragma unroll
    for (int r = 0; r < 16; ++r) { p0[r] = keep ? p0[r] : NEG; p1[r] = keep ? p1[r] : NEG; }
}
__device__ __forceinline__ void partialSM(f32x16& p0, f32x16& p1, float& m_reg, float& mn, float& alpha) {
    float pmax = p0[0]; for (int r = 1; r < 16; ++r) pmax = fmaxf(pmax, p0[r]); for (int r = 0; r < 16; ++r) pmax = fmaxf(pmax, p1[r]);
    { auto rr = __builtin_amdgcn_permlane32_swap(__float_as_uint(pmax), __float_as_uint(pmax), false, false);
      pmax = fmaxf(__uint_as_float(rr[0]), __uint_as_float(rr[1])); }
    constexpr float C2 = 1.4426950408889634f * SCALE;
    if (__builtin_expect(__all((pmax - m_reg) * SCALE <= THR), 1)) { mn = m_reg; alpha = 1.f; }
    else { mn = fmaxf(m_reg, pmax); alpha = __builtin_amdgcn_exp2f((m_reg - mn) * C2); m_reg = mn; }
    const float mnL = -mn * C2;
    for (int r = 0; r < 16; ++r) p0[r] = fmaf(p0[r], C2, mnL); for (int r = 0; r < 16; ++r) p1[r] = fmaf(p1[r], C2, mnL);
    for (int r = 0; r < 16; ++r) p0[r] = __builtin_amdgcn_exp2f(p0[r]);
}
__device__ __forceinline__ void finishSM(f32x16& p0, f32x16& p1, float alpha, float& l_reg, bf16x8& pa0, bf16x8& pa1, bf16x8& pa2, bf16x8& pa3) {
    for (int r = 0; r < 16; ++r) p1[r] = __builtin_amdgcn_exp2f(p1[r]);
    float ps = 0; for (int r = 0; r < 16; ++r) ps += p0[r]; for (int r = 0; r < 16; ++r) ps += p1[r];
    { auto rr = __builtin_amdgcn_permlane32_swap(__float_as_uint(ps), __float_as_uint(ps), false, false);
      ps = __uint_as_float(rr[0]) + __uint_as_float(rr[1]); }
    l_reg = l_reg * alpha + ps;
#define PK4(P, B_, OUT) do { unsigned a0 = cvtpk(P[B_+0], P[B_+1]), a1 = cvtpk(P[B_+2], P[B_+3]);                          \
        unsigned b0 = cvtpk(P[B_+4], P[B_+5]), b1 = cvtpk(P[B_+6], P[B_+7]);                                             \
        auto r0 = __builtin_amdgcn_permlane32_swap(a0, b0, false, false); auto r1 = __builtin_amdgcn_permlane32_swap(a1, b1, false, false); \
        u32x4 w = {r0[0], r1[0], r0[1], r1[1]}; OUT = *reinterpret_cast<bf16x8*>(&w); } while (0)
    PK4(p0, 0, pa0); PK4(p0, 8, pa1); PK4(p1, 0, pa2); PK4(p1, 8, pa3);
#undef PK4
}
template <int KB>
__device__ __forceinline__ void qkt(f32x16& p0, f32x16& p1, const char* K_lds, int r32, int hi, const bf16x8* qr) {
    p0 = f32x16{}; p1 = f32x16{};
    const char* kb[4];
#pragma unroll
    for (int dd = 0; dd < 4; ++dd) kb[dd] = K_lds + KB * SHM_K + KSWZ(r32, (dd * 16 + hi * 8) * 2);
#pragma unroll
    for (int d0 = 0; d0 < 8; ++d0) { const char* a = kb[d0 & 3] + (d0 >> 2) * 128;
        bf16x8 b0 = *reinterpret_cast<const bf16x8*>(a);
        bf16x8 b1 = *reinterpret_cast<const bf16x8*>(a + 32 * 256);
        p0 = __builtin_amdgcn_mfma_f32_32x32x16_bf16(b0, qr[d0], p0, 0, 0, 0);
        p1 = __builtin_amdgcn_mfma_f32_32x32x16_bf16(b1, qr[d0], p1, 0, 0, 0); }
}
template <int VB>
__device__ __forceinline__ void pv_tile(f32x16* o, int vb0, bf16x8 pa0, bf16x8 pa1, bf16x8 pa2, bf16x8 pa3) {
#define TRRD(dst, off) asm volatile("ds_read_b64_tr_b16 %0, %1 offset:%2" : "=&v"(dst) : "v"(vb0), "i"(off) : "memory")
#define PV_D0(d0) do { s16x4 l0, l1, l2, l3, h0, h1, h2, h3; constexpr int b_ = VB * SHM_V + v_rd_off(d0, 0, 0); \
        TRRD(l0, b_); TRRD(h0, b_ + 2048); TRRD(l1, b_ + 4096); TRRD(h1, b_ + 6144); TRRD(l2, b_ + 8192); TRRD(h2, b_ + 10240); TRRD(l3, b_ + 12288); TRRD(h3, b_ + 14336); \
        asm volatile("s_waitcnt lgkmcnt(0)" ::: "memory"); SBAR();   \
        o[d0] = __builtin_amdgcn_mfma_f32_32x32x16_bf16(pa0, (bf16x8){l0[0], l0[1], l0[2], l0[3], h0[0], h0[1], h0[2], h0[3]}, o[d0], 0, 0, 0);   \
        o[d0] = __builtin_amdgcn_mfma_f32_32x32x16_bf16(pa1, (bf16x8){l1[0], l1[1], l1[2], l1[3], h1[0], h1[1], h1[2], h1[3]}, o[d0], 0, 0, 0);   \
        o[d0] = __builtin_amdgcn_mfma_f32_32x32x16_bf16(pa2, (bf16x8){l2[0], l2[1], l2[2], l2[3], h2[0], h2[1], h2[2], h2[3]}, o[d0], 0, 0, 0);   \
        o[d0] = __builtin_amdgcn_mfma_f32_32x32x16_bf16(pa3, (bf16x8){l3[0], l3[1], l3[2], l3[3], h3[0], h3[1], h3[2], h3[3]}, o[d0], 0, 0, 0); } while (0)
    PV_D0(0); PV_D0(1); PV_D0(2); PV_D0(3);
#undef PV_D0
#undef TRRD
}
constexpr int KM_OFF = 69632;
__device__ __forceinline__ unsigned moba_gate(const bf16x8* qr, const float* km, int qb, int hi) {
    float v1 = -__builtin_inff(), v2 = v1, v3 = v1; int i1 = -1, i2 = -1, i3 = -1;
    for (int n = 0; n < qb; ++n) { const float* kp = km + n * DH + hi * 8; float sc = 0.f;
#pragma unroll
        for (int d0 = 0; d0 < 8; ++d0) { const f32x4 k0 = *(const f32x4*)(kp + d0 * 16), k1 = *(const f32x4*)(kp + d0 * 16 + 4); const bf16x8 q = qr[d0];
#pragma unroll
            for (int e = 0; e < 4; ++e) { sc += __uint_as_float(((unsigned)(unsigned short)q[e]) << 16) * k0[e]; sc += __uint_as_float(((unsigned)(unsigned short)q[4 + e]) << 16) * k1[e]; } }
        sc += __shfl_xor(sc, 32);
        if (sc > v1) { v3 = v2; i3 = i2; v2 = v1; i2 = i1; v1 = sc; i1 = n; }
        else if (sc > v2) { v3 = v2; i3 = i2; v2 = sc; i2 = n; }
        else if (sc > v3) { v3 = sc; i3 = n; } }
    unsigned m = 0u; if (i1 >= 0) m |= 1u << i1; if (i2 >= 0) m |= 1u << i2; if (i3 >= 0) m |= 1u << i3;
    return m;
}
struct BlockRef { const bf16_t* Q; const bf16_t* K; const bf16_t* V; bf16_t* O; int qb; };
struct Seam { bf16x8 qr[8]; bf16x8 st_v0, st_v1, st_k0, st_k1; };
#define VMW() asm volatile("s_waitcnt vmcnt(0)" ::: "memory")
#define VMWN(n) asm volatile("s_waitcnt vmcnt(%0)" :: "i"(n) : "memory")
#define GLD8(ubase) (*reinterpret_cast<const bf16x8*>((ubase) + toff))
#define SLOAD_H(Kp, Vp, k0) do { const char* kb__ = (const char*)(Kp) + (size_t)(k0) * (LD * 2); const char* vb__ = (const char*)(Vp) + (size_t)(k0) * (LD * 2); \
                         S.st_v0 = GLD8(vb__); S.st_v1 = GLD8(vb__ + 32 * LD * 2); S.st_k0 = GLD8(kb__); S.st_k1 = GLD8(kb__ + 32 * LD * 2); } while (0)
#define SWRITE_HK(bf) do { *(bf16x8*)(K_lds + (bf) * SHM_K + kws) = S.st_k0; *(bf16x8*)(K_lds + (bf) * SHM_K + kws + 32 * 256) = S.st_k1; } while (0)
#define SWRITE_HV(bf) do { *(bf16x8*)(V_lds + (bf) * SHM_V + vst0) = S.st_v0; *(bf16x8*)(V_lds + (bf) * SHM_V + vst1) = S.st_v1; } while (0)
#define SWRITE_H(bf) do { SWRITE_HV(bf); SWRITE_HK(bf); } while (0)
__device__ __forceinline__ void moba_prime(const BlockRef& cur, char* lds, Seam& S, int tid) {
    const int wid = __builtin_amdgcn_readfirstlane(tid >> 6), lane = tid & 63, r32 = lane & 31, hi = lane >> 5;
    const int sr = tid >> 4, sc = (tid & 15) * 8, kws = KSWZ(sr, sc * 2); char* K_lds = lds + 2 * SHM_V;
    const unsigned toff = (unsigned)(sr * LD + sc) * 2u, qoff = (unsigned)(r32 * LD + hi * 8) * 2u;
    { const char* qb_ = (const char*)cur.Q + (size_t)(wid * QBLK) * (LD * 2);
#pragma unroll
      for (int d0 = 0; d0 < 8; ++d0) S.qr[d0] = *reinterpret_cast<const bf16x8*>(qb_ + d0 * 32 + qoff); }
    SLOAD_H(cur.K, cur.V, 0); VMW(); SWRITE_HK(0);
    __syncthreads();
}
__device__ __forceinline__ void moba_block(const BlockRef& cur, const BlockRef& nxt, char* lds, Seam& S, int tid) {
    const int wid = __builtin_amdgcn_readfirstlane(tid >> 6), lane = tid & 63, r32 = lane & 31, hi = lane >> 5;
    const int NT = 4 * (cur.qb + 1);
    const int P0 = cur.qb * QB;
    const int qlo = P0 + wid * QBLK, qm = qlo + r32 - 4 * hi;
    const unsigned msk = moba_gate(S.qr, (const float*)(lds + KM_OFF), cur.qb, hi);
    char* V_lds = lds; char* K_lds = lds + 2 * SHM_V;
    float* ws = (float*)(lds + 2 * SHM_V + 2 * SHM_K) + wid * 64; float* li_l = ws, * al_l = ws + 32;
    float m_reg = -1e30f, l_reg = 0; f32x16 o[4] = {};
    const int sr = tid >> 4, sc = (tid & 15) * 8, vst0 = v_st(sr, sc), vst1 = v_st(32 + sr, sc), kws = KSWZ(sr, sc * 2);
    const unsigned toff = (unsigned)(sr * LD + sc) * 2u, qoff = (unsigned)(r32 * LD + hi * 8) * 2u;
    const int vb0 = (int)(uintptr_t)V_lds + v_rd_base(lane);
    const bf16_t* Kh = cur.K; const bf16_t* Vh = cur.V;
#define RESC(a) do { if (__any((a) < 1.f)) { if (hi == 0) al_l[r32] = (a); asm volatile("s_waitcnt lgkmcnt(0)" ::: "memory");              \
                     for (int d_ = 0; d_ < 4; ++d_) for (int r = 0; r < 16; ++r) o[d_][r] *= al_l[crow(r, hi)]; } } while (0)
#define KBASE(t) ((t) * KVBLK)
#define MASKT(P0_, P1_, t) do { const int kb_ = KBASE(t); const int jb_ = (t) >> 2; \
        if (jb_ < cur.qb) { mask_all(P0_, P1_, ((msk >> jb_) & 1u) != 0u); } \
        else if (kb_ + KVBLK - 1 > qlo) mask_causal(P0_, P1_, qm - kb_); } while (0)
    constexpr int NQL = 8;
#define SEAM_K0() do { VMWN(NQL); SWRITE_HK(0); SBAR(); } while (0)
    f32x16 pA0, pA1, pB0, pB1; float mnA, mnB, alA, alB; bf16x8 pa0, pa1, pa2, pa3;
    SWRITE_HV(0); SBAR();
    if (NT > 1) { SLOAD_H(Kh, Vh, KBASE(1)); }
    SBAR(); qkt<0>(pA0, pA1, K_lds, r32, hi, S.qr);
    MASKT(pA0, pA1, 0); partialSM(pA0, pA1, m_reg, mnA, alA);
    if (NT > 1) { VMW(); SWRITE_H(1); }
    __syncthreads();
#define HALF_STEP(PX0, PX1, mnX, alX, PY0, PY1, alY, t, KB, VB, SB) do {                                                      \
        SBAR(); qkt<KB>(PX0, PX1, K_lds, r32, hi, S.qr);                                             \
        finishSM(PY0, PY1, alY, l_reg, pa0, pa1, pa2, pa3); SBAR();                                                           \
        if ((t) + 1 < NT) { SLOAD_H(Kh, Vh, KBASE((t) + 1)); SBAR(); }                                               \
        pv_tile<VB>(o, vb0, pa0, pa1, pa2, pa3); MASKT(PX0, PX1, (t)); partialSM(PX0, PX1, m_reg, mnX, alX);                                        \
        __syncthreads();                                                                                                      \
        if ((t) + 1 < NT) { VMW(); SWRITE_H(SB); }                                                                          \
        RESC(alX); __syncthreads(); } while (0)
    for (int t = 1; t + 1 < NT; t += 2) {
        HALF_STEP(pB0, pB1, mnB, alB, pA0, pA1, alA, t, 1, 0, 0);
        HALF_STEP(pA0, pA1, mnA, alA, pB0, pB1, alB, t + 1, 0, 1, 1);
    }
    const bool even = (NT & 1) == 0;
    if (even) { SBAR(); qkt<1>(pB0, pB1, K_lds, r32, hi, S.qr); SBAR(); }
    SLOAD_H(nxt.K, nxt.V, 0); SBAR();
    { const char* qb_ = (const char*)nxt.Q + (size_t)(wid * QBLK) * (LD * 2);
#pragma unroll
      for (int d0 = 0; d0 < 8; ++d0) S.qr[d0] = *reinterpret_cast<const bf16x8*>(qb_ + d0 * 32 + qoff); }
    SBAR();
    finishSM(pA0, pA1, alA, l_reg, pa0, pa1, pa2, pa3); SBAR();
    pv_tile<0>(o, vb0, pa0, pa1, pa2, pa3);
    if (even) { MASKT(pB0, pB1, NT - 1); partialSM(pB0, pB1, m_reg, mnB, alB); __syncthreads(); RESC(alB);
        finishSM(pB0, pB1, alB, l_reg, pa0, pa1, pa2, pa3); SBAR(); pv_tile<1>(o, vb0, pa0, pa1, pa2, pa3); }
    SBAR(); SEAM_K0();
    if (hi == 0) li_l[r32] = l_reg; asm volatile("s_waitcnt lgkmcnt(0)" ::: "memory");
    float rli[16];
#pragma unroll
    for (int r = 0; r < 16; ++r) rli[r] = __builtin_amdgcn_rcpf(li_l[crow(r, hi)]);
    char* Ow = (char*)cur.O + (size_t)(wid * QBLK) * (LD * 2);
    const unsigned ooff = (unsigned)(4 * hi * LD + r32) * 2u;
#pragma unroll
    for (int r = 0; r < 16; ++r) { char* Or = Ow + (size_t)((r & 3) + 8 * (r >> 2)) * (LD * 2);
#pragma unroll
        for (int d0 = 0; d0 < 4; ++d0) { const float v = o[d0][r] * rli[r];
            const float vn = __shfl_xor(v, 1);
            if ((r32 & 1) == 0) *(unsigned*)(Or + d0 * 64 + ooff) = cvtpk(v, vn); } }
    __syncthreads();
#undef RESC
#undef KBASE
#undef MASKT
#undef SEAM_K0
#undef HALF_STEP
}
#undef VMW
#undef VMWN
#undef SLOAD_H
#undef GLD8
#undef SWRITE_HK
#undef SWRITE_HV
#undef SWRITE_H
}

struct Args { const float* in[25]; float* out; unsigned char* ws; int ph_lo, ph_hi, li, pad; };
enum { IN_X = 0, IN_C, IN_NMG, IN_NFG, IN_WMOD, IN_BMOD, IN_LWIN, IN_LCW, IN_LCB, IN_LWA, IN_LBA, IN_LWX, IN_LBX, IN_LLAM, IN_LWOUT,
       IN_AQKV, IN_AQG, IN_AKG, IN_AWOUT, IN_RW, IN_RB, IN_WGU, IN_BGU, IN_WDN, IN_BDN };
struct Frame {
    LAS unsigned char* lds;
    unsigned char* ws;
    int tid, lane, wave, vcu, G;
};

__device__ __forceinline__ void cvt_tile(const float* W, int ldw, int k0, int n0, bf16_t* WT, int ldt, int drow0, LAS float* scr, int lane) {
    const int q = lane & 15, rr = lane >> 4;
    f32x4 v[16];
#pragma unroll
    for (int i = 0; i < 16; ++i) v[i] = __builtin_nontemporal_load((const f32x4*)(W + (size_t)(k0 + 4 * i + rr) * ldw + n0 + 4 * q));
#pragma unroll
    for (int i = 0; i < 16; ++i) { LAS float* s = scr + (4 * i + rr) * 65 + 4 * q; s[0] = v[i][0]; s[1] = v[i][1]; s[2] = v[i][2]; s[3] = v[i][3]; }
    LDS_WAIT();
    const int c = lane & 7;
#pragma unroll
    for (int jj = 0; jj < 8; ++jj) { const int n = (lane >> 3) + 8 * jj; const LAS float* s = scr + (8 * c) * 65 + n;
        u32x4 o; o.x = cvt_pk_bf16(s[0 * 65], s[1 * 65]); o.y = cvt_pk_bf16(s[2 * 65], s[3 * 65]); o.z = cvt_pk_bf16(s[4 * 65], s[5 * 65]); o.w = cvt_pk_bf16(s[6 * 65], s[7 * 65]);
        const int dr = drow0 + n;
        __builtin_nontemporal_store(o, (u32x4*)(WT + ((size_t)(dr >> 8) * (ldt >> 6) + (k0 >> 6)) * (256 * 64) + (size_t)(dr & 255) * 64 + 8 * c)); }
    LDS_WAIT();
}
__device__ __forceinline__ void phase_prologue(Frame& F, const Args& a) {
    if (blockIdx.x < 96) {
        LAS float* cond = (LAS float*)F.lds;
        LAS float* red = (LAS float*)(F.lds + 16384);
        const float* c = a.in[IN_C];
        for (int i = F.tid; i < BATCH * D; i += NTHR) { const float x = c[i]; cond[i] = x * sigmoidf_(x); }
        __syncthreads();
        const int l = blockIdx.x / 24, n0 = (blockIdx.x % 24) * 256;
        const float* W = a.in[IN_WMOD] + (size_t)l * D * 6 * D + n0 + 4 * F.lane;
        f32x4 acc[4];
#pragma unroll
        for (int b = 0; b < 4; ++b) acc[b] = (f32x4){0.f, 0.f, 0.f, 0.f};
        const int kb = F.wave * 128;
#pragma unroll 8
        for (int k = 0; k < 128; ++k) { const f32x4 w = *(const f32x4*)(W + (size_t)(kb + k) * 6 * D);
#pragma unroll
            for (int b = 0; b < 4; ++b) acc[b] += w * cond[b * D + kb + k]; }
#pragma unroll
        for (int b = 0; b < 4; ++b) *(LAS f32x4*)(red + (F.wave * 4 + b) * 256 + 4 * F.lane) = acc[b];
        __syncthreads();
        float* MOD = (float*)(F.ws + WS_MOD);
        for (int o = F.tid; o < 1024; o += NTHR) { const int b = o >> 8, n = o & 255; float s = 0.f;
#pragma unroll
            for (int w = 0; w < 8; ++w) s += red[(w * 4 + b) * 256 + n];
            MOD[((size_t)l * BATCH + b) * 6 * D + n0 + n] = s + a.in[IN_BMOD][(size_t)l * 6 * D + n0 + n]; }
        __syncthreads();
    }
    { const int g = blockIdx.x * NTHR + F.tid; if (g < 2 * D) { const float lam = a.in[IN_LLAM][g]; const float z = -lam;
        const float sp = z > 20.f ? z : log1pf(__expf(z)); ((float*)(F.ws + WS_SP8))[g] = 8.0f * sp; } }
    { float* PAR = (float*)(F.ws + WS_PAR); const int g = blockIdx.x * NTHR + F.tid, GS = F.G * NTHR;
#define CPY(dst, src, n) for (int i = g; i < (n) / 4; i += GS) *(f32x4*)(PAR + (dst) + 4 * i) = *(const f32x4*)(a.in[src] + 4 * i)
      CPY(PAR_NMG, IN_NMG, 4 * 1024); CPY(PAR_NFG, IN_NFG, 4 * 1024); CPY(PAR_LCW, IN_LCW, 2 * 4 * 1024); CPY(PAR_LCB, IN_LCB, 2 * 1024); CPY(PAR_LBA, IN_LBA, 2 * 1024); CPY(PAR_LBX, IN_LBX, 2 * 1024);
      CPY(PAR_AQG, IN_AQG, 256); CPY(PAR_AKG, IN_AKG, 256); CPY(PAR_RW, IN_RW, 4 * 1024 * 32); CPY(PAR_RB, IN_RB, 128); CPY(PAR_BGU, IN_BGU, 4 * 32 * 2048); CPY(PAR_BDN, IN_BDN, 4 * 32 * 1024);
#undef CPY
    }
    LAS float* scr = (LAS float*)(F.lds + F.wave * 16640);
    const int gw = F.vcu * NWAVES + F.wave, NGW = F.G * NWAVES;
    constexpr int I0 = 128 * 512, I1 = 128 * 256, I2 = 2 * 512, I3 = 16 * 16, I4 = 2 * 256, I5 = 2 * 768, I6 = 2 * 256;
    constexpr int NITEMS = I0 + I1 + I2 + I3 + I4 + I5 + I6;
    for (int it = gw; it < NITEMS; it += NGW) {
        int r = it;
        if (r < I0) { const int mat = r >> 9, q = r & 511, kb = q >> 5, nb = q & 31, n0 = nb * 64;
            const int dr = n0 < D ? (n0 >> 7) * 256 + (n0 & 127) : ((n0 - D) >> 7) * 256 + 128 + ((n0 - D) & 127);
            cvt_tile(a.in[IN_WGU] + (size_t)mat * D * 2 * D, 2 * D, kb * 64, n0, (bf16_t*)(F.ws + WS_WGU) + (size_t)mat * 2 * D * D, D, dr, scr, F.lane); continue; } r -= I0;
        if (r < I1) { const int mat = r >> 8, q = r & 255, kb = q >> 4, nb = q & 15;
            cvt_tile(a.in[IN_WDN] + (size_t)mat * D * D, D, kb * 64, nb * 64, (bf16_t*)(F.ws + WS_WDN) + (size_t)mat * D * D, D, nb * 64, scr, F.lane); continue; } r -= I1;
        if (r < I2) { const int mat = r >> 9, q = r & 511, kb = q >> 5, nb = q & 31;
            cvt_tile(a.in[IN_LWIN] + (size_t)mat * D * 2 * D, 2 * D, kb * 64, nb * 64, (bf16_t*)(F.ws + WS_WIN) + (size_t)mat * 2 * D * D, D, nb * 64, scr, F.lane); continue; } r -= I2;
        if (r < I3) { const int mat = r >> 4, q = r & 15, kb = q >> 2, nb = q & 3;
            const int layer = mat >> 3, ax = (mat >> 2) & 1, g = mat & 3, n0 = nb * 64;
            const float* src = (ax ? a.in[IN_LWX] : a.in[IN_LWA]) + (size_t)(layer * 4 + g) * 256 * 256;
            const int dr = (g * 2 + (n0 >> 7)) * 256 + ax * 128 + (n0 & 127);
            cvt_tile(src, 256, kb * 64, n0, (bf16_t*)(F.ws + WS_WG) + (size_t)layer * 2048 * 256, 256, dr, scr, F.lane); continue; } r -= I3;
        if (r < I4) { const int mat = r >> 8, q = r & 255, kb = q >> 4, nb = q & 15;
            cvt_tile(a.in[IN_LWOUT] + (size_t)mat * D * D, D, kb * 64, nb * 64, (bf16_t*)(F.ws + WS_WLO) + (size_t)mat * D * D, D, nb * 64, scr, F.lane); continue; } r -= I4;
        if (r < I5) { const int mat = r / 768, q = r % 768, kb = q / 48, nb = q % 48;
            cvt_tile(a.in[IN_AQKV] + (size_t)mat * D * 3 * D, 3 * D, kb * 64, nb * 64, (bf16_t*)(F.ws + WS_WQKV) + (size_t)mat * 3 * D * D, D, nb * 64, scr, F.lane); continue; } r -= I5;
        { const int mat = r >> 8, q = r & 255, kb = q >> 4, nb = q & 15;
            cvt_tile(a.in[IN_AWOUT] + (size_t)mat * D * D, D, kb * 64, nb * 64, (bf16_t*)(F.ws + WS_WAO) + (size_t)mat * D * D, D, nb * 64, scr, F.lane); }
    }
}

__device__ __forceinline__ void phase_norm(Frame& F, const float* xin, int layer) {
    const float* PAR = (const float*)(F.ws + WS_PAR);
    const int gw = F.vcu * NWAVES + F.wave; const int m0 = gw * 8; const int b = m0 / SEQ;
    const float* MOD = (const float*)(F.ws + WS_MOD);
    const float* X = (layer == 0) ? xin : (const float*)(F.ws + WS_XB);
    f32x4 gain[4], sc[4], sh[4];
#pragma unroll
    for (int j = 0; j < 4; ++j) { const int c = 4 * F.lane + 256 * j;
        gain[j] = *(const f32x4*)(PAR + PAR_NMG + (size_t)layer * D + c);
        sh[j] = *(const f32x4*)(MOD + ((size_t)layer * BATCH + b) * 6 * D + c); sc[j] = *(const f32x4*)(MOD + ((size_t)layer * BATCH + b) * 6 * D + D + c);
        gain[j] = gain[j] * (1.0f + sc[j]); }
    bf16_t* H = (bf16_t*)(F.ws + WS_H);
#pragma unroll 2
    for (int r = 0; r < 8; ++r) { const int m = m0 + r;
        f32x4 x[4];
#pragma unroll
        for (int j = 0; j < 4; ++j) x[j] = *(const f32x4*)(X + (size_t)m * D + 4 * F.lane + 256 * j);
        float ss = 0.f;
#pragma unroll
        for (int j = 0; j < 4; ++j) ss += (x[j][0] * x[j][0] + x[j][1] * x[j][1]) + (x[j][2] * x[j][2] + x[j][3] * x[j][3]);
        const float rstd = __builtin_amdgcn_rsqf(wave_sum(ss) * (1.0f / D) + NORM_EPS);
#pragma unroll
        for (int j = 0; j < 4; ++j) { const int c = 4 * F.lane + 256 * j;
            const f32x4 h = x[j] * rstd * gain[j] + sh[j];
            u32x2 o; o.x = cvt_pk_bf16(h[0], h[1]); o.y = cvt_pk_bf16(h[2], h[3]); *(u32x2*)(H + (size_t)m * D + c) = o; }
    }
}

constexpr int MOE_TOK = T / TOPK;
__device__ __forceinline__ void phase_router(Frame& F, int layer) {
    constexpr int RPW = MOE_TOK / (256 * NWAVES * 2);
    const float* PAR = (const float*)(F.ws + WS_PAR);
    LAS float* rw = (LAS float*)F.lds;
    LAS unsigned* lcnt = (LAS unsigned*)(F.lds + LDS_X);
    LAS unsigned* lbase = lcnt + 32;
    LAS unsigned* pend = lcnt + 64;
    { const float* RW = PAR + PAR_RW + (size_t)layer * D * NE;
      for (int i = F.tid; i < D * NE / 4; i += NTHR) { const int col = i >> 3, ch = i & 7; const f32x4 v = *(const f32x4*)(RW + (size_t)i * 4);
          *(LAS f32x4*)(rw + col * 32 + ((ch ^ ((col >> 2) & 7)) << 2)) = v; }
      if (F.tid < 32) lcnt[F.tid] = 0u; }
    __syncthreads();
    const int gw = F.vcu * NWAVES + F.wave; const int m0 = gw * 2 * RPW; const int b = m0 / SEQ;
    const float* MOD = (const float*)(F.ws + WS_MOD);
    f32x4 gain[4], sc[4], sh[4];
#pragma unroll
    for (int j = 0; j < 4; ++j) { const int c = 4 * F.lane + 256 * j; gain[j] = *(const f32x4*)(PAR + PAR_NFG + (size_t)layer * D + c);
        sh[j] = *(const f32x4*)(MOD + ((size_t)layer * BATCH + b) * 6 * D + 3 * D + c); sc[j] = *(const f32x4*)(MOD + ((size_t)layer * BATCH + b) * 6 * D + 4 * D + c); }
    const float* XB = (const float*)(F.ws + WS_XB); bf16_t* H = (bf16_t*)(F.ws + WS_H);
    const float rbias = PAR[PAR_RB + layer * NE + (F.lane & 31)];
    const int sw = F.lane & 7;
    for (int rp = 0; rp < RPW; ++rp) {
        f32x4 h[2][4];
#pragma unroll
        for (int q = 0; q < 2; ++q) { const int m = m0 + rp * 2 + q;
            f32x4 x[4]; float ss = 0.f;
#pragma unroll
            for (int j = 0; j < 4; ++j) { x[j] = *(const f32x4*)(XB + (size_t)m * D + 4 * F.lane + 256 * j); ss += (x[j][0] * x[j][0] + x[j][1] * x[j][1]) + (x[j][2] * x[j][2] + x[j][3] * x[j][3]); }
            const float rstd = __builtin_amdgcn_rsqf(wave_sum(ss) * (1.0f / D) + NORM_EPS);
#pragma unroll
            for (int j = 0; j < 4; ++j) { h[q][j] = x[j] * rstd * gain[j] * (1.0f + sc[j]) + sh[j];
                u32x2 o; o.x = cvt_pk_bf16(h[q][j][0], h[q][j][1]); o.y = cvt_pk_bf16(h[q][j][2], h[q][j][3]); *(u32x2*)(H + (size_t)m * D + 4 * F.lane + 256 * j) = o; } }
        float v[64];
#pragma unroll
        for (int i = 0; i < 64; ++i) v[i] = 0.f;
#pragma unroll
        for (int j = 0; j < 4; ++j)
#pragma unroll
            for (int cc = 0; cc < 4; ++cc) { const int col = 4 * F.lane + 256 * j + cc; const LAS float* rp_ = rw + col * 32;
#pragma unroll
                for (int eq = 0; eq < 8; ++eq) { const f32x4 w = *(const LAS f32x4*)(rp_ + ((eq ^ sw) << 2));
#pragma unroll
                    for (int k = 0; k < 4; ++k) { v[eq * 4 + k] = fmaf(h[0][j][cc], w[k], v[eq * 4 + k]); v[32 + eq * 4 + k] = fmaf(h[1][j][cc], w[k], v[32 + eq * 4 + k]); } } }
#pragma unroll
        for (int i = 0; i < 32; ++i) { const bool up = (F.lane & 32) != 0; const float send = up ? v[i] : v[32 + i]; const float recv = __shfl_xor(send, 32); v[i] = (up ? v[32 + i] : v[i]) + recv; }
#pragma unroll
        for (int i = 0; i < 16; ++i) { const bool up = (F.lane & 16) != 0; const float send = up ? v[i] : v[16 + i]; const float recv = __shfl_xor(send, 16); v[i] = (up ? v[16 + i] : v[i]) + recv; }
#pragma unroll
        for (int i = 0; i < 8; ++i) { const bool up = (F.lane & 8) != 0; const float send = up ? v[i] : v[8 + i]; const float recv = __shfl_xor(send, 8); v[i] = (up ? v[8 + i] : v[i]) + recv; }
#pragma unroll
        for (int i = 0; i < 4; ++i) { const bool up = (F.lane & 4) != 0; const float send = up ? v[i] : v[4 + i]; const float recv = __shfl_xor(send, 4); v[i] = (up ? v[4 + i] : v[i]) + recv; }
#pragma unroll
        for (int i = 0; i < 2; ++i) { const bool up = (F.lane & 2) != 0; const float send = up ? v[i] : v[2 + i]; const float recv = __shfl_xor(send, 2); v[i] = (up ? v[2 + i] : v[i]) + recv; }
        { const bool up = (F.lane & 1) != 0; const float send = up ? v[0] : v[1]; const float recv = __shfl_xor(send, 1); v[0] = (up ? v[1] : v[0]) + recv; }
        float logit = v[0] + rbias;
        float tv[4]; int te[4];
#pragma unroll
        for (int k = 0; k < 4; ++k) { float bv = logit; int be = F.lane & 31;
#pragma unroll
            for (int o = 1; o < 32; o <<= 1) { const float ov = __shfl_xor(bv, o); const int oe = __shfl_xor(be, o); if (ov > bv || (ov == bv && oe < be)) { bv = ov; be = oe; } }
            tv[k] = bv; te[k] = be; if ((F.lane & 31) == be) logit = -__builtin_inff(); }
        const float e1 = __expf(tv[1] - tv[0]), e2 = __expf(tv[2] - tv[0]), e3 = __expf(tv[3] - tv[0]); const float inv = 1.0f / (1.0f + e1 + e2 + e3);
        const int kk = F.lane & 31;
        if (kk < 4) { const int e = kk == 0 ? te[0] : (kk == 1 ? te[1] : (kk == 2 ? te[2] : te[3]));
            const float w = (kk == 0 ? 1.0f : (kk == 1 ? e1 : (kk == 2 ? e2 : e3))) * inv;
            const unsigned rank = __hip_atomic_fetch_add(&lcnt[e], 1u, __ATOMIC_RELAXED, __HIP_MEMORY_SCOPE_WORKGROUP);
            const int rl = F.wave * 2 * RPW + rp * 2 + (F.lane >> 5);
            pend[(rl * 4 + kk) * 2 + 0] = (unsigned)e | (rank << 8); pend[(rl * 4 + kk) * 2 + 1] = __float_as_uint(w); }
    }
    __syncthreads();
    unsigned* gcnt = (unsigned*)(F.ws + WS_CTL) + CW_CNT + 64 * layer;
    if (F.tid < 32) lbase[F.tid] = __hip_atomic_fetch_add(gcnt + F.tid, lcnt[F.tid], __ATOMIC_RELAXED, __HIP_MEMORY_SCOPE_AGENT);
    __syncthreads();
    if (F.tid < NWAVES * 2 * RPW * 4) { const int rl = F.tid >> 2, k = F.tid & 3; const unsigned p0 = pend[(rl * 4 + k) * 2], p1 = pend[(rl * 4 + k) * 2 + 1];
        const unsigned e = p0 & 255u, rank = p0 >> 8; const unsigned pos = lbase[e] + rank; const unsigned tok = (unsigned)(F.vcu * NWAVES * 2 * RPW + rl);
        ((u32x2*)(F.ws + WS_ROWLIST))[(size_t)e * CAP + pos] = (u32x2){tok * 4u + (unsigned)k, p1}; }
}

__device__ __forceinline__ int moe_units(Frame& F, int layer, int npn) {
    LAS int* moe = (LAS int*)(F.lds + LDS_MOE);
    LAS int* units = (LAS int*)(F.lds + LDS_UNITS);
    if (F.wave == 0) {
        const unsigned* gcnt = (const unsigned*)(F.ws + WS_CTL) + CW_CNT + 64 * layer;
        const int e_ = F.lane & 31;
        const int cnt = (int)gcnt[e_]; const int ntl = (cnt + 255) >> 8;
        const int lastv = cnt - (ntl - 1) * 256;
        const int ntail = (ntl > 0 && lastv <= 128) ? 1 : 0, nfull = ntl - ntail;
        int incl = ntl, fincl = nfull, tincl = ntail;
#pragma unroll
        for (int o = 1; o < 32; o <<= 1) { const int t0 = __shfl_up(incl, o), t1 = __shfl_up(fincl, o), t2 = __shfl_up(tincl, o); if ((F.lane & 31) >= o) { incl += t0; fincl += t1; tincl += t2; } }
        const int start = incl - ntl, fstart = fincl - nfull, tstart = tincl - ntail; const int ts = __shfl(incl, 31), nf = __shfl(fincl, 31);
        const int c = blockIdx.x, xcd = c & 7, slot = c >> 3, rpx = 32 / npn;
        const int i = F.lane;
        const int p = (i * 8 + xcd) * rpx + slot / npn, pn = slot % npn;
        int e = 0, j = 0, st = 0, cn = 0;
        for (int q = 0; q < 32; ++q) { const int s_ = __shfl(start, q), c_ = __shfl(cnt, q), fs_ = __shfl(fstart, q), nf_ = __shfl(nfull, q), ts_ = __shfl(tstart, q), nt_ = __shfl(ntail, q), nl_ = __shfl(ntl, q);
            if (p < nf) { if (p >= fs_ && p < fs_ + nf_) { e = q; j = p - fs_; st = s_; cn = c_; } }
            else { const int pt = p - nf; if (pt >= ts_ && pt < ts_ + nt_) { e = q; j = nl_ - 1; st = s_; cn = c_; } } }
        const bool ok = (F.lane < 32) && (p < ts);
        const unsigned long long bal = __ballot(ok);
        if (ok) { int valid = cn - j * 256; valid = valid > 256 ? 256 : valid;
            units[i * 4 + 0] = st + j; units[i * 4 + 1] = pn; units[i * 4 + 2] = e | (j << 8); units[i * 4 + 3] = valid; }
        if (F.lane == 0) moe[40] = __popcll(bal);
    }
    __syncthreads();
    return __builtin_amdgcn_readfirstlane(moe[40]);
}

__device__ __forceinline__ void phase_conv(Frame& F, int j) {
    const float* PAR = (const float*)(F.ws + WS_PAR);
    const int g = F.vcu * NTHR + F.tid; const int chunk = g & 127, seg = g >> 7; const int c0 = chunk * 8, m0 = seg * 16; const int s0 = m0 & (SEQ - 1);
    const bf16_t* RB = (const bf16_t*)(F.ws + WS_RB); bf16_t* XC = (bf16_t*)(F.ws + WS_XC);
    float w[4][8], bias[8];
#pragma unroll
    for (int k = 0; k < 4; ++k) { const f32x4 w0 = *(const f32x4*)(PAR + PAR_LCW + ((size_t)j * 4 + k) * D + c0), w1 = *(const f32x4*)(PAR + PAR_LCW + ((size_t)j * 4 + k) * D + c0 + 4);
#pragma unroll
        for (int i = 0; i < 4; ++i) { w[k][i] = w0[i]; w[k][4 + i] = w1[i]; } }
    { const f32x4 b0 = *(const f32x4*)(PAR + PAR_LCB + (size_t)j * D + c0), b1 = *(const f32x4*)(PAR + PAR_LCB + (size_t)j * D + c0 + 4);
#pragma unroll
      for (int i = 0; i < 4; ++i) { bias[i] = b0[i]; bias[4 + i] = b1[i]; } }
    float x0[8], x1[8], x2[8];
#pragma unroll
    for (int i = 0; i < 8; ++i) { x0[i] = 0.f; x1[i] = 0.f; x2[i] = 0.f; }
    if (s0 != 0) {
        const u32x4 r0 = *(const u32x4*)(RB + (size_t)(m0 - 3) * D + c0), r1 = *(const u32x4*)(RB + (size_t)(m0 - 2) * D + c0), r2 = *(const u32x4*)(RB + (size_t)(m0 - 1) * D + c0);
#pragma unroll
        for (int i = 0; i < 4; ++i) { x0[2 * i] = bflo(r0[i]); x0[2 * i + 1] = bfhi(r0[i]); x1[2 * i] = bflo(r1[i]); x1[2 * i + 1] = bfhi(r1[i]); x2[2 * i] = bflo(r2[i]); x2[2 * i + 1] = bfhi(r2[i]); }
    }
#pragma unroll 4
    for (int t = 0; t < 16; ++t) {
        const u32x4 rr = *(const u32x4*)(RB + (size_t)(m0 + t) * D + c0);
        float x3[8], y[8];
#pragma unroll
        for (int i = 0; i < 4; ++i) { x3[2 * i] = bflo(rr[i]); x3[2 * i + 1] = bfhi(rr[i]); }
#pragma unroll
        for (int i = 0; i < 8; ++i) { y[i] = bias[i] + w[0][i] * x0[i] + w[1][i] * x1[i] + w[2][i] * x2[i] + w[3][i] * x3[i]; x0[i] = x1[i]; x1[i] = x2[i]; x2[i] = x3[i]; }
        u32x4 o; o.x = cvt_pk_bf16(y[0], y[1]); o.y = cvt_pk_bf16(y[2], y[3]); o.z = cvt_pk_bf16(y[4], y[5]); o.w = cvt_pk_bf16(y[6], y[7]);
        *(u32x4*)(XC + (size_t)(m0 + t) * D + c0) = o;
    }
}
__device__ __forceinline__ void phase_scan1(Frame& F) {
    const int item = F.vcu; const int m0 = item * 64; const int ch = 2 * F.tid;
    const bf16_t* LA = (const bf16_t*)(F.ws + WS_AF); const bf16_t* UB = (const bf16_t*)(F.ws + WS_UF);
    float h0 = 0.f, h1 = 0.f, s0 = 0.f, s1 = 0.f;
#pragma unroll 16
    for (int t = 0; t < 64; ++t) { const unsigned lw = *(const unsigned*)(LA + (size_t)(m0 + t) * D + ch), uw = *(const unsigned*)(UB + (size_t)(m0 + t) * D + ch);
        const float l0 = bflo(lw), l1 = bfhi(lw);
        h0 = __builtin_amdgcn_exp2f(l0) * h0 + bflo(uw); h1 = __builtin_amdgcn_exp2f(l1) * h1 + bfhi(uw); s0 += l0; s1 += l1; }
    float* PS = (float*)(F.ws + WS_PS);
    *(f32x4*)(PS + ((size_t)item * D + ch) * 2) = (f32x4){__builtin_amdgcn_exp2f(s0), h0, __builtin_amdgcn_exp2f(s1), h1};
}
__device__ __forceinline__ void phase_scan2(Frame& F) {
    const int item = F.vcu; const int m0 = item * 64; const int ch = 2 * F.tid; const int c = item & 63, b = item >> 6;
    const bf16_t* LA = (const bf16_t*)(F.ws + WS_AF); const bf16_t* UB = (const bf16_t*)(F.ws + WS_UF);
    const float* PS = (const float*)(F.ws + WS_PS); const bf16_t* GB = (const bf16_t*)(F.ws + WS_GB); bf16_t* YB = (bf16_t*)(F.ws + WS_YB);
    float h0 = 0.f, h1 = 0.f;
#pragma unroll 32
    for (int jj = 0; jj < c; ++jj) { const f32x4 s = *(const f32x4*)(PS + ((size_t)(b * 64 + jj) * D + ch) * 2); h0 = s[0] * h0 + s[1]; h1 = s[2] * h1 + s[3]; }
#pragma unroll 16
    for (int t = 0; t < 64; ++t) { const unsigned lw = *(const unsigned*)(LA + (size_t)(m0 + t) * D + ch), uw = *(const unsigned*)(UB + (size_t)(m0 + t) * D + ch);
        const unsigned gw_ = *(const unsigned*)(GB + (size_t)(m0 + t) * D + ch);
        h0 = __builtin_amdgcn_exp2f(bflo(lw)) * h0 + bflo(uw); h1 = __builtin_amdgcn_exp2f(bfhi(lw)) * h1 + bfhi(uw);
        *(unsigned*)(YB + (size_t)(m0 + t) * D + ch) = cvt_pk_bf16(bflo(gw_) * h0, bfhi(gw_) * h1); }
}

__device__ __forceinline__ void phase_qknorm(Frame& F, int j) {
    const float* PAR = (const float*)(F.ws + WS_PAR);
    bf16_t* Q = (bf16_t*)(F.ws + WS_Q); bf16_t* Kb = (bf16_t*)(F.ws + WS_K); float* KM = (float*)(F.ws + WS_KMEAN);
    LAS float* red = (LAS float*)F.lds;
    const int rr = F.lane >> 4, cq = F.lane & 15;
    f32x4 qg0 = *(const f32x4*)(PAR + PAR_AQG + (size_t)j * HD + cq * 8), qg1 = *(const f32x4*)(PAR + PAR_AQG + (size_t)j * HD + cq * 8 + 4);
    f32x4 kg0 = *(const f32x4*)(PAR + PAR_AKG + (size_t)j * HD + cq * 8), kg1 = *(const f32x4*)(PAR + PAR_AKG + (size_t)j * HD + cq * 8 + 4);
    for (int it = F.vcu; it < BATCH * NBLK * NH; it += F.G) {
        const int h = it & 7, blk = (it >> 3) & 15, b = it >> 7;
        const size_t base = ((size_t)(b * SEQ + blk * MBLK + F.wave * 32)) * D + h * HD + cq * 8;
        float ks[8];
#pragma unroll
        for (int i = 0; i < 8; ++i) ks[i] = 0.f;
#pragma unroll 2
        for (int i = 0; i < 8; ++i) { const size_t off = base + (size_t)(i * 4 + rr) * D;
            const u32x4 qw = *(const u32x4*)(Q + off), kw = *(const u32x4*)(Kb + off);
            float qv[8], kv[8]; float sq = 0.f, sk = 0.f;
#pragma unroll
            for (int e = 0; e < 4; ++e) { qv[2 * e] = bflo(qw[e]); qv[2 * e + 1] = bfhi(qw[e]); kv[2 * e] = bflo(kw[e]); kv[2 * e + 1] = bfhi(kw[e]); }
#pragma unroll
            for (int e = 0; e < 8; ++e) { sq += qv[e] * qv[e]; sk += kv[e] * kv[e]; }
#pragma unroll
            for (int o = 1; o < 16; o <<= 1) { sq += __shfl_xor(sq, o); sk += __shfl_xor(sk, o); }
            const float rq = __builtin_amdgcn_rsqf(sq * (1.0f / HD) + NORM_EPS), rk = __builtin_amdgcn_rsqf(sk * (1.0f / HD) + NORM_EPS);
#pragma unroll
            for (int e = 0; e < 8; ++e) { qv[e] = qv[e] * rq * (e < 4 ? qg0[e & 3] : qg1[e & 3]); kv[e] = kv[e] * rk * (e < 4 ? kg0[e & 3] : kg1[e & 3]); ks[e] += kv[e]; }
            u32x4 qo, ko;
#pragma unroll
            for (int e = 0; e < 4; ++e) { qo[e] = cvt_pk_bf16(qv[2 * e], qv[2 * e + 1]); ko[e] = cvt_pk_bf16(kv[2 * e], kv[2 * e + 1]); }
            *(u32x4*)(Q + off) = qo; *(u32x4*)(Kb + off) = ko; }
#pragma unroll
        for (int e = 0; e < 8; ++e) { ks[e] += __shfl_xor(ks[e], 16); ks[e] += __shfl_xor(ks[e], 32); }
        __syncthreads();
        if (F.lane < 16) {
#pragma unroll
            for (int e = 0; e < 8; ++e) red[F.wave * 128 + cq * 8 + e] = ks[e]; }
        __syncthreads();
        if (F.tid < 128) { float s = 0.f;
#pragma unroll
            for (int w = 0; w < 8; ++w) s += red[w * 128 + F.tid];
            KM[(((size_t)b * NH + h) * NBLK + blk) * HD + F.tid] = s * (1.0f / MBLK); }
    }
}
__device__ __forceinline__ void phase_gate(Frame& F) {
    const bf16_t* Q = (const bf16_t*)(F.ws + WS_Q); const float* KM = (const float*)(F.ws + WS_KMEAN); unsigned* SEL = (unsigned*)(F.ws + WS_SEL);
    LAS float* km = (LAS float*)F.lds;
    const int it = F.vcu; const int s8 = it & 7, h = (it >> 3) & 7, b = it >> 6;
    for (int i = F.tid; i < NBLK * HD / 4; i += NTHR) *(LAS f32x4*)(km + 4 * i) = *(const f32x4*)(KM + ((size_t)b * NH + h) * NBLK * HD + 4 * i);
    __syncthreads();
    const int s = s8 * 512 + F.tid; const int qb = __builtin_amdgcn_readfirstlane(s >> 8);
    u32x4 qw[16];
    const bf16_t* qp = Q + ((size_t)(b * SEQ + s)) * D + h * HD;
#pragma unroll
    for (int i = 0; i < 16; ++i) qw[i] = *(const u32x4*)(qp + 8 * i);
    float v1 = -__builtin_inff(), v2 = v1, v3 = v1; int i1 = -1, i2 = -1, i3 = -1;
    for (int n = 0; n < qb; ++n) { float sc = 0.f;
#pragma unroll
        for (int i = 0; i < 16; ++i) { const f32x4 k0 = *(const LAS f32x4*)(km + n * HD + 8 * i), k1 = *(const LAS f32x4*)(km + n * HD + 8 * i + 4);
            sc += bflo(qw[i][0]) * k0[0] + bfhi(qw[i][0]) * k0[1] + bflo(qw[i][1]) * k0[2] + bfhi(qw[i][1]) * k0[3]
                + bflo(qw[i][2]) * k1[0] + bfhi(qw[i][2]) * k1[1] + bflo(qw[i][3]) * k1[2] + bfhi(qw[i][3]) * k1[3]; }
        if (sc > v1) { v3 = v2; i3 = i2; v2 = v1; i2 = i1; v1 = sc; i1 = n; }
        else if (sc > v2) { v3 = v2; i3 = i2; v2 = sc; i2 = n; }
        else if (sc > v3) { v3 = sc; i3 = n; } }
    unsigned m = 0u; if (i1 >= 0) m |= 1u << i1; if (i2 >= 0) m |= 1u << i2; if (i3 >= 0) m |= 1u << i3;
    SEL[((size_t)b * NH + h) * SEQ + s] = m;
}
__device__ __forceinline__ att::BlockRef att_ref(Frame& F, int L, int pass) {
    const int bh = L >> 3, x = L & 7; const int qb = pass ? 15 - x : x; const int b = bh >> 3, h = bh & 7;
    att::BlockRef r; const size_t ro = ((size_t)(b * SEQ + qb * MBLK)) * D + h * HD;
    r.Q = (const bf16_t*)(F.ws + WS_Q) + ro; r.O = (bf16_t*)(F.ws + WS_YB) + ro;
    r.K = (const bf16_t*)(F.ws + WS_K) + (size_t)(b * SEQ) * D + h * HD; r.V = (const bf16_t*)(F.ws + WS_V) + (size_t)(b * SEQ) * D + h * HD;
    r.qb = qb; return r;
}
__device__ __forceinline__ void phase_attn(Frame& F, char* lds) {
    const int total = BATCH * NH * 8, stride = F.G;
    int L = F.vcu; if (L >= total) return;
    int pass = 0;
    att::BlockRef cur = att_ref(F, L, 0);
    att::Seam S;
    att::moba_prime(cur, lds, S, F.tid);
    for (;;) {
        if (pass == 0) {
            const float* KM = (const float*)(F.ws + WS_KMEAN) + (size_t)(L >> 3) * NBLK * HD;
            int t2 = F.tid; asm volatile("" : "+v"(t2));
            *(f32x4*)(lds + att::KM_OFF + t2 * 16) = *(const f32x4*)(KM + t2 * 4);
            __syncthreads(); }
        const bool more_pass = pass == 0, more_item = L + stride < total, last = !more_pass && !more_item;
        int passn = pass + 1, Ln = L;
        if (!more_pass) { passn = 0; Ln = more_item ? L + stride : L; }
        const att::BlockRef nxt = last ? cur : att_ref(F, Ln, passn);
        att::moba_block(cur, nxt, lds, S, F.tid);
        if (last) break;
        cur = nxt; pass = passn; L = Ln;
    }
}

constexpr int NPH = 42;
__global__ void __launch_bounds__(NTHR, 2) fwd(Args args) {
    extern __shared__ __attribute__((aligned(16))) unsigned char lds_[];
    Frame F;
    F.lds = (LAS unsigned char*)lds_; F.ws = args.ws;
    F.tid = threadIdx.x; F.lane = F.tid & 63; F.wave = __builtin_amdgcn_readfirstlane(F.tid >> 6);
    F.G = gridDim.x; { const int bx = blockIdx.x; F.vcu = (F.G % 8 == 0) ? (bx % 8) * (F.G / 8) + bx / 8 : bx; }
    volatile LAS unsigned* MISC = (volatile LAS unsigned*)(F.lds + LDS_MISC);
    if (F.tid < 64) MISC[F.tid] = 0u;
    __syncthreads();
#ifdef PROBE_ORD
    if (F.tid == 0) *(volatile LAS unsigned long long*)(MISC + 14) = __builtin_amdgcn_s_memrealtime();
    __syncthreads();
#endif
    const int lo = args.ph_lo, hi = args.ph_hi;
    unsigned* ctl = (unsigned*)(F.ws + WS_CTL);
    XcdBarrier bar; bar.bar = ctl + CW_BAR + args.li * XCD_BAR_WORDS; bar.x = 0; bar.st = nullptr;
    if (hi - lo > 1) bar = xcd_barrier_post(ctl + CW_BAR + args.li * XCD_BAR_WORDS, MISC + 8);
#ifdef ONLY
#define EN(code) ((code) == ONLY)
#else
#define EN(code) true
#endif
#define IN(k) (lo <= (k) && (k) < hi)
#ifdef PROBE_ORD
#define SEAM(k) do { if (IN(k) && IN((k) + 1)) { xcd_barrier(bar); if (threadIdx.x == 0) { const unsigned n_ = MISC[12] + 1u; MISC[12] = n_; if (n_ == PROBE_ORD) { while (__builtin_amdgcn_s_memrealtime() - *(volatile LAS unsigned long long*)(MISC + 14) < (unsigned long long)(PROBE_US) * 100ull) __builtin_amdgcn_s_sleep(20); } } __syncthreads(); } } while (0)
#else
#define SEAM(k) do { if (IN(k) && IN((k) + 1)) xcd_barrier(bar); } while (0)
#endif
#ifdef PROBE_CODE
#define REPS(code) ((code) == PROBE_CODE ? 1 + PROBE_EXTRA : 1)
#else
#define REPS(code) 1
#endif
#define PF() Frame Fp = F; asm volatile("" : "+v"(Fp.tid)); Fp.lane = Fp.tid & 63
    LAS unsigned* tab = (LAS unsigned*)(F.lds + LDS_TAB);
    const float* xin = args.in[IN_X]; float* out = args.out; const float* PAR = (const float*)(F.ws + WS_PAR);

    if (EN(0) && IN(0)) { for (int rep_ = 0; rep_ < REPS(0); ++rep_) { if (rep_) __syncthreads(); PF(); phase_prologue(Fp, args); } } SEAM(0);

#pragma nounroll
    for (int l = 0; l < DEPTH; ++l) {
        const int pb = 1 + 10 * l; const int j = l >> 1; const bool lru = (l & 1) == 0;
        if (EN(10) && IN(pb + 0)) { for (int rep_ = 0; rep_ < REPS(10); ++rep_) { if (rep_) __syncthreads(); PF(); phase_norm(Fp, xin, l); } } SEAM(pb + 0);
        if (lru) {
            if (EN(21) && IN(pb + 1)) { for (int rep_ = 0; rep_ < REPS(21); ++rep_) { if (rep_) __syncthreads(); pg8::ProbPlain P; P.init((const bf16_t*)(F.ws + WS_H), (const bf16_t*)(F.ws + WS_WIN) + (size_t)j * 2 * D * D, T, 2 * D, D, D, -1, F.G, (int)blockIdx.x);
                pg8::EpiWin E{(bf16_t*)(F.ws + WS_GB), (bf16_t*)(F.ws + WS_RB)};
                pg8::gemm_phase<pg8::EpiWin, pg8::ProbPlain, true, true>(F.lds, tab, P, E); } } SEAM(pb + 1);
            if (EN(22) && IN(pb + 2)) { for (int rep_ = 0; rep_ < REPS(22); ++rep_) { if (rep_) __syncthreads(); PF(); phase_conv(Fp, j); } } SEAM(pb + 2);
            if (EN(23) && IN(pb + 3)) { for (int rep_ = 0; rep_ < REPS(23); ++rep_) { if (rep_) __syncthreads(); pg8::ProbPlain P; P.init((const bf16_t*)(F.ws + WS_XC), (const bf16_t*)(F.ws + WS_WG) + (size_t)j * 2048 * 256, T, 2 * D, 256, D, 1, F.G, (int)blockIdx.x);
                pg8::EpiGates E{(const bf16_t*)(F.ws + WS_XC), (bf16_t*)(F.ws + WS_AF), (bf16_t*)(F.ws + WS_UF), PAR + PAR_LBA + (size_t)j * D, PAR + PAR_LBX + (size_t)j * D, (const float*)(F.ws + WS_SP8) + (size_t)j * D};
                pg8::gemm_phase<pg8::EpiGates, pg8::ProbPlain, true, true>(F.lds, tab, P, E); } } SEAM(pb + 3);
            if (EN(24) && IN(pb + 4)) { for (int rep_ = 0; rep_ < REPS(24); ++rep_) { if (rep_) __syncthreads(); PF(); phase_scan1(Fp); } } SEAM(pb + 4);
            if (EN(25) && IN(pb + 5)) { for (int rep_ = 0; rep_ < REPS(25); ++rep_) { if (rep_) __syncthreads(); PF(); phase_scan2(Fp); } } SEAM(pb + 5);
        } else {
            if (EN(31) && IN(pb + 1)) { for (int rep_ = 0; rep_ < REPS(31); ++rep_) { if (rep_) __syncthreads(); pg8::ProbPlain P; P.init((const bf16_t*)(F.ws + WS_H), (const bf16_t*)(F.ws + WS_WQKV) + (size_t)j * 3 * D * D, T, 3 * D, D, D, -1, F.G, (int)blockIdx.x);
                pg8::EpiQKV E{(bf16_t*)(F.ws + WS_Q), PAR + PAR_AQG + (size_t)j * HD, PAR + PAR_AKG + (size_t)j * HD, (float*)(F.ws + WS_KMEAN), (LAS float*)(F.lds + LDS_X)};
                pg8::gemm_phase<pg8::EpiQKV, pg8::ProbPlain, true, true>(F.lds, tab, P, E); } } SEAM(pb + 1);
            if (EN(34) && IN(pb + 4)) { for (int rep_ = 0; rep_ < REPS(34); ++rep_) { if (rep_) __syncthreads(); PF(); phase_attn(Fp, (char*)lds_); } } SEAM(pb + 4);
        }
        if (EN(16) && IN(pb + 6)) { for (int rep_ = 0; rep_ < REPS(16); ++rep_) { if (rep_) __syncthreads(); pg8::ProbPlain P; P.init((const bf16_t*)(F.ws + WS_YB), (const bf16_t*)(F.ws + (lru ? WS_WLO : WS_WAO)) + (size_t)j * D * D, T, D, D, D, -1, F.G, (int)blockIdx.x);
            pg8::EpiResid E{l == 0 ? xin : (const float*)(F.ws + WS_XB), (float*)(F.ws + WS_XB), (const float*)(F.ws + WS_MOD) + (size_t)l * BATCH * 6 * D + 2 * D};
            pg8::gemm_phase<pg8::EpiResid, pg8::ProbPlain, false, true>(F.lds, tab, P, E); } } SEAM(pb + 6);
        if (EN(17) && IN(pb + 7)) { PF(); phase_router(Fp, l); } SEAM(pb + 7);
        if (EN(18) && IN(pb + 8)) { for (int rep_ = 0; rep_ < REPS(18); ++rep_) { if (rep_) __syncthreads(); PF(); const int nu = moe_units(Fp, l, 8);
            pg8::ProbMoE<true> P; P.A = (const bf16_t*)(F.ws + WS_H); P.Bt = (const bf16_t*)(F.ws + WS_WGU) + (size_t)l * NE * 2 * D * D; P.K = D; P.lda = D; P.bstride = (size_t)2 * D * D;
            P.rowlist = (const unsigned*)(F.ws + WS_ROWLIST); P.units = (const LAS int*)(F.lds + LDS_UNITS); P.nunits = nu;
            pg8::EpiSwiglu E{(bf16_t*)(F.ws + WS_ACT), PAR + PAR_BGU + (size_t)l * NE * 2 * D};
            pg8::gemm_phase<pg8::EpiSwiglu, pg8::ProbMoE<true>, true, true>(F.lds, tab, P, E); } } SEAM(pb + 8);
        if (EN(19) && IN(pb + 9)) { for (int rep_ = 0; rep_ < REPS(19); ++rep_) { if (rep_) __syncthreads(); PF(); const int nu = moe_units(Fp, l, 4);
            pg8::ProbMoE<false> P; P.A = (const bf16_t*)(F.ws + WS_ACT); P.Bt = (const bf16_t*)(F.ws + WS_WDN) + (size_t)l * NE * D * D; P.K = D; P.lda = D; P.bstride = (size_t)D * D;
            P.rowlist = (const unsigned*)(F.ws + WS_ROWLIST); P.units = (const LAS int*)(F.lds + LDS_UNITS); P.nunits = nu;
            pg8::EpiDown E{(const float*)(F.ws + WS_XB), l == DEPTH - 1 ? out : (float*)(F.ws + WS_XB), (const float*)(F.ws + WS_MOD) + (size_t)l * BATCH * 6 * D + 5 * D, PAR + PAR_BDN + (size_t)l * NE * D, (const unsigned*)(F.ws + WS_ROWLIST)};
            pg8::gemm_phase<pg8::EpiDown, pg8::ProbMoE<false>, true, true>(F.lds, tab, P, E); } } SEAM(pb + 9);
    }
#undef IN
#undef SEAM
#undef EN
}

#ifndef DEBUG_CHECKS
#define DEBUG_CHECKS 0
#endif
#ifndef CHK_FROM
#define CHK_FROM 0
#endif
#if DEBUG_CHECKS
constexpr int CW_CHK = 70000;
__device__ __forceinline__ unsigned hsh(unsigned x) { x ^= x >> 16; x *= 0x7feb352du; x ^= x >> 15; x *= 0x846ca68bu; x ^= x >> 16; return x; }
__device__ __forceinline__ bool cls(float got, float ref, float rt, float at) { return (fabsf(got - ref) <= rt * fabsf(ref) + at); }
__device__ __forceinline__ float bfq(const bf16_t* p, size_t i) { return __uint_as_float(((unsigned)p[i]) << 16); }
__device__ __forceinline__ float gelu_ref(float x) { return 0.5f * x * (1.0f + tanhf(0.7978845608028654f * (x + 0.044715f * x * x * x))); }
__global__ void __launch_bounds__(64) chk(Args a, int id, int l, int code) {
    const int j = l >> 1;
    unsigned char* ws = a.ws; unsigned* ctl = (unsigned*)(ws + WS_CTL); const int lane = threadIdx.x;
    const float* MOD = (const float*)(ws + WS_MOD); const float* PAR = (const float*)(ws + WS_PAR);
    const bf16_t* H = (const bf16_t*)(ws + WS_H);
    bool bad = false;
    for (int it = 0; it < 8; ++it) {
        const unsigned sd = hsh(blockIdx.x * 131u + it * 7919u + id * 104729u + 12345u);
        if (id == 1) {
            const int l = sd & 3, b = (sd >> 2) & 3, n = (sd >> 4) % (6 * D); float s = 0.f;
            for (int k = lane; k < D; k += 64) { const float c = a.in[IN_C][b * D + k]; s += (c / (1.0f + expf(-c))) * a.in[IN_WMOD][((size_t)l * D + k) * 6 * D + n]; }
            s = wave_sum(s) + a.in[IN_BMOD][l * 6 * D + n];
            if (!cls(MOD[((size_t)l * BATCH + b) * 6 * D + n], s, 1e-3f, 1e-3f)) bad = true;
        } else if (id == 2) {
            const int m = sd % T, b = m / SEQ; float ss = 0.f;
            for (int k = lane; k < D; k += 64) { const float x = a.in[IN_X][(size_t)m * D + k]; ss += x * x; }
            const float rstd = 1.0f / sqrtf(wave_sum(ss) / D + NORM_EPS);
            for (int k = lane; k < D; k += 64) { const float x = a.in[IN_X][(size_t)m * D + k];
                const float h = x * rstd * a.in[IN_NMG][k] * (1.0f + MOD[(size_t)b * 6 * D + D + k]) + MOD[(size_t)b * 6 * D + k];
                if (!cls(bfq(H, (size_t)m * D + k), h, 0.01f, 0.01f)) bad = true; }
        } else if (id == 3) {
            const int m = sd % T, n = (sd >> 14) % (2 * D); float s = 0.f;
            for (int k = lane; k < D; k += 64) s += bfq(H, (size_t)m * D + k) * a.in[IN_LWIN][((size_t)j * D + k) * 2 * D + n];
            s = wave_sum(s);
            const float got = n < D ? bfq((const bf16_t*)(ws + WS_GB), (size_t)m * D + n) : bfq((const bf16_t*)(ws + WS_RB), (size_t)m * D + n - D);
            const float ref = n < D ? gelu_ref(s) : s;
            if (!cls(got, ref, 0.02f, 0.02f)) bad = true;
        } else if (id == 4) {
            const int m = sd % T, c = (sd >> 14) % D, s0 = m % SEQ; const bf16_t* RB = (const bf16_t*)(ws + WS_RB);
            float y = a.in[IN_LCB][j * D + c];
            for (int k = 0; k < 4; ++k) { const int t = s0 - 3 + k; if (t >= 0) y += a.in[IN_LCW][(j * 4 + k) * D + c] * bfq(RB, (size_t)(m - 3 + k) * D + c); }
            if (!cls(bfq((const bf16_t*)(ws + WS_XC), (size_t)m * D + c), y, 0.01f, 0.01f)) bad = true;
        } else if (id == 5) {
            const int m = sd % T, ch = (sd >> 14) % D, g = ch >> 8, jc = ch & 255; const bf16_t* XC = (const bf16_t*)(ws + WS_XC);
            float sa = 0.f, sx = 0.f;
            for (int i = lane; i < 256; i += 64) { const float xv = bfq(XC, (size_t)m * D + g * 256 + i); sa += xv * a.in[IN_LWA][((size_t)(j * 4 + g) * 256 + i) * 256 + jc]; sx += xv * a.in[IN_LWX][((size_t)(j * 4 + g) * 256 + i) * 256 + jc]; }
            sa = wave_sum(sa) + a.in[IN_LBA][j * D + ch]; sx = wave_sum(sx) + a.in[IN_LBX][j * D + ch];
            const float r = 1.0f / (1.0f + expf(-sa)), ig = 1.0f / (1.0f + expf(-sx)); const float lam = a.in[IN_LLAM][j * D + ch];
            const float la = -8.0f * r * log1pf(expf(-lam)); const float av = expf(la), uv = sqrtf(-expm1f(2.0f * la)) * ig * bfq(XC, (size_t)m * D + ch);
            if (!cls(((const float*)(ws + WS_AF))[(size_t)m * D + ch], av, 2e-3f, 1e-4f)) bad = true;
            if (!cls(((const float*)(ws + WS_UF))[(size_t)m * D + ch], uv, 0.03f, 0.003f)) bad = true;
        } else if (id == 6) {
            const int b = sd & 3, ch = ((sd >> 2) + lane * 17) % D; const float* AF = (const float*)(ws + WS_AF); const float* UF = (const float*)(ws + WS_UF);
            const bf16_t* GB = (const bf16_t*)(ws + WS_GB); const bf16_t* YB = (const bf16_t*)(ws + WS_YB);
            float h = 0.f;
            for (int t = 0; t < SEQ; ++t) { const size_t o = ((size_t)b * SEQ + t) * D + ch; h = AF[o] * h + UF[o];
                if ((t & 127) == 77 || t == SEQ - 1 || t == 0 || t == 64) { if (!cls(bfq(YB, o), bfq(GB, o) * h, 0.02f, 0.01f)) bad = true; } }
        } else if (id == 7) {
            const int m = sd % T, n = (sd >> 14) % D, b = m / SEQ; float s = 0.f; const bf16_t* YB = (const bf16_t*)(ws + WS_YB);
            for (int k = lane; k < D; k += 64) s += bfq(YB, (size_t)m * D + k) * a.in[IN_LWOUT][((size_t)j * D + k) * D + n];
            s = wave_sum(s);
            const float ref = (l == 0 ? a.in[IN_X][(size_t)m * D + n] : ((const float*)(ws + WS_XA))[(size_t)m * D + n]) + MOD[((size_t)l * BATCH + b) * 6 * D + 2 * D + n] * s;
            if (!cls(((const float*)(ws + WS_XB))[(size_t)m * D + n], ref, 0.01f, 0.01f)) bad = true;
        } else if (id == 8) {
            __shared__ float hrow[D];
            const int m = sd % MOE_TOK, b = m / SEQ; const float* XB = (const float*)(ws + WS_XB); float ss = 0.f;
            for (int k = lane; k < D; k += 64) { const float x = XB[(size_t)m * D + k]; ss += x * x; }
            const float rstd = 1.0f / sqrtf(wave_sum(ss) / D + NORM_EPS);
            __syncthreads();
            for (int k = lane; k < D; k += 64) { const float x = XB[(size_t)m * D + k];
                const float h = x * rstd * a.in[IN_NFG][l * D + k] * (1.0f + MOD[((size_t)l * BATCH + b) * 6 * D + 4 * D + k]) + MOD[((size_t)l * BATCH + b) * 6 * D + 3 * D + k]; hrow[k] = h;
                if (!cls(bfq(H, (size_t)m * D + k), h, 0.01f, 0.01f)) bad = true; }
            __syncthreads();
            const int e = lane & 31; float lg = a.in[IN_RB][l * NE + e];
            for (int k = 0; k < D; ++k) lg += hrow[k] * a.in[IN_RW][((size_t)l * D + k) * NE + e];
            int rank = 0; float mx = -1e30f;
            for (int q = 0; q < 32; ++q) { const float o = __shfl(lg, q); if (o > lg || (o == lg && q < e)) ++rank; mx = fmaxf(mx, o); }
            const bool sel = rank < 4; float den = 0.f;
            for (int q = 0; q < 32; ++q) { const float o = __shfl(lg, q); const int rk = __shfl(rank, q); if (rk < 4) den += expf(o - mx); }
            const float wref = expf(lg - mx) / den;
            float v4 = 0.f, v5 = 0.f; for (int q = 0; q < 32; ++q) { const float o = __shfl(lg, q); const int rk = __shfl(rank, q); if (rk == 3) v4 = o; if (rk == 4) v5 = o; }
            const unsigned* gcnt = ctl + CW_CNT + 64 * l; const unsigned* RL = (const unsigned*)(ws + WS_ROWLIST); const float* TW = (const float*)(ws + WS_TOPW);
            if (v4 - v5 > 1e-3f && lane < 32) {
                const int cnt = (int)gcnt[e]; int found = -1;
                for (int p = 0; p < cnt; ++p) { const unsigned r = RL[(size_t)e * CAP + p]; if ((int)(r >> 2) == m) found = (int)r; }
                if (sel) { if (found < 0) bad = true; else if (!cls(TW[found], wref, 0.01f, 1e-3f)) bad = true; }
                else if (found >= 0) bad = true;
            }
            unsigned tot = 0; for (int q = 0; q < 32; ++q) tot += gcnt[q]; if (tot != (unsigned)T) bad = true;
        } else if (id == 9 || id == 10) {
            const unsigned* gcnt = ctl + CW_CNT + 64 * l; const unsigned* RL = (const unsigned*)(ws + WS_ROWLIST); const float* TW = (const float*)(ws + WS_TOPW);
            const int e = sd & 31; int ts = 0; for (int q = 0; q < e; ++q) ts += ((int)gcnt[q] + 255) >> 8;
            const int cnt = (int)gcnt[e]; if (cnt == 0) continue;
            const int pos = (sd >> 5) % cnt; const unsigned dest = RL[(size_t)e * CAP + pos]; const int tok = dest >> 2; const size_t arow = (size_t)ts * 256 + pos;
            const int col = (sd >> 17) % D; const bf16_t* ACT = (const bf16_t*)(ws + WS_ACT);
            if (id == 9) { float sg = 0.f, su = 0.f;
                for (int k = lane; k < D; k += 64) { const float hv = bfq(H, (size_t)tok * D + k); sg += hv * a.in[IN_WGU][((size_t)(l * NE + e) * D + k) * 2 * D + col]; su += hv * a.in[IN_WGU][((size_t)(l * NE + e) * D + k) * 2 * D + D + col]; }
                sg = wave_sum(sg) + a.in[IN_BGU][(size_t)(l * NE + e) * 2 * D + col]; su = wave_sum(su) + a.in[IN_BGU][(size_t)(l * NE + e) * 2 * D + D + col];
                const float gv = fminf(sg, 7.f), uv = fminf(fmaxf(su, -7.f), 7.f); const float ref = gv / (1.0f + expf(-1.702f * gv)) * (uv + 1.0f);
                if (!cls(bfq(ACT, arow * D + col), ref, 0.03f, 0.02f)) bad = true;
            } else { float s = 0.f;
                for (int k = lane; k < D; k += 64) s += bfq(ACT, arow * D + k) * a.in[IN_WDN][((size_t)(l * NE + e) * D + k) * D + col];
                s = (wave_sum(s) + a.in[IN_BDN][(size_t)(l * NE + e) * D + col]) * TW[dest];
                if (!cls(bfq((const bf16_t*)(ws + WS_YK), (size_t)dest * D + col), s, 0.03f, 0.01f)) bad = true; }
        } else if (id == 11) {
            const int m = sd % T, h = (sd >> 14) & 7, which = (sd >> 17) % 3; float r0 = 0.f, r1 = 0.f;
            for (int k = 0; k < D; ++k) { const float hv = bfq(H, (size_t)m * D + k); const float* w = a.in[IN_AQKV] + ((size_t)j * D + k) * 3 * D + which * D + h * HD; r0 += hv * w[lane]; r1 += hv * w[lane + 64]; }
            const bf16_t* buf = (const bf16_t*)(ws + (which == 0 ? WS_Q : (which == 1 ? WS_K : WS_V)));
            const float g0 = bfq(buf, (size_t)m * D + h * HD + lane), g1 = bfq(buf, (size_t)m * D + h * HD + lane + 64);
            if (which == 2) { if (!cls(g0, r0, 0.02f, 0.02f) || !cls(g1, r1, 0.02f, 0.02f)) bad = true; }
            else { const float rs = 1.0f / sqrtf(wave_sum(r0 * r0 + r1 * r1) / HD + NORM_EPS); const float* gg = a.in[which == 0 ? IN_AQG : IN_AKG] + j * HD;
                if (!cls(g0, r0 * rs * gg[lane], 0.03f, 0.03f) || !cls(g1, r1 * rs * gg[lane + 64], 0.03f, 0.03f)) bad = true; }
        } else if (id == 12) {
            const int b = sd & 3, h = (sd >> 2) & 7, blk = (sd >> 5) & 15; const bf16_t* Kb = (const bf16_t*)(ws + WS_K); const float* KM = (const float*)(ws + WS_KMEAN);
            float s0 = 0.f, s1 = 0.f;
            for (int r = 0; r < MBLK; ++r) { const size_t o = ((size_t)b * SEQ + blk * MBLK + r) * D + h * HD; s0 += bfq(Kb, o + lane); s1 += bfq(Kb, o + lane + 64); }
            const float* km = KM + (((size_t)b * NH + h) * NBLK + blk) * HD;
            if (!cls(km[lane], s0 / MBLK, 0.03f, 0.003f) || !cls(km[lane + 64], s1 / MBLK, 0.03f, 0.003f)) bad = true;
            const int s = (sd >> 9) % SEQ, qb = s >> 8; const bf16_t* Q = (const bf16_t*)(ws + WS_Q); const unsigned msk = ((const unsigned*)(ws + WS_SEL))[((size_t)b * NH + h) * SEQ + s];
            float sc[16]; const size_t qo = ((size_t)b * SEQ + s) * D + h * HD;
#pragma unroll
            for (int n = 0; n < 16; ++n) { const float* kk = KM + (((size_t)b * NH + h) * NBLK + n) * HD; sc[n] = wave_sum(bfq(Q, qo + lane) * kk[lane] + bfq(Q, qo + lane + 64) * kk[lane + 64]); }
            int cntb = 0; float minsel = 1e30f;
#pragma unroll
            for (int n = 0; n < 16; ++n) if ((msk >> n) & 1u) { ++cntb; if (n >= qb) bad = true; minsel = fminf(minsel, sc[n]); }
            if (cntb != (qb < 3 ? qb : 3) || (msk >> 16)) bad = true;
            int better = 0;
#pragma unroll
            for (int n = 0; n < 16; ++n) if (n < qb && !((msk >> n) & 1u) && sc[n] > minsel + 1e-3f) ++better;
            if (better) bad = true;
        } else if (id == 13) {
            const int b = sd & 3, h = (sd >> 2) & 7, s = (sd >> 5) % SEQ, qb = s >> 8;
            const bf16_t* Q = (const bf16_t*)(ws + WS_Q); const bf16_t* Kb = (const bf16_t*)(ws + WS_K); const bf16_t* V = (const bf16_t*)(ws + WS_V); const bf16_t* O = (const bf16_t*)(ws + WS_YB);
            const unsigned msk = ((const unsigned*)(ws + WS_SEL))[((size_t)b * NH + h) * SEQ + s] | (1u << qb);
            const size_t qo = ((size_t)b * SEQ + s) * D + h * HD;
            float mx = -1e30f;
            for (int pass = 0; pass < 2; ++pass) {
                float den = 0.f, o0 = 0.f, o1 = 0.f;
                for (int blk = 0; blk <= qb; ++blk) if ((msk >> blk) & 1u) {
                    const int kend = blk == qb ? (s & 255) + 1 : 256;
                    for (int kk = 0; kk < kend; ++kk) { const size_t ko = ((size_t)b * SEQ + blk * MBLK + kk) * D + h * HD;
                        const float sc = wave_sum(bfq(Q, qo + lane) * bfq(Kb, ko + lane) + bfq(Q, qo + lane + 64) * bfq(Kb, ko + lane + 64)) * 0.08838834764831845f;
                        if (pass == 0) mx = fmaxf(mx, sc); else { const float p = expf(sc - mx); den += p; o0 += p * bfq(V, ko + lane); o1 += p * bfq(V, ko + lane + 64); } } }
                if (pass == 1) { if (!cls(bfq(O, qo + lane), o0 / den, 0.03f, 0.01f) || !cls(bfq(O, qo + lane + 64), o1 / den, 0.03f, 0.01f)) bad = true; }
            }
        } else if (id == 14) {
            const int m = sd % T, n = (sd >> 14) % D, b = m / SEQ; float s = 0.f; const bf16_t* YB = (const bf16_t*)(ws + WS_YB);
            for (int k = lane; k < D; k += 64) s += bfq(YB, (size_t)m * D + k) * a.in[IN_AWOUT][((size_t)j * D + k) * D + n];
            s = wave_sum(s);
            const float ref = ((const float*)(ws + WS_XA))[(size_t)m * D + n] + MOD[((size_t)l * BATCH + b) * 6 * D + 2 * D + n] * s;
            if (!cls(((const float*)(ws + WS_XB))[(size_t)m * D + n], ref, 0.01f, 0.01f)) bad = true;
        } else if (id == 15) {
            const int m = sd % T, b = m / SEQ; float ss = 0.f; const float* XA = (const float*)(ws + WS_XA); const bf16_t* YK = (const bf16_t*)(ws + WS_YK);
            for (int k = lane; k < D; k += 64) { const float x = XA[(size_t)m * D + k]; ss += x * x;
                const float sy = bfq(YK, (size_t)m * D + k);
                if (!cls(x, ((const float*)(ws + WS_XB))[(size_t)m * D + k] + MOD[((size_t)(l - 1) * BATCH + b) * 6 * D + 5 * D + k] * sy, 1e-3f, 1e-3f)) bad = true; }
            const float rstd = 1.0f / sqrtf(wave_sum(ss) / D + NORM_EPS);
            for (int k = lane; k < D; k += 64) { const float x = XA[(size_t)m * D + k];
                const float hh = x * rstd * a.in[IN_NMG][l * D + k] * (1.0f + MOD[((size_t)l * BATCH + b) * 6 * D + D + k]) + MOD[((size_t)l * BATCH + b) * 6 * D + k];
                if (!cls(bfq(H, (size_t)m * D + k), hh, 0.01f, 0.01f)) bad = true; }
        }
    }
    if (id == 16) {
        for (int it = 0; it < 8; ++it) { const unsigned sd = hsh(blockIdx.x * 131u + it * 7919u + 777u); const int m = sd % T, b = m / SEQ; const bf16_t* YK = (const bf16_t*)(ws + WS_YK);
            for (int k = lane; k < D; k += 64) { const float sy = bfq(YK, (size_t)m * D + k);
                if (!cls(a.out[(size_t)m * D + k], ((const float*)(ws + WS_XB))[(size_t)m * D + k] + MOD[((size_t)3 * BATCH + b) * 6 * D + 5 * D + k] * sy, 1e-3f, 1e-3f)) bad = true; } } }
    if (id == 99) bad = true;
    if (__any(bad) && lane == 0) atomicMax(ctl + CW_CHK, (unsigned)(100 - code));
    (void)PAR;
}
__global__ void chk_encode(Args a) {
    const unsigned v = ((const unsigned*)(a.ws + WS_CTL))[CW_CHK]; if (v == 0u) return;
    const float f = 1.0f + (float)(100 - (int)v);
    for (size_t i = (size_t)blockIdx.x * blockDim.x + threadIdx.x; i < (size_t)T * D; i += (size_t)gridDim.x * blockDim.x) a.out[i] = a.in[IN_X][i] * f;
}
#endif

#ifndef N_LAUNCH_MODE
#define N_LAUNCH_MODE 1
#endif
extern "C" void kernel_launch(void* const* d_in, const int* in_sizes, int n_in, void* d_out, int out_size, void* d_ws, size_t ws_size, hipStream_t stream) {
    static int grid = 0;
    if (grid == 0) {
        if (n_in != 25 || out_size != T * D || ws_size < WS_END) { fprintf(stderr, "kernel_launch: unexpected shapes (n_in %d out %d ws %zu)\n", n_in, out_size, ws_size); grid = -1; return; }
        int dev = 0, cus = 0;
        if (hipGetDevice(&dev) != hipSuccess || hipDeviceGetAttribute(&cus, hipDeviceAttributeMultiprocessorCount, dev) != hipSuccess) { grid = -1; return; }
        if (hipFuncSetAttribute((const void*)fwd, hipFuncAttributeMaxDynamicSharedMemorySize, LDS_BYTES) != hipSuccess) { fprintf(stderr, "kernel_launch: hipFuncSetAttribute failed\n"); grid = -1; return; }
        int per_cu = 0;
        if (hipOccupancyMaxActiveBlocksPerMultiprocessor(&per_cu, (const void*)fwd, NTHR, LDS_BYTES) != hipSuccess || per_cu < 1) fprintf(stderr, "kernel_launch: occupancy query says %d\n", per_cu);
        (void)hipGetLastError();
        if (cus < 256) { fprintf(stderr, "kernel_launch: %d CUs < 256\n", cus); grid = -1; return; }
        grid = 256;
    }
    if (grid < 0) return;
    (void)hipMemsetAsync((char*)d_ws + WS_CTL, 0, CTL_ZERO_BYTES, stream);
    Args a{};
    for (int i = 0; i < 25; ++i) a.in[i] = (const float*)d_in[i];
    a.out = (float*)d_out; a.ws = (unsigned char*)d_ws; a.pad = 0;
#if N_LAUNCH_MODE == 1
    a.ph_lo = 0; a.ph_hi = NPH - 1; a.li = 0;
    hipLaunchKernelGGL(fwd, dim3(grid), dim3(NTHR), LDS_BYTES, stream, a);
#else
    int ordinal = 0; (void)ordinal;
    for (int p = 0; p < NPH; ++p) {
        const int l = (p - 1) / 10, o = (p - 1) % 10;
        if (p >= 1 && p <= 40 && (l & 1) == 1 && o == 5) continue;
        a.ph_lo = p; a.ph_hi = p + 1; a.li = 0;
        hipLaunchKernelGGL(fwd, dim3(grid), dim3(NTHR), LDS_BYTES, stream, a);
#if DEBUG_CHECKS
        {
            const int lch = (p - 1) / 10, och = (p - 1) % 10; int cid = 0;
            if (p == 0) cid = 1;
            else if (p == 41) cid = 16;
            else if ((lch & 1) == 0) { const int t[10] = {lch == 0 ? 2 : 15, 3, 4, 5, 0, 6, 7, 8, 9, 10}; cid = t[och]; }
            else { const int t[10] = {15, 0, 11, 12, 13, 0, 14, 8, 9, 10}; cid = t[och]; }
            if (cid && p >= CHK_FROM) { ++ordinal; hipLaunchKernelGGL(chk, dim3(64), dim3(64), 0, stream, a, cid, lch < 0 ? 0 : (p == 41 ? 3 : lch), ordinal); }
            if (p == 41) { ++ordinal; hipLaunchKernelGGL(chk, dim3(64), dim3(64), 0, stream, a, 99, 0, ordinal); }
        }
#endif
    }
#if DEBUG_CHECKS
    hipLaunchKernelGGL(chk_encode, dim3(1024), dim3(256), 0, stream, a);
#endif
#endif
}
```

```cpp
#include <hip/hip_runtime.h>
#include <stdint.h>
#include <stdio.h>

#define LAS __attribute__((address_space(3)))
#define GAS __attribute__((address_space(1)))
typedef unsigned short bf16_t;
typedef short bf16x8 __attribute__((ext_vector_type(8)));
typedef float f32x4 __attribute__((ext_vector_type(4)));
typedef float f32x2 __attribute__((ext_vector_type(2)));
typedef unsigned u32x4 __attribute__((ext_vector_type(4)));
typedef unsigned u32x2 __attribute__((ext_vector_type(2)));

constexpr int BATCH = 4, SEQ = 4096, D = 1024, T = BATCH * SEQ, DEPTH = 4;
constexpr int NE = 32, TOPK = 4, NH = 8, HD = 128, NBLK = 16, MBLK = 256;
constexpr float NORM_EPS = 1e-6f;
constexpr int NWAVES = 8, NTHR = 512;
constexpr int CAP = T / TOPK;
constexpr int MAXTILES = T * TOPK / 256 + NE;

constexpr size_t MiB = 1u << 20;
constexpr size_t WS_CTL = 0, CTL_ZERO_BYTES = 1 * MiB;
constexpr size_t WS_MOD = 1 * MiB;
constexpr size_t WS_SP8 = 2 * MiB;
constexpr size_t WS_KMEAN = 3 * MiB;
constexpr size_t WS_SEL = 4 * MiB;
constexpr size_t WS_ROWLIST = 5 * MiB;
constexpr size_t WS_TOPW = 7 * MiB;
constexpr size_t WS_PS = 8 * MiB;
constexpr size_t WS_PAR = 10 * MiB;
constexpr int PAR_NMG = 0, PAR_NFG = PAR_NMG + 4 * 1024, PAR_LCW = PAR_NFG + 4 * 1024, PAR_LCB = PAR_LCW + 2 * 4 * 1024, PAR_LBA = PAR_LCB + 2 * 1024, PAR_LBX = PAR_LBA + 2 * 1024,
              PAR_AQG = PAR_LBX + 2 * 1024, PAR_AKG = PAR_AQG + 256, PAR_RW = PAR_AKG + 256, PAR_RB = PAR_RW + 4 * 1024 * 32, PAR_BGU = PAR_RB + 128, PAR_BDN = PAR_BGU + 4 * 32 * 2048, PAR_END = PAR_BDN + 4 * 32 * 1024;
static_assert((size_t)PAR_END * 4 <= 6 * MiB, "param region");
constexpr size_t WS_WIN = 16 * MiB;
constexpr size_t WS_WG = 24 * MiB;
constexpr size_t WS_WLO = 26 * MiB;
constexpr size_t WS_WQKV = 30 * MiB;
constexpr size_t WS_WAO = 42 * MiB;
constexpr size_t WS_WGU = 64 * MiB;
constexpr size_t WS_WDN = 576 * MiB;
constexpr size_t WS_XA = 832 * MiB;
constexpr size_t WS_XB = 896 * MiB;
constexpr size_t WS_H = 960 * MiB;
constexpr size_t WS_GB = 992 * MiB;
constexpr size_t WS_RB = 1024 * MiB;
constexpr size_t WS_XC = 1056 * MiB;
constexpr size_t WS_AF = 1088 * MiB;
constexpr size_t WS_UF = 1152 * MiB;
constexpr size_t WS_YB = 1216 * MiB;
constexpr size_t WS_Q = 1248 * MiB, WS_K = 1280 * MiB, WS_V = 1312 * MiB;
constexpr size_t WS_ACT = 1344 * MiB;
constexpr size_t WS_YK = 1488 * MiB;
constexpr size_t WS_END = 1616 * MiB;

constexpr int CW_BAR = 4096;
constexpr int CW_CNT = 65536;

constexpr int RING_BYTES = 131072;
constexpr int LDS_TAB = RING_BYTES;
constexpr int LDS_UNITS = LDS_TAB + 1024;
constexpr int LDS_MOE = LDS_UNITS + 512;
constexpr int LDS_MISC = LDS_MOE + 512;
constexpr int LDS_X = LDS_MISC + 256;
constexpr int LDS_BYTES = 147456;

__device__ __forceinline__ float bf2f(unsigned h) { return __uint_as_float(h << 16); }
__device__ __forceinline__ float bflo(unsigned u) { return __uint_as_float(u << 16); }
__device__ __forceinline__ float bfhi(unsigned u) { return __uint_as_float(u & 0xffff0000u); }
__device__ __forceinline__ unsigned cvt_pk_bf16(float lo, float hi) { unsigned r; asm("v_cvt_pk_bf16_f32 %0, %1, %2" : "=v"(r) : "v"(lo), "v"(hi)); return r; }
__device__ __forceinline__ float wave_sum(float v) {
#pragma unroll
    for (int o = 1; o < 64; o <<= 1) v += __shfl_xor(v, o);
    return v;
}
__device__ __forceinline__ float fast_exp(float x) { return __builtin_amdgcn_exp2f(x * 1.4426950408889634f); }
__device__ __forceinline__ float sigmoidf_(float x) { return __builtin_amdgcn_rcpf(1.0f + fast_exp(-x)); }
#define LDS_WAIT() asm volatile("s_waitcnt lgkmcnt(0)" ::: "memory")
#define VM_WAIT() asm volatile("s_waitcnt vmcnt(0)" ::: "memory")

#define XB_TMO      128
#define XB_XCNT(j)  (256  + 64 * (j))
#define XB_XSUB(j)  (1280 + 64 * (j))
#define XB_XGEN(j)  (2304 + 64 * (j))
#define XB_TOP      3328
#define XB_TOPGEN   3392
#define XCD_BAR_WORDS 3456
#define XB_SPIN_CAP (1u << 18)
__device__ __forceinline__ unsigned xb_ld(unsigned* p)              { return __hip_atomic_load(p, __ATOMIC_RELAXED, __HIP_MEMORY_SCOPE_AGENT); }
__device__ __forceinline__ unsigned xb_add(unsigned* p, unsigned v) { return __hip_atomic_fetch_add(p, v, __ATOMIC_RELAXED, __HIP_MEMORY_SCOPE_AGENT); }
__device__ __forceinline__ unsigned xb_xcc_id() { return (unsigned)__builtin_amdgcn_s_getreg((3 << 11) | 20) & 0xFu; }
#define XB_SPIN(cond, bar) do { unsigned _sp = 0; while (cond) { __builtin_amdgcn_s_sleep(1); \
    if ((++_sp & 255u) == 0u) { if (xb_ld(&(bar)[XB_TMO])) break; if (_sp > XB_SPIN_CAP) { atomicAdd(&(bar)[XB_TMO], 1u); break; } } } } while (0)
struct XcdBarrier { unsigned* bar; unsigned x; volatile LAS unsigned* st; };
__device__ __forceinline__ XcdBarrier xcd_barrier_post(unsigned* bar, volatile LAS unsigned* st) {
    XcdBarrier b; b.bar = bar; b.x = xb_xcc_id(); b.st = st;
    if (threadIdx.x == 0) (void)xb_add(&bar[XB_XCNT(b.x)], 1u);
    return b;
}
__device__ __forceinline__ void xcd_barrier_complete(unsigned* bar, unsigned x, unsigned& nloc, unsigned& nx) {
    const unsigned G = gridDim.x * gridDim.y * gridDim.z;
    unsigned sum, cnt, mine, sp = 0u;
    for (;;) {
        sum = 0u; cnt = 0u; mine = 0u;
#pragma unroll
        for (unsigned j = 0; j < 16; ++j) { const unsigned c = xb_ld(&bar[XB_XCNT(j)]); sum += c; cnt += (c > 0u) ? 1u : 0u; mine = (j == x) ? c : mine; }
        if (sum == G) break;
        __builtin_amdgcn_s_sleep(1);
        if ((++sp & 255u) == 0u) { if (xb_ld(&bar[XB_TMO])) break; if (sp > XB_SPIN_CAP) { atomicAdd(&bar[XB_TMO], 1u); break; } }
    }
    nloc = mine > 0u ? mine : 1u; nx = cnt > 0u ? cnt : 1u;
}
__device__ __forceinline__ void xcd_barrier(const XcdBarrier& b) {
    asm volatile("s_waitcnt vmcnt(0)" ::: "memory");
    __syncthreads();
    if (threadIdx.x == 0) {
        unsigned* bar = b.bar;
        __builtin_amdgcn_s_waitcnt(0);
        unsigned nloc = b.st[0], nx = b.st[1];
        if (nloc == 0u) { xcd_barrier_complete(bar, b.x, nloc, nx); b.st[0] = nloc; b.st[1] = nx; }
        const unsigned old = xb_add(&bar[XB_XSUB(b.x)], 1u);
        const unsigned gen = old / nloc;
        if (old + 1u == (gen + 1u) * nloc) {
            __builtin_amdgcn_fence(__ATOMIC_RELEASE, "agent");
            asm volatile("s_waitcnt vmcnt(0)" ::: "memory");
            const unsigned og = xb_add(&bar[XB_TOP], 1u);
            const unsigned tg = og / nx;
            if (og + 1u == (tg + 1u) * nx) xb_add(&bar[XB_TOPGEN], 1u);
            else XB_SPIN(xb_ld(&bar[XB_TOPGEN]) == tg, bar);
            __builtin_amdgcn_fence(__ATOMIC_ACQUIRE, "agent");
            xb_add(&bar[XB_XGEN(b.x)], 1u);
            asm volatile("s_waitcnt vmcnt(0)" ::: "memory");
        } else {
            XB_SPIN(xb_ld(&bar[XB_XGEN(b.x)]) == gen, bar);
            __builtin_amdgcn_fence(__ATOMIC_ACQUIRE, "agent");
            asm volatile("s_waitcnt vmcnt(0)" ::: "memory");
        }
    }
    __syncthreads();
}

namespace pg8 {
constexpr int BM = 256, BK = 64, HALF = 128, HTB = HALF * BK * 2, STAGE_BYTES = 8 * HTB, NXCD = 8, WGM = 8;
__host__ __device__ __forceinline__ int lds_byte(int r, int c) { const int st = (r >> 4) * 2 + (c >> 5), rr = r & 15, cc = c & 31, ob = rr * 64 + cc * 2; return st * 1024 + (ob ^ (((ob >> 9) & 1) << 5)); }
__host__ __device__ __forceinline__ void stage_rc(int b, int& R, int& C) { const int st = b / 1024, sb = b % 1024, swz = sb ^ (((sb >> 9) & 1) << 5); R = (st >> 1) * 16 + swz / 64; C = (st & 1) * 32 + (swz % 64) / 2; }
__host__ __device__ __forceinline__ int perm32(int rho) { const int n = rho >> 4, i = rho & 15; return 8 * (i >> 2) + 4 * n + (i & 3); }

struct Unit { int pm, pn, e, valid, j; };

struct ProbPlain {
    static constexpr bool GATHER = false, TAILS = false, ATILED = false;
    const bf16_t* A; const bf16_t* Bt; int M, N, K, lda; int acol_sh;
    int nM, nN, nwg, G, c;
    __device__ __forceinline__ void init(const bf16_t* A_, const bf16_t* Bt_, int M_, int N_, int K_, int lda_, int acol_sh_, int G_, int c_) {
        A = A_; Bt = Bt_; M = M_; N = N_; K = K_; lda = lda_; acol_sh = acol_sh_; nM = M / BM; nN = N / BM; nwg = nM * nN; G = G_; c = c_; }
    __device__ __forceinline__ bool next(int i, Unit& u) const {
        const long L = (long)i * G + c; if (L >= nwg) return false;
        int wgid = (int)L; { const int q = nwg / NXCD, r = nwg % NXCD, xcd = wgid % NXCD, off = wgid / NXCD; wgid = (xcd < r ? xcd * (q + 1) : r * (q + 1) + (xcd - r) * q) + off; }
        const int nig = WGM * nN, gid = wgid / nig, fm = gid * WGM, gsz = (nM - fm) < WGM ? (nM - fm) : WGM;
        u.pm = fm + ((wgid % nig) % gsz); u.pn = (wgid % nig) / gsz; u.e = 0; u.valid = 256; u.j = 0; return true;
    }
    __device__ __forceinline__ const char* a_base(const Unit& u) const { const int ac = acol_sh >= 0 ? (u.pn >> acol_sh) * 256 : 0; return (const char*)(A + (size_t)u.pm * BM * lda + ac); }
    __device__ __forceinline__ const char* b_base(const Unit& u) const { return (const char*)(Bt + (size_t)u.pn * BM * K); }
    __device__ __forceinline__ void fill_tab(const Unit&, LAS unsigned*) const {}
    __device__ __forceinline__ void a_off(const Unit&, const int (&R)[2], const int (&C)[2], unsigned (&v)[2][2], const LAS unsigned*) const {
#pragma unroll
        for (int h = 0; h < 2; ++h)
#pragma unroll
            for (int i = 0; i < 2; ++i) v[h][i] = (unsigned)((h * HALF + R[i]) * lda + C[i]) * 2u;
    }
};
template <bool GATHER_> struct ProbMoE {
    static constexpr bool GATHER = GATHER_, TAILS = true, ATILED = !GATHER_;
    const bf16_t* A; const bf16_t* Bt; int K, lda; size_t bstride;
    const unsigned* rowlist; const LAS int* units; int nunits;
    __device__ __forceinline__ bool next(int i, Unit& u) const {
        if (i >= nunits) return false;
        u.pm = __builtin_amdgcn_readfirstlane(units[i * 4 + 0]); u.pn = __builtin_amdgcn_readfirstlane(units[i * 4 + 1]);
        const int ej = __builtin_amdgcn_readfirstlane(units[i * 4 + 2]); u.e = ej & 255; u.j = ej >> 8; u.valid = __builtin_amdgcn_readfirstlane(units[i * 4 + 3]); return true;
    }
    __device__ __forceinline__ const char* a_base(const Unit& u) const { return GATHER ? (const char*)A : (const char*)(A + (size_t)u.pm * BM * lda); }
    __device__ __forceinline__ const char* b_base(const Unit& u) const { return (const char*)(Bt + (size_t)u.e * bstride + (size_t)u.pn * BM * K); }
    __device__ __forceinline__ void fill_tab(const Unit& u, LAS unsigned* tab) const {
        if (GATHER && threadIdx.x < 256) {
            const u32x2* rl = (const u32x2*)rowlist + (size_t)u.e * CAP + u.j * 256;
            const int r = (int)threadIdx.x < u.valid ? (int)threadIdx.x : 0;
            tab[threadIdx.x] = rl[r].x >> 2;
        }
    }
    __device__ __forceinline__ void a_off(const Unit&, const int (&R)[2], const int (&C)[2], unsigned (&v)[2][2], const LAS unsigned* tab) const {
#pragma unroll
        for (int h = 0; h < 2; ++h)
#pragma unroll
            for (int i = 0; i < 2; ++i) {
                if (GATHER) v[h][i] = (tab[h * HALF + R[i]] * (unsigned)lda + (unsigned)C[i]) * 2u;
                else v[h][i] = (unsigned)((h * HALF + R[i]) * BK + C[i]) * 2u;
            }
    }
};

template <class Epi, class Prob, bool ALIGN_EPI, bool SP2>
__device__ __forceinline__ void gemm_phase(LAS unsigned char* lds, LAS unsigned* tab, const Prob& P, const Epi& E) {
    int tid = threadIdx.x; asm volatile("" : "+v"(tid));
    const int wid = __builtin_amdgcn_readfirstlane(tid >> 6), lane = tid & 63, wr = wid >> 2, wc = wid & 3, fr = lane & 15, fq = lane >> 4;
    const int K = P.K, nt = K / BK;
    int Rr[2], Cc[2]; unsigned voffB[2];
#pragma unroll
    for (int i = 0; i < 2; ++i) { int R, C; stage_rc(tid * 16 + i * 8192, R, C); Rr[i] = R; Cc[i] = C; const int Rb = Epi::PERM ? ((R & ~31) + perm32(R & 31)) : R; voffB[i] = (unsigned)(Rb * BK + C) * 2u; }
    const size_t kstepB = (size_t)BM * BK * 2;
    const size_t hstepB = (size_t)HALF * BK * 2;
    const size_t kstep = Prob::ATILED ? (size_t)BM * BK * 2 : (size_t)(BK * 2);
    const size_t hstepA = Prob::GATHER ? (size_t)0 : (Prob::ATILED ? (size_t)HALF * BK * 2 : (size_t)HALF * P.lda * 2);
#define PG8_V1 (Prob::GATHER ? vcur[1] : vcur[0])
    const unsigned ldsw = (unsigned)wid * 1024u;
    const int aoff = lds_byte(wr * 64 + fr, fq * 8), boff = lds_byte(wc * 32 + fr, fq * 8);
#define PG8_SA(b, h) (((b) * 2 + (h)) * HTB)
#define PG8_SB(b, h) ((4 + (b) * 2 + (h)) * HTB)
#define PG8_STAGE(bufoff, gbase, voff) do { _Pragma("unroll") for (int _i = 0; _i < 2; ++_i) \
        __builtin_amdgcn_global_load_lds((const unsigned*)((const char*)(gbase) + (voff)[_i]), (LAS unsigned*)(lds + (bufoff) + ldsw + _i * 8192), 16, 0, 0); } while (0)
#define PG8_LDA(dst, b, h) do { _Pragma("unroll") for (int m = 0; m < 4; ++m) _Pragma("unroll") for (int k = 0; k < 2; ++k) dst[m][k] = *(const LAS bf16x8*)(lds + PG8_SA(b, h) + aoff + m * 2048 + k * 1024); } while (0)
#define PG8_LDB(dst, b, h) do { _Pragma("unroll") for (int n = 0; n < 2; ++n) _Pragma("unroll") for (int k = 0; k < 2; ++k) dst[n][k] = *(const LAS bf16x8*)(lds + PG8_SB(b, h) + boff + n * 2048 + k * 1024); } while (0)
#define PG8_MMA(ai, bj, At, Bt) do { __builtin_amdgcn_s_setprio(1); _Pragma("unroll") for (int m = 0; m < 4; ++m) _Pragma("unroll") for (int n = 0; n < 2; ++n) _Pragma("unroll") for (int k = 0; k < 2; ++k) \
        acc[ai][bj][m][n] = __builtin_amdgcn_mfma_f32_16x16x32_bf16(Bt[n][k], At[m][k], acc[ai][bj][m][n], 0, 0, 0); __builtin_amdgcn_s_setprio(0); } while (0)
#define PG8_WAIT_V(n) asm volatile("s_waitcnt vmcnt(" #n ")" ::: "memory")
#define PG8_WAIT_L(n) asm volatile("s_waitcnt lgkmcnt(" #n ")" ::: "memory")
#define PG8_BAR __builtin_amdgcn_s_barrier()
#define PG8_SCHED __builtin_amdgcn_sched_barrier(0)
    Unit cur, nxt; int ui = 0;
    if (!P.next(0, cur)) return;
    unsigned vcur[2][2];
    if constexpr (Prob::GATHER) { P.fill_tab(cur, tab); asm volatile("s_waitcnt vmcnt(0) lgkmcnt(0)" ::: "memory"); PG8_BAR; asm volatile("" ::: "memory"); }
    P.a_off(cur, Rr, Cc, vcur, tab);
    if constexpr (Prob::GATHER) { asm volatile("s_waitcnt lgkmcnt(0)" ::: "memory"); }
    f32x4 acc[2][2][4][2];
#pragma unroll
    for (int a = 0; a < 2; ++a)
#pragma unroll
        for (int b = 0; b < 2; ++b)
#pragma unroll
            for (int m = 0; m < 4; ++m)
#pragma unroll
                for (int n = 0; n < 2; ++n) acc[a][b][m][n] = (f32x4){0.f, 0.f, 0.f, 0.f};
    bf16x8 At[4][2], B0[2][2], B1[2][2];
    const char* cA = P.a_base(cur); const char* cB = P.b_base(cur);
    static_assert(SP2, "only the two-MFMA-blocks-per-barrier-pair loop is kept");
    PG8_STAGE(PG8_SB(0, 0), cB, voffB); PG8_STAGE(PG8_SB(0, 1), cB + hstepB, voffB); PG8_STAGE(PG8_SA(0, 0), cA, vcur[0]); PG8_STAGE(PG8_SA(0, 1), cA + hstepA, PG8_V1);
    if (wr == 1) PG8_BAR;
    PG8_WAIT_V(2); PG8_BAR;
    PG8_STAGE(PG8_SB(1, 0), cB + kstepB, voffB); PG8_STAGE(PG8_SA(1, 0), cA + kstep, vcur[0]); PG8_STAGE(PG8_SB(1, 1), cB + hstepB + kstepB, voffB);
    PG8_WAIT_V(6); PG8_BAR;
    for (;;) {
        const bool has_next = P.next(ui + 1, nxt);
        const char* nA = has_next ? P.a_base(nxt) : cA; const char* nB = has_next ? P.b_base(nxt) : cB;
        if constexpr (Prob::GATHER) { if (has_next) P.fill_tab(nxt, tab); }
        const bool full = !Prob::TAILS || cur.valid > HALF;
        for (int t = 0; t < nt; t += 2) {
            const bool last = (t == nt - 2);
            const char* a1 = cA + (size_t)(t + 1) * kstep;
            const char* a2 = last ? nA : cA + (size_t)(t + 2) * kstep; const char* b2 = last ? nB : cB + (size_t)(t + 2) * kstepB;
            const char* a3 = a2 + kstep; const char* b3 = b2 + kstepB;
            PG8_LDB(B0, 0, 0); PG8_LDB(B1, 0, 1); PG8_SCHED; PG8_LDA(At, 0, 0); PG8_STAGE(PG8_SA(1, 1), a1 + hstepA, PG8_V1);
            if constexpr (Prob::GATHER) { if (last && has_next) P.a_off(nxt, Rr, Cc, vcur, tab); }
            PG8_WAIT_V(8); PG8_WAIT_L(0); PG8_BAR; PG8_MMA(0, 0, At, B0); PG8_MMA(0, 1, At, B1); PG8_BAR; PG8_SCHED;
            if (full) { PG8_LDA(At, 0, 1); } PG8_STAGE(PG8_SB(0, 0), b2, voffB); PG8_STAGE(PG8_SB(0, 1), b2 + hstepB, voffB); PG8_STAGE(PG8_SA(0, 0), a2, vcur[0]);
            PG8_WAIT_V(8); PG8_WAIT_L(0); PG8_BAR; if (full) { PG8_MMA(1, 0, At, B0); PG8_MMA(1, 1, At, B1); } PG8_BAR; PG8_SCHED;
            PG8_LDB(B0, 1, 0); PG8_LDB(B1, 1, 1); PG8_SCHED; PG8_LDA(At, 1, 0); PG8_STAGE(PG8_SA(0, 1), a2 + hstepA, PG8_V1);
            PG8_WAIT_V(8); PG8_WAIT_L(0); PG8_BAR; PG8_MMA(0, 0, At, B0); PG8_MMA(0, 1, At, B1); PG8_BAR; PG8_SCHED;
            if (full) { PG8_LDA(At, 1, 1); } PG8_STAGE(PG8_SB(1, 0), b3, voffB); PG8_STAGE(PG8_SB(1, 1), b3 + hstepB, voffB); PG8_STAGE(PG8_SA(1, 0), a3, vcur[0]);
            PG8_WAIT_V(8); PG8_WAIT_L(0); PG8_BAR; if (full) { PG8_MMA(1, 0, At, B0); PG8_MMA(1, 1, At, B1); } PG8_BAR; PG8_SCHED;
        }
        if constexpr (ALIGN_EPI) { if (wr == 0) PG8_BAR; }
        E(acc, cur, wr, wc, fr, fq);
        if (!has_next) break;
#pragma unroll
        for (int a = 0; a < 2; ++a)
#pragma unroll
            for (int b = 0; b < 2; ++b)
#pragma unroll
                for (int m = 0; m < 4; ++m)
#pragma unroll
                    for (int n = 0; n < 2; ++n) acc[a][b][m][n] = (f32x4){0.f, 0.f, 0.f, 0.f};
        cur = nxt; cA = nA; cB = nB; ++ui;
        if constexpr (ALIGN_EPI) { if (wr == 1) PG8_BAR; }
    }
    PG8_WAIT_V(0);
    if constexpr (!ALIGN_EPI) { if (wr == 0) PG8_BAR; }
    PG8_BAR;
#undef PG8_V1
#undef PG8_SA
#undef PG8_SB
#undef PG8_STAGE
#undef PG8_LDA
#undef PG8_LDB
#undef PG8_MMA
#undef PG8_WAIT_V
#undef PG8_WAIT_L
#undef PG8_BAR
#undef PG8_SCHED
}

typedef f32x4 AccT[2][2][4][2];
__device__ __forceinline__ float gelu_tanh(float x) {
    const float z = 1.5957691216057308f * (x + 0.044715f * x * x * x);
    return x * __builtin_amdgcn_rcpf(1.0f + __builtin_amdgcn_exp2f(-1.4426950408889634f * z));
}
struct EpiWin {
    static constexpr bool PERM = true;
    bf16_t* GB; bf16_t* RB;
    __device__ __forceinline__ void operator()(const AccT& acc, const Unit& u, int wr, int wc, int fr, int fq) const {
        const int row0 = u.pm * BM + wr * 64 + fr; const bool gate = u.pn < 4;
        bf16_t* base = GB + (size_t)(u.pn >> 2) * ((WS_RB - WS_GB) / 2); const int col0 = (u.pn & 3) * BM + wc * 32 + 8 * fq;
#pragma unroll
        for (int ai = 0; ai < 2; ++ai)
#pragma unroll
            for (int m = 0; m < 4; ++m) { bf16_t* rowp = base + (size_t)(row0 + ai * HALF + m * 16) * D + col0;
#pragma unroll
                for (int bj = 0; bj < 2; ++bj) { f32x4 v0 = acc[ai][bj][m][0], v1 = acc[ai][bj][m][1];
                    if (gate) {
#pragma unroll
                        for (int j = 0; j < 4; ++j) { v0[j] = gelu_tanh(v0[j]); v1[j] = gelu_tanh(v1[j]); } }
                    u32x4 w; w.x = cvt_pk_bf16(v0[0], v0[1]); w.y = cvt_pk_bf16(v0[2], v0[3]); w.z = cvt_pk_bf16(v1[0], v1[1]); w.w = cvt_pk_bf16(v1[2], v1[3]);
                    *(u32x4*)(rowp + bj * HALF) = w; } }
    }
};
struct EpiQKV {
    static constexpr bool PERM = true;
    bf16_t* Q; const float* qg; const float* kg; float* KM; LAS float* xl;
    __device__ __forceinline__ void operator()(const AccT& acc, const Unit& u, int wr, int wc, int fr, int fq) const {
        const int row0 = u.pm * BM + wr * 64 + fr; const int t = u.pn >> 2;
        bf16_t* base = Q + (size_t)t * ((WS_K - WS_Q) / 2); const int col0 = (u.pn & 3) * BM + wc * 32 + 8 * fq;
        LAS float* SS = xl; LAS float* KS = xl + 2048;
#pragma unroll
        for (int ai = 0; ai < 2; ++ai)
#pragma unroll
            for (int m = 0; m < 4; ++m)
#pragma unroll
                for (int bj = 0; bj < 2; ++bj) { const f32x4 v0 = acc[ai][bj][m][0], v1 = acc[ai][bj][m][1];
                    float ss = (v0[0] * v0[0] + v0[1] * v0[1]) + (v0[2] * v0[2] + v0[3] * v0[3]) + (v1[0] * v1[0] + v1[1] * v1[1]) + (v1[2] * v1[2] + v1[3] * v1[3]);
                    ss += __shfl_xor(ss, 16); ss += __shfl_xor(ss, 32);
                    if (fq == 0) SS[((ai * HALF + wr * 64 + m * 16 + fr) * 2 + bj) * 4 + wc] = ss; __builtin_amdgcn_sched_barrier(0); }
        asm volatile("s_waitcnt lgkmcnt(0)" ::: "memory"); __builtin_amdgcn_s_barrier(); asm volatile("" ::: "memory");
        const bool isv = (t == 2);
        const float* gp = (t == 0 ? qg : kg) + wc * 32 + 8 * fq;
        f32x4 g0 = *(const f32x4*)gp, g1 = *(const f32x4*)(gp + 4);
        if (isv) { g0 = (f32x4){1.f, 1.f, 1.f, 1.f}; g1 = g0; }
        {
#pragma unroll
            for (int bj = 0; bj < 2; ++bj) {
                float cs[8];
#pragma unroll
                for (int q = 0; q < 8; ++q) cs[q] = 0.f;
#pragma unroll
                for (int ai = 0; ai < 2; ++ai)
#pragma unroll
                    for (int m = 0; m < 4; ++m) { const int r = ai * HALF + wr * 64 + m * 16 + fr; bf16_t* rowp = base + (size_t)(u.pm * BM + r) * D + col0;
                        const f32x4 p = *(const LAS f32x4*)(SS + (r * 2 + bj) * 4);
                        const float rstd = isv ? 1.0f : __builtin_amdgcn_rsqf(((p[0] + p[1]) + (p[2] + p[3])) * (1.0f / HD) + NORM_EPS);
                        const f32x4 v0 = acc[ai][bj][m][0] * rstd * g0, v1 = acc[ai][bj][m][1] * rstd * g1;
#pragma unroll
                        for (int q = 0; q < 4; ++q) { cs[q] += v0[q]; cs[4 + q] += v1[q]; }
                        u32x4 w; w.x = cvt_pk_bf16(v0[0], v0[1]); w.y = cvt_pk_bf16(v0[2], v0[3]); w.z = cvt_pk_bf16(v1[0], v1[1]); w.w = cvt_pk_bf16(v1[2], v1[3]);
                        *(u32x4*)(rowp + bj * HALF) = w; __builtin_amdgcn_sched_barrier(0); }
#pragma unroll
                for (int q = 0; q < 8; ++q) { float v = cs[q]; v += __shfl_xor(v, 1); v += __shfl_xor(v, 2); v += __shfl_xor(v, 4); v += __shfl_xor(v, 8);
                    if (fr == 0) KS[wr * 256 + bj * HALF + wc * 32 + 8 * fq + q] = v; }
            }
            asm volatile("s_waitcnt lgkmcnt(0)" ::: "memory"); __builtin_amdgcn_s_barrier(); asm volatile("" ::: "memory");
            int tid = threadIdx.x; asm volatile("" : "+v"(tid));
            if (tid < 256 && t == 1) { const int b = u.pm >> 4, blk = u.pm & 15, h = 2 * (u.pn & 3) + (tid >> 7);
                KM[(((size_t)b * NH + h) * NBLK + blk) * HD + (tid & 127)] = (KS[tid] + KS[256 + tid]) * (1.0f / MBLK); }
        }
    }
};
struct EpiGates {
    static constexpr bool PERM = true;
    const bf16_t* XC; bf16_t* LA; bf16_t* UB; const float* ba; const float* bx; const float* sp8;
    __device__ __forceinline__ void operator()(const AccT& acc, const Unit& u, int wr, int wc, int fr, int fq) const {
        const int row0 = u.pm * BM + wr * 64 + fr; const int ch0 = (u.pn >> 1) * 256 + (u.pn & 1) * 128 + wc * 32 + 8 * fq;
        f32x4 bav[2], bxv[2], spv[2];
#pragma unroll
        for (int n = 0; n < 2; ++n) { bav[n] = *(const f32x4*)(ba + ch0 + n * 4); bxv[n] = *(const f32x4*)(bx + ch0 + n * 4); spv[n] = *(const f32x4*)(sp8 + ch0 + n * 4) * 1.4426950408889634f; }
#pragma unroll
        for (int ai = 0; ai < 2; ++ai)
#pragma unroll
            for (int m = 0; m < 4; ++m) { const size_t ro = (size_t)(row0 + ai * HALF + m * 16) * D + ch0;
                const u32x4 xw = *(const u32x4*)(XC + ro);
                float lo[8], uo[8];
#pragma unroll
                for (int n = 0; n < 2; ++n)
#pragma unroll
                    for (int j = 0; j < 4; ++j) { const int q = n * 4 + j; const float xcv = (q & 1) ? bfhi(xw[q >> 1]) : bflo(xw[q >> 1]);
                        const float r = sigmoidf_(acc[ai][0][m][n][j] + bav[n][j]), ig = sigmoidf_(acc[ai][1][m][n][j] + bxv[n][j]);
                        const float l2 = -spv[n][j] * r;
                        const float a2 = __builtin_amdgcn_exp2f(2.0f * l2);
                        lo[q] = l2; uo[q] = __builtin_amdgcn_sqrtf(1.0f - a2) * ig * xcv; }
                u32x4 lw, uw;
#pragma unroll
                for (int q = 0; q < 4; ++q) { lw[q] = cvt_pk_bf16(lo[2 * q], lo[2 * q + 1]); uw[q] = cvt_pk_bf16(uo[2 * q], uo[2 * q + 1]); }
                *(u32x4*)(LA + ro) = lw; *(u32x4*)(UB + ro) = uw; }
    }
};
struct EpiResid {
    static constexpr bool PERM = false;
    const float* X; float* XB; const float* g1;
    __device__ __forceinline__ void operator()(const AccT& acc, const Unit& u, int wr, int wc, int fr, int fq) const {
        const int row0 = u.pm * BM + wr * 64 + fr, col0 = u.pn * BM + wc * 32 + 4 * fq; const int b = (u.pm * BM) / SEQ;
        f32x4 gv[2][2];
#pragma unroll
        for (int bj = 0; bj < 2; ++bj)
#pragma unroll
            for (int n = 0; n < 2; ++n) gv[bj][n] = *(const f32x4*)(g1 + (size_t)b * 6 * D + col0 + bj * HALF + n * 16);
#pragma unroll
        for (int ai = 0; ai < 2; ++ai) {
            f32x4 xv[4][2][2];
#pragma unroll
            for (int m = 0; m < 4; ++m) { const size_t ro = (size_t)(row0 + ai * HALF + m * 16) * D + col0;
#pragma unroll
                for (int bj = 0; bj < 2; ++bj)
#pragma unroll
                    for (int n = 0; n < 2; ++n) xv[m][bj][n] = *(const f32x4*)(X + ro + bj * HALF + n * 16); }
#pragma unroll
            for (int m = 0; m < 4; ++m) { const size_t ro = (size_t)(row0 + ai * HALF + m * 16) * D + col0;
#pragma unroll
                for (int bj = 0; bj < 2; ++bj)
#pragma unroll
                    for (int n = 0; n < 2; ++n) *(f32x4*)(XB + ro + bj * HALF + n * 16) = xv[m][bj][n] + gv[bj][n] * acc[ai][bj][m][n]; }
            asm volatile("" ::: "memory"); }
    }
};
struct EpiSwiglu {
    static constexpr bool PERM = true;
    bf16_t* ACT; const float* bgu;
    __device__ __forceinline__ void operator()(const AccT& acc, const Unit& u, int wr, int wc, int fr, int fq) const {
        const int row0 = u.pm * BM + wr * 64 + fr; const int j0 = u.pn * HALF + wc * 32 + 8 * fq;
        const float* bp = bgu + (size_t)u.e * 2 * D + j0;
        const f32x4 bg0 = *(const f32x4*)(bp), bg1 = *(const f32x4*)(bp + 4), bu0 = *(const f32x4*)(bp + D), bu1 = *(const f32x4*)(bp + D + 4);
#pragma unroll
        for (int ai = 0; ai < 2; ++ai)
#pragma unroll
            for (int m = 0; m < 4; ++m) {
                float o[8];
#pragma unroll
                for (int n = 0; n < 2; ++n)
#pragma unroll
                    for (int j = 0; j < 4; ++j) { const float g = acc[ai][0][m][n][j] + (n ? bg1[j] : bg0[j]), up = acc[ai][1][m][n][j] + (n ? bu1[j] : bu0[j]);
                        const float gv = fminf(g, 7.0f), uv = fminf(fmaxf(up, -7.0f), 7.0f);
                        o[n * 4 + j] = gv * sigmoidf_(1.702f * gv) * (uv + 1.0f); }
                u32x4 w; w.x = cvt_pk_bf16(o[0], o[1]); w.y = cvt_pk_bf16(o[2], o[3]); w.z = cvt_pk_bf16(o[4], o[5]); w.w = cvt_pk_bf16(o[6], o[7]);
                *(u32x4*)(ACT + (size_t)u.pm * BM * D + (size_t)(j0 >> 6) * (BM * BK) + (size_t)(wr * 64 + fr + ai * HALF + m * 16) * BK + (j0 & 63)) = w; }
    }
};
struct EpiDown {
    static constexpr bool PERM = false;
    const float* XB; float* XO; const float* __restrict__ g2; const float* __restrict__ bdn; const unsigned* __restrict__ rowlist;
    __device__ __forceinline__ void operator()(const AccT& acc, const Unit& u, int wr, int wc, int fr, int fq) const {
        const int c0 = u.pn * BM + wc * 32 + 4 * fq;
        const float* bp = bdn + (size_t)u.e * D + c0;
        f32x4 bv[2][2];
#pragma unroll
        for (int bj = 0; bj < 2; ++bj) { bv[bj][0] = *(const f32x4*)(bp + bj * HALF); bv[bj][1] = *(const f32x4*)(bp + bj * HALF + 16); }
        const u32x2* rl = (const u32x2*)rowlist + (size_t)u.e * CAP + u.j * 256;
        u32x2 ri[2][4];
#pragma unroll
        for (int ai = 0; ai < 2; ++ai)
#pragma unroll
            for (int m = 0; m < 4; ++m) { const int r = ai * HALF + wr * 64 + m * 16 + fr; ri[ai][m] = rl[r < u.valid ? r : 0]; }
#pragma unroll
        for (int ai = 0; ai < 2; ++ai)
#pragma unroll
            for (int mp = 0; mp < 2; ++mp) {
                f32x4 xv[2][2][2];
#pragma unroll
                for (int q = 0; q < 2; ++q) { const size_t ro = (size_t)ri[ai][2 * mp + q].x * D + c0;
#pragma unroll
                    for (int bj = 0; bj < 2; ++bj)
#pragma unroll
                        for (int n = 0; n < 2; ++n) xv[q][bj][n] = *(const f32x4*)(XB + ro + bj * HALF + n * 16); }
#pragma unroll
                for (int q = 0; q < 2; ++q) { const int m = 2 * mp + q; const int r = ai * HALF + wr * 64 + m * 16 + fr; const unsigned dest = ri[ai][m].x; const float w = __uint_as_float(ri[ai][m].y);
                    const size_t ro = (size_t)dest * D + c0; const float* gp = g2 + (size_t)(dest / SEQ) * 6 * D + c0;
                    if (r < u.valid) {
#pragma unroll
                        for (int bj = 0; bj < 2; ++bj)
#pragma unroll
                            for (int n = 0; n < 2; ++n) { const f32x4 gv = *(const f32x4*)(gp + bj * HALF + n * 16);
                                *(f32x4*)(XO + ro + bj * HALF + n * 16) = xv[q][bj][n] + gv * ((acc[ai][bj][m][n] + bv[bj][n]) * w); } } }
            }
    }
};
}

namespace att {
typedef short s16x4 __attribute__((ext_vector_type(4)));
typedef float f32x16 __attribute__((ext_vector_type(16)));
constexpr int NW = 8, QBLK = 32, KVBLK = 64, QB = NW * QBLK, DH = 128, LD = 1024;
constexpr int SHM_V = KVBLK * DH * 2, SHM_K = KVBLK * DH * 2;
constexpr int ATT_LDS_BYTES = 2 * SHM_V + 2 * SHM_K + NW * 64 * 4;
constexpr float SCALE = 0.08838834764831845f;
constexpr float THR = 8.f;
#define KSWZ(row, colB) ((row) * 256 + ((colB) ^ (((row) & 7) << 4)))
#define SBAR() __builtin_amdgcn_sched_barrier(0)
__device__ __forceinline__ int v_st(int k, int c) { const int kk = (k & ~0xC) | ((k & 4) << 1) | ((k & 8) >> 1); return ((kk >> 3) * 4 + (c >> 5)) * 512 + ((kk & 7) * 32 + (c & 31)) * 2; }
__device__ __forceinline__ int v_rd_base(int lane) { return ((lane & 3) << 3) | (((lane >> 2) & 3) << 6) | (((lane >> 4) & 1) << 5) | (((lane >> 5) & 1) << 8); }
constexpr int v_rd_off(int d0, int ks, int half) { return d0 * 512 + ks * 4096 + half * 2048; }
__device__ __forceinline__ int crow(int r, int hi) { return (r & 3) + 8 * (r >> 2) + 4 * hi; }
__device__ __forceinline__ unsigned cvtpk(float lo, float hi) { unsigned r; asm volatile("v_cvt_pk_bf16_f32 %0, %1, %2" : "=v"(r) : "v"(lo), "v"(hi)); return r; }
__device__ __forceinline__ bf16x8 ld8(const bf16_t* p) { return *reinterpret_cast<const bf16x8*>(p); }
__device__ __forceinline__ void mask_causal(f32x16& p0, f32x16& p1, int dq) {
    const float NEG = -__builtin_inff();
#pragma unroll
    for (int r = 0; r < 16; ++r) {
        const int c = (r & 3) + 8 * (r >> 2);
        if (dq - c < 0) p0[r] = NEG;
        if (dq - c - 32 < 0) p1[r] = NEG;
    }
}
__device__ __forceinline__ void mask_all(f32x16& p0, f32x16& p1, bool keep) {
    const float NEG = -__builtin_inff();
#pragma unroll
    for (int r = 0; r < 16; ++r) { p0[r] = keep ? p0[r] : NEG; p1[r] = keep ? p1[r] : NEG; }
}
__device__ __forceinline__ void partialSM(f32x16& p0, f32x16& p1, float& m_reg, float& mn, float& alpha) {
    float pmax = p0[0]; for (int r = 1; r < 16; ++r) pmax = fmaxf(pmax, p0[r]); for (int r = 0; r < 16; ++r) pmax = fmaxf(pmax, p1[r]);
    { auto rr = __builtin_amdgcn_permlane32_swap(__float_as_uint(pmax), __float_as_uint(pmax), false, false);
      pmax = fmaxf(__uint_as_float(rr[0]), __uint_as_float(rr[1])); }
    constexpr float C2 = 1.4426950408889634f * SCALE;
    if (__builtin_expect(__all((pmax - m_reg) * SCALE <= THR), 1)) { mn = m_reg; alpha = 1.f; }
    else { mn = fmaxf(m_reg, pmax); alpha = __builtin_amdgcn_exp2f((m_reg - mn) * C2); m_reg = mn; }
    const float mnL = -mn * C2;
    for (int r = 0; r < 16; ++r) p0[r] = fmaf(p0[r], C2, mnL); for (int r = 0; r < 16; ++r) p1[r] = fmaf(p1[r], C2, mnL);
    for (int r = 0; r < 16; ++r) p0[r] = __builtin_amdgcn_exp2f(p0[r]);
}
__device__ __forceinline__ void finishSM(f32x16& p0, f32x16& p1, float alpha, float& l_reg, bf16x8& pa0, bf16x8& pa1, bf16x8& pa2, bf16x8& pa3) {
    for (int r = 0; r < 16; ++r) p1[r] = __builtin_amdgcn_exp2f(p1[r]);
    float ps = 0; for (int r = 0; r < 16; ++r) ps += p0[r]; for (int r = 0; r < 16; ++r) ps += p1[r];
    { auto rr = __builtin_amdgcn_permlane32_swap(__float_as_uint(ps), __float_as_uint(ps), false, false);
      ps = __uint_as_float(rr[0]) + __uint_as_float(rr[1]); }
    l_reg = l_reg * alpha + ps;
#define PK4(P, B_, OUT) do { unsigned a0 = cvtpk(P[B_+0], P[B_+1]), a1 = cvtpk(P[B_+2], P[B_+3]);                          \
        unsigned b0 = cvtpk(P[B_+4], P[B_+5]), b1 = cvtpk(P[B_+6], P[B_+7]);                                             \
        auto r0 = __builtin_amdgcn_permlane32_swap(a0, b0, false, false); auto r1 = __builtin_amdgcn_permlane32_swap(a1, b1, false, false); \
        u32x4 w = {r0[0], r1[0], r0[1], r1[1]}; OUT = *reinterpret_cast<bf16x8*>(&w); } while (0)
    PK4(p0, 0, pa0); PK4(p0, 8, pa1); PK4(p1, 0, pa2); PK4(p1, 8, pa3);
#undef PK4
}
template <int KB>
__device__ __forceinline__ void qkt(f32x16& p0, f32x16& p1, const char* K_lds, int r32, int hi, const bf16x8* qr) {
    p0 = f32x16{}; p1 = f32x16{};
    const char* kb[4];
#pragma unroll
    for (int dd = 0; dd < 4; ++dd) kb[dd] = K_lds + KB * SHM_K + KSWZ(r32, (dd * 16 + hi * 8) * 2);
#pragma unroll
    for (int d0 = 0; d0 < 8; ++d0) { const char* a = kb[d0 & 3] + (d0 >> 2) * 128;
        bf16x8 b0 = *reinterpret_cast<const bf16x8*>(a);
        bf16x8 b1 = *reinterpret_cast<const bf16x8*>(a + 32 * 256);
        p0 = __builtin_amdgcn_mfma_f32_32x32x16_bf16(b0, qr[d0], p0, 0, 0, 0);
        p1 = __builtin_amdgcn_mfma_f32_32x32x16_bf16(b1, qr[d0], p1, 0, 0, 0); }
}
template <int VB>
__device__ __forceinline__ void pv_tile(f32x16* o, int vb0, bf16x8 pa0, bf16x8 pa1, bf16x8 pa2, bf16x8 pa3) {
#define TRRD(dst, off) asm volatile("ds_read_b64_tr_b16 %0, %1 offset:%2" : "=&v"(dst) : "v"(vb0), "i"(off) : "memory")
#define PV_D0(d0) do { s16x4 l0, l1, l2, l3, h0, h1, h2, h3; constexpr int b_ = VB * SHM_V + v_rd_off(d0, 0, 0); \
        TRRD(l0, b_); TRRD(h0, b_ + 2048); TRRD(l1, b_ + 4096); TRRD(h1, b_ + 6144); TRRD(l2, b_ + 8192); TRRD(h2, b_ + 10240); TRRD(l3, b_ + 12288); TRRD(h3, b_ + 14336); \
        asm volatile("s_waitcnt lgkmcnt(0)" ::: "memory"); SBAR();   \
        o[d0] = __builtin_amdgcn_mfma_f32_32x32x16_bf16(pa0, (bf16x8){l0[0], l0[1], l0[2], l0[3], h0[0], h0[1], h0[2], h0[3]}, o[d0], 0, 0, 0);   \
        o[d0] = __builtin_amdgcn_mfma_f32_32x32x16_bf16(pa1, (bf16x8){l1[0], l1[1], l1[2], l1[3], h1[0], h1[1], h1[2], h1[3]}, o[d0], 0, 0, 0);   \
        o[d0] = __builtin_amdgcn_mfma_f32_32x32x16_bf16(pa2, (bf16x8){l2[0], l2[1], l2[2], l2[3], h2[0], h2[1], h2[2], h2[3]}, o[d0], 0, 0, 0);   \
        o[d0] = __builtin_amdgcn_mfma_f32_32x32x16_bf16(pa3, (bf16x8){l3[0], l3[1], l3[2], l3[3], h3[0], h3[1], h3[2], h3[3]}, o[d0], 0, 0, 0); } while (0)
    PV_D0(0); PV_D0(1); PV_D0(2); PV_D0(3);
#undef PV_D0
#undef TRRD
}
constexpr int KM_OFF = 69632;
__device__ __forceinline__ unsigned moba_gate(const bf16x8* qr, const float* km, int qb, int hi) {
    float v1 = -__builtin_inff(), v2 = v1, v3 = v1; int i1 = -1, i2 = -1, i3 = -1;
    for (int n = 0; n < qb; ++n) { const float* kp = km + n * DH + hi * 8; float sc = 0.f;
#pragma unroll
        for (int d0 = 0; d0 < 8; ++d0) { const f32x4 k0 = *(const f32x4*)(kp + d0 * 16), k1 = *(const f32x4*)(kp + d0 * 16 + 4); const bf16x8 q = qr[d0];
#pragma unroll
            for (int e = 0; e < 4; ++e) { sc += __uint_as_float(((unsigned)(unsigned short)q[e]) << 16) * k0[e]; sc += __uint_as_float(((unsigned)(unsigned short)q[4 + e]) << 16) * k1[e]; } }
        sc += __shfl_xor(sc, 32);
        if (sc > v1) { v3 = v2; i3 = i2; v2 = v1; i2 = i1; v1 = sc; i1 = n; }
        else if (sc > v2) { v3 = v2; i3 = i2; v2 = sc; i2 = n; }
        else if (sc > v3) { v3 = sc; i3 = n; } }
    unsigned m = 0u; if (i1 >= 0) m |= 1u << i1; if (i2 >= 0) m |= 1u << i2; if (i3 >= 0) m |= 1u << i3;
    return m;
}
struct BlockRef { const bf16_t* Q; const bf16_t* K; const bf16_t* V; bf16_t* O; int qb; };
struct Seam { bf16x8 qr[8]; bf16x8 st_v0, st_v1, st_k0, st_k1; };
#define VMW() asm volatile("s_waitcnt vmcnt(0)" ::: "memory")
#define VMWN(n) asm volatile("s_waitcnt vmcnt(%0)" :: "i"(n) : "memory")
#define GLD8(ubase) (*reinterpret_cast<const bf16x8*>((ubase) + toff))
#define SLOAD_H(Kp, Vp, k0) do { const char* kb__ = (const char*)(Kp) + (size_t)(k0) * (LD * 2); const char* vb__ = (const char*)(Vp) + (size_t)(k0) * (LD * 2); \
                         S.st_v0 = GLD8(vb__); S.st_v1 = GLD8(vb__ + 32 * LD * 2); S.st_k0 = GLD8(kb__); S.st_k1 = GLD8(kb__ + 32 * LD * 2); } while (0)
#define SWRITE_HK(bf) do { *(bf16x8*)(K_lds + (bf) * SHM_K + kws) = S.st_k0; *(bf16x8*)(K_lds + (bf) * SHM_K + kws + 32 * 256) = S.st_k1; } while (0)
#define SWRITE_HV(bf) do { *(bf16x8*)(V_lds + (bf) * SHM_V + vst0) = S.st_v0; *(bf16x8*)(V_lds + (bf) * SHM_V + vst1) = S.st_v1; } while (0)
#define SWRITE_H(bf) do { SWRITE_HV(bf); SWRITE_HK(bf); } while (0)
__device__ __forceinline__ void moba_prime(const BlockRef& cur, char* lds, Seam& S, int tid) {
    const int wid = __builtin_amdgcn_readfirstlane(tid >> 6), lane = tid & 63, r32 = lane & 31, hi = lane >> 5;
    const int sr = tid >> 4, sc = (tid & 15) * 8, kws = KSWZ(sr, sc * 2); char* K_lds = lds + 2 * SHM_V;
    const unsigned toff = (unsigned)(sr * LD + sc) * 2u, qoff = (unsigned)(r32 * LD + hi * 8) * 2u;
    { const char* qb_ = (const char*)cur.Q + (size_t)(wid * QBLK) * (LD * 2);
#pragma unroll
      for (int d0 = 0; d0 < 8; ++d0) S.qr[d0] = *reinterpret_cast<const bf16x8*>(qb_ + d0 * 32 + qoff); }
    SLOAD_H(cur.K, cur.V, 0); VMW(); SWRITE_HK(0);
    __syncthreads();
}
__device__ __forceinline__ void moba_block(const BlockRef& cur, const BlockRef& nxt, char* lds, Seam& S, int tid) {
    const int wid = __builtin_amdgcn_readfirstlane(tid >> 6), lane = tid & 63, r32 = lane & 31, hi = lane >> 5;
    const int NT = 4 * (cur.qb + 1);
    const int P0 = cur.qb * QB;
    const int qlo = P0 + wid * QBLK, qm = qlo + r32 - 4 * hi;
    const unsigned msk = moba_gate(S.qr, (const float*)(lds + KM_OFF), cur.qb, hi);
    char* V_lds = lds; char* K_lds = lds + 2 * SHM_V;
    float* ws = (float*)(lds + 2 * SHM_V + 2 * SHM_K) + wid * 64; float* li_l = ws, * al_l = ws + 32;
    float m_reg = -1e30f, l_reg = 0; f32x16 o[4] = {};
    const int sr = tid >> 4, sc = (tid & 15) * 8, vst0 = v_st(sr, sc), vst1 = v_st(32 + sr, sc), kws = KSWZ(sr, sc * 2);
    const unsigned toff = (unsigned)(sr * LD + sc) * 2u, qoff = (unsigned)(r32 * LD + hi * 8) * 2u;
    const int vb0 = (int)(uintptr_t)V_lds + v_rd_base(lane);
    const bf16_t* Kh = cur.K; const bf16_t* Vh = cur.V;
#define RESC(a) do { if (__any((a) < 1.f)) { if (hi == 0) al_l[r32] = (a); asm volatile("s_waitcnt lgkmcnt(0)" ::: "memory");              \
                     for (int d_ = 0; d_ < 4; ++d_) for (int r = 0; r < 16; ++r) o[d_][r] *= al_l[crow(r, hi)]; } } while (0)
#define KBASE(t) ((t) * KVBLK)
#define MASKT(P0_, P1_, t) do { const int kb_ = KBASE(t); const int jb_ = (t) >> 2; \
        if (jb_ < cur.qb) { mask_all(P0_, P1_, ((msk >> jb_) & 1u) != 0u); } \
        else if (kb_ + KVBLK - 1 > qlo) mask_causal(P0_, P1_, qm - kb_); } while (0)
    constexpr int NQL = 8;
#define SEAM_K0() do { VMWN(NQL); SWRITE_HK(0); SBAR(); } while (0)
    f32x16 pA0, pA1, pB0, pB1; float mnA, mnB, alA, alB; bf16x8 pa0, pa1, pa2, pa3;
    SWRITE_HV(0); SBAR();
    if (NT > 1) { SLOAD_H(Kh, Vh, KBASE(1)); }
    SBAR(); qkt<0>(pA0, pA1, K_lds, r32, hi, S.qr);
    MASKT(pA0, pA1, 0); partialSM(pA0, pA1, m_reg, mnA, alA);
    if (NT > 1) { VMW(); SWRITE_H(1); }
    __syncthreads();
#define HALF_STEP(PX0, PX1, mnX, alX, PY0, PY1, alY, t, KB, VB, SB) do {                                                      \
        SBAR(); qkt<KB>(PX0, PX1, K_lds, r32, hi, S.qr);                                             \
        finishSM(PY0, PY1, alY, l_reg, pa0, pa1, pa2, pa3); SBAR();                                                           \
        if ((t) + 1 < NT) { SLOAD_H(Kh, Vh, KBASE((t) + 1)); SBAR(); }                                               \
        pv_tile<VB>(o, vb0, pa0, pa1, pa2, pa3); MASKT(PX0, PX1, (t)); partialSM(PX0, PX1, m_reg, mnX, alX);                                        \
        __syncthreads();                                                                                                      \
        if ((t) + 1 < NT) { VMW(); SWRITE_H(SB); }                                                                          \
        RESC(alX); __syncthreads(); } while (0)
    for (int t = 1; t + 1 < NT; t += 2) {
        HALF_STEP(pB0, pB1, mnB, alB, pA0, pA1, alA, t, 1, 0, 0);
        HALF_STEP(pA0, pA1, mnA, alA, pB0, pB1, alB, t + 1, 0, 1, 1);
    }
    const bool even = (NT & 1) == 0;
    if (even) { SBAR(); qkt<1>(pB0, pB1, K_lds, r32, hi, S.qr); SBAR(); }
    SLOAD_H(nxt.K, nxt.V, 0); SBAR();
    { const char* qb_ = (const char*)nxt.Q + (size_t)(wid * QBLK) * (LD * 2);
#pragma unroll
      for (int d0 = 0; d0 < 8; ++d0) S.qr[d0] = *reinterpret_cast<const bf16x8*>(qb_ + d0 * 32 + qoff); }
    SBAR();
    finishSM(pA0, pA1, alA, l_reg, pa0, pa1, pa2, pa3); SBAR();
    pv_tile<0>(o, vb0, pa0, pa1, pa2, pa3);
    if (even) { MASKT(pB0, pB1, NT - 1); partialSM(pB0, pB1, m_reg, mnB, alB); __syncthreads(); RESC(alB);
        finishSM(pB0, pB1, alB, l_reg, pa0, pa1, pa2, pa3); SBAR(); pv_tile<1>(o, vb0, pa0, pa1, pa2, pa3); }
    SBAR(); SEAM_K0();
    if (hi == 0) li_l[r32] = l_reg; asm volatile("s_waitcnt lgkmcnt(0)" ::: "memory");
    float rli[16];
#pragma unroll
    for (int r = 0; r < 16; ++r) rli[r] = __builtin_amdgcn_rcpf(li_l[crow(r, hi)]);
    char* Ow = (char*)cur.O + (size_t)(wid * QBLK) * (LD * 2);
    const unsigned ooff = (unsigned)(4 * hi * LD + r32) * 2u;
#pragma unroll
    for (int r = 0; r < 16; ++r) { char* Or = Ow + (size_t)((r & 3) + 8 * (r >> 2)) * (LD * 2);
#pragma unroll
        for (int d0 = 0; d0 < 4; ++d0) { const float v = o[d0][r] * rli[r];
            const float vn = __shfl_xor(v, 1);
            if ((r32 & 1) == 0) *(unsigned*)(Or + d0 * 64 + ooff) = cvtpk(v, vn); } }
    __syncthreads();
#undef RESC
#undef KBASE
#undef MASKT
#undef SEAM_K0
#undef HALF_STEP
}
#undef VMW
#undef VMWN
#undef SLOAD_H
#undef GLD8
#undef SWRITE_HK
#undef SWRITE_HV
#undef SWRITE_H
}

struct Args { const float* in[25]; float* out; unsigned char* ws; int ph_lo, ph_hi, li, pad; };
enum { IN_X = 0, IN_C, IN_NMG, IN_NFG, IN_WMOD, IN_BMOD, IN_LWIN, IN_LCW, IN_LCB, IN_LWA, IN_LBA, IN_LWX, IN_LBX, IN_LLAM, IN_LWOUT,
       IN_AQKV, IN_AQG, IN_AKG, IN_AWOUT, IN_RW, IN_RB, IN_WGU, IN_BGU, IN_WDN, IN_BDN };
struct Frame {
    LAS unsigned char* lds;
    unsigned char* ws;
    int tid, lane, wave, vcu, G;
};

__device__ __forceinline__ void cvt_tile(const float* W, int ldw, int k0, int n0, bf16_t* WT, int ldt, int drow0, LAS float* scr, int lane) {
    const int q = lane & 15, rr = lane >> 4;
    f32x4 v[16];
#pragma unroll
    for (int i = 0; i < 16; ++i) v[i] = __builtin_nontemporal_load((const f32x4*)(W + (size_t)(k0 + 4 * i + rr) * ldw + n0 + 4 * q));
#pragma unroll
    for (int i = 0; i < 16; ++i) { LAS float* s = scr + (4 * i + rr) * 65 + 4 * q; s[0] = v[i][0]; s[1] = v[i][1]; s[2] = v[i][2]; s[3] = v[i][3]; }
    LDS_WAIT();
    const int c = lane & 7;
#pragma unroll
    for (int jj = 0; jj < 8; ++jj) { const int n = (lane >> 3) + 8 * jj; const LAS float* s = scr + (8 * c) * 65 + n;
        u32x4 o; o.x = cvt_pk_bf16(s[0 * 65], s[1 * 65]); o.y = cvt_pk_bf16(s[2 * 65], s[3 * 65]); o.z = cvt_pk_bf16(s[4 * 65], s[5 * 65]); o.w = cvt_pk_bf16(s[6 * 65], s[7 * 65]);
        const int dr = drow0 + n;
        *(u32x4*)(WT + ((size_t)(dr >> 8) * (ldt >> 6) + (k0 >> 6)) * (256 * 64) + (size_t)(dr & 255) * 64 + 8 * c) = o; }
    LDS_WAIT();
}
__device__ __forceinline__ void phase_prologue(Frame& F, const Args& a) {
    if (blockIdx.x < 96) {
        LAS float* cond = (LAS float*)F.lds;
        LAS float* red = (LAS float*)(F.lds + 16384);
        const float* c = a.in[IN_C];
        for (int i = F.tid; i < BATCH * D; i += NTHR) { const float x = c[i]; cond[i] = x * sigmoidf_(x); }
        __syncthreads();
        const int l = blockIdx.x / 24, n0 = (blockIdx.x % 24) * 256;
        const float* W = a.in[IN_WMOD] + (size_t)l * D * 6 * D + n0 + 4 * F.lane;
        f32x4 acc[4];
#pragma unroll
        for (int b = 0; b < 4; ++b) acc[b] = (f32x4){0.f, 0.f, 0.f, 0.f};
        const int kb = F.wave * 128;
#pragma unroll 8
        for (int k = 0; k < 128; ++k) { const f32x4 w = *(const f32x4*)(W + (size_t)(kb + k) * 6 * D);
#pragma unroll
            for (int b = 0; b < 4; ++b) acc[b] += w * cond[b * D + kb + k]; }
#pragma unroll
        for (int b = 0; b < 4; ++b) *(LAS f32x4*)(red + (F.wave * 4 + b) * 256 + 4 * F.lane) = acc[b];
        __syncthreads();
        float* MOD = (float*)(F.ws + WS_MOD);
        for (int o = F.tid; o < 1024; o += NTHR) { const int b = o >> 8, n = o & 255; float s = 0.f;
#pragma unroll
            for (int w = 0; w < 8; ++w) s += red[(w * 4 + b) * 256 + n];
            MOD[((size_t)l * BATCH + b) * 6 * D + n0 + n] = s + a.in[IN_BMOD][(size_t)l * 6 * D + n0 + n]; }
        __syncthreads();
    }
    { const int g = blockIdx.x * NTHR + F.tid; if (g < 2 * D) { const float lam = a.in[IN_LLAM][g]; const float z = -lam;
        const float sp = z > 20.f ? z : log1pf(__expf(z)); ((float*)(F.ws + WS_SP8))[g] = 8.0f * sp; } }
    { float* PAR = (float*)(F.ws + WS_PAR); const int g = blockIdx.x * NTHR + F.tid, GS = F.G * NTHR;
#define CPY(dst, src, n) for (int i = g; i < (n) / 4; i += GS) *(f32x4*)(PAR + (dst) + 4 * i) = *(const f32x4*)(a.in[src] + 4 * i)
      CPY(PAR_NMG, IN_NMG, 4 * 1024); CPY(PAR_NFG, IN_NFG, 4 * 1024); CPY(PAR_LCW, IN_LCW, 2 * 4 * 1024); CPY(PAR_LCB, IN_LCB, 2 * 1024); CPY(PAR_LBA, IN_LBA, 2 * 1024); CPY(PAR_LBX, IN_LBX, 2 * 1024);
      CPY(PAR_AQG, IN_AQG, 256); CPY(PAR_AKG, IN_AKG, 256); CPY(PAR_RW, IN_RW, 4 * 1024 * 32); CPY(PAR_RB, IN_RB, 128); CPY(PAR_BGU, IN_BGU, 4 * 32 * 2048); CPY(PAR_BDN, IN_BDN, 4 * 32 * 1024);
#undef CPY
    }
    LAS float* scr = (LAS float*)(F.lds + F.wave * 16640);
    const int gw = F.vcu * NWAVES + F.wave, NGW = F.G * NWAVES;
    constexpr int I2 = 2 * 512, I3 = 16 * 16, I4 = 2 * 256, I5 = 2 * 768, I6 = 2 * 256;
    constexpr int NITEMS = I2 + I3 + I4 + I5 + I6;
    for (int it = gw; it < NITEMS; it += NGW) {
        int r = it;
        if (r < I2) { const int mat = r >> 9, q = r & 511, kb = q >> 5, nb = q & 31;
            cvt_tile(a.in[IN_LWIN] + (size_t)mat * D * 2 * D, 2 * D, kb * 64, nb * 64, (bf16_t*)(F.ws + WS_WIN) + (size_t)mat * 2 * D * D, D, nb * 64, scr, F.lane); continue; } r -= I2;
        if (r < I3) { const int mat = r >> 4, q = r & 15, kb = q >> 2, nb = q & 3;
            const int layer = mat >> 3, ax = (mat >> 2) & 1, g = mat & 3, n0 = nb * 64;
            const float* src = (ax ? a.in[IN_LWX] : a.in[IN_LWA]) + (size_t)(layer * 4 + g) * 256 * 256;
            const int dr = (g * 2 + (n0 >> 7)) * 256 + ax * 128 + (n0 & 127);
            cvt_tile(src, 256, kb * 64, n0, (bf16_t*)(F.ws + WS_WG) + (size_t)layer * 2048 * 256, 256, dr, scr, F.lane); continue; } r -= I3;
        if (r < I4) { const int mat = r >> 8, q = r & 255, kb = q >> 4, nb = q & 15;
            cvt_tile(a.in[IN_LWOUT] + (size_t)mat * D * D, D, kb * 64, nb * 64, (bf16_t*)(F.ws + WS_WLO) + (size_t)mat * D * D, D, nb * 64, scr, F.lane); continue; } r -= I4;
        if (r < I5) { const int mat = r / 768, q = r % 768, kb = q / 48, nb = q % 48;
            cvt_tile(a.in[IN_AQKV] + (size_t)mat * D * 3 * D, 3 * D, kb * 64, nb * 64, (bf16_t*)(F.ws + WS_WQKV) + (size_t)mat * 3 * D * D, D, nb * 64, scr, F.lane); continue; } r -= I5;
        { const int mat = r >> 8, q = r & 255, kb = q >> 4, nb = q & 15;
            cvt_tile(a.in[IN_AWOUT] + (size_t)mat * D * D, D, kb * 64, nb * 64, (bf16_t*)(F.ws + WS_WAO) + (size_t)mat * D * D, D, nb * 64, scr, F.lane); }
    }
}

__device__ __forceinline__ void phase_convert_experts(Frame& F, const float* wgu, const float* wdn, int layer) {
    LAS float* scr = (LAS float*)(F.lds + F.wave * 16640);
    const int gw = F.vcu * NWAVES + F.wave, NGW = F.G * NWAVES;
    constexpr int J0 = NE * 512, J1 = NE * 256;
    for (int it0 = gw; it0 < J0 + J1; it0 += NGW) {
        const int it = it0 < J1 ? J0 + it0 : it0 - J1;
        if (it < J0) { const int e = it >> 9, q = it & 511, kb = q >> 5, nb = q & 31, n0 = nb * 64; const int mat = layer * NE + e;
            const int dr = n0 < D ? (n0 >> 7) * 256 + (n0 & 127) : ((n0 - D) >> 7) * 256 + 128 + ((n0 - D) & 127);
            cvt_tile(wgu + (size_t)mat * D * 2 * D, 2 * D, kb * 64, n0, (bf16_t*)(F.ws + WS_WGU) + (size_t)mat * 2 * D * D, D, dr, scr, F.lane); }
        else { const int r = it - J0; const int e = r >> 8, q = r & 255, kb = q >> 4, nb = q & 15; const int mat = layer * NE + e;
            cvt_tile(wdn + (size_t)mat * D * D, D, kb * 64, nb * 64, (bf16_t*)(F.ws + WS_WDN) + (size_t)mat * D * D, D, nb * 64, scr, F.lane); }
    }
}

__device__ __forceinline__ void phase_norm(Frame& F, const float* xin, int layer) {
    const float* PAR = (const float*)(F.ws + WS_PAR);
    const int gw = F.vcu * NWAVES + F.wave; const int m0 = gw * 8; const int b = m0 / SEQ;
    const float* MOD = (const float*)(F.ws + WS_MOD);
    const float* X = (layer == 0) ? xin : (const float*)(F.ws + WS_XB);
    f32x4 gain[4], sc[4], sh[4];
#pragma unroll
    for (int j = 0; j < 4; ++j) { const int c = 4 * F.lane + 256 * j;
        gain[j] = *(const f32x4*)(PAR + PAR_NMG + (size_t)layer * D + c);
        sh[j] = *(const f32x4*)(MOD + ((size_t)layer * BATCH + b) * 6 * D + c); sc[j] = *(const f32x4*)(MOD + ((size_t)layer * BATCH + b) * 6 * D + D + c);
        gain[j] = gain[j] * (1.0f + sc[j]); }
    bf16_t* H = (bf16_t*)(F.ws + WS_H);
#pragma unroll 2
    for (int r = 0; r < 8; ++r) { const int m = m0 + r;
        f32x4 x[4];
#pragma unroll
        for (int j = 0; j < 4; ++j) x[j] = *(const f32x4*)(X + (size_t)m * D + 4 * F.lane + 256 * j);
        float ss = 0.f;
#pragma unroll
        for (int j = 0; j < 4; ++j) ss += (x[j][0] * x[j][0] + x[j][1] * x[j][1]) + (x[j][2] * x[j][2] + x[j][3] * x[j][3]);
        const float rstd = __builtin_amdgcn_rsqf(wave_sum(ss) * (1.0f / D) + NORM_EPS);
#pragma unroll
        for (int j = 0; j < 4; ++j) { const int c = 4 * F.lane + 256 * j;
            const f32x4 h = x[j] * rstd * gain[j] + sh[j];
            u32x2 o; o.x = cvt_pk_bf16(h[0], h[1]); o.y = cvt_pk_bf16(h[2], h[3]); *(u32x2*)(H + (size_t)m * D + c) = o; }
    }
}

constexpr int MOE_TOK = T / TOPK;
__device__ __forceinline__ void phase_router(Frame& F, int layer) {
    constexpr int RPW = MOE_TOK / (256 * NWAVES * 2);
    const float* PAR = (const float*)(F.ws + WS_PAR);
    LAS float* rw = (LAS float*)F.lds;
    LAS unsigned* lcnt = (LAS unsigned*)(F.lds + LDS_X);
    LAS unsigned* lbase = lcnt + 32;
    LAS unsigned* pend = lcnt + 64;
    { const float* RW = PAR + PAR_RW + (size_t)layer * D * NE;
      for (int i = F.tid; i < D * NE / 4; i += NTHR) { const int col = i >> 3, ch = i & 7; const f32x4 v = *(const f32x4*)(RW + (size_t)i * 4);
          *(LAS f32x4*)(rw + col * 32 + ((ch ^ ((col >> 2) & 7)) << 2)) = v; }
      if (F.tid < 32) lcnt[F.tid] = 0u; }
    __syncthreads();
    const int gw = F.vcu * NWAVES + F.wave; const int m0 = gw * 2 * RPW; const int b = m0 / SEQ;
    const float* MOD = (const float*)(F.ws + WS_MOD);
    f32x4 gain[4], sc[4], sh[4];
#pragma unroll
    for (int j = 0; j < 4; ++j) { const int c = 4 * F.lane + 256 * j; gain[j] = *(const f32x4*)(PAR + PAR_NFG + (size_t)layer * D + c);
        sh[j] = *(const f32x4*)(MOD + ((size_t)layer * BATCH + b) * 6 * D + 3 * D + c); sc[j] = *(const f32x4*)(MOD + ((size_t)layer * BATCH + b) * 6 * D + 4 * D + c); }
    const float* XB = (const float*)(F.ws + WS_XB); bf16_t* H = (bf16_t*)(F.ws + WS_H);
    const float rbias = PAR[PAR_RB + layer * NE + (F.lane & 31)];
    const int sw = F.lane & 7;
    for (int rp = 0; rp < RPW; ++rp) {
        f32x4 h[2][4];
#pragma unroll
        for (int q = 0; q < 2; ++q) { const int m = m0 + rp * 2 + q;
            f32x4 x[4]; float ss = 0.f;
#pragma unroll
            for (int j = 0; j < 4; ++j) { x[j] = *(const f32x4*)(XB + (size_t)m * D + 4 * F.lane + 256 * j); ss += (x[j][0] * x[j][0] + x[j][1] * x[j][1]) + (x[j][2] * x[j][2] + x[j][3] * x[j][3]); }
            const float rstd = __builtin_amdgcn_rsqf(wave_sum(ss) * (1.0f / D) + NORM_EPS);
#pragma unroll
            for (int j = 0; j < 4; ++j) { h[q][j] = x[j] * rstd * gain[j] * (1.0f + sc[j]) + sh[j];
                u32x2 o; o.x = cvt_pk_bf16(h[q][j][0], h[q][j][1]); o.y = cvt_pk_bf16(h[q][j][2], h[q][j][3]); *(u32x2*)(H + (size_t)m * D + 4 * F.lane + 256 * j) = o; } }
        float v[64];
#pragma unroll
        for (int i = 0; i < 64; ++i) v[i] = 0.f;
#pragma unroll
        for (int j = 0; j < 4; ++j)
#pragma unroll
            for (int cc = 0; cc < 4; ++cc) { const int col = 4 * F.lane + 256 * j + cc; const LAS float* rp_ = rw + col * 32;
#pragma unroll
                for (int eq = 0; eq < 8; ++eq) { const f32x4 w = *(const LAS f32x4*)(rp_ + ((eq ^ sw) << 2));
#pragma unroll
                    for (int k = 0; k < 4; ++k) { v[eq * 4 + k] = fmaf(h[0][j][cc], w[k], v[eq * 4 + k]); v[32 + eq * 4 + k] = fmaf(h[1][j][cc], w[k], v[32 + eq * 4 + k]); } } }
#pragma unroll
        for (int i = 0; i < 32; ++i) { const bool up = (F.lane & 32) != 0; const float send = up ? v[i] : v[32 + i]; const float recv = __shfl_xor(send, 32); v[i] = (up ? v[32 + i] : v[i]) + recv; }
#pragma unroll
        for (int i = 0; i < 16; ++i) { const bool up = (F.lane & 16) != 0; const float send = up ? v[i] : v[16 + i]; const float recv = __shfl_xor(send, 16); v[i] = (up ? v[16 + i] : v[i]) + recv; }
#pragma unroll
        for (int i = 0; i < 8; ++i) { const bool up = (F.lane & 8) != 0; const float send = up ? v[i] : v[8 + i]; const float recv = __shfl_xor(send, 8); v[i] = (up ? v[8 + i] : v[i]) + recv; }
#pragma unroll
        for (int i = 0; i < 4; ++i) { const bool up = (F.lane & 4) != 0; const float send = up ? v[i] : v[4 + i]; const float recv = __shfl_xor(send, 4); v[i] = (up ? v[4 + i] : v[i]) + recv; }
#pragma unroll
        for (int i = 0; i < 2; ++i) { const bool up = (F.lane & 2) != 0; const float send = up ? v[i] : v[2 + i]; const float recv = __shfl_xor(send, 2); v[i] = (up ? v[2 + i] : v[i]) + recv; }
        { const bool up = (F.lane & 1) != 0; const float send = up ? v[0] : v[1]; const float recv = __shfl_xor(send, 1); v[0] = (up ? v[1] : v[0]) + recv; }
        float logit = v[0] + rbias;
        float tv[4]; int te[4];
#pragma unroll
        for (int k = 0; k < 4; ++k) { float bv = logit; int be = F.lane & 31;
#pragma unroll
            for (int o = 1; o < 32; o <<= 1) { const float ov = __shfl_xor(bv, o); const int oe = __shfl_xor(be, o); if (ov > bv || (ov == bv && oe < be)) { bv = ov; be = oe; } }
            tv[k] = bv; te[k] = be; if ((F.lane & 31) == be) logit = -__builtin_inff(); }
        const float e1 = __expf(tv[1] - tv[0]), e2 = __expf(tv[2] - tv[0]), e3 = __expf(tv[3] - tv[0]); const float inv = 1.0f / (1.0f + e1 + e2 + e3);
        const int kk = F.lane & 31;
        if (kk < 4) { const int e = kk == 0 ? te[0] : (kk == 1 ? te[1] : (kk == 2 ? te[2] : te[3]));
            const float w = (kk == 0 ? 1.0f : (kk == 1 ? e1 : (kk == 2 ? e2 : e3))) * inv;
            const unsigned rank = __hip_atomic_fetch_add(&lcnt[e], 1u, __ATOMIC_RELAXED, __HIP_MEMORY_SCOPE_WORKGROUP);
            const int rl = F.wave * 2 * RPW + rp * 2 + (F.lane >> 5);
            pend[(rl * 4 + kk) * 2 + 0] = (unsigned)e | (rank << 8); pend[(rl * 4 + kk) * 2 + 1] = __float_as_uint(w); }
    }
    __syncthreads();
    unsigned* gcnt = (unsigned*)(F.ws + WS_CTL) + CW_CNT + 64 * layer;
    if (F.tid < 32) lbase[F.tid] = __hip_atomic_fetch_add(gcnt + F.tid, lcnt[F.tid], __ATOMIC_RELAXED, __HIP_MEMORY_SCOPE_AGENT);
    __syncthreads();
    if (F.tid < NWAVES * 2 * RPW * 4) { const int rl = F.tid >> 2, k = F.tid & 3; const unsigned p0 = pend[(rl * 4 + k) * 2], p1 = pend[(rl * 4 + k) * 2 + 1];
        const unsigned e = p0 & 255u, rank = p0 >> 8; const unsigned pos = lbase[e] + rank; const unsigned tok = (unsigned)(F.vcu * NWAVES * 2 * RPW + rl);
        ((u32x2*)(F.ws + WS_ROWLIST))[(size_t)e * CAP + pos] = (u32x2){tok * 4u + (unsigned)k, p1}; }
}

__device__ __forceinline__ int moe_units(Frame& F, int layer, int npn) {
    LAS int* moe = (LAS int*)(F.lds + LDS_MOE);
    LAS int* units = (LAS int*)(F.lds + LDS_UNITS);
    if (F.wave == 0) {
        const unsigned* gcnt = (const unsigned*)(F.ws + WS_CTL) + CW_CNT + 64 * layer;
        const int e_ = F.lane & 31;
        const int cnt = (int)gcnt[e_]; const int ntl = (cnt + 255) >> 8;
        const int lastv = cnt - (ntl - 1) * 256;
        const int ntail = (ntl > 0 && lastv <= 128) ? 1 : 0, nfull = ntl - ntail;
        int incl = ntl, fincl = nfull, tincl = ntail;
#pragma unroll
        for (int o = 1; o < 32; o <<= 1) { const int t0 = __shfl_up(incl, o), t1 = __shfl_up(fincl, o), t2 = __shfl_up(tincl, o); if ((F.lane & 31) >= o) { incl += t0; fincl += t1; tincl += t2; } }
        const int start = incl - ntl, fstart = fincl - nfull, tstart = tincl - ntail; const int ts = __shfl(incl, 31), nf = __shfl(fincl, 31);
        const int c = blockIdx.x, xcd = c & 7, slot = c >> 3, rpx = 32 / npn;
        const int i = F.lane;
        const int p = (i * 8 + xcd) * rpx + slot / npn, pn = slot % npn;
        int e = 0, j = 0, st = 0, cn = 0;
        for (int q = 0; q < 32; ++q) { const int s_ = __shfl(start, q), c_ = __shfl(cnt, q), fs_ = __shfl(fstart, q), nf_ = __shfl(nfull, q), ts_ = __shfl(tstart, q), nt_ = __shfl(ntail, q), nl_ = __shfl(ntl, q);
            if (p < nf) { if (p >= fs_ && p < fs_ + nf_) { e = q; j = p - fs_; st = s_; cn = c_; } }
            else { const int pt = p - nf; if (pt >= ts_ && pt < ts_ + nt_) { e = q; j = nl_ - 1; st = s_; cn = c_; } } }
        const bool ok = (F.lane < 32) && (p < ts);
        const unsigned long long bal = __ballot(ok);
        if (ok) { int valid = cn - j * 256; valid = valid > 256 ? 256 : valid;
            units[i * 4 + 0] = st + j; units[i * 4 + 1] = pn; units[i * 4 + 2] = e | (j << 8); units[i * 4 + 3] = valid; }
        if (F.lane == 0) moe[40] = __popcll(bal);
    }
    __syncthreads();
    return __builtin_amdgcn_readfirstlane(moe[40]);
}

__device__ __forceinline__ void phase_conv(Frame& F, int j) {
    const float* PAR = (const float*)(F.ws + WS_PAR);
    const int g = F.vcu * NTHR + F.tid; const int chunk = g & 127, seg = g >> 7; const int c0 = chunk * 8, m0 = seg * 16; const int s0 = m0 & (SEQ - 1);
    const bf16_t* RB = (const bf16_t*)(F.ws + WS_RB); bf16_t* XC = (bf16_t*)(F.ws + WS_XC);
    float w[4][8], bias[8];
#pragma unroll
    for (int k = 0; k < 4; ++k) { const f32x4 w0 = *(const f32x4*)(PAR + PAR_LCW + ((size_t)j * 4 + k) * D + c0), w1 = *(const f32x4*)(PAR + PAR_LCW + ((size_t)j * 4 + k) * D + c0 + 4);
#pragma unroll
        for (int i = 0; i < 4; ++i) { w[k][i] = w0[i]; w[k][4 + i] = w1[i]; } }
    { const f32x4 b0 = *(const f32x4*)(PAR + PAR_LCB + (size_t)j * D + c0), b1 = *(const f32x4*)(PAR + PAR_LCB + (size_t)j * D + c0 + 4);
#pragma unroll
      for (int i = 0; i < 4; ++i) { bias[i] = b0[i]; bias[4 + i] = b1[i]; } }
    float x0[8], x1[8], x2[8];
#pragma unroll
    for (int i = 0; i < 8; ++i) { x0[i] = 0.f; x1[i] = 0.f; x2[i] = 0.f; }
    if (s0 != 0) {
        const u32x4 r0 = *(const u32x4*)(RB + (size_t)(m0 - 3) * D + c0), r1 = *(const u32x4*)(RB + (size_t)(m0 - 2) * D + c0), r2 = *(const u32x4*)(RB + (size_t)(m0 - 1) * D + c0);
#pragma unroll
        for (int i = 0; i < 4; ++i) { x0[2 * i] = bflo(r0[i]); x0[2 * i + 1] = bfhi(r0[i]); x1[2 * i] = bflo(r1[i]); x1[2 * i + 1] = bfhi(r1[i]); x2[2 * i] = bflo(r2[i]); x2[2 * i + 1] = bfhi(r2[i]); }
    }
#pragma unroll 4
    for (int t = 0; t < 16; ++t) {
        const u32x4 rr = *(const u32x4*)(RB + (size_t)(m0 + t) * D + c0);
        float x3[8], y[8];
#pragma unroll
        for (int i = 0; i < 4; ++i) { x3[2 * i] = bflo(rr[i]); x3[2 * i + 1] = bfhi(rr[i]); }
#pragma unroll
        for (int i = 0; i < 8; ++i) { y[i] = bias[i] + w[0][i] * x0[i] + w[1][i] * x1[i] + w[2][i] * x2[i] + w[3][i] * x3[i]; x0[i] = x1[i]; x1[i] = x2[i]; x2[i] = x3[i]; }
        u32x4 o; o.x = cvt_pk_bf16(y[0], y[1]); o.y = cvt_pk_bf16(y[2], y[3]); o.z = cvt_pk_bf16(y[4], y[5]); o.w = cvt_pk_bf16(y[6], y[7]);
        *(u32x4*)(XC + (size_t)(m0 + t) * D + c0) = o;
    }
}
__device__ __forceinline__ void phase_scan1(Frame& F) {
    const int item = F.vcu; const int m0 = item * 64; const int ch = 2 * F.tid;
    const bf16_t* LA = (const bf16_t*)(F.ws + WS_AF); const bf16_t* UB = (const bf16_t*)(F.ws + WS_UF);
    float h0 = 0.f, h1 = 0.f, s0 = 0.f, s1 = 0.f;
#pragma unroll 16
    for (int t = 0; t < 64; ++t) { const unsigned lw = *(const unsigned*)(LA + (size_t)(m0 + t) * D + ch), uw = *(const unsigned*)(UB + (size_t)(m0 + t) * D + ch);
        const float l0 = bflo(lw), l1 = bfhi(lw);
        h0 = __builtin_amdgcn_exp2f(l0) * h0 + bflo(uw); h1 = __builtin_amdgcn_exp2f(l1) * h1 + bfhi(uw); s0 += l0; s1 += l1; }
    float* PS = (float*)(F.ws + WS_PS);
    *(f32x4*)(PS + ((size_t)item * D + ch) * 2) = (f32x4){__builtin_amdgcn_exp2f(s0), h0, __builtin_amdgcn_exp2f(s1), h1};
}
__device__ __forceinline__ void phase_scan2(Frame& F) {
    const int item = F.vcu; const int m0 = item * 64; const int ch = 2 * F.tid; const int c = item & 63, b = item >> 6;
    const bf16_t* LA = (const bf16_t*)(F.ws + WS_AF); const bf16_t* UB = (const bf16_t*)(F.ws + WS_UF);
    const float* PS = (const float*)(F.ws + WS_PS); const bf16_t* GB = (const bf16_t*)(F.ws + WS_GB); bf16_t* YB = (bf16_t*)(F.ws + WS_YB);
    float h0 = 0.f, h1 = 0.f;
#pragma unroll 32
    for (int jj = 0; jj < c; ++jj) { const f32x4 s = *(const f32x4*)(PS + ((size_t)(b * 64 + jj) * D + ch) * 2); h0 = s[0] * h0 + s[1]; h1 = s[2] * h1 + s[3]; }
#pragma unroll 16
    for (int t = 0; t < 64; ++t) { const unsigned lw = *(const unsigned*)(LA + (size_t)(m0 + t) * D + ch), uw = *(const unsigned*)(UB + (size_t)(m0 + t) * D + ch);
        const unsigned gw_ = *(const unsigned*)(GB + (size_t)(m0 + t) * D + ch);
        h0 = __builtin_amdgcn_exp2f(bflo(lw)) * h0 + bflo(uw); h1 = __builtin_amdgcn_exp2f(bfhi(lw)) * h1 + bfhi(uw);
        *(unsigned*)(YB + (size_t)(m0 + t) * D + ch) = cvt_pk_bf16(bflo(gw_) * h0, bfhi(gw_) * h1); }
}

__device__ __forceinline__ void phase_qknorm(Frame& F, int j) {
    const float* PAR = (const float*)(F.ws + WS_PAR);
    bf16_t* Q = (bf16_t*)(F.ws + WS_Q); bf16_t* Kb = (bf16_t*)(F.ws + WS_K); float* KM = (float*)(F.ws + WS_KMEAN);
    LAS float* red = (LAS float*)F.lds;
    const int rr = F.lane >> 4, cq = F.lane & 15;
    f32x4 qg0 = *(const f32x4*)(PAR + PAR_AQG + (size_t)j * HD + cq * 8), qg1 = *(const f32x4*)(PAR + PAR_AQG + (size_t)j * HD + cq * 8 + 4);
    f32x4 kg0 = *(const f32x4*)(PAR + PAR_AKG + (size_t)j * HD + cq * 8), kg1 = *(const f32x4*)(PAR + PAR_AKG + (size_t)j * HD + cq * 8 + 4);
    for (int it = F.vcu; it < BATCH * NBLK * NH; it += F.G) {
        const int h = it & 7, blk = (it >> 3) & 15, b = it >> 7;
        const size_t base = ((size_t)(b * SEQ + blk * MBLK + F.wave * 32)) * D + h * HD + cq * 8;
        float ks[8];
#pragma unroll
        for (int i = 0; i < 8; ++i) ks[i] = 0.f;
#pragma unroll 2
        for (int i = 0; i < 8; ++i) { const size_t off = base + (size_t)(i * 4 + rr) * D;
            const u32x4 qw = *(const u32x4*)(Q + off), kw = *(const u32x4*)(Kb + off);
            float qv[8], kv[8]; float sq = 0.f, sk = 0.f;
#pragma unroll
            for (int e = 0; e < 4; ++e) { qv[2 * e] = bflo(qw[e]); qv[2 * e + 1] = bfhi(qw[e]); kv[2 * e] = bflo(kw[e]); kv[2 * e + 1] = bfhi(kw[e]); }
#pragma unroll
            for (int e = 0; e < 8; ++e) { sq += qv[e] * qv[e]; sk += kv[e] * kv[e]; }
#pragma unroll
            for (int o = 1; o < 16; o <<= 1) { sq += __shfl_xor(sq, o); sk += __shfl_xor(sk, o); }
            const float rq = __builtin_amdgcn_rsqf(sq * (1.0f / HD) + NORM_EPS), rk = __builtin_amdgcn_rsqf(sk * (1.0f / HD) + NORM_EPS);
#pragma unroll
            for (int e = 0; e < 8; ++e) { qv[e] = qv[e] * rq * (e < 4 ? qg0[e & 3] : qg1[e & 3]); kv[e] = kv[e] * rk * (e < 4 ? kg0[e & 3] : kg1[e & 3]); ks[e] += kv[e]; }
            u32x4 qo, ko;
#pragma unroll
            for (int e = 0; e < 4; ++e) { qo[e] = cvt_pk_bf16(qv[2 * e], qv[2 * e + 1]); ko[e] = cvt_pk_bf16(kv[2 * e], kv[2 * e + 1]); }
            *(u32x4*)(Q + off) = qo; *(u32x4*)(Kb + off) = ko; }
#pragma unroll
        for (int e = 0; e < 8; ++e) { ks[e] += __shfl_xor(ks[e], 16); ks[e] += __shfl_xor(ks[e], 32); }
        __syncthreads();
        if (F.lane < 16) {
#pragma unroll
            for (int e = 0; e < 8; ++e) red[F.wave * 128 + cq * 8 + e] = ks[e]; }
        __syncthreads();
        if (F.tid < 128) { float s = 0.f;
#pragma unroll
            for (int w = 0; w < 8; ++w) s += red[w * 128 + F.tid];
            KM[(((size_t)b * NH + h) * NBLK + blk) * HD + F.tid] = s * (1.0f / MBLK); }
    }
}
__device__ __forceinline__ void phase_gate(Frame& F) {
    const bf16_t* Q = (const bf16_t*)(F.ws + WS_Q); const float* KM = (const float*)(F.ws + WS_KMEAN); unsigned* SEL = (unsigned*)(F.ws + WS_SEL);
    LAS float* km = (LAS float*)F.lds;
    const int it = F.vcu; const int s8 = it & 7, h = (it >> 3) & 7, b = it >> 6;
    for (int i = F.tid; i < NBLK * HD / 4; i += NTHR) *(LAS f32x4*)(km + 4 * i) = *(const f32x4*)(KM + ((size_t)b * NH + h) * NBLK * HD + 4 * i);
    __syncthreads();
    const int s = s8 * 512 + F.tid; const int qb = __builtin_amdgcn_readfirstlane(s >> 8);
    u32x4 qw[16];
    const bf16_t* qp = Q + ((size_t)(b * SEQ + s)) * D + h * HD;
#pragma unroll
    for (int i = 0; i < 16; ++i) qw[i] = *(const u32x4*)(qp + 8 * i);
    float v1 = -__builtin_inff(), v2 = v1, v3 = v1; int i1 = -1, i2 = -1, i3 = -1;
    for (int n = 0; n < qb; ++n) { float sc = 0.f;
#pragma unroll
        for (int i = 0; i < 16; ++i) { const f32x4 k0 = *(const LAS f32x4*)(km + n * HD + 8 * i), k1 = *(const LAS f32x4*)(km + n * HD + 8 * i + 4);
            sc += bflo(qw[i][0]) * k0[0] + bfhi(qw[i][0]) * k0[1] + bflo(qw[i][1]) * k0[2] + bfhi(qw[i][1]) * k0[3]
                + bflo(qw[i][2]) * k1[0] + bfhi(qw[i][2]) * k1[1] + bflo(qw[i][3]) * k1[2] + bfhi(qw[i][3]) * k1[3]; }
        if (sc > v1) { v3 = v2; i3 = i2; v2 = v1; i2 = i1; v1 = sc; i1 = n; }
        else if (sc > v2) { v3 = v2; i3 = i2; v2 = sc; i2 = n; }
        else if (sc > v3) { v3 = sc; i3 = n; } }
    unsigned m = 0u; if (i1 >= 0) m |= 1u << i1; if (i2 >= 0) m |= 1u << i2; if (i3 >= 0) m |= 1u << i3;
    SEL[((size_t)b * NH + h) * SEQ + s] = m;
}
__device__ __forceinline__ att::BlockRef att_ref(Frame& F, int L, int pass) {
    const int bh = L >> 3, x = L & 7; const int qb = pass ? 15 - x : x; const int b = bh >> 3, h = bh & 7;
    att::BlockRef r; const size_t ro = ((size_t)(b * SEQ + qb * MBLK)) * D + h * HD;
    r.Q = (const bf16_t*)(F.ws + WS_Q) + ro; r.O = (bf16_t*)(F.ws + WS_YB) + ro;
    r.K = (const bf16_t*)(F.ws + WS_K) + (size_t)(b * SEQ) * D + h * HD; r.V = (const bf16_t*)(F.ws + WS_V) + (size_t)(b * SEQ) * D + h * HD;
    r.qb = qb; return r;
}
__device__ __forceinline__ void phase_attn(Frame& F, char* lds) {
    const int total = BATCH * NH * 8, stride = F.G;
    int L = F.vcu; if (L >= total) return;
    int pass = 0;
    att::BlockRef cur = att_ref(F, L, 0);
    att::Seam S;
    att::moba_prime(cur, lds, S, F.tid);
    for (;;) {
        if (pass == 0) {
            const float* KM = (const float*)(F.ws + WS_KMEAN) + (size_t)(L >> 3) * NBLK * HD;
            int t2 = F.tid; asm volatile("" : "+v"(t2));
            *(f32x4*)(lds + att::KM_OFF + t2 * 16) = *(const f32x4*)(KM + t2 * 4);
            __syncthreads(); }
        const bool more_pass = pass == 0, more_item = L + stride < total, last = !more_pass && !more_item;
        int passn = pass + 1, Ln = L;
        if (!more_pass) { passn = 0; Ln = more_item ? L + stride : L; }
        const att::BlockRef nxt = last ? cur : att_ref(F, Ln, passn);
        att::moba_block(cur, nxt, lds, S, F.tid);
        if (last) break;
        cur = nxt; pass = passn; L = Ln;
    }
}

constexpr int NPH = 42;
__global__ void __launch_bounds__(NTHR, 2) fwd(Args args) {
    extern __shared__ __attribute__((aligned(16))) unsigned char lds_[];
    Frame F;
    F.lds = (LAS unsigned char*)lds_; F.ws = args.ws;
    F.tid = threadIdx.x; F.lane = F.tid & 63; F.wave = __builtin_amdgcn_readfirstlane(F.tid >> 6);
    F.G = gridDim.x; { const int bx = blockIdx.x; F.vcu = (F.G % 8 == 0) ? (bx % 8) * (F.G / 8) + bx / 8 : bx; }
    volatile LAS unsigned* MISC = (volatile LAS unsigned*)(F.lds + LDS_MISC);
    if (F.tid < 64) MISC[F.tid] = 0u;
    __syncthreads();
#ifdef PROBE_ORD
    if (F.tid == 0) *(volatile LAS unsigned long long*)(MISC + 14) = __builtin_amdgcn_s_memrealtime();
    __syncthreads();
#endif
    const int lo = args.ph_lo, hi = args.ph_hi;
    unsigned* ctl = (unsigned*)(F.ws + WS_CTL);
    XcdBarrier bar; bar.bar = ctl + CW_BAR + args.li * XCD_BAR_WORDS; bar.x = 0; bar.st = nullptr;
    if (hi - lo > 1) bar = xcd_barrier_post(ctl + CW_BAR + args.li * XCD_BAR_WORDS, MISC + 8);
#ifdef ONLY
#define EN(code) ((code) == ONLY)
#else
#define EN(code) true
#endif
#define IN(k) (lo <= (k) && (k) < hi)
#ifdef PROBE_ORD
#define SEAM(k) do { if (IN(k) && IN((k) + 1)) { xcd_barrier(bar); if (threadIdx.x == 0) { const unsigned n_ = MISC[12] + 1u; MISC[12] = n_; if (n_ == PROBE_ORD) { while (__builtin_amdgcn_s_memrealtime() - *(volatile LAS unsigned long long*)(MISC + 14) < (unsigned long long)(PROBE_US) * 100ull) __builtin_amdgcn_s_sleep(20); } } __syncthreads(); } } while (0)
#else
#define SEAM(k) do { if (IN(k) && IN((k) + 1)) xcd_barrier(bar); } while (0)
#endif
#ifdef PROBE_CODE
#define REPS(code) ((code) == PROBE_CODE ? 1 + PROBE_EXTRA : 1)
#else
#define REPS(code) 1
#endif
#define PF() Frame Fp = F; asm volatile("" : "+v"(Fp.tid)); Fp.lane = Fp.tid & 63
    LAS unsigned* tab = (LAS unsigned*)(F.lds + LDS_TAB);
    const float* xin = args.in[IN_X]; float* out = args.out; const float* PAR = (const float*)(F.ws + WS_PAR);
    const float* wgu_in = args.in[IN_WGU]; const float* wdn_in = args.in[IN_WDN];

    if (EN(0) && IN(0)) { for (int rep_ = 0; rep_ < REPS(0); ++rep_) { if (rep_) __syncthreads(); PF(); phase_prologue(Fp, args); } } SEAM(0);

#pragma nounroll
    for (int l = 0; l < DEPTH; ++l) {
        const int pb = 1 + 10 * l; const int j = l >> 1; const bool lru = (l & 1) == 0;
        if (EN(10) && IN(pb + 0)) { for (int rep_ = 0; rep_ < REPS(10); ++rep_) { if (rep_) __syncthreads(); PF(); phase_norm(Fp, xin, l); } } SEAM(pb + 0);
        if (lru) {
            if (EN(21) && IN(pb + 1)) { for (int rep_ = 0; rep_ < REPS(21); ++rep_) { if (rep_) __syncthreads(); pg8::ProbPlain P; P.init((const bf16_t*)(F.ws + WS_H), (const bf16_t*)(F.ws + WS_WIN) + (size_t)j * 2 * D * D, T, 2 * D, D, D, -1, F.G, (int)blockIdx.x);
                pg8::EpiWin E{(bf16_t*)(F.ws + WS_GB), (bf16_t*)(F.ws + WS_RB)};
                pg8::gemm_phase<pg8::EpiWin, pg8::ProbPlain, true, true>(F.lds, tab, P, E); } } SEAM(pb + 1);
            if (EN(22) && IN(pb + 2)) { for (int rep_ = 0; rep_ < REPS(22); ++rep_) { if (rep_) __syncthreads(); PF(); phase_conv(Fp, j); } } SEAM(pb + 2);
            if (EN(23) && IN(pb + 3)) { for (int rep_ = 0; rep_ < REPS(23); ++rep_) { if (rep_) __syncthreads(); pg8::ProbPlain P; P.init((const bf16_t*)(F.ws + WS_XC), (const bf16_t*)(F.ws + WS_WG) + (size_t)j * 2048 * 256, T, 2 * D, 256, D, 1, F.G, (int)blockIdx.x);
                pg8::EpiGates E{(const bf16_t*)(F.ws + WS_XC), (bf16_t*)(F.ws + WS_AF), (bf16_t*)(F.ws + WS_UF), PAR + PAR_LBA + (size_t)j * D, PAR + PAR_LBX + (size_t)j * D, (const float*)(F.ws + WS_SP8) + (size_t)j * D};
                pg8::gemm_phase<pg8::EpiGates, pg8::ProbPlain, true, true>(F.lds, tab, P, E); } } SEAM(pb + 3);
            if (EN(24) && IN(pb + 4)) { for (int rep_ = 0; rep_ < REPS(24); ++rep_) { if (rep_) __syncthreads(); PF(); phase_scan1(Fp); } } SEAM(pb + 4);
            if (EN(25) && IN(pb + 5)) { for (int rep_ = 0; rep_ < REPS(25); ++rep_) { if (rep_) __syncthreads(); PF(); phase_scan2(Fp); } } SEAM(pb + 5);
        } else {
            if (EN(31) && IN(pb + 1)) { for (int rep_ = 0; rep_ < REPS(31); ++rep_) { if (rep_) __syncthreads(); pg8::ProbPlain P; P.init((const bf16_t*)(F.ws + WS_H), (const bf16_t*)(F.ws + WS_WQKV) + (size_t)j * 3 * D * D, T, 3 * D, D, D, -1, F.G, (int)blockIdx.x);
                pg8::EpiQKV E{(bf16_t*)(F.ws + WS_Q), PAR + PAR_AQG + (size_t)j * HD, PAR + PAR_AKG + (size_t)j * HD, (float*)(F.ws + WS_KMEAN), (LAS float*)(F.lds + LDS_X)};
                pg8::gemm_phase<pg8::EpiQKV, pg8::ProbPlain, true, true>(F.lds, tab, P, E); } } SEAM(pb + 1);
            if (EN(34) && IN(pb + 4)) { for (int rep_ = 0; rep_ < REPS(34); ++rep_) { if (rep_) __syncthreads(); PF(); phase_attn(Fp, (char*)lds_); } } SEAM(pb + 4);
        }
        if (EN(16) && IN(pb + 6)) { for (int rep_ = 0; rep_ < REPS(16); ++rep_) { if (rep_) __syncthreads(); pg8::ProbPlain P; P.init((const bf16_t*)(F.ws + WS_YB), (const bf16_t*)(F.ws + (lru ? WS_WLO : WS_WAO)) + (size_t)j * D * D, T, D, D, D, -1, F.G, (int)blockIdx.x);
            pg8::EpiResid E{l == 0 ? xin : (const float*)(F.ws + WS_XB), (float*)(F.ws + WS_XB), (const float*)(F.ws + WS_MOD) + (size_t)l * BATCH * 6 * D + 2 * D};
            pg8::gemm_phase<pg8::EpiResid, pg8::ProbPlain, false, true>(F.lds, tab, P, E); } } SEAM(pb + 6);
        if (EN(17) && IN(pb + 7)) { PF(); phase_router(Fp, l); __syncthreads(); phase_convert_experts(Fp, wgu_in, wdn_in, l); } SEAM(pb + 7);
        if (EN(18) && IN(pb + 8)) { for (int rep_ = 0; rep_ < REPS(18); ++rep_) { if (rep_) __syncthreads(); PF(); const int nu = moe_units(Fp, l, 8);
            pg8::ProbMoE<true> P; P.A = (const bf16_t*)(F.ws + WS_H); P.Bt = (const bf16_t*)(F.ws + WS_WGU) + (size_t)l * NE * 2 * D * D; P.K = D; P.lda = D; P.bstride = (size_t)2 * D * D;
            P.rowlist = (const unsigned*)(F.ws + WS_ROWLIST); P.units = (const LAS int*)(F.lds + LDS_UNITS); P.nunits = nu;
            pg8::EpiSwiglu E{(bf16_t*)(F.ws + WS_ACT), PAR + PAR_BGU + (size_t)l * NE * 2 * D};
            pg8::gemm_phase<pg8::EpiSwiglu, pg8::ProbMoE<true>, true, true>(F.lds, tab, P, E); } } SEAM(pb + 8);
        if (EN(19) && IN(pb + 9)) { for (int rep_ = 0; rep_ < REPS(19); ++rep_) { if (rep_) __syncthreads(); PF(); const int nu = moe_units(Fp, l, 4);
            pg8::ProbMoE<false> P; P.A = (const bf16_t*)(F.ws + WS_ACT); P.Bt = (const bf16_t*)(F.ws + WS_WDN) + (size_t)l * NE * D * D; P.K = D; P.lda = D; P.bstride = (size_t)D * D;
            P.rowlist = (const unsigned*)(F.ws + WS_ROWLIST); P.units = (const LAS int*)(F.lds + LDS_UNITS); P.nunits = nu;
            pg8::EpiDown E{(const float*)(F.ws + WS_XB), l == DEPTH - 1 ? out : (float*)(F.ws + WS_XB), (const float*)(F.ws + WS_MOD) + (size_t)l * BATCH * 6 * D + 5 * D, PAR + PAR_BDN + (size_t)l * NE * D, (const unsigned*)(F.ws + WS_ROWLIST)};
            pg8::gemm_phase<pg8::EpiDown, pg8::ProbMoE<false>, true, true>(F.lds, tab, P, E); } } SEAM(pb + 9);
    }
#undef IN
#undef SEAM
#undef EN
}

#ifndef DEBUG_CHECKS
#define DEBUG_CHECKS 0
#endif
#ifndef CHK_FROM
#define CHK_FROM 0
#endif
#if DEBUG_CHECKS
constexpr int CW_CHK = 70000;
__device__ __forceinline__ unsigned hsh(unsigned x) { x ^= x >> 16; x *= 0x7feb352du; x ^= x >> 15; x *= 0x846ca68bu; x ^= x >> 16; return x; }
__device__ __forceinline__ bool cls(float got, float ref, float rt, float at) { return (fabsf(got - ref) <= rt * fabsf(ref) + at); }
__device__ __forceinline__ float bfq(const bf16_t* p, size_t i) { return __uint_as_float(((unsigned)p[i]) << 16); }
__device__ __forceinline__ float gelu_ref(float x) { return 0.5f * x * (1.0f + tanhf(0.7978845608028654f * (x + 0.044715f * x * x * x))); }
__global__ void __launch_bounds__(64) chk(Args a, int id, int l, int code) {
    const int j = l >> 1;
    unsigned char* ws = a.ws; unsigned* ctl = (unsigned*)(ws + WS_CTL); const int lane = threadIdx.x;
    const float* MOD = (const float*)(ws + WS_MOD); const float* PAR = (const float*)(ws + WS_PAR);
    const bf16_t* H = (const bf16_t*)(ws + WS_H);
    bool bad = false;
    for (int it = 0; it < 8; ++it) {
        const unsigned sd = hsh(blockIdx.x * 131u + it * 7919u + id * 104729u + 12345u);
        if (id == 1) {
            const int l = sd & 3, b = (sd >> 2) & 3, n = (sd >> 4) % (6 * D); float s = 0.f;
            for (int k = lane; k < D; k += 64) { const float c = a.in[IN_C][b * D + k]; s += (c / (1.0f + expf(-c))) * a.in[IN_WMOD][((size_t)l * D + k) * 6 * D + n]; }
            s = wave_sum(s) + a.in[IN_BMOD][l * 6 * D + n];
            if (!cls(MOD[((size_t)l * BATCH + b) * 6 * D + n], s, 1e-3f, 1e-3f)) bad = true;
        } else if (id == 2) {
            const int m = sd % T, b = m / SEQ; float ss = 0.f;
            for (int k = lane; k < D; k += 64) { const float x = a.in[IN_X][(size_t)m * D + k]; ss += x * x; }
            const float rstd = 1.0f / sqrtf(wave_sum(ss) / D + NORM_EPS);
            for (int k = lane; k < D; k += 64) { const float x = a.in[IN_X][(size_t)m * D + k];
                const float h = x * rstd * a.in[IN_NMG][k] * (1.0f + MOD[(size_t)b * 6 * D + D + k]) + MOD[(size_t)b * 6 * D + k];
                if (!cls(bfq(H, (size_t)m * D + k), h, 0.01f, 0.01f)) bad = true; }
        } else if (id == 3) {
            const int m = sd % T, n = (sd >> 14) % (2 * D); float s = 0.f;
            for (int k = lane; k < D; k += 64) s += bfq(H, (size_t)m * D + k) * a.in[IN_LWIN][((size_t)j * D + k) * 2 * D + n];
            s = wave_sum(s);
            const float got = n < D ? bfq((const bf16_t*)(ws + WS_GB), (size_t)m * D + n) : bfq((const bf16_t*)(ws + WS_RB), (size_t)m * D + n - D);
            const float ref = n < D ? gelu_ref(s) : s;
            if (!cls(got, ref, 0.02f, 0.02f)) bad = true;
        } else if (id == 4) {
            const int m = sd % T, c = (sd >> 14) % D, s0 = m % SEQ; const bf16_t* RB = (const bf16_t*)(ws + WS_RB);
            float y = a.in[IN_LCB][j * D + c];
            for (int k = 0; k < 4; ++k) { const int t = s0 - 3 + k; if (t >= 0) y += a.in[IN_LCW][(j * 4 + k) * D + c] * bfq(RB, (size_t)(m - 3 + k) * D + c); }
            if (!cls(bfq((const bf16_t*)(ws + WS_XC), (size_t)m * D + c), y, 0.01f, 0.01f)) bad = true;
        } else if (id == 5) {
            const int m = sd % T, ch = (sd >> 14) % D, g = ch >> 8, jc = ch & 255; const bf16_t* XC = (const bf16_t*)(ws + WS_XC);
            float sa = 0.f, sx = 0.f;
            for (int i = lane; i < 256; i += 64) { const float xv = bfq(XC, (size_t)m * D + g * 256 + i); sa += xv * a.in[IN_LWA][((size_t)(j * 4 + g) * 256 + i) * 256 + jc]; sx += xv * a.in[IN_LWX][((size_t)(j * 4 + g) * 256 + i) * 256 + jc]; }
            sa = wave_sum(sa) + a.in[IN_LBA][j * D + ch]; sx = wave_sum(sx) + a.in[IN_LBX][j * D + ch];
            const float r = 1.0f / (1.0f + expf(-sa)), ig = 1.0f / (1.0f + expf(-sx)); const float lam = a.in[IN_LLAM][j * D + ch];
            const float la = -8.0f * r * log1pf(expf(-lam)); const float av = expf(la), uv = sqrtf(-expm1f(2.0f * la)) * ig * bfq(XC, (size_t)m * D + ch);
            if (!cls(((const float*)(ws + WS_AF))[(size_t)m * D + ch], av, 2e-3f, 1e-4f)) bad = true;
            if (!cls(((const float*)(ws + WS_UF))[(size_t)m * D + ch], uv, 0.03f, 0.003f)) bad = true;
        } else if (id == 6) {
            const int b = sd & 3, ch = ((sd >> 2) + lane * 17) % D; const float* AF = (const float*)(ws + WS_AF); const float* UF = (const float*)(ws + WS_UF);
            const bf16_t* GB = (const bf16_t*)(ws + WS_GB); const bf16_t* YB = (const bf16_t*)(ws + WS_YB);
            float h = 0.f;
            for (int t = 0; t < SEQ; ++t) { const size_t o = ((size_t)b * SEQ + t) * D + ch; h = AF[o] * h + UF[o];
                if ((t & 127) == 77 || t == SEQ - 1 || t == 0 || t == 64) { if (!cls(bfq(YB, o), bfq(GB, o) * h, 0.02f, 0.01f)) bad = true; } }
        } else if (id == 7) {
            const int m = sd % T, n = (sd >> 14) % D, b = m / SEQ; float s = 0.f; const bf16_t* YB = (const bf16_t*)(ws + WS_YB);
            for (int k = lane; k < D; k += 64) s += bfq(YB, (size_t)m * D + k) * a.in[IN_LWOUT][((size_t)j * D + k) * D + n];
            s = wave_sum(s);
            const float ref = (l == 0 ? a.in[IN_X][(size_t)m * D + n] : ((const float*)(ws + WS_XA))[(size_t)m * D + n]) + MOD[((size_t)l * BATCH + b) * 6 * D + 2 * D + n] * s;
            if (!cls(((const float*)(ws + WS_XB))[(size_t)m * D + n], ref, 0.01f, 0.01f)) bad = true;
        } else if (id == 8) {
            __shared__ float hrow[D];
            const int m = sd % MOE_TOK, b = m / SEQ; const float* XB = (const float*)(ws + WS_XB); float ss = 0.f;
            for (int k = lane; k < D; k += 64) { const float x = XB[(size_t)m * D + k]; ss += x * x; }
            const float rstd = 1.0f / sqrtf(wave_sum(ss) / D + NORM_EPS);
            __syncthreads();
            for (int k = lane; k < D; k += 64) { const float x = XB[(size_t)m * D + k];
                const float h = x * rstd * a.in[IN_NFG][l * D + k] * (1.0f + MOD[((size_t)l * BATCH + b) * 6 * D + 4 * D + k]) + MOD[((size_t)l * BATCH + b) * 6 * D + 3 * D + k]; hrow[k] = h;
                if (!cls(bfq(H, (size_t)m * D + k), h, 0.01f, 0.01f)) bad = true; }
            __syncthreads();
            const int e = lane & 31; float lg = a.in[IN_RB][l * NE + e];
            for (int k = 0; k < D; ++k) lg += hrow[k] * a.in[IN_RW][((size_t)l * D + k) * NE + e];
            int rank = 0; float mx = -1e30f;
            for (int q = 0; q < 32; ++q) { const float o = __shfl(lg, q); if (o > lg || (o == lg && q < e)) ++rank; mx = fmaxf(mx, o); }
            const bool sel = rank < 4; float den = 0.f;
            for (int q = 0; q < 32; ++q) { const float o = __shfl(lg, q); const int rk = __shfl(rank, q); if (rk < 4) den += expf(o - mx); }
            const float wref = expf(lg - mx) / den;
            float v4 = 0.f, v5 = 0.f; for (int q = 0; q < 32; ++q) { const float o = __shfl(lg, q); const int rk = __shfl(rank, q); if (rk == 3) v4 = o; if (rk == 4) v5 = o; }
            const unsigned* gcnt = ctl + CW_CNT + 64 * l; const unsigned* RL = (const unsigned*)(ws + WS_ROWLIST); const float* TW = (const float*)(ws + WS_TOPW);
            if (v4 - v5 > 1e-3f && lane < 32) {
                const int cnt = (int)gcnt[e]; int found = -1;
                for (int p = 0; p < cnt; ++p) { const unsigned r = RL[(size_t)e * CAP + p]; if ((int)(r >> 2) == m) found = (int)r; }
                if (sel) { if (found < 0) bad = true; else if (!cls(TW[found], wref, 0.01f, 1e-3f)) bad = true; }
                else if (found >= 0) bad = true;
            }
            unsigned tot = 0; for (int q = 0; q < 32; ++q) tot += gcnt[q]; if (tot != (unsigned)T) bad = true;
        } else if (id == 9 || id == 10) {
            const unsigned* gcnt = ctl + CW_CNT + 64 * l; const unsigned* RL = (const unsigned*)(ws + WS_ROWLIST); const float* TW = (const float*)(ws + WS_TOPW);
            const int e = sd & 31; int ts = 0; for (int q = 0; q < e; ++q) ts += ((int)gcnt[q] + 255) >> 8;
            const int cnt = (int)gcnt[e]; if (cnt == 0) continue;
            const int pos = (sd >> 5) % cnt; const unsigned dest = RL[(size_t)e * CAP + pos]; const int tok = dest >> 2; const size_t arow = (size_t)ts * 256 + pos;
            const int col = (sd >> 17) % D; const bf16_t* ACT = (const bf16_t*)(ws + WS_ACT);
            if (id == 9) { float sg = 0.f, su = 0.f;
                for (int k = lane; k < D; k += 64) { const float hv = bfq(H, (size_t)tok * D + k); sg += hv * a.in[IN_WGU][((size_t)(l * NE + e) * D + k) * 2 * D + col]; su += hv * a.in[IN_WGU][((size_t)(l * NE + e) * D + k) * 2 * D + D + col]; }
                sg = wave_sum(sg) + a.in[IN_BGU][(size_t)(l * NE + e) * 2 * D + col]; su = wave_sum(su) + a.in[IN_BGU][(size_t)(l * NE + e) * 2 * D + D + col];
                const float gv = fminf(sg, 7.f), uv = fminf(fmaxf(su, -7.f), 7.f); const float ref = gv / (1.0f + expf(-1.702f * gv)) * (uv + 1.0f);
                if (!cls(bfq(ACT, arow * D + col), ref, 0.03f, 0.02f)) bad = true;
            } else { float s = 0.f;
                for (int k = lane; k < D; k += 64) s += bfq(ACT, arow * D + k) * a.in[IN_WDN][((size_t)(l * NE + e) * D + k) * D + col];
                s = (wave_sum(s) + a.in[IN_BDN][(size_t)(l * NE + e) * D + col]) * TW[dest];
                if (!cls(bfq((const bf16_t*)(ws + WS_YK), (size_t)dest * D + col), s, 0.03f, 0.01f)) bad = true; }
        } else if (id == 11) {
            const int m = sd % T, h = (sd >> 14) & 7, which = (sd >> 17) % 3; float r0 = 0.f, r1 = 0.f;
            for (int k = 0; k < D; ++k) { const float hv = bfq(H, (size_t)m * D + k); const float* w = a.in[IN_AQKV] + ((size_t)j * D + k) * 3 * D + which * D + h * HD; r0 += hv * w[lane]; r1 += hv * w[lane + 64]; }
            const bf16_t* buf = (const bf16_t*)(ws + (which == 0 ? WS_Q : (which == 1 ? WS_K : WS_V)));
            const float g0 = bfq(buf, (size_t)m * D + h * HD + lane), g1 = bfq(buf, (size_t)m * D + h * HD + lane + 64);
            if (which == 2) { if (!cls(g0, r0, 0.02f, 0.02f) || !cls(g1, r1, 0.02f, 0.02f)) bad = true; }
            else { const float rs = 1.0f / sqrtf(wave_sum(r0 * r0 + r1 * r1) / HD + NORM_EPS); const float* gg = a.in[which == 0 ? IN_AQG : IN_AKG] + j * HD;
                if (!cls(g0, r0 * rs * gg[lane], 0.03f, 0.03f) || !cls(g1, r1 * rs * gg[lane + 64], 0.03f, 0.03f)) bad = true; }
        } else if (id == 12) {
            const int b = sd & 3, h = (sd >> 2) & 7, blk = (sd >> 5) & 15; const bf16_t* Kb = (const bf16_t*)(ws + WS_K); const float* KM = (const float*)(ws + WS_KMEAN);
            float s0 = 0.f, s1 = 0.f;
            for (int r = 0; r < MBLK; ++r) { const size_t o = ((size_t)b * SEQ + blk * MBLK + r) * D + h * HD; s0 += bfq(Kb, o + lane); s1 += bfq(Kb, o + lane + 64); }
            const float* km = KM + (((size_t)b * NH + h) * NBLK + blk) * HD;
            if (!cls(km[lane], s0 / MBLK, 0.03f, 0.003f) || !cls(km[lane + 64], s1 / MBLK, 0.03f, 0.003f)) bad = true;
            const int s = (sd >> 9) % SEQ, qb = s >> 8; const bf16_t* Q = (const bf16_t*)(ws + WS_Q); const unsigned msk = ((const unsigned*)(ws + WS_SEL))[((size_t)b * NH + h) * SEQ + s];
            float sc[16]; const size_t qo = ((size_t)b * SEQ + s) * D + h * HD;
#pragma unroll
            for (int n = 0; n < 16; ++n) { const float* kk = KM + (((size_t)b * NH + h) * NBLK + n) * HD; sc[n] = wave_sum(bfq(Q, qo + lane) * kk[lane] + bfq(Q, qo + lane + 64) * kk[lane + 64]); }
            int cntb = 0; float minsel = 1e30f;
#pragma unroll
            for (int n = 0; n < 16; ++n) if ((msk >> n) & 1u) { ++cntb; if (n >= qb) bad = true; minsel = fminf(minsel, sc[n]); }
            if (cntb != (qb < 3 ? qb : 3) || (msk >> 16)) bad = true;
            int better = 0;
#pragma unroll
            for (int n = 0; n < 16; ++n) if (n < qb && !((msk >> n) & 1u) && sc[n] > minsel + 1e-3f) ++better;
            if (better) bad = true;
        } else if (id == 13) {
            const int b = sd & 3, h = (sd >> 2) & 7, s = (sd >> 5) % SEQ, qb = s >> 8;
            const bf16_t* Q = (const bf16_t*)(ws + WS_Q); const bf16_t* Kb = (const bf16_t*)(ws + WS_K); const bf16_t* V = (const bf16_t*)(ws + WS_V); const bf16_t* O = (const bf16_t*)(ws + WS_YB);
            const unsigned msk = ((const unsigned*)(ws + WS_SEL))[((size_t)b * NH + h) * SEQ + s] | (1u << qb);
            const size_t qo = ((size_t)b * SEQ + s) * D + h * HD;
            float mx = -1e30f;
            for (int pass = 0; pass < 2; ++pass) {
                float den = 0.f, o0 = 0.f, o1 = 0.f;
                for (int blk = 0; blk <= qb; ++blk) if ((msk >> blk) & 1u) {
                    const int kend = blk == qb ? (s & 255) + 1 : 256;
                    for (int kk = 0; kk < kend; ++kk) { const size_t ko = ((size_t)b * SEQ + blk * MBLK + kk) * D + h * HD;
                        const float sc = wave_sum(bfq(Q, qo + lane) * bfq(Kb, ko + lane) + bfq(Q, qo + lane + 64) * bfq(Kb, ko + lane + 64)) * 0.08838834764831845f;
                        if (pass == 0) mx = fmaxf(mx, sc); else { const float p = expf(sc - mx); den += p; o0 += p * bfq(V, ko + lane); o1 += p * bfq(V, ko + lane + 64); } } }
                if (pass == 1) { if (!cls(bfq(O, qo + lane), o0 / den, 0.03f, 0.01f) || !cls(bfq(O, qo + lane + 64), o1 / den, 0.03f, 0.01f)) bad = true; }
            }
        } else if (id == 14) {
            const int m = sd % T, n = (sd >> 14) % D, b = m / SEQ; float s = 0.f; const bf16_t* YB = (const bf16_t*)(ws + WS_YB);
            for (int k = lane; k < D; k += 64) s += bfq(YB, (size_t)m * D + k) * a.in[IN_AWOUT][((size_t)j * D + k) * D + n];
            s = wave_sum(s);
            const float ref = ((const float*)(ws + WS_XA))[(size_t)m * D + n] + MOD[((size_t)l * BATCH + b) * 6 * D + 2 * D + n] * s;
            if (!cls(((const float*)(ws + WS_XB))[(size_t)m * D + n], ref, 0.01f, 0.01f)) bad = true;
        } else if (id == 15) {
            const int m = sd % T, b = m / SEQ; float ss = 0.f; const float* XA = (const float*)(ws + WS_XA); const bf16_t* YK = (const bf16_t*)(ws + WS_YK);
            for (int k = lane; k < D; k += 64) { const float x = XA[(size_t)m * D + k]; ss += x * x;
                const float sy = bfq(YK, (size_t)m * D + k);
                if (!cls(x, ((const float*)(ws + WS_XB))[(size_t)m * D + k] + MOD[((size_t)(l - 1) * BATCH + b) * 6 * D + 5 * D + k] * sy, 1e-3f, 1e-3f)) bad = true; }
            const float rstd = 1.0f / sqrtf(wave_sum(ss) / D + NORM_EPS);
            for (int k = lane; k < D; k += 64) { const float x = XA[(size_t)m * D + k];
                const float hh = x * rstd * a.in[IN_NMG][l * D + k] * (1.0f + MOD[((size_t)l * BATCH + b) * 6 * D + D + k]) + MOD[((size_t)l * BATCH + b) * 6 * D + k];
                if (!cls(bfq(H, (size_t)m * D + k), hh, 0.01f, 0.01f)) bad = true; }
        }
    }
    if (id == 16) {
        for (int it = 0; it < 8; ++it) { const unsigned sd = hsh(blockIdx.x * 131u + it * 7919u + 777u); const int m = sd % T, b = m / SEQ; const bf16_t* YK = (const bf16_t*)(ws + WS_YK);
            for (int k = lane; k < D; k += 64) { const float sy = bfq(YK, (size_t)m * D + k);
                if (!cls(a.out[(size_t)m * D + k], ((const float*)(ws + WS_XB))[(size_t)m * D + k] + MOD[((size_t)3 * BATCH + b) * 6 * D + 5 * D + k] * sy, 1e-3f, 1e-3f)) bad = true; } } }
    if (id == 99) bad = true;
    if (__any(bad) && lane == 0) atomicMax(ctl + CW_CHK, (unsigned)(100 - code));
    (void)PAR;
}
__global__ void chk_encode(Args a) {
    const unsigned v = ((const unsigned*)(a.ws + WS_CTL))[CW_CHK]; if (v == 0u) return;
    const float f = 1.0f + (float)(100 - (int)v);
    for (size_t i = (size_t)blockIdx.x * blockDim.x + threadIdx.x; i < (size_t)T * D; i += (size_t)gridDim.x * blockDim.x) a.out[i] = a.in[IN_X][i] * f;
}
#endif

#ifndef N_LAUNCH_MODE
#define N_LAUNCH_MODE 1
#endif
extern "C" void kernel_launch(void* const* d_in, const int* in_sizes, int n_in, void* d_out, int out_size, void* d_ws, size_t ws_size, hipStream_t stream) {
    static int grid = 0;
    if (grid == 0) {
        if (n_in != 25 || out_size != T * D || ws_size < WS_END) { fprintf(stderr, "kernel_launch: unexpected shapes (n_in %d out %d ws %zu)\n", n_in, out_size, ws_size); grid = -1; return; }
        int dev = 0, cus = 0;
        if (hipGetDevice(&dev) != hipSuccess || hipDeviceGetAttribute(&cus, hipDeviceAttributeMultiprocessorCount, dev) != hipSuccess) { grid = -1; return; }
        if (hipFuncSetAttribute((const void*)fwd, hipFuncAttributeMaxDynamicSharedMemorySize, LDS_BYTES) != hipSuccess) { fprintf(stderr, "kernel_launch: hipFuncSetAttribute failed\n"); grid = -1; return; }
        int per_cu = 0;
        if (hipOccupancyMaxActiveBlocksPerMultiprocessor(&per_cu, (const void*)fwd, NTHR, LDS_BYTES) != hipSuccess || per_cu < 1) fprintf(stderr, "kernel_launch: occupancy query says %d\n", per_cu);
        (void)hipGetLastError();
        if (cus < 256) { fprintf(stderr, "kernel_launch: %d CUs < 256\n", cus); grid = -1; return; }
        grid = 256;
    }
    if (grid < 0) return;
    (void)hipMemsetAsync((char*)d_ws + WS_CTL, 0, CTL_ZERO_BYTES, stream);
    Args a{};
    for (int i = 0; i < 25; ++i) a.in[i] = (const float*)d_in[i];
    a.out = (float*)d_out; a.ws = (unsigned char*)d_ws; a.pad = 0;
#if N_LAUNCH_MODE == 1
    a.ph_lo = 0; a.ph_hi = NPH - 1; a.li = 0;
    hipLaunchKernelGGL(fwd, dim3(grid), dim3(NTHR), LDS_BYTES, stream, a);
#else
    int ordinal = 0; (void)ordinal;
    for (int p = 0; p < NPH; ++p) {
        const int l = (p - 1) / 10, o = (p - 1) % 10;
        if (p >= 1 && p <= 40 && (l & 1) == 1 && o == 5) continue;
        a.ph_lo = p; a.ph_hi = p + 1; a.li = 0;
        hipLaunchKernelGGL(fwd, dim3(grid), dim3(NTHR), LDS_BYTES, stream, a);
#if DEBUG_CHECKS
        {
            const int lch = (p - 1) / 10, och = (p - 1) % 10; int cid = 0;
            if (p == 0) cid = 1;
            else if (p == 41) cid = 16;
            else if ((lch & 1) == 0) { const int t[10] = {lch == 0 ? 2 : 15, 3, 4, 5, 0, 6, 7, 8, 9, 10}; cid = t[och]; }
            else { const int t[10] = {15, 0, 11, 12, 13, 0, 14, 8, 9, 10}; cid = t[och]; }
            if (cid && p >= CHK_FROM) { ++ordinal; hipLaunchKernelGGL(chk, dim3(64), dim3(64), 0, stream, a, cid, lch < 0 ? 0 : (p == 41 ? 3 : lch), ordinal); }
            if (p == 41) { ++ordinal; hipLaunchKernelGGL(chk, dim3(64), dim3(64), 0, stream, a, 99, 0, ordinal); }
        }
#endif
    }
#if DEBUG_CHECKS
    hipLaunchKernelGGL(chk_encode, dim3(1024), dim3(256), 0, stream, a);
#endif
#endif
}
```

```cpp
#include <hip/hip_runtime.h>
#include <stdint.h>
#include <stdio.h>

#define LAS __attribute__((address_space(3)))
#define GAS __attribute__((address_space(1)))
typedef unsigned short bf16_t;
typedef short bf16x8 __attribute__((ext_vector_type(8)));
typedef float f32x4 __attribute__((ext_vector_type(4)));
typedef float f32x2 __attribute__((ext_vector_type(2)));
typedef unsigned u32x4 __attribute__((ext_vector_type(4)));
typedef unsigned u32x2 __attribute__((ext_vector_type(2)));
typedef long l64x2 __attribute__((ext_vector_type(2)));

constexpr int BATCH = 4, SEQ = 4096, D = 1024, T = BATCH * SEQ, DEPTH = 4;
constexpr int NE = 32, TOPK = 4, NH = 8, HD = 128, NBLK = 16, MBLK = 256;
constexpr float NORM_EPS = 1e-6f;
constexpr int NWAVES = 8, NTHR = 512;
constexpr int CAP = T / TOPK;
constexpr int MAXTILES = T * TOPK / 256 + NE;
constexpr float W8_SCALE = 32.0f;

constexpr size_t MiB = 1u << 20;
constexpr size_t WS_CTL = 0, CTL_ZERO_BYTES = 1 * MiB;
constexpr size_t WS_MOD = 1 * MiB;
constexpr size_t WS_SP8 = 2 * MiB;
constexpr size_t WS_KMEAN = 3 * MiB;
constexpr size_t WS_SEL = 4 * MiB;
constexpr size_t WS_ROWLIST = 5 * MiB;
constexpr size_t WS_TOPW = 7 * MiB;
constexpr size_t WS_PS = 8 * MiB;
constexpr size_t WS_PAR = 10 * MiB;
constexpr int PAR_NMG = 0, PAR_NFG = PAR_NMG + 4 * 1024, PAR_LCW = PAR_NFG + 4 * 1024, PAR_LCB = PAR_LCW + 2 * 4 * 1024, PAR_LBA = PAR_LCB + 2 * 1024, PAR_LBX = PAR_LBA + 2 * 1024,
              PAR_AQG = PAR_LBX + 2 * 1024, PAR_AKG = PAR_AQG + 256, PAR_RW = PAR_AKG + 256, PAR_RB = PAR_RW + 4 * 1024 * 32, PAR_BGU = PAR_RB + 128, PAR_BDN = PAR_BGU + 4 * 32 * 2048, PAR_END = PAR_BDN + 4 * 32 * 1024;
static_assert((size_t)PAR_END * 4 <= 6 * MiB, "param region");
constexpr size_t WS_WIN = 16 * MiB;
constexpr size_t WS_WG = 24 * MiB;
constexpr size_t WS_WLO = 26 * MiB;
constexpr size_t WS_WQKV = 30 * MiB;
constexpr size_t WS_WAO = 42 * MiB;
constexpr size_t WS_WGU = 64 * MiB;
constexpr size_t WS_WDN = 576 * MiB;
constexpr size_t WS_XA = 832 * MiB;
constexpr size_t WS_XB = 896 * MiB;
constexpr size_t WS_H = 960 * MiB;
constexpr size_t WS_GB = 992 * MiB;
constexpr size_t WS_RB = 1024 * MiB;
constexpr size_t WS_XC = 1056 * MiB;
constexpr size_t WS_AF = 1088 * MiB;
constexpr size_t WS_UF = 1152 * MiB;
constexpr size_t WS_YB = 1216 * MiB;
constexpr size_t WS_Q = 1248 * MiB, WS_K = 1280 * MiB, WS_V = 1312 * MiB;
constexpr size_t WS_ACT = 1344 * MiB;
constexpr size_t WS_YK = 1488 * MiB;
constexpr size_t WS_H8 = 1616 * MiB;
constexpr size_t WS_END = 1620 * MiB;

constexpr int CW_BAR = 4096;
constexpr int CW_CNT = 65536;

constexpr int RING_BYTES = 131072;
constexpr int LDS_TAB = RING_BYTES;
constexpr int LDS_UNITS = LDS_TAB + 1024;
constexpr int LDS_MOE = LDS_UNITS + 512;
constexpr int LDS_MISC = LDS_MOE + 512;
constexpr int LDS_X = LDS_MISC + 256;
constexpr int LDS_BYTES = 147456;

__device__ __forceinline__ float bf2f(unsigned h) { return __uint_as_float(h << 16); }
__device__ __forceinline__ float bflo(unsigned u) { return __uint_as_float(u << 16); }
__device__ __forceinline__ float bfhi(unsigned u) { return __uint_as_float(u & 0xffff0000u); }
__device__ __forceinline__ unsigned cvt_pk_bf16(float lo, float hi) { unsigned r; asm("v_cvt_pk_bf16_f32 %0, %1, %2" : "=v"(r) : "v"(lo), "v"(hi)); return r; }
__device__ __forceinline__ float wave_sum(float v) {
#pragma unroll
    for (int o = 1; o < 64; o <<= 1) v += __shfl_xor(v, o);
    return v;
}
__device__ __forceinline__ float fast_exp(float x) { return __builtin_amdgcn_exp2f(x * 1.4426950408889634f); }
__device__ __forceinline__ float sigmoidf_(float x) { return __builtin_amdgcn_rcpf(1.0f + fast_exp(-x)); }
__device__ __forceinline__ unsigned cvt4_fp8(float a, float b, float c, float d) { unsigned w = 0u; w = __builtin_amdgcn_cvt_pk_fp8_f32(a, b, w, false); w = __builtin_amdgcn_cvt_pk_fp8_f32(c, d, w, true); return w; }
#define LDS_WAIT() asm volatile("s_waitcnt lgkmcnt(0)" ::: "memory")
#define VM_WAIT() asm volatile("s_waitcnt vmcnt(0)" ::: "memory")

#define XB_TMO      128
#define XB_XCNT(j)  (256  + 64 * (j))
#define XB_XSUB(j)  (1280 + 64 * (j))
#define XB_XGEN(j)  (2304 + 64 * (j))
#define XB_TOP      3328
#define XB_TOPGEN   3392
#define XCD_BAR_WORDS 3456
#define XB_SPIN_CAP (1u << 18)
__device__ __forceinline__ unsigned xb_ld(unsigned* p)              { return __hip_atomic_load(p, __ATOMIC_RELAXED, __HIP_MEMORY_SCOPE_AGENT); }
__device__ __forceinline__ unsigned xb_add(unsigned* p, unsigned v) { return __hip_atomic_fetch_add(p, v, __ATOMIC_RELAXED, __HIP_MEMORY_SCOPE_AGENT); }
__device__ __forceinline__ unsigned xb_xcc_id() { return (unsigned)__builtin_amdgcn_s_getreg((3 << 11) | 20) & 0xFu; }
#define XB_SPIN(cond, bar) do { unsigned _sp = 0; while (cond) { \
    if ((++_sp & 255u) == 0u) { if (xb_ld(&(bar)[XB_TMO])) break; if (_sp > XB_SPIN_CAP) { atomicAdd(&(bar)[XB_TMO], 1u); break; } } } } while (0)
struct XcdBarrier { unsigned* bar; unsigned x; volatile LAS unsigned* st; };
__device__ __forceinline__ XcdBarrier xcd_barrier_post(unsigned* bar, volatile LAS unsigned* st) {
    XcdBarrier b; b.bar = bar; b.x = xb_xcc_id(); b.st = st;
    if (threadIdx.x == 0) (void)xb_add(&bar[XB_XCNT(b.x)], 1u);
    return b;
}
__device__ __forceinline__ void xcd_barrier_complete(unsigned* bar, unsigned x, unsigned& nloc, unsigned& nx) {
    const unsigned G = gridDim.x * gridDim.y * gridDim.z;
    unsigned sum, cnt, mine, sp = 0u;
    for (;;) {
        sum = 0u; cnt = 0u; mine = 0u;
#pragma unroll
        for (unsigned j = 0; j < 16; ++j) { const unsigned c = xb_ld(&bar[XB_XCNT(j)]); sum += c; cnt += (c > 0u) ? 1u : 0u; mine = (j == x) ? c : mine; }
        if (sum == G) break;
        __builtin_amdgcn_s_sleep(1);
        if ((++sp & 255u) == 0u) { if (xb_ld(&bar[XB_TMO])) break; if (sp > XB_SPIN_CAP) { atomicAdd(&bar[XB_TMO], 1u); break; } }
    }
    nloc = mine > 0u ? mine : 1u; nx = cnt > 0u ? cnt : 1u;
}
__device__ __forceinline__ void xcd_barrier(const XcdBarrier& b) {
    asm volatile("s_waitcnt vmcnt(0)" ::: "memory");
    __syncthreads();
    if (threadIdx.x == 0) {
        unsigned* bar = b.bar;
        __builtin_amdgcn_s_waitcnt(0);
        unsigned nloc = b.st[0], nx = b.st[1];
        if (nloc == 0u) { xcd_barrier_complete(bar, b.x, nloc, nx); b.st[0] = nloc; b.st[1] = nx; }
        const unsigned old = xb_add(&bar[XB_XSUB(b.x)], 1u);
        const unsigned gen = old / nloc;
        if (old + 1u == (gen + 1u) * nloc) {
            __builtin_amdgcn_fence(__ATOMIC_RELEASE, "agent");
            asm volatile("s_waitcnt vmcnt(0)" ::: "memory");
            const unsigned og = xb_add(&bar[XB_TOP], 1u);
            const unsigned tg = og / nx;
            if (og + 1u == (tg + 1u) * nx) xb_add(&bar[XB_TOPGEN], 1u);
            else XB_SPIN(xb_ld(&bar[XB_TOPGEN]) == tg, bar);
            __builtin_amdgcn_fence(__ATOMIC_ACQUIRE, "agent");
            xb_add(&bar[XB_XGEN(b.x)], 1u);
            asm volatile("s_waitcnt vmcnt(0)" ::: "memory");
        } else {
            XB_SPIN(xb_ld(&bar[XB_XGEN(b.x)]) == gen, bar);
            __builtin_amdgcn_fence(__ATOMIC_ACQUIRE, "agent");
            asm volatile("s_waitcnt vmcnt(0)" ::: "memory");
        }
    }
    __syncthreads();
}

namespace pg8 {
constexpr int BM = 256, BK = 64, HALF = 128, HTB = HALF * BK * 2, STAGE_BYTES = 8 * HTB, NXCD = 8, WGM = 8;
__host__ __device__ __forceinline__ int lds_byte(int r, int c) { const int st = (r >> 4) * 2 + (c >> 5), rr = r & 15, cc = c & 31, ob = rr * 64 + cc * 2; return st * 1024 + (ob ^ (((ob >> 9) & 1) << 5)); }
__host__ __device__ __forceinline__ void stage_rc(int b, int& R, int& C) { const int st = b / 1024, sb = b % 1024, swz = sb ^ (((sb >> 9) & 1) << 5); R = (st >> 1) * 16 + swz / 64; C = (st & 1) * 32 + (swz % 64) / 2; }
__host__ __device__ __forceinline__ int perm32(int rho) { const int n = rho >> 4, i = rho & 15; return 8 * (i >> 2) + 4 * n + (i & 3); }

struct Unit { int pm, pn, e, valid, j; };

struct ProbPlain {
    static constexpr bool GATHER = false, TAILS = false, ATILED = false, FP8 = false;
    const bf16_t* A; const bf16_t* Bt; int M, N, K, lda; int acol_sh;
    int nM, nN, nwg, G, c;
    __device__ __forceinline__ void init(const bf16_t* A_, const bf16_t* Bt_, int M_, int N_, int K_, int lda_, int acol_sh_, int G_, int c_) {
        A = A_; Bt = Bt_; M = M_; N = N_; K = K_; lda = lda_; acol_sh = acol_sh_; nM = M / BM; nN = N / BM; nwg = nM * nN; G = G_; c = c_; }
    __device__ __forceinline__ bool next(int i, Unit& u) const {
        const long L = (long)i * G + c; if (L >= nwg) return false;
        int wgid = (int)L; { const int q = nwg / NXCD, r = nwg % NXCD, xcd = wgid % NXCD, off = wgid / NXCD; wgid = (xcd < r ? xcd * (q + 1) : r * (q + 1) + (xcd - r) * q) + off; }
        const int nig = WGM * nN, gid = wgid / nig, fm = gid * WGM, gsz = (nM - fm) < WGM ? (nM - fm) : WGM;
        u.pm = fm + ((wgid % nig) % gsz); u.pn = (wgid % nig) / gsz; u.e = 0; u.valid = 256; u.j = 0; return true;
    }
    __device__ __forceinline__ const char* a_base(const Unit& u) const { const int ac = acol_sh >= 0 ? (u.pn >> acol_sh) * 256 : 0; return (const char*)(A + (size_t)u.pm * BM * lda + ac); }
    __device__ __forceinline__ const char* b_base(const Unit& u) const { return (const char*)(Bt + (size_t)u.pn * BM * K); }
    __device__ __forceinline__ void fill_tab(const Unit&, LAS unsigned*) const {}
    __device__ __forceinline__ void a_off(const Unit&, const int (&R)[2], const int (&C)[2], unsigned (&v)[2][2], const LAS unsigned*) const {
#pragma unroll
        for (int h = 0; h < 2; ++h)
#pragma unroll
            for (int i = 0; i < 2; ++i) v[h][i] = (unsigned)((h * HALF + R[i]) * lda + C[i]) * 2u;
    }
};
template <bool GATHER_> struct ProbMoE {
    static constexpr bool GATHER = GATHER_, TAILS = true, ATILED = !GATHER_, FP8 = true;
    const bf16_t* A; const bf16_t* Bt; int K, lda; size_t bstride;
    const unsigned* rowlist; const LAS int* units; int nunits;
    __device__ __forceinline__ bool next(int i, Unit& u) const {
        if (i >= nunits) return false;
        u.pm = __builtin_amdgcn_readfirstlane(units[i * 4 + 0]); u.pn = __builtin_amdgcn_readfirstlane(units[i * 4 + 1]);
        const int ej = __builtin_amdgcn_readfirstlane(units[i * 4 + 2]); u.e = ej & 255; u.j = ej >> 8; u.valid = __builtin_amdgcn_readfirstlane(units[i * 4 + 3]); return true;
    }
    __device__ __forceinline__ const char* a_base(const Unit& u) const { return GATHER ? (const char*)A : (const char*)(A + (size_t)u.pm * BM * lda); }
    __device__ __forceinline__ const char* b_base(const Unit& u) const { return (const char*)(Bt + (size_t)u.e * bstride + (size_t)u.pn * BM * K); }
    __device__ __forceinline__ void fill_tab(const Unit& u, LAS unsigned* tab) const {
        if (GATHER && threadIdx.x < 256) {
            const u32x2* rl = (const u32x2*)rowlist + (size_t)u.e * CAP + u.j * 256;
            const int r = (int)threadIdx.x < u.valid ? (int)threadIdx.x : 0;
            tab[threadIdx.x] = rl[r].x >> 2;
        }
    }
    __device__ __forceinline__ void a_off(const Unit&, const int (&R)[2], const int (&C)[2], unsigned (&v)[2][2], const LAS unsigned* tab) const {
#pragma unroll
        for (int h = 0; h < 2; ++h)
#pragma unroll
            for (int i = 0; i < 2; ++i) {
                if (GATHER) v[h][i] = (tab[h * HALF + R[i]] * (unsigned)lda + (unsigned)C[i]) * 2u;
                else v[h][i] = (unsigned)((h * HALF + R[i]) * BK + C[i]) * 2u;
            }
    }
};

template <class Epi, class Prob, bool ALIGN_EPI, bool SP2>
__device__ __forceinline__ void gemm_phase(LAS unsigned char* lds, LAS unsigned* tab, const Prob& P, const Epi& E) {
    int tid = threadIdx.x; asm volatile("" : "+v"(tid));
    const int wid = __builtin_amdgcn_readfirstlane(tid >> 6), lane = tid & 63, wr = wid >> 2, wc = wid & 3, fr = lane & 15, fq = lane >> 4;
    const int K = P.K, nt = K / BK;
    int Rr[2], Cc[2]; unsigned voffB[2];
#pragma unroll
    for (int i = 0; i < 2; ++i) { int R, C; stage_rc(tid * 16 + i * 8192, R, C); Rr[i] = R; Cc[i] = C; const int Rb = Epi::PERM ? ((R & ~31) + perm32(R & 31)) : R; voffB[i] = (unsigned)(Rb * BK + C) * 2u; }
    const size_t kstepB = (size_t)BM * BK * 2;
    const size_t hstepB = (size_t)HALF * BK * 2;
    const size_t kstep = Prob::ATILED ? (size_t)BM * BK * 2 : (size_t)(BK * 2);
    const size_t hstepA = Prob::GATHER ? (size_t)0 : (Prob::ATILED ? (size_t)HALF * BK * 2 : (size_t)HALF * P.lda * 2);
#define PG8_V1 (Prob::GATHER ? vcur[1] : vcur[0])
    const unsigned ldsw = (unsigned)wid * 1024u;
    const int aoff = lds_byte(wr * 64 + fr, fq * 8), boff = lds_byte(wc * 32 + fr, fq * 8);
#define PG8_SA(b, h) (((b) * 2 + (h)) * HTB)
#define PG8_SB(b, h) ((4 + (b) * 2 + (h)) * HTB)
#define PG8_STAGE(bufoff, gbase, voff) do { _Pragma("unroll") for (int _i = 0; _i < 2; ++_i) \
        __builtin_amdgcn_global_load_lds((const unsigned*)((const char*)(gbase) + (voff)[_i]), (LAS unsigned*)(lds + (bufoff) + ldsw + _i * 8192), 16, 0, 0); } while (0)
#define PG8_LDA(dst, b, h) do { _Pragma("unroll") for (int m = 0; m < 4; ++m) _Pragma("unroll") for (int k = 0; k < 2; ++k) dst[m][k] = *(const LAS bf16x8*)(lds + PG8_SA(b, h) + aoff + m * 2048 + k * 1024); } while (0)
#define PG8_LDB(dst, b, h) do { _Pragma("unroll") for (int n = 0; n < 2; ++n) _Pragma("unroll") for (int k = 0; k < 2; ++k) dst[n][k] = *(const LAS bf16x8*)(lds + PG8_SB(b, h) + boff + n * 2048 + k * 1024); } while (0)
#define PG8_MMA(ai, bj, At, Bt) do { __builtin_amdgcn_s_setprio(1); _Pragma("unroll") for (int m = 0; m < 4; ++m) _Pragma("unroll") for (int n = 0; n < 2; ++n) _Pragma("unroll") for (int k = 0; k < 2; ++k) { \
        if constexpr (Prob::FP8) { const l64x2 bb_ = __builtin_bit_cast(l64x2, Bt[n][k]), aa_ = __builtin_bit_cast(l64x2, At[m][k]); \
            acc[ai][bj][m][n] = __builtin_amdgcn_mfma_f32_16x16x32_fp8_fp8(bb_[0], aa_[0], acc[ai][bj][m][n], 0, 0, 0); acc[ai][bj][m][n] = __builtin_amdgcn_mfma_f32_16x16x32_fp8_fp8(bb_[1], aa_[1], acc[ai][bj][m][n], 0, 0, 0); } \
        else acc[ai][bj][m][n] = __builtin_amdgcn_mfma_f32_16x16x32_bf16(Bt[n][k], At[m][k], acc[ai][bj][m][n], 0, 0, 0); } __builtin_amdgcn_s_setprio(0); } while (0)
#define PG8_WAIT_V(n) asm volatile("s_waitcnt vmcnt(" #n ")" ::: "memory")
#define PG8_WAIT_L(n) asm volatile("s_waitcnt lgkmcnt(" #n ")" ::: "memory")
#define PG8_BAR __builtin_amdgcn_s_barrier()
#define PG8_SCHED __builtin_amdgcn_sched_barrier(0)
    Unit cur, nxt; int ui = 0;
    if (!P.next(0, cur)) return;
    unsigned vcur[2][2];
    if constexpr (Prob::GATHER) { P.fill_tab(cur, tab); asm volatile("s_waitcnt vmcnt(0) lgkmcnt(0)" ::: "memory"); PG8_BAR; asm volatile("" ::: "memory"); }
    P.a_off(cur, Rr, Cc, vcur, tab);
    if constexpr (Prob::GATHER) { asm volatile("s_waitcnt lgkmcnt(0)" ::: "memory"); }
    f32x4 acc[2][2][4][2];
#pragma unroll
    for (int a = 0; a < 2; ++a)
#pragma unroll
        for (int b = 0; b < 2; ++b)
#pragma unroll
            for (int m = 0; m < 4; ++m)
#pragma unroll
                for (int n = 0; n < 2; ++n) acc[a][b][m][n] = (f32x4){0.f, 0.f, 0.f, 0.f};
    bf16x8 At[4][2], B0[2][2], B1[2][2];
    const char* cA = P.a_base(cur); const char* cB = P.b_base(cur);
    static_assert(SP2, "only the two-MFMA-blocks-per-barrier-pair loop is kept");
    PG8_STAGE(PG8_SB(0, 0), cB, voffB); PG8_STAGE(PG8_SB(0, 1), cB + hstepB, voffB); PG8_STAGE(PG8_SA(0, 0), cA, vcur[0]); PG8_STAGE(PG8_SA(0, 1), cA + hstepA, PG8_V1);
    if (wr == 1) PG8_BAR;
    PG8_WAIT_V(2); PG8_BAR;
    PG8_STAGE(PG8_SB(1, 0), cB + kstepB, voffB); PG8_STAGE(PG8_SA(1, 0), cA + kstep, vcur[0]); PG8_STAGE(PG8_SB(1, 1), cB + hstepB + kstepB, voffB);
    PG8_WAIT_V(6); PG8_BAR;
    for (;;) {
        const bool has_next = P.next(ui + 1, nxt);
        const char* nA = has_next ? P.a_base(nxt) : cA; const char* nB = has_next ? P.b_base(nxt) : cB;
        if constexpr (Prob::GATHER) { if (has_next) P.fill_tab(nxt, tab); }
        const bool full = !Prob::TAILS || cur.valid > HALF;
        for (int t = 0; t < nt; t += 2) {
            const bool last = (t == nt - 2);
            const char* a1 = cA + (size_t)(t + 1) * kstep;
            const char* a2 = last ? nA : cA + (size_t)(t + 2) * kstep; const char* b2 = last ? nB : cB + (size_t)(t + 2) * kstepB;
            const char* a3 = a2 + kstep; const char* b3 = b2 + kstepB;
            PG8_LDB(B0, 0, 0); PG8_LDB(B1, 0, 1); PG8_SCHED; PG8_LDA(At, 0, 0); PG8_STAGE(PG8_SA(1, 1), a1 + hstepA, PG8_V1);
            if constexpr (Prob::GATHER) { if (last && has_next) P.a_off(nxt, Rr, Cc, vcur, tab); }
            PG8_WAIT_V(8); PG8_WAIT_L(0); PG8_BAR; PG8_MMA(0, 0, At, B0); PG8_MMA(0, 1, At, B1); PG8_BAR; PG8_SCHED;
            if (full) { PG8_LDA(At, 0, 1); } PG8_STAGE(PG8_SB(0, 0), b2, voffB); PG8_STAGE(PG8_SB(0, 1), b2 + hstepB, voffB); PG8_STAGE(PG8_SA(0, 0), a2, vcur[0]);
            PG8_WAIT_V(8); PG8_WAIT_L(0); PG8_BAR; if (full) { PG8_MMA(1, 0, At, B0); PG8_MMA(1, 1, At, B1); } PG8_BAR; PG8_SCHED;
            PG8_LDB(B0, 1, 0); PG8_LDB(B1, 1, 1); PG8_SCHED; PG8_LDA(At, 1, 0); PG8_STAGE(PG8_SA(0, 1), a2 + hstepA, PG8_V1);
            PG8_WAIT_V(8); PG8_WAIT_L(0); PG8_BAR; PG8_MMA(0, 0, At, B0); PG8_MMA(0, 1, At, B1); PG8_BAR; PG8_SCHED;
            if (full) { PG8_LDA(At, 1, 1); } PG8_STAGE(PG8_SB(1, 0), b3, voffB); PG8_STAGE(PG8_SB(1, 1), b3 + hstepB, voffB); PG8_STAGE(PG8_SA(1, 0), a3, vcur[0]);
            PG8_WAIT_V(8); PG8_WAIT_L(0); PG8_BAR; if (full) { PG8_MMA(1, 0, At, B0); PG8_MMA(1, 1, At, B1); } PG8_BAR; PG8_SCHED;
        }
        if constexpr (ALIGN_EPI) { if (wr == 0) PG8_BAR; }
        E(acc, cur, wr, wc, fr, fq);
        if (!has_next) break;
#pragma unroll
        for (int a = 0; a < 2; ++a)
#pragma unroll
            for (int b = 0; b < 2; ++b)
#pragma unroll
                for (int m = 0; m < 4; ++m)
#pragma unroll
                    for (int n = 0; n < 2; ++n) acc[a][b][m][n] = (f32x4){0.f, 0.f, 0.f, 0.f};
        cur = nxt; cA = nA; cB = nB; ++ui;
        if constexpr (ALIGN_EPI) { if (wr == 1) PG8_BAR; }
    }
    PG8_WAIT_V(0);
    if constexpr (!ALIGN_EPI) { if (wr == 0) PG8_BAR; }
    PG8_BAR;
#undef PG8_V1
#undef PG8_SA
#undef PG8_SB
#undef PG8_STAGE
#undef PG8_LDA
#undef PG8_LDB
#undef PG8_MMA
#undef PG8_WAIT_V
#undef PG8_WAIT_L
#undef PG8_BAR
#undef PG8_SCHED
}

typedef f32x4 AccT[2][2][4][2];
__device__ __forceinline__ float gelu_tanh(float x) {
    const float z = 1.5957691216057308f * (x + 0.044715f * x * x * x);
    return x * __builtin_amdgcn_rcpf(1.0f + __builtin_amdgcn_exp2f(-1.4426950408889634f * z));
}
struct EpiWin {
    static constexpr bool PERM = true;
    bf16_t* GB; bf16_t* RB;
    __device__ __forceinline__ void operator()(const AccT& acc, const Unit& u, int wr, int wc, int fr, int fq) const {
        const int row0 = u.pm * BM + wr * 64 + fr; const bool gate = u.pn < 4;
        bf16_t* base = GB + (size_t)(u.pn >> 2) * ((WS_RB - WS_GB) / 2); const int col0 = (u.pn & 3) * BM + wc * 32 + 8 * fq;
#pragma unroll
        for (int ai = 0; ai < 2; ++ai)
#pragma unroll
            for (int m = 0; m < 4; ++m) { bf16_t* rowp = base + (size_t)(row0 + ai * HALF + m * 16) * D + col0;
#pragma unroll
                for (int bj = 0; bj < 2; ++bj) { f32x4 v0 = acc[ai][bj][m][0], v1 = acc[ai][bj][m][1];
                    if (gate) {
#pragma unroll
                        for (int j = 0; j < 4; ++j) { v0[j] = gelu_tanh(v0[j]); v1[j] = gelu_tanh(v1[j]); } }
                    u32x4 w; w.x = cvt_pk_bf16(v0[0], v0[1]); w.y = cvt_pk_bf16(v0[2], v0[3]); w.z = cvt_pk_bf16(v1[0], v1[1]); w.w = cvt_pk_bf16(v1[2], v1[3]);
                    *(u32x4*)(rowp + bj * HALF) = w; } }
    }
};
struct EpiQKV {
    static constexpr bool PERM = true;
    bf16_t* Q; const float* qg; const float* kg; float* KM; LAS float* xl;
    __device__ __forceinline__ void operator()(const AccT& acc, const Unit& u, int wr, int wc, int fr, int fq) const {
        const int row0 = u.pm * BM + wr * 64 + fr; const int t = u.pn >> 2;
        bf16_t* base = Q + (size_t)t * ((WS_K - WS_Q) / 2); const int col0 = (u.pn & 3) * BM + wc * 32 + 8 * fq;
        LAS float* SS = xl; LAS float* KS = xl + 2048;
#pragma unroll
        for (int ai = 0; ai < 2; ++ai)
#pragma unroll
            for (int m = 0; m < 4; ++m)
#pragma unroll
                for (int bj = 0; bj < 2; ++bj) { const f32x4 v0 = acc[ai][bj][m][0], v1 = acc[ai][bj][m][1];
                    float ss = (v0[0] * v0[0] + v0[1] * v0[1]) + (v0[2] * v0[2] + v0[3] * v0[3]) + (v1[0] * v1[0] + v1[1] * v1[1]) + (v1[2] * v1[2] + v1[3] * v1[3]);
                    ss += __shfl_xor(ss, 16); ss += __shfl_xor(ss, 32);
                    if (fq == 0) SS[((ai * HALF + wr * 64 + m * 16 + fr) * 2 + bj) * 4 + wc] = ss; __builtin_amdgcn_sched_barrier(0); }
        asm volatile("s_waitcnt lgkmcnt(0)" ::: "memory"); __builtin_amdgcn_s_barrier(); asm volatile("" ::: "memory");
        const bool isv = (t == 2);
        const float* gp = (t == 0 ? qg : kg) + wc * 32 + 8 * fq;
        f32x4 g0 = *(const f32x4*)gp, g1 = *(const f32x4*)(gp + 4);
        if (isv) { g0 = (f32x4){1.f, 1.f, 1.f, 1.f}; g1 = g0; }
        {
#pragma unroll
            for (int bj = 0; bj < 2; ++bj) {
                float cs[8];
#pragma unroll
                for (int q = 0; q < 8; ++q) cs[q] = 0.f;
#pragma unroll
                for (int ai = 0; ai < 2; ++ai)
#pragma unroll
                    for (int m = 0; m < 4; ++m) { const int r = ai * HALF + wr * 64 + m * 16 + fr; bf16_t* rowp = base + (size_t)(u.pm * BM + r) * D + col0;
                        const f32x4 p = *(const LAS f32x4*)(SS + (r * 2 + bj) * 4);
                        const float rstd = isv ? 1.0f : __builtin_amdgcn_rsqf(((p[0] + p[1]) + (p[2] + p[3])) * (1.0f / HD) + NORM_EPS);
                        const f32x4 v0 = acc[ai][bj][m][0] * rstd * g0, v1 = acc[ai][bj][m][1] * rstd * g1;
#pragma unroll
                        for (int q = 0; q < 4; ++q) { cs[q] += v0[q]; cs[4 + q] += v1[q]; }
                        u32x4 w; w.x = cvt_pk_bf16(v0[0], v0[1]); w.y = cvt_pk_bf16(v0[2], v0[3]); w.z = cvt_pk_bf16(v1[0], v1[1]); w.w = cvt_pk_bf16(v1[2], v1[3]);
                        *(u32x4*)(rowp + bj * HALF) = w; __builtin_amdgcn_sched_barrier(0); }
#pragma unroll
                for (int q = 0; q < 8; ++q) { float v = cs[q]; v += __shfl_xor(v, 1); v += __shfl_xor(v, 2); v += __shfl_xor(v, 4); v += __shfl_xor(v, 8);
                    if (fr == 0) KS[wr * 256 + bj * HALF + wc * 32 + 8 * fq + q] = v; }
            }
            asm volatile("s_waitcnt lgkmcnt(0)" ::: "memory"); __builtin_amdgcn_s_barrier(); asm volatile("" ::: "memory");
            int tid = threadIdx.x; asm volatile("" : "+v"(tid));
            if (tid < 256 && t == 1) { const int b = u.pm >> 4, blk = u.pm & 15, h = 2 * (u.pn & 3) + (tid >> 7);
                KM[(((size_t)b * NH + h) * NBLK + blk) * HD + (tid & 127)] = (KS[tid] + KS[256 + tid]) * (1.0f / MBLK); }
        }
    }
};
struct EpiGates {
    static constexpr bool PERM = true;
    const bf16_t* XC; bf16_t* LA; bf16_t* UB; const float* ba; const float* bx; const float* sp8;
    __device__ __forceinline__ void operator()(const AccT& acc, const Unit& u, int wr, int wc, int fr, int fq) const {
        const int row0 = u.pm * BM + wr * 64 + fr; const int ch0 = (u.pn >> 1) * 256 + (u.pn & 1) * 128 + wc * 32 + 8 * fq;
        f32x4 bav[2], bxv[2], spv[2];
#pragma unroll
        for (int n = 0; n < 2; ++n) { bav[n] = *(const f32x4*)(ba + ch0 + n * 4); bxv[n] = *(const f32x4*)(bx + ch0 + n * 4); spv[n] = *(const f32x4*)(sp8 + ch0 + n * 4) * 1.4426950408889634f; }
#pragma unroll
        for (int ai = 0; ai < 2; ++ai)
#pragma unroll
            for (int m = 0; m < 4; ++m) { const size_t ro = (size_t)(row0 + ai * HALF + m * 16) * D + ch0;
                const u32x4 xw = *(const u32x4*)(XC + ro);
                float lo[8], uo[8];
#pragma unroll
                for (int n = 0; n < 2; ++n)
#pragma unroll
                    for (int j = 0; j < 4; ++j) { const int q = n * 4 + j; const float xcv = (q & 1) ? bfhi(xw[q >> 1]) : bflo(xw[q >> 1]);
                        const float r = sigmoidf_(acc[ai][0][m][n][j] + bav[n][j]), ig = sigmoidf_(acc[ai][1][m][n][j] + bxv[n][j]);
                        const float l2 = -spv[n][j] * r;
                        const float a2 = __builtin_amdgcn_exp2f(2.0f * l2);
                        lo[q] = l2; uo[q] = __builtin_amdgcn_sqrtf(1.0f - a2) * ig * xcv; }
                u32x4 lw, uw;
#pragma unroll
                for (int q = 0; q < 4; ++q) { lw[q] = cvt_pk_bf16(lo[2 * q], lo[2 * q + 1]); uw[q] = cvt_pk_bf16(uo[2 * q], uo[2 * q + 1]); }
                *(u32x4*)(LA + ro) = lw; *(u32x4*)(UB + ro) = uw; }
    }
};
struct EpiResid {
    static constexpr bool PERM = false;
    const float* X; float* XB; const float* g1;
    __device__ __forceinline__ void operator()(const AccT& acc, const Unit& u, int wr, int wc, int fr, int fq) const {
        const int row0 = u.pm * BM + wr * 64 + fr, col0 = u.pn * BM + wc * 32 + 4 * fq; const int b = (u.pm * BM) / SEQ;
        f32x4 gv[2][2];
#pragma unroll
        for (int bj = 0; bj < 2; ++bj)
#pragma unroll
            for (int n = 0; n < 2; ++n) gv[bj][n] = *(const f32x4*)(g1 + (size_t)b * 6 * D + col0 + bj * HALF + n * 16);
#pragma unroll
        for (int ai = 0; ai < 2; ++ai) {
            f32x4 xv[4][2][2];
#pragma unroll
            for (int m = 0; m < 4; ++m) { const size_t ro = (size_t)(row0 + ai * HALF + m * 16) * D + col0;
#pragma unroll
                for (int bj = 0; bj < 2; ++bj)
#pragma unroll
                    for (int n = 0; n < 2; ++n) xv[m][bj][n] = *(const f32x4*)(X + ro + bj * HALF + n * 16); }
#pragma unroll
            for (int m = 0; m < 4; ++m) { const size_t ro = (size_t)(row0 + ai * HALF + m * 16) * D + col0;
#pragma unroll
                for (int bj = 0; bj < 2; ++bj)
#pragma unroll
                    for (int n = 0; n < 2; ++n) *(f32x4*)(XB + ro + bj * HALF + n * 16) = xv[m][bj][n] + gv[bj][n] * acc[ai][bj][m][n]; }
            asm volatile("" ::: "memory"); }
    }
};
struct EpiSwiglu {
    static constexpr bool PERM = true;
    unsigned char* ACT; const float* bgu;
    __device__ __forceinline__ void operator()(const AccT& acc, const Unit& u, int wr, int wc, int fr, int fq) const {
        const int j0 = u.pn * HALF + wc * 32 + 8 * fq;
        const float* bp = bgu + (size_t)u.e * 2 * D + j0;
        const f32x4 bg0 = *(const f32x4*)(bp), bg1 = *(const f32x4*)(bp + 4), bu0 = *(const f32x4*)(bp + D), bu1 = *(const f32x4*)(bp + D + 4);
        constexpr float IS = 1.0f / W8_SCALE;
#pragma unroll
        for (int ai = 0; ai < 2; ++ai)
#pragma unroll
            for (int m = 0; m < 4; ++m) {
                float o[8];
#pragma unroll
                for (int n = 0; n < 2; ++n)
#pragma unroll
                    for (int j = 0; j < 4; ++j) { const float g = acc[ai][0][m][n][j] * IS + (n ? bg1[j] : bg0[j]), up = acc[ai][1][m][n][j] * IS + (n ? bu1[j] : bu0[j]);
                        const float gv = fminf(g, 7.0f), uv = fminf(fmaxf(up, -7.0f), 7.0f);
                        o[n * 4 + j] = gv * sigmoidf_(1.702f * gv) * (uv + 1.0f); }
                u32x2 w; w.x = cvt4_fp8(o[0], o[1], o[2], o[3]); w.y = cvt4_fp8(o[4], o[5], o[6], o[7]);
                *(u32x2*)(ACT + (size_t)u.pm * BM * D + (size_t)u.pn * (BM * 128) + (size_t)(wr * 64 + fr + ai * HALF + m * 16) * 128 + (wc * 32 + 8 * fq)) = w; }
    }
};
struct EpiDown {
    static constexpr bool PERM = false;
    const float* XB; float* XO; const float* __restrict__ g2; const float* __restrict__ bdn; const unsigned* __restrict__ rowlist;
    __device__ __forceinline__ void operator()(const AccT& acc, const Unit& u, int wr, int wc, int fr, int fq) const {
        const int c0 = u.pn * BM + wc * 32 + 4 * fq;
        const float* bp = bdn + (size_t)u.e * D + c0;
        f32x4 bv[2][2];
#pragma unroll
        for (int bj = 0; bj < 2; ++bj) { bv[bj][0] = *(const f32x4*)(bp + bj * HALF); bv[bj][1] = *(const f32x4*)(bp + bj * HALF + 16); }
        const u32x2* rl = (const u32x2*)rowlist + (size_t)u.e * CAP + u.j * 256;
        u32x2 ri[2][4];
#pragma unroll
        for (int ai = 0; ai < 2; ++ai)
#pragma unroll
            for (int m = 0; m < 4; ++m) { const int r = ai * HALF + wr * 64 + m * 16 + fr; ri[ai][m] = rl[r < u.valid ? r : 0]; }
#pragma unroll
        for (int ai = 0; ai < 2; ++ai)
#pragma unroll
            for (int mp = 0; mp < 2; ++mp) {
                f32x4 xv[2][2][2];
#pragma unroll
                for (int q = 0; q < 2; ++q) { const size_t ro = (size_t)ri[ai][2 * mp + q].x * D + c0;
#pragma unroll
                    for (int bj = 0; bj < 2; ++bj)
#pragma unroll
                        for (int n = 0; n < 2; ++n) xv[q][bj][n] = *(const f32x4*)(XB + ro + bj * HALF + n * 16); }
#pragma unroll
                for (int q = 0; q < 2; ++q) { const int m = 2 * mp + q; const int r = ai * HALF + wr * 64 + m * 16 + fr; const unsigned dest = ri[ai][m].x; const float w = __uint_as_float(ri[ai][m].y);
                    const size_t ro = (size_t)dest * D + c0; const float* gp = g2 + (size_t)(dest / SEQ) * 6 * D + c0;
                    if (r < u.valid) {
#pragma unroll
                        for (int bj = 0; bj < 2; ++bj)
#pragma unroll
                            for (int n = 0; n < 2; ++n) { const f32x4 gv = *(const f32x4*)(gp + bj * HALF + n * 16);
                                *(f32x4*)(XO + ro + bj * HALF + n * 16) = xv[q][bj][n] + gv * ((acc[ai][bj][m][n] * (1.0f / W8_SCALE) + bv[bj][n]) * w); } } }
            }
    }
};
}

namespace att {
typedef short s16x4 __attribute__((ext_vector_type(4)));
typedef float f32x16 __attribute__((ext_vector_type(16)));
constexpr int NW = 8, QBLK = 32, KVBLK = 64, QB = NW * QBLK, DH = 128, LD = 1024;
constexpr int SHM_V = KVBLK * DH * 2, SHM_K = KVBLK * DH * 2;
constexpr int ATT_LDS_BYTES = 2 * SHM_V + 2 * SHM_K + NW * 64 * 4;
constexpr float SCALE = 0.08838834764831845f;
constexpr float THR = 8.f;
#define KSWZ(row, colB) ((row) * 256 + ((colB) ^ (((row) & 7) << 4)))
#define SBAR() __builtin_amdgcn_sched_barrier(0)
__device__ __forceinline__ int v_st(int k, int c) { const int kk = (k & ~0xC) | ((k & 4) << 1) | ((k & 8) >> 1); return ((kk >> 3) * 4 + (c >> 5)) * 512 + ((kk & 7) * 32 + (c & 31)) * 2; }
__device__ __forceinline__ int v_rd_base(int lane) { return ((lane & 3) << 3) | (((lane >> 2) & 3) << 6) | (((lane >> 4) & 1) << 5) | (((lane >> 5) & 1) << 8); }
constexpr int v_rd_off(int d0, int ks, int half) { return d0 * 512 + ks * 4096 + half * 2048; }
__device__ __forceinline__ int crow(int r, int hi) { return (r & 3) + 8 * (r >> 2) + 4 * hi; }
__device__ __forceinline__ unsigned cvtpk(float lo, float hi) { unsigned r; asm volatile("v_cvt_pk_bf16_f32 %0, %1, %2" : "=v"(r) : "v"(lo), "v"(hi)); return r; }
__device__ __forceinline__ bf16x8 ld8(const bf16_t* p) { return *reinterpret_cast<const bf16x8*>(p); }
__device__ __forceinline__ void mask_causal(f32x16& p0, f32x16& p1, int dq) {
    const float NEG = -__builtin_inff();
#pragma unroll
    for (int r = 0; r < 16; ++r) {
        const int c = (r & 3) + 8 * (r >> 2);
        if (dq - c < 0) p0[r] = NEG;
        if (dq - c - 32 < 0) p1[r] = NEG;
    }
}
__device__ __forceinline__ void mask_all(f32x16& p0, f32x16& p1, bool keep) {
    const float NEG = -__builtin_inff();
#pragma unroll
    for (int r = 0; r < 16; ++r) { p0[r] = keep ? p0[r] : NEG; p1[r] = keep ? p1[r] : NEG; }
}
__device__ __forceinline__ void partialSM(f32x16& p0, f32x16& p1, float& m_reg, float& mn, float& alpha) {
    float pmax = p0[0]; for (int r = 1; r < 16; ++r) pmax = fmaxf(pmax, p0[r]); for (int r = 0; r < 16; ++r) pmax = fmaxf(pmax, p1[r]);
    { auto rr = __builtin_amdgcn_permlane32_swap(__float_as_uint(pmax), __float_as_uint(pmax), false, false);
      pmax = fmaxf(__uint_as_float(rr[0]), __uint_as_float(rr[1])); }
    constexpr float C2 = 1.4426950408889634f * SCALE;
    if (__builtin_expect(__all((pmax - m_reg) * SCALE <= THR), 1)) { mn = m_reg; alpha = 1.f; }
    else { mn = fmaxf(m_reg, pmax); alpha = __builtin_amdgcn_exp2f((m_reg - mn) * C2); m_reg = mn; }
    const float mnL = -mn * C2;
    for (int r = 0; r < 16; ++r) p0[r] = fmaf(p0[r], C2, mnL); for (int r = 0; r < 16; ++r) p1[r] = fmaf(p1[r], C2, mnL);
    for (int r = 0; r < 16; ++r) p0[r] = __builtin_amdgcn_exp2f(p0[r]);
}
__device__ __forceinline__ void finishSM(f32x16& p0, f32x16& p1, float alpha, float& l_reg, bf16x8& pa0, bf16x8& pa1, bf16x8& pa2, bf16x8& pa3) {
    for (int r = 0; r < 16; ++r) p1[r] = __builtin_amdgcn_exp2f(p1[r]);
    float ps = 0; for (int r = 0; r < 16; ++r) ps += p0[r]; for (int r = 0; r < 16; ++r) ps += p1[r];
    { auto rr = __builtin_amdgcn_permlane32_swap(__float_as_uint(ps), __float_as_uint(ps), false, false);
      ps = __uint_as_float(rr[0]) + __uint_as_float(rr[1]); }
    l_reg = l_reg * alpha + ps;
#define PK4(P, B_, OUT) do { unsigned a0 = cvtpk(P[B_+0], P[B_+1]), a1 = cvtpk(P[B_+2], P[B_+3]);                          \
        unsigned b0 = cvtpk(P[B_+4], P[B_+5]), b1 = cvtpk(P[B_+6], P[B_+7]);                                             \
        auto r0 = __builtin_amdgcn_permlane32_swap(a0, b0, false, false); auto r1 = __builtin_amdgcn_permlane32_swap(a1, b1, false, false); \
        u32x4 w = {r0[0], r1[0], r0[1], r1[1]}; OUT = *reinterpret_cast<bf16x8*>(&w); } while (0)
    PK4(p0, 0, pa0); PK4(p0, 8, pa1); PK4(p1, 0, pa2); PK4(p1, 8, pa3);
#undef PK4
}
template <int KB>
__device__ __forceinline__ void qkt(f32x16& p0, f32x16& p1, const char* K_lds, int r32, int hi, const bf16x8* qr) {
    p0 = f32x16{}; p1 = f32x16{};
    const char* kb[4];
#pragma unroll
    for (int dd = 0; dd < 4; ++dd) kb[dd] = K_lds + KB * SHM_K + KSWZ(r32, (dd * 16 + hi * 8) * 2);
#pragma unroll
    for (int d0 = 0; d0 < 8; ++d0) { const char* a = kb[d0 & 3] + (d0 >> 2) * 128;
        bf16x8 b0 = *reinterpret_cast<const bf16x8*>(a);
        bf16x8 b1 = *reinterpret_cast<const bf16x8*>(a + 32 * 256);
        p0 = __builtin_amdgcn_mfma_f32_32x32x16_bf16(b0, qr[d0], p0, 0, 0, 0);
        p1 = __builtin_amdgcn_mfma_f32_32x32x16_bf16(b1, qr[d0], p1, 0, 0, 0); }
}
template <int VB>
__device__ __forceinline__ void pv_tile(f32x16* o, int vb0, bf16x8 pa0, bf16x8 pa1, bf16x8 pa2, bf16x8 pa3) {
#define TRRD(dst, off) asm volatile("ds_read_b64_tr_b16 %0, %1 offset:%2" : "=&v"(dst) : "v"(vb0), "i"(off) : "memory")
#define PV_D0(d0) do { s16x4 l0, l1, l2, l3, h0, h1, h2, h3; constexpr int b_ = VB * SHM_V + v_rd_off(d0, 0, 0); \
        TRRD(l0, b_); TRRD(h0, b_ + 2048); TRRD(l1, b_ + 4096); TRRD(h1, b_ + 6144); TRRD(l2, b_ + 8192); TRRD(h2, b_ + 10240); TRRD(l3, b_ + 12288); TRRD(h3, b_ + 14336); \
        asm volatile("s_waitcnt lgkmcnt(0)" ::: "memory"); SBAR();   \
        o[d0] = __builtin_amdgcn_mfma_f32_32x32x16_bf16(pa0, (bf16x8){l0[0], l0[1], l0[2], l0[3], h0[0], h0[1], h0[2], h0[3]}, o[d0], 0, 0, 0);   \
        o[d0] = __builtin_amdgcn_mfma_f32_32x32x16_bf16(pa1, (bf16x8){l1[0], l1[1], l1[2], l1[3], h1[0], h1[1], h1[2], h1[3]}, o[d0], 0, 0, 0);   \
        o[d0] = __builtin_amdgcn_mfma_f32_32x32x16_bf16(pa2, (bf16x8){l2[0], l2[1], l2[2], l2[3], h2[0], h2[1], h2[2], h2[3]}, o[d0], 0, 0, 0);   \
        o[d0] = __builtin_amdgcn_mfma_f32_32x32x16_bf16(pa3, (bf16x8){l3[0], l3[1], l3[2], l3[3], h3[0], h3[1], h3[2], h3[3]}, o[d0], 0, 0, 0); } while (0)
    PV_D0(0); PV_D0(1); PV_D0(2); PV_D0(3);
#undef PV_D0
#undef TRRD
}
constexpr int KM_OFF = 69632;
__device__ __forceinline__ unsigned moba_gate(const bf16x8* qr, const float* km, int qb, int hi) {
    float v1 = -__builtin_inff(), v2 = v1, v3 = v1; int i1 = -1, i2 = -1, i3 = -1;
    for (int n = 0; n < qb; ++n) { const float* kp = km + n * DH + hi * 8; float sc = 0.f;
#pragma unroll
        for (int d0 = 0; d0 < 8; ++d0) { const f32x4 k0 = *(const f32x4*)(kp + d0 * 16), k1 = *(const f32x4*)(kp + d0 * 16 + 4); const bf16x8 q = qr[d0];
#pragma unroll
            for (int e = 0; e < 4; ++e) { sc += __uint_as_float(((unsigned)(unsigned short)q[e]) << 16) * k0[e]; sc += __uint_as_float(((unsigned)(unsigned short)q[4 + e]) << 16) * k1[e]; } }
        sc += __shfl_xor(sc, 32);
        if (sc > v1) { v3 = v2; i3 = i2; v2 = v1; i2 = i1; v1 = sc; i1 = n; }
        else if (sc > v2) { v3 = v2; i3 = i2; v2 = sc; i2 = n; }
        else if (sc > v3) { v3 = sc; i3 = n; } }
    unsigned m = 0u; if (i1 >= 0) m |= 1u << i1; if (i2 >= 0) m |= 1u << i2; if (i3 >= 0) m |= 1u << i3;
    return m;
}
struct BlockRef { const bf16_t* Q; const bf16_t* K; const bf16_t* V; bf16_t* O; int qb; };
struct Seam { bf16x8 qr[8]; bf16x8 st_v0, st_v1, st_k0, st_k1; };
#define VMW() asm volatile("s_waitcnt vmcnt(0)" ::: "memory")
#define VMWN(n) asm volatile("s_waitcnt vmcnt(%0)" :: "i"(n) : "memory")
#define GLD8(ubase) (*reinterpret_cast<const bf16x8*>((ubase) + toff))
#define SLOAD_H(Kp, Vp, k0) do { const char* kb__ = (const char*)(Kp) + (size_t)(k0) * (LD * 2); const char* vb__ = (const char*)(Vp) + (size_t)(k0) * (LD * 2); \
                         S.st_v0 = GLD8(vb__); S.st_v1 = GLD8(vb__ + 32 * LD * 2); S.st_k0 = GLD8(kb__); S.st_k1 = GLD8(kb__ + 32 * LD * 2); } while (0)
#define SWRITE_HK(bf) do { *(bf16x8*)(K_lds + (bf) * SHM_K + kws) = S.st_k0; *(bf16x8*)(K_lds + (bf) * SHM_K + kws + 32 * 256) = S.st_k1; } while (0)
#define SWRITE_HV(bf) do { *(bf16x8*)(V_lds + (bf) * SHM_V + vst0) = S.st_v0; *(bf16x8*)(V_lds + (bf) * SHM_V + vst1) = S.st_v1; } while (0)
#define SWRITE_H(bf) do { SWRITE_HV(bf); SWRITE_HK(bf); } while (0)
__device__ __forceinline__ void moba_prime(const BlockRef& cur, char* lds, Seam& S, int tid) {
    const int wid = __builtin_amdgcn_readfirstlane(tid >> 6), lane = tid & 63, r32 = lane & 31, hi = lane >> 5;
    const int sr = tid >> 4, sc = (tid & 15) * 8, kws = KSWZ(sr, sc * 2); char* K_lds = lds + 2 * SHM_V;
    const unsigned toff = (unsigned)(sr * LD + sc) * 2u, qoff = (unsigned)(r32 * LD + hi * 8) * 2u;
    { const char* qb_ = (const char*)cur.Q + (size_t)(wid * QBLK) * (LD * 2);
#pragma unroll
      for (int d0 = 0; d0 < 8; ++d0) S.qr[d0] = *reinterpret_cast<const bf16x8*>(qb_ + d0 * 32 + qoff); }
    SLOAD_H(cur.K, cur.V, 0); VMW(); SWRITE_HK(0);
    __syncthreads();
}
__device__ __forceinline__ void moba_block(const BlockRef& cur, const BlockRef& nxt, char* lds, Seam& S, int tid) {
    const int wid = __builtin_amdgcn_readfirstlane(tid >> 6), lane = tid & 63, r32 = lane & 31, hi = lane >> 5;
    const int NT = 4 * (cur.qb + 1);
    const int P0 = cur.qb * QB;
    const int qlo = P0 + wid * QBLK, qm = qlo + r32 - 4 * hi;
    const unsigned msk = moba_gate(S.qr, (const float*)(lds + KM_OFF), cur.qb, hi);
    char* V_lds = lds; char* K_lds = lds + 2 * SHM_V;
    float* ws = (float*)(lds + 2 * SHM_V + 2 * SHM_K) + wid * 64; float* li_l = ws, * al_l = ws + 32;
    float m_reg = -1e30f, l_reg = 0; f32x16 o[4] = {};
    const int sr = tid >> 4, sc = (tid & 15) * 8, vst0 = v_st(sr, sc), vst1 = v_st(32 + sr, sc), kws = KSWZ(sr, sc * 2);
    const unsigned toff = (unsigned)(sr * LD + sc) * 2u, qoff = (unsigned)(r32 * LD + hi * 8) * 2u;
    const int vb0 = (int)(uintptr_t)V_lds + v_rd_base(lane);
    const bf16_t* Kh = cur.K; const bf16_t* Vh = cur.V;
#define RESC(a) do { if (__any((a) < 1.f)) { if (hi == 0) al_l[r32] = (a); asm volatile("s_waitcnt lgkmcnt(0)" ::: "memory");              \
                     for (int d_ = 0; d_ < 4; ++d_) for (int r = 0; r < 16; ++r) o[d_][r] *= al_l[crow(r, hi)]; } } while (0)
#define KBASE(t) ((t) * KVBLK)
#define MASKT(P0_, P1_, t) do { const int kb_ = KBASE(t); const int jb_ = (t) >> 2; \
        if (jb_ < cur.qb) { mask_all(P0_, P1_, ((msk >> jb_) & 1u) != 0u); } \
        else if (kb_ + KVBLK - 1 > qlo) mask_causal(P0_, P1_, qm - kb_); } while (0)
    constexpr int NQL = 8;
#define SEAM_K0() do { VMWN(NQL); SWRITE_HK(0); SBAR(); } while (0)
    f32x16 pA0, pA1, pB0, pB1; float mnA, mnB, alA, alB; bf16x8 pa0, pa1, pa2, pa3;
    SWRITE_HV(0); SBAR();
    if (NT > 1) { SLOAD_H(Kh, Vh, KBASE(1)); }
    SBAR(); qkt<0>(pA0, pA1, K_lds, r32, hi, S.qr);
    MASKT(pA0, pA1, 0); partialSM(pA0, pA1, m_reg, mnA, alA);
    if (NT > 1) { VMW(); SWRITE_H(1); }
    __syncthreads();
#define HALF_STEP(PX0, PX1, mnX, alX, PY0, PY1, alY, t, KB, VB, SB) do {                                                      \
        SBAR(); qkt<KB>(PX0, PX1, K_lds, r32, hi, S.qr);                                             \
        finishSM(PY0, PY1, alY, l_reg, pa0, pa1, pa2, pa3); SBAR();                                                           \
        if ((t) + 1 < NT) { SLOAD_H(Kh, Vh, KBASE((t) + 1)); SBAR(); }                                               \
        pv_tile<VB>(o, vb0, pa0, pa1, pa2, pa3); MASKT(PX0, PX1, (t)); partialSM(PX0, PX1, m_reg, mnX, alX);                                        \
        __syncthreads();                                                                                                      \
        if ((t) + 1 < NT) { VMW(); SWRITE_H(SB); }                                                                          \
        RESC(alX); __syncthreads(); } while (0)
    for (int t = 1; t + 1 < NT; t += 2) {
        HALF_STEP(pB0, pB1, mnB, alB, pA0, pA1, alA, t, 1, 0, 0);
        HALF_STEP(pA0, pA1, mnA, alA, pB0, pB1, alB, t + 1, 0, 1, 1);
    }
    const bool even = (NT & 1) == 0;
    if (even) { SBAR(); qkt<1>(pB0, pB1, K_lds, r32, hi, S.qr); SBAR(); }
    SLOAD_H(nxt.K, nxt.V, 0); SBAR();
    { const char* qb_ = (const char*)nxt.Q + (size_t)(wid * QBLK) * (LD * 2);
#pragma unroll
      for (int d0 = 0; d0 < 8; ++d0) S.qr[d0] = *reinterpret_cast<const bf16x8*>(qb_ + d0 * 32 + qoff); }
    SBAR();
    finishSM(pA0, pA1, alA, l_reg, pa0, pa1, pa2, pa3); SBAR();
    pv_tile<0>(o, vb0, pa0, pa1, pa2, pa3);
    if (even) { MASKT(pB0, pB1, NT - 1); partialSM(pB0, pB1, m_reg, mnB, alB); __syncthreads(); RESC(alB);
        finishSM(pB0, pB1, alB, l_reg, pa0, pa1, pa2, pa3); SBAR(); pv_tile<1>(o, vb0, pa0, pa1, pa2, pa3); }
    SBAR(); SEAM_K0();
    if (hi == 0) li_l[r32] = l_reg; asm volatile("s_waitcnt lgkmcnt(0)" ::: "memory");
    float rli[16];
#pragma unroll
    for (int r = 0; r < 16; ++r) rli[r] = __builtin_amdgcn_rcpf(li_l[crow(r, hi)]);
    char* Ow = (char*)cur.O + (size_t)(wid * QBLK) * (LD * 2);
    const unsigned ooff = (unsigned)(4 * hi * LD + r32) * 2u;
#pragma unroll
    for (int r = 0; r < 16; ++r) { char* Or = Ow + (size_t)((r & 3) + 8 * (r >> 2)) * (LD * 2);
#pragma unroll
        for (int d0 = 0; d0 < 4; ++d0) { const float v = o[d0][r] * rli[r];
            const float vn = __shfl_xor(v, 1);
            if ((r32 & 1) == 0) *(unsigned*)(Or + d0 * 64 + ooff) = cvtpk(v, vn); } }
    __syncthreads();
#undef RESC
#undef KBASE
#undef MASKT
#undef SEAM_K0
#undef HALF_STEP
}
#undef VMW
#undef VMWN
#undef SLOAD_H
#undef GLD8
#undef SWRITE_HK
#undef SWRITE_HV
#undef SWRITE_H
}

struct Args { const float* in[25]; float* out; unsigned char* ws; int ph_lo, ph_hi, li, pad; };
enum { IN_X = 0, IN_C, IN_NMG, IN_NFG, IN_WMOD, IN_BMOD, IN_LWIN, IN_LCW, IN_LCB, IN_LWA, IN_LBA, IN_LWX, IN_LBX, IN_LLAM, IN_LWOUT,
       IN_AQKV, IN_AQG, IN_AKG, IN_AWOUT, IN_RW, IN_RB, IN_WGU, IN_BGU, IN_WDN, IN_BDN };
struct Frame {
    LAS unsigned char* lds;
    unsigned char* ws;
    int tid, lane, wave, vcu, G;
};

__device__ __forceinline__ void cvt_tile(const float* W, int ldw, int k0, int n0, bf16_t* WT, int ldt, int drow0, LAS float* scr, int lane) {
    const int q = lane & 15, rr = lane >> 4;
    f32x4 v[16];
#pragma unroll
    for (int i = 0; i < 16; ++i) v[i] = __builtin_nontemporal_load((const f32x4*)(W + (size_t)(k0 + 4 * i + rr) * ldw + n0 + 4 * q));
#pragma unroll
    for (int i = 0; i < 16; ++i) { LAS float* s = scr + (4 * i + rr) * 65 + 4 * q; s[0] = v[i][0]; s[1] = v[i][1]; s[2] = v[i][2]; s[3] = v[i][3]; }
    LDS_WAIT();
    const int c = lane & 7;
#pragma unroll
    for (int jj = 0; jj < 8; ++jj) { const int n = (lane >> 3) + 8 * jj; const LAS float* s = scr + (8 * c) * 65 + n;
        u32x4 o; o.x = cvt_pk_bf16(s[0 * 65], s[1 * 65]); o.y = cvt_pk_bf16(s[2 * 65], s[3 * 65]); o.z = cvt_pk_bf16(s[4 * 65], s[5 * 65]); o.w = cvt_pk_bf16(s[6 * 65], s[7 * 65]);
        const int dr = drow0 + n;
        *(u32x4*)(WT + ((size_t)(dr >> 8) * (ldt >> 6) + (k0 >> 6)) * (256 * 64) + (size_t)(dr & 255) * 64 + 8 * c) = o; }
    LDS_WAIT();
}
__device__ __forceinline__ void phase_prologue(Frame& F, const Args& a) {
    if (blockIdx.x < 96) {
        LAS float* cond = (LAS float*)F.lds;
        LAS float* red = (LAS float*)(F.lds + 16384);
        const float* c = a.in[IN_C];
        for (int i = F.tid; i < BATCH * D; i += NTHR) { const float x = c[i]; cond[i] = x * sigmoidf_(x); }
        __syncthreads();
        const int l = blockIdx.x / 24, n0 = (blockIdx.x % 24) * 256;
        const float* W = a.in[IN_WMOD] + (size_t)l * D * 6 * D + n0 + 4 * F.lane;
        f32x4 acc[4];
#pragma unroll
        for (int b = 0; b < 4; ++b) acc[b] = (f32x4){0.f, 0.f, 0.f, 0.f};
        const int kb = F.wave * 128;
#pragma unroll 8
        for (int k = 0; k < 128; ++k) { const f32x4 w = *(const f32x4*)(W + (size_t)(kb + k) * 6 * D);
#pragma unroll
            for (int b = 0; b < 4; ++b) acc[b] += w * cond[b * D + kb + k]; }
#pragma unroll
        for (int b = 0; b < 4; ++b) *(LAS f32x4*)(red + (F.wave * 4 + b) * 256 + 4 * F.lane) = acc[b];
        __syncthreads();
        float* MOD = (float*)(F.ws + WS_MOD);
        for (int o = F.tid; o < 1024; o += NTHR) { const int b = o >> 8, n = o & 255; float s = 0.f;
#pragma unroll
            for (int w = 0; w < 8; ++w) s += red[(w * 4 + b) * 256 + n];
            MOD[((size_t)l * BATCH + b) * 6 * D + n0 + n] = s + a.in[IN_BMOD][(size_t)l * 6 * D + n0 + n]; }
        __syncthreads();
    }
    { const int g = blockIdx.x * NTHR + F.tid; if (g < 2 * D) { const float lam = a.in[IN_LLAM][g]; const float z = -lam;
        const float sp = z > 20.f ? z : log1pf(__expf(z)); ((float*)(F.ws + WS_SP8))[g] = 8.0f * sp; } }
    { float* PAR = (float*)(F.ws + WS_PAR); const int g = blockIdx.x * NTHR + F.tid, GS = F.G * NTHR;
#define CPY(dst, src, n) for (int i = g; i < (n) / 4; i += GS) *(f32x4*)(PAR + (dst) + 4 * i) = *(const f32x4*)(a.in[src] + 4 * i)
      CPY(PAR_NMG, IN_NMG, 4 * 1024); CPY(PAR_NFG, IN_NFG, 4 * 1024); CPY(PAR_LCW, IN_LCW, 2 * 4 * 1024); CPY(PAR_LCB, IN_LCB, 2 * 1024); CPY(PAR_LBA, IN_LBA, 2 * 1024); CPY(PAR_LBX, IN_LBX, 2 * 1024);
      CPY(PAR_AQG, IN_AQG, 256); CPY(PAR_AKG, IN_AKG, 256); CPY(PAR_RW, IN_RW, 4 * 1024 * 32); CPY(PAR_RB, IN_RB, 128); CPY(PAR_BGU, IN_BGU, 4 * 32 * 2048); CPY(PAR_BDN, IN_BDN, 4 * 32 * 1024);
#undef CPY
    }
    LAS float* scr = (LAS float*)(F.lds + F.wave * 16640);
    const int gw = F.vcu * NWAVES + F.wave, NGW = F.G * NWAVES;
    constexpr int I2 = 2 * 512, I3 = 16 * 16, I4 = 2 * 256, I5 = 2 * 768, I6 = 2 * 256;
    constexpr int NITEMS = I2 + I3 + I4 + I5 + I6;
    for (int it = gw; it < NITEMS; it += NGW) {
        int r = it;
        if (r < I2) { const int mat = r >> 9, q = r & 511, kb = q >> 5, nb = q & 31;
            cvt_tile(a.in[IN_LWIN] + (size_t)mat * D * 2 * D, 2 * D, kb * 64, nb * 64, (bf16_t*)(F.ws + WS_WIN) + (size_t)mat * 2 * D * D, D, nb * 64, scr, F.lane); continue; } r -= I2;
        if (r < I3) { const int mat = r >> 4, q = r & 15, kb = q >> 2, nb = q & 3;
            const int layer = mat >> 3, ax = (mat >> 2) & 1, g = mat & 3, n0 = nb * 64;
            const float* src = (ax ? a.in[IN_LWX] : a.in[IN_LWA]) + (size_t)(layer * 4 + g) * 256 * 256;
            const int dr = (g * 2 + (n0 >> 7)) * 256 + ax * 128 + (n0 & 127);
            cvt_tile(src, 256, kb * 64, n0, (bf16_t*)(F.ws + WS_WG) + (size_t)layer * 2048 * 256, 256, dr, scr, F.lane); continue; } r -= I3;
        if (r < I4) { const int mat = r >> 8, q = r & 255, kb = q >> 4, nb = q & 15;
            cvt_tile(a.in[IN_LWOUT] + (size_t)mat * D * D, D, kb * 64, nb * 64, (bf16_t*)(F.ws + WS_WLO) + (size_t)mat * D * D, D, nb * 64, scr, F.lane); continue; } r -= I4;
        if (r < I5) { const int mat = r / 768, q = r % 768, kb = q / 48, nb = q % 48;
            cvt_tile(a.in[IN_AQKV] + (size_t)mat * D * 3 * D, 3 * D, kb * 64, nb * 64, (bf16_t*)(F.ws + WS_WQKV) + (size_t)mat * 3 * D * D, D, nb * 64, scr, F.lane); continue; } r -= I5;
        { const int mat = r >> 8, q = r & 255, kb = q >> 4, nb = q & 15;
            cvt_tile(a.in[IN_AWOUT] + (size_t)mat * D * D, D, kb * 64, nb * 64, (bf16_t*)(F.ws + WS_WAO) + (size_t)mat * D * D, D, nb * 64, scr, F.lane); }
    }
}

__device__ __forceinline__ void cvt_tile8(const float* W, int ldw, int k0, int n0, unsigned char* WT, int kbytes, int drow0, LAS float* scr, int lane) {
    const int q = lane & 15, rr = lane >> 4;
    f32x4 v[16];
#pragma unroll
    for (int i = 0; i < 16; ++i) v[i] = __builtin_nontemporal_load((const f32x4*)(W + (size_t)(k0 + 4 * i + rr) * ldw + n0 + 4 * q));
#pragma unroll
    for (int i = 0; i < 16; ++i) { LAS float* s = scr + (4 * i + rr) * 65 + 4 * q; s[0] = v[i][0]; s[1] = v[i][1]; s[2] = v[i][2]; s[3] = v[i][3]; }
    LDS_WAIT();
    const int c = lane & 7;
#pragma unroll
    for (int jj = 0; jj < 8; ++jj) { const int n = (lane >> 3) + 8 * jj; const LAS float* s = scr + (8 * c) * 65 + n;
        u32x2 o; o.x = cvt4_fp8(s[0 * 65] * W8_SCALE, s[1 * 65] * W8_SCALE, s[2 * 65] * W8_SCALE, s[3 * 65] * W8_SCALE); o.y = cvt4_fp8(s[4 * 65] * W8_SCALE, s[5 * 65] * W8_SCALE, s[6 * 65] * W8_SCALE, s[7 * 65] * W8_SCALE);
        const int dr = drow0 + n;
        *(u32x2*)(WT + ((size_t)(dr >> 8) * (kbytes >> 7) + (k0 >> 7)) * (256 * 128) + (size_t)(dr & 255) * 128 + (k0 & 127) + 8 * c) = o; }
    LDS_WAIT();
}
__device__ __forceinline__ void phase_convert_experts(Frame& F, const float* wgu, const float* wdn, int layer) {
    LAS float* scr = (LAS float*)(F.lds + F.wave * 16640);
    const int gw = F.vcu * NWAVES + F.wave, NGW = F.G * NWAVES;
    constexpr int J0 = NE * 512, J1 = NE * 256;
    for (int it0 = gw; it0 < J0 + J1; it0 += NGW) {
        const int it = it0 < J1 ? J0 + it0 : it0 - J1;
        if (it < J0) { const int e = it >> 9, q = it & 511, kb = q >> 5, nb = q & 31, n0 = nb * 64; const int mat = layer * NE + e;
            const int dr = n0 < D ? (n0 >> 7) * 256 + (n0 & 127) : ((n0 - D) >> 7) * 256 + 128 + ((n0 - D) & 127);
            cvt_tile8(wgu + (size_t)mat * D * 2 * D, 2 * D, kb * 64, n0, (unsigned char*)(F.ws + WS_WGU) + (size_t)mat * 2 * D * D, D, dr, scr, F.lane); }
        else { const int r = it - J0; const int e = r >> 8, q = r & 255, kb = q >> 4, nb = q & 15; const int mat = layer * NE + e;
            cvt_tile8(wdn + (size_t)mat * D * D, D, kb * 64, nb * 64, (unsigned char*)(F.ws + WS_WDN) + (size_t)mat * D * D, D, nb * 64, scr, F.lane); }
    }
}

__device__ __forceinline__ void phase_norm(Frame& F, const float* xin, int layer) {
    const float* PAR = (const float*)(F.ws + WS_PAR);
    const int gw = F.vcu * NWAVES + F.wave; const int m0 = gw * 8; const int b = m0 / SEQ;
    const float* MOD = (const float*)(F.ws + WS_MOD);
    const float* X = (layer == 0) ? xin : (const float*)(F.ws + WS_XB);
    f32x4 gain[4], sc[4], sh[4];
#pragma unroll
    for (int j = 0; j < 4; ++j) { const int c = 4 * F.lane + 256 * j;
        gain[j] = *(const f32x4*)(PAR + PAR_NMG + (size_t)layer * D + c);
        sh[j] = *(const f32x4*)(MOD + ((size_t)layer * BATCH + b) * 6 * D + c); sc[j] = *(const f32x4*)(MOD + ((size_t)layer * BATCH + b) * 6 * D + D + c);
        gain[j] = gain[j] * (1.0f + sc[j]); }
    bf16_t* H = (bf16_t*)(F.ws + WS_H);
#pragma unroll 2
    for (int r = 0; r < 8; ++r) { const int m = m0 + r;
        f32x4 x[4];
#pragma unroll
        for (int j = 0; j < 4; ++j) x[j] = *(const f32x4*)(X + (size_t)m * D + 4 * F.lane + 256 * j);
        float ss = 0.f;
#pragma unroll
        for (int j = 0; j < 4; ++j) ss += (x[j][0] * x[j][0] + x[j][1] * x[j][1]) + (x[j][2] * x[j][2] + x[j][3] * x[j][3]);
        const float rstd = __builtin_amdgcn_rsqf(wave_sum(ss) * (1.0f / D) + NORM_EPS);
#pragma unroll
        for (int j = 0; j < 4; ++j) { const int c = 4 * F.lane + 256 * j;
            const f32x4 h = x[j] * rstd * gain[j] + sh[j];
            u32x2 o; o.x = cvt_pk_bf16(h[0], h[1]); o.y = cvt_pk_bf16(h[2], h[3]); *(u32x2*)(H + (size_t)m * D + c) = o; }
    }
}

constexpr int MOE_TOK = T / TOPK;
__device__ __forceinline__ void phase_router(Frame& F, int layer) {
    constexpr int RPW = MOE_TOK / (256 * NWAVES * 2);
    const float* PAR = (const float*)(F.ws + WS_PAR);
    LAS float* rw = (LAS float*)F.lds;
    LAS unsigned* lcnt = (LAS unsigned*)(F.lds + LDS_X);
    LAS unsigned* lbase = lcnt + 32;
    LAS unsigned* pend = lcnt + 64;
    { const float* RW = PAR + PAR_RW + (size_t)layer * D * NE;
      for (int i = F.tid; i < D * NE / 4; i += NTHR) { const int col = i >> 3, ch = i & 7; const f32x4 v = *(const f32x4*)(RW + (size_t)i * 4);
          *(LAS f32x4*)(rw + col * 32 + ((ch ^ ((col >> 2) & 7)) << 2)) = v; }
      if (F.tid < 32) lcnt[F.tid] = 0u; }
    __syncthreads();
    const int gw = F.vcu * NWAVES + F.wave; const int m0 = gw * 2 * RPW; const int b = m0 / SEQ;
    const float* MOD = (const float*)(F.ws + WS_MOD);
    f32x4 gain[4], sc[4], sh[4];
#pragma unroll
    for (int j = 0; j < 4; ++j) { const int c = 4 * F.lane + 256 * j; gain[j] = *(const f32x4*)(PAR + PAR_NFG + (size_t)layer * D + c);
        sh[j] = *(const f32x4*)(MOD + ((size_t)layer * BATCH + b) * 6 * D + 3 * D + c); sc[j] = *(const f32x4*)(MOD + ((size_t)layer * BATCH + b) * 6 * D + 4 * D + c); }
    const float* XB = (const float*)(F.ws + WS_XB); unsigned char* H8 = (unsigned char*)(F.ws + WS_H8);
    const float rbias = PAR[PAR_RB + layer * NE + (F.lane & 31)];
    const int sw = F.lane & 7;
    for (int rp = 0; rp < RPW; ++rp) {
        f32x4 h[2][4];
#pragma unroll
        for (int q = 0; q < 2; ++q) { const int m = m0 + rp * 2 + q;
            f32x4 x[4]; float ss = 0.f;
#pragma unroll
            for (int j = 0; j < 4; ++j) { x[j] = *(const f32x4*)(XB + (size_t)m * D + 4 * F.lane + 256 * j); ss += (x[j][0] * x[j][0] + x[j][1] * x[j][1]) + (x[j][2] * x[j][2] + x[j][3] * x[j][3]); }
            const float rstd = __builtin_amdgcn_rsqf(wave_sum(ss) * (1.0f / D) + NORM_EPS);
#pragma unroll
            for (int j = 0; j < 4; ++j) { h[q][j] = x[j] * rstd * gain[j] * (1.0f + sc[j]) + sh[j];
                *(unsigned*)(H8 + (size_t)m * D + 4 * F.lane + 256 * j) = cvt4_fp8(h[q][j][0], h[q][j][1], h[q][j][2], h[q][j][3]); } }
        float v[64];
#pragma unroll
        for (int i = 0; i < 64; ++i) v[i] = 0.f;
#pragma unroll
        for (int j = 0; j < 4; ++j)
#pragma unroll
            for (int cc = 0; cc < 4; ++cc) { const int col = 4 * F.lane + 256 * j + cc; const LAS float* rp_ = rw + col * 32;
#pragma unroll
                for (int eq = 0; eq < 8; ++eq) { const f32x4 w = *(const LAS f32x4*)(rp_ + ((eq ^ sw) << 2));
#pragma unroll
                    for (int k = 0; k < 4; ++k) { v[eq * 4 + k] = fmaf(h[0][j][cc], w[k], v[eq * 4 + k]); v[32 + eq * 4 + k] = fmaf(h[1][j][cc], w[k], v[32 + eq * 4 + k]); } } }
#pragma unroll
        for (int i = 0; i < 32; ++i) { const bool up = (F.lane & 32) != 0; const float send = up ? v[i] : v[32 + i]; const float recv = __shfl_xor(send, 32); v[i] = (up ? v[32 + i] : v[i]) + recv; }
#pragma unroll
        for (int i = 0; i < 16; ++i) { const bool up = (F.lane & 16) != 0; const float send = up ? v[i] : v[16 + i]; const float recv = __shfl_xor(send, 16); v[i] = (up ? v[16 + i] : v[i]) + recv; }
#pragma unroll
        for (int i = 0; i < 8; ++i) { const bool up = (F.lane & 8) != 0; const float send = up ? v[i] : v[8 + i]; const float recv = __shfl_xor(send, 8); v[i] = (up ? v[8 + i] : v[i]) + recv; }
#pragma unroll
        for (int i = 0; i < 4; ++i) { const bool up = (F.lane & 4) != 0; const float send = up ? v[i] : v[4 + i]; const float recv = __shfl_xor(send, 4); v[i] = (up ? v[4 + i] : v[i]) + recv; }
#pragma unroll
        for (int i = 0; i < 2; ++i) { const bool up = (F.lane & 2) != 0; const float send = up ? v[i] : v[2 + i]; const float recv = __shfl_xor(send, 2); v[i] = (up ? v[2 + i] : v[i]) + recv; }
        { const bool up = (F.lane & 1) != 0; const float send = up ? v[0] : v[1]; const float recv = __shfl_xor(send, 1); v[0] = (up ? v[1] : v[0]) + recv; }
        float logit = v[0] + rbias;
        float tv[4]; int te[4];
#pragma unroll
        for (int k = 0; k < 4; ++k) { float bv = logit; int be = F.lane & 31;
#pragma unroll
            for (int o = 1; o < 32; o <<= 1) { const float ov = __shfl_xor(bv, o); const int oe = __shfl_xor(be, o); if (ov > bv || (ov == bv && oe < be)) { bv = ov; be = oe; } }
            tv[k] = bv; te[k] = be; if ((F.lane & 31) == be) logit = -__builtin_inff(); }
        const float e1 = __expf(tv[1] - tv[0]), e2 = __expf(tv[2] - tv[0]), e3 = __expf(tv[3] - tv[0]); const float inv = 1.0f / (1.0f + e1 + e2 + e3);
        const int kk = F.lane & 31;
        if (kk < 4) { const int e = kk == 0 ? te[0] : (kk == 1 ? te[1] : (kk == 2 ? te[2] : te[3]));
            const float w = (kk == 0 ? 1.0f : (kk == 1 ? e1 : (kk == 2 ? e2 : e3))) * inv;
            const unsigned rank = __hip_atomic_fetch_add(&lcnt[e], 1u, __ATOMIC_RELAXED, __HIP_MEMORY_SCOPE_WORKGROUP);
            const int rl = F.wave * 2 * RPW + rp * 2 + (F.lane >> 5);
            pend[(rl * 4 + kk) * 2 + 0] = (unsigned)e | (rank << 8); pend[(rl * 4 + kk) * 2 + 1] = __float_as_uint(w); }
    }
    __syncthreads();
    unsigned* gcnt = (unsigned*)(F.ws + WS_CTL) + CW_CNT + 64 * layer;
    if (F.tid < 32) lbase[F.tid] = __hip_atomic_fetch_add(gcnt + F.tid, lcnt[F.tid], __ATOMIC_RELAXED, __HIP_MEMORY_SCOPE_AGENT);
    __syncthreads();
    if (F.tid < NWAVES * 2 * RPW * 4) { const int rl = F.tid >> 2, k = F.tid & 3; const unsigned p0 = pend[(rl * 4 + k) * 2], p1 = pend[(rl * 4 + k) * 2 + 1];
        const unsigned e = p0 & 255u, rank = p0 >> 8; const unsigned pos = lbase[e] + rank; const unsigned tok = (unsigned)(F.vcu * NWAVES * 2 * RPW + rl);
        ((u32x2*)(F.ws + WS_ROWLIST))[(size_t)e * CAP + pos] = (u32x2){tok * 4u + (unsigned)k, p1}; }
}

__device__ __forceinline__ int moe_units(Frame& F, int layer, int npn) {
    LAS int* moe = (LAS int*)(F.lds + LDS_MOE);
    LAS int* units = (LAS int*)(F.lds + LDS_UNITS);
    if (F.wave == 0) {
        const unsigned* gcnt = (const unsigned*)(F.ws + WS_CTL) + CW_CNT + 64 * layer;
        const int e_ = F.lane & 31;
        const int cnt = (int)gcnt[e_]; const int ntl = (cnt + 255) >> 8;
        const int lastv = cnt - (ntl - 1) * 256;
        const int ntail = (ntl > 0 && lastv <= 128) ? 1 : 0, nfull = ntl - ntail;
        int incl = ntl, fincl = nfull, tincl = ntail;
#pragma unroll
        for (int o = 1; o < 32; o <<= 1) { const int t0 = __shfl_up(incl, o), t1 = __shfl_up(fincl, o), t2 = __shfl_up(tincl, o); if ((F.lane & 31) >= o) { incl += t0; fincl += t1; tincl += t2; } }
        const int start = incl - ntl, fstart = fincl - nfull, tstart = tincl - ntail; const int ts = __shfl(incl, 31), nf = __shfl(fincl, 31);
        const int c = blockIdx.x, xcd = c & 7, slot = c >> 3, rpx = 32 / npn;
        const int i = F.lane;
        const int p = (i * 8 + xcd) * rpx + slot / npn, pn = slot % npn;
        int e = 0, j = 0, st = 0, cn = 0;
        for (int q = 0; q < 32; ++q) { const int s_ = __shfl(start, q), c_ = __shfl(cnt, q), fs_ = __shfl(fstart, q), nf_ = __shfl(nfull, q), ts_ = __shfl(tstart, q), nt_ = __shfl(ntail, q), nl_ = __shfl(ntl, q);
            if (p < nf) { if (p >= fs_ && p < fs_ + nf_) { e = q; j = p - fs_; st = s_; cn = c_; } }
            else { const int pt = p - nf; if (pt >= ts_ && pt < ts_ + nt_) { e = q; j = nl_ - 1; st = s_; cn = c_; } } }
        const bool ok = (F.lane < 32) && (p < ts);
        const unsigned long long bal = __ballot(ok);
        if (ok) { int valid = cn - j * 256; valid = valid > 256 ? 256 : valid;
            units[i * 4 + 0] = st + j; units[i * 4 + 1] = pn; units[i * 4 + 2] = e | (j << 8); units[i * 4 + 3] = valid; }
        if (F.lane == 0) moe[40] = __popcll(bal);
    }
    __syncthreads();
    return __builtin_amdgcn_readfirstlane(moe[40]);
}

__device__ __forceinline__ void phase_conv(Frame& F, int j) {
    const float* PAR = (const float*)(F.ws + WS_PAR);
    const int g = F.vcu * NTHR + F.tid; const int chunk = g & 127, seg = g >> 7; const int c0 = chunk * 8, m0 = seg * 16; const int s0 = m0 & (SEQ - 1);
    const bf16_t* RB = (const bf16_t*)(F.ws + WS_RB); bf16_t* XC = (bf16_t*)(F.ws + WS_XC);
    float w[4][8], bias[8];
#pragma unroll
    for (int k = 0; k < 4; ++k) { const f32x4 w0 = *(const f32x4*)(PAR + PAR_LCW + ((size_t)j * 4 + k) * D + c0), w1 = *(const f32x4*)(PAR + PAR_LCW + ((size_t)j * 4 + k) * D + c0 + 4);
#pragma unroll
        for (int i = 0; i < 4; ++i) { w[k][i] = w0[i]; w[k][4 + i] = w1[i]; } }
    { const f32x4 b0 = *(const f32x4*)(PAR + PAR_LCB + (size_t)j * D + c0), b1 = *(const f32x4*)(PAR + PAR_LCB + (size_t)j * D + c0 + 4);
#pragma unroll
      for (int i = 0; i < 4; ++i) { bias[i] = b0[i]; bias[4 + i] = b1[i]; } }
    float x0[8], x1[8], x2[8];
#pragma unroll
    for (int i = 0; i < 8; ++i) { x0[i] = 0.f; x1[i] = 0.f; x2[i] = 0.f; }
    if (s0 != 0) {
        const u32x4 r0 = *(const u32x4*)(RB + (size_t)(m0 - 3) * D + c0), r1 = *(const u32x4*)(RB + (size_t)(m0 - 2) * D + c0), r2 = *(const u32x4*)(RB + (size_t)(m0 - 1) * D + c0);
#pragma unroll
        for (int i = 0; i < 4; ++i) { x0[2 * i] = bflo(r0[i]); x0[2 * i + 1] = bfhi(r0[i]); x1[2 * i] = bflo(r1[i]); x1[2 * i + 1] = bfhi(r1[i]); x2[2 * i] = bflo(r2[i]); x2[2 * i + 1] = bfhi(r2[i]); }
    }
#pragma unroll 4
    for (int t = 0; t < 16; ++t) {
        const u32x4 rr = *(const u32x4*)(RB + (size_t)(m0 + t) * D + c0);
        float x3[8], y[8];
#pragma unroll
        for (int i = 0; i < 4; ++i) { x3[2 * i] = bflo(rr[i]); x3[2 * i + 1] = bfhi(rr[i]); }
#pragma unroll
        for (int i = 0; i < 8; ++i) { y[i] = bias[i] + w[0][i] * x0[i] + w[1][i] * x1[i] + w[2][i] * x2[i] + w[3][i] * x3[i]; x0[i] = x1[i]; x1[i] = x2[i]; x2[i] = x3[i]; }
        u32x4 o; o.x = cvt_pk_bf16(y[0], y[1]); o.y = cvt_pk_bf16(y[2], y[3]); o.z = cvt_pk_bf16(y[4], y[5]); o.w = cvt_pk_bf16(y[6], y[7]);
        *(u32x4*)(XC + (size_t)(m0 + t) * D + c0) = o;
    }
}
__device__ __forceinline__ void phase_scan1(Frame& F) {
    const int item = F.vcu; const int m0 = item * 64; const int ch = 2 * F.tid;
    const bf16_t* LA = (const bf16_t*)(F.ws + WS_AF); const bf16_t* UB = (const bf16_t*)(F.ws + WS_UF);
    float h0 = 0.f, h1 = 0.f, s0 = 0.f, s1 = 0.f;
#pragma unroll 16
    for (int t = 0; t < 64; ++t) { const unsigned lw = *(const unsigned*)(LA + (size_t)(m0 + t) * D + ch), uw = *(const unsigned*)(UB + (size_t)(m0 + t) * D + ch);
        const float l0 = bflo(lw), l1 = bfhi(lw);
        h0 = __builtin_amdgcn_exp2f(l0) * h0 + bflo(uw); h1 = __builtin_amdgcn_exp2f(l1) * h1 + bfhi(uw); s0 += l0; s1 += l1; }
    float* PS = (float*)(F.ws + WS_PS);
    *(f32x4*)(PS + ((size_t)item * D + ch) * 2) = (f32x4){__builtin_amdgcn_exp2f(s0), h0, __builtin_amdgcn_exp2f(s1), h1};
}
__device__ __forceinline__ void phase_scan2(Frame& F) {
    const int item = F.vcu; const int m0 = item * 64; const int ch = 2 * F.tid; const int c = item & 63, b = item >> 6;
    const bf16_t* LA = (const bf16_t*)(F.ws + WS_AF); const bf16_t* UB = (const bf16_t*)(F.ws + WS_UF);
    const float* PS = (const float*)(F.ws + WS_PS); const bf16_t* GB = (const bf16_t*)(F.ws + WS_GB); bf16_t* YB = (bf16_t*)(F.ws + WS_YB);
    float h0 = 0.f, h1 = 0.f;
#pragma unroll 32
    for (int jj = 0; jj < c; ++jj) { const f32x4 s = *(const f32x4*)(PS + ((size_t)(b * 64 + jj) * D + ch) * 2); h0 = s[0] * h0 + s[1]; h1 = s[2] * h1 + s[3]; }
#pragma unroll 16
    for (int t = 0; t < 64; ++t) { const unsigned lw = *(const unsigned*)(LA + (size_t)(m0 + t) * D + ch), uw = *(const unsigned*)(UB + (size_t)(m0 + t) * D + ch);
        const unsigned gw_ = *(const unsigned*)(GB + (size_t)(m0 + t) * D + ch);
        h0 = __builtin_amdgcn_exp2f(bflo(lw)) * h0 + bflo(uw); h1 = __builtin_amdgcn_exp2f(bfhi(lw)) * h1 + bfhi(uw);
        *(unsigned*)(YB + (size_t)(m0 + t) * D + ch) = cvt_pk_bf16(bflo(gw_) * h0, bfhi(gw_) * h1); }
}

__device__ __forceinline__ void phase_qknorm(Frame& F, int j) {
    const float* PAR = (const float*)(F.ws + WS_PAR);
    bf16_t* Q = (bf16_t*)(F.ws + WS_Q); bf16_t* Kb = (bf16_t*)(F.ws + WS_K); float* KM = (float*)(F.ws + WS_KMEAN);
    LAS float* red = (LAS float*)F.lds;
    const int rr = F.lane >> 4, cq = F.lane & 15;
    f32x4 qg0 = *(const f32x4*)(PAR + PAR_AQG + (size_t)j * HD + cq * 8), qg1 = *(const f32x4*)(PAR + PAR_AQG + (size_t)j * HD + cq * 8 + 4);
    f32x4 kg0 = *(const f32x4*)(PAR + PAR_AKG + (size_t)j * HD + cq * 8), kg1 = *(const f32x4*)(PAR + PAR_AKG + (size_t)j * HD + cq * 8 + 4);
    for (int it = F.vcu; it < BATCH * NBLK * NH; it += F.G) {
        const int h = it & 7, blk = (it >> 3) & 15, b = it >> 7;
        const size_t base = ((size_t)(b * SEQ + blk * MBLK + F.wave * 32)) * D + h * HD + cq * 8;
        float ks[8];
#pragma unroll
        for (int i = 0; i < 8; ++i) ks[i] = 0.f;
#pragma unroll 2
        for (int i = 0; i < 8; ++i) { const size_t off = base + (size_t)(i * 4 + rr) * D;
            const u32x4 qw = *(const u32x4*)(Q + off), kw = *(const u32x4*)(Kb + off);
            float qv[8], kv[8]; float sq = 0.f, sk = 0.f;
#pragma unroll
            for (int e = 0; e < 4; ++e) { qv[2 * e] = bflo(qw[e]); qv[2 * e + 1] = bfhi(qw[e]); kv[2 * e] = bflo(kw[e]); kv[2 * e + 1] = bfhi(kw[e]); }
#pragma unroll
            for (int e = 0; e < 8; ++e) { sq += qv[e] * qv[e]; sk += kv[e] * kv[e]; }
#pragma unroll
            for (int o = 1; o < 16; o <<= 1) { sq += __shfl_xor(sq, o); sk += __shfl_xor(sk, o); }
            const float rq = __builtin_amdgcn_rsqf(sq * (1.0f / HD) + NORM_EPS), rk = __builtin_amdgcn_rsqf(sk * (1.0f / HD) + NORM_EPS);
#pragma unroll
            for (int e = 0; e < 8; ++e) { qv[e] = qv[e] * rq * (e < 4 ? qg0[e & 3] : qg1[e & 3]); kv[e] = kv[e] * rk * (e < 4 ? kg0[e & 3] : kg1[e & 3]); ks[e] += kv[e]; }
            u32x4 qo, ko;
#pragma unroll
            for (int e = 0; e < 4; ++e) { qo[e] = cvt_pk_bf16(qv[2 * e], qv[2 * e + 1]); ko[e] = cvt_pk_bf16(kv[2 * e], kv[2 * e + 1]); }
            *(u32x4*)(Q + off) = qo; *(u32x4*)(Kb + off) = ko; }
#pragma unroll
        for (int e = 0; e < 8; ++e) { ks[e] += __shfl_xor(ks[e], 16); ks[e] += __shfl_xor(ks[e], 32); }
        __syncthreads();
        if (F.lane < 16) {
#pragma unroll
            for (int e = 0; e < 8; ++e) red[F.wave * 128 + cq * 8 + e] = ks[e]; }
        __syncthreads();
        if (F.tid < 128) { float s = 0.f;
#pragma unroll
            for (int w = 0; w < 8; ++w) s += red[w * 128 + F.tid];
            KM[(((size_t)b * NH + h) * NBLK + blk) * HD + F.tid] = s * (1.0f / MBLK); }
    }
}
__device__ __forceinline__ void phase_gate(Frame& F) {
    const bf16_t* Q = (const bf16_t*)(F.ws + WS_Q); const float* KM = (const float*)(F.ws + WS_KMEAN); unsigned* SEL = (unsigned*)(F.ws + WS_SEL);
    LAS float* km = (LAS float*)F.lds;
    const int it = F.vcu; const int s8 = it & 7, h = (it >> 3) & 7, b = it >> 6;
    for (int i = F.tid; i < NBLK * HD / 4; i += NTHR) *(LAS f32x4*)(km + 4 * i) = *(const f32x4*)(KM + ((size_t)b * NH + h) * NBLK * HD + 4 * i);
    __syncthreads();
    const int s = s8 * 512 + F.tid; const int qb = __builtin_amdgcn_readfirstlane(s >> 8);
    u32x4 qw[16];
    const bf16_t* qp = Q + ((size_t)(b * SEQ + s)) * D + h * HD;
#pragma unroll
    for (int i = 0; i < 16; ++i) qw[i] = *(const u32x4*)(qp + 8 * i);
    float v1 = -__builtin_inff(), v2 = v1, v3 = v1; int i1 = -1, i2 = -1, i3 = -1;
    for (int n = 0; n < qb; ++n) { float sc = 0.f;
#pragma unroll
        for (int i = 0; i < 16; ++i) { const f32x4 k0 = *(const LAS f32x4*)(km + n * HD + 8 * i), k1 = *(const LAS f32x4*)(km + n * HD + 8 * i + 4);
            sc += bflo(qw[i][0]) * k0[0] + bfhi(qw[i][0]) * k0[1] + bflo(qw[i][1]) * k0[2] + bfhi(qw[i][1]) * k0[3]
                + bflo(qw[i][2]) * k1[0] + bfhi(qw[i][2]) * k1[1] + bflo(qw[i][3]) * k1[2] + bfhi(qw[i][3]) * k1[3]; }
        if (sc > v1) { v3 = v2; i3 = i2; v2 = v1; i2 = i1; v1 = sc; i1 = n; }
        else if (sc > v2) { v3 = v2; i3 = i2; v2 = sc; i2 = n; }
        else if (sc > v3) { v3 = sc; i3 = n; } }
    unsigned m = 0u; if (i1 >= 0) m |= 1u << i1; if (i2 >= 0) m |= 1u << i2; if (i3 >= 0) m |= 1u << i3;
    SEL[((size_t)b * NH + h) * SEQ + s] = m;
}
__device__ __forceinline__ att::BlockRef att_ref(Frame& F, int L, int pass) {
    const int bh = L >> 3, x = L & 7; const int qb = pass ? 15 - x : x; const int b = bh >> 3, h = bh & 7;
    att::BlockRef r; const size_t ro = ((size_t)(b * SEQ + qb * MBLK)) * D + h * HD;
    r.Q = (const bf16_t*)(F.ws + WS_Q) + ro; r.O = (bf16_t*)(F.ws + WS_YB) + ro;
    r.K = (const bf16_t*)(F.ws + WS_K) + (size_t)(b * SEQ) * D + h * HD; r.V = (const bf16_t*)(F.ws + WS_V) + (size_t)(b * SEQ) * D + h * HD;
    r.qb = qb; return r;
}
__device__ __forceinline__ void phase_attn(Frame& F, char* lds) {
    const int total = BATCH * NH * 8, stride = F.G;
    int L = F.vcu; if (L >= total) return;
    int pass = 0;
    att::BlockRef cur = att_ref(F, L, 0);
    att::Seam S;
    att::moba_prime(cur, lds, S, F.tid);
    for (;;) {
        if (pass == 0) {
            const float* KM = (const float*)(F.ws + WS_KMEAN) + (size_t)(L >> 3) * NBLK * HD;
            int t2 = F.tid; asm volatile("" : "+v"(t2));
            *(f32x4*)(lds + att::KM_OFF + t2 * 16) = *(const f32x4*)(KM + t2 * 4);
            __syncthreads(); }
        const bool more_pass = pass == 0, more_item = L + stride < total, last = !more_pass && !more_item;
        int passn = pass + 1, Ln = L;
        if (!more_pass) { passn = 0; Ln = more_item ? L + stride : L; }
        const att::BlockRef nxt = last ? cur : att_ref(F, Ln, passn);
        att::moba_block(cur, nxt, lds, S, F.tid);
        if (last) break;
        cur = nxt; pass = passn; L = Ln;
    }
}

constexpr int NPH = 42;
__global__ void __launch_bounds__(NTHR, 2) fwd(Args args) {
    extern __shared__ __attribute__((aligned(16))) unsigned char lds_[];
    Frame F;
    F.lds = (LAS unsigned char*)lds_; F.ws = args.ws;
    F.tid = threadIdx.x; F.lane = F.tid & 63; F.wave = __builtin_amdgcn_readfirstlane(F.tid >> 6);
    F.G = gridDim.x; { const int bx = blockIdx.x; F.vcu = (F.G % 8 == 0) ? (bx % 8) * (F.G / 8) + bx / 8 : bx; }
    volatile LAS unsigned* MISC = (volatile LAS unsigned*)(F.lds + LDS_MISC);
    if (F.tid < 64) MISC[F.tid] = 0u;
    __syncthreads();
#ifdef PROBE_ORD
    if (F.tid == 0) *(volatile LAS unsigned long long*)(MISC + 14) = __builtin_amdgcn_s_memrealtime();
    __syncthreads();
#endif
    const int lo = args.ph_lo, hi = args.ph_hi;
    unsigned* ctl = (unsigned*)(F.ws + WS_CTL);
    XcdBarrier bar; bar.bar = ctl + CW_BAR + args.li * XCD_BAR_WORDS; bar.x = 0; bar.st = nullptr;
    if (hi - lo > 1) bar = xcd_barrier_post(ctl + CW_BAR + args.li * XCD_BAR_WORDS, MISC + 8);
#ifdef ONLY
#define EN(code) ((code) == ONLY)
#else
#define EN(code) true
#endif
#define IN(k) (lo <= (k) && (k) < hi)
#ifdef PROBE_ORD
#define SEAM(k) do { if (IN(k) && IN((k) + 1)) { xcd_barrier(bar); if (threadIdx.x == 0) { const unsigned n_ = MISC[12] + 1u; MISC[12] = n_; if (n_ == PROBE_ORD) { while (__builtin_amdgcn_s_memrealtime() - *(volatile LAS unsigned long long*)(MISC + 14) < (unsigned long long)(PROBE_US) * 100ull) __builtin_amdgcn_s_sleep(20); } } __syncthreads(); } } while (0)
#else
#define SEAM(k) do { if (IN(k) && IN((k) + 1)) xcd_barrier(bar); } while (0)
#endif
#ifdef PROBE_CODE
#define REPS(code) ((code) == PROBE_CODE ? 1 + PROBE_EXTRA : 1)
#else
#define REPS(code) 1
#endif
#define PF() Frame Fp = F; asm volatile("" : "+v"(Fp.tid)); Fp.lane = Fp.tid & 63
    LAS unsigned* tab = (LAS unsigned*)(F.lds + LDS_TAB);
    const float* xin = args.in[IN_X]; float* out = args.out; const float* PAR = (const float*)(F.ws + WS_PAR);
    const float* wgu_in = args.in[IN_WGU]; const float* wdn_in = args.in[IN_WDN];

    if (EN(0) && IN(0)) { for (int rep_ = 0; rep_ < REPS(0); ++rep_) { if (rep_) __syncthreads(); PF(); phase_prologue(Fp, args); } } SEAM(0);

#pragma nounroll
    for (int l = 0; l < DEPTH; ++l) {
        const int pb = 1 + 10 * l; const int j = l >> 1; const bool lru = (l & 1) == 0;
        if (EN(10) && IN(pb + 0)) { for (int rep_ = 0; rep_ < REPS(10); ++rep_) { if (rep_) __syncthreads(); PF(); phase_norm(Fp, xin, l); } } SEAM(pb + 0);
        if (lru) {
            if (EN(21) && IN(pb + 1)) { for (int rep_ = 0; rep_ < REPS(21); ++rep_) { if (rep_) __syncthreads(); pg8::ProbPlain P; P.init((const bf16_t*)(F.ws + WS_H), (const bf16_t*)(F.ws + WS_WIN) + (size_t)j * 2 * D * D, T, 2 * D, D, D, -1, F.G, (int)blockIdx.x);
                pg8::EpiWin E{(bf16_t*)(F.ws + WS_GB), (bf16_t*)(F.ws + WS_RB)};
                pg8::gemm_phase<pg8::EpiWin, pg8::ProbPlain, true, true>(F.lds, tab, P, E); } } SEAM(pb + 1);
            if (EN(22) && IN(pb + 2)) { for (int rep_ = 0; rep_ < REPS(22); ++rep_) { if (rep_) __syncthreads(); PF(); phase_conv(Fp, j); } } SEAM(pb + 2);
            if (EN(23) && IN(pb + 3)) { for (int rep_ = 0; rep_ < REPS(23); ++rep_) { if (rep_) __syncthreads(); pg8::ProbPlain P; P.init((const bf16_t*)(F.ws + WS_XC), (const bf16_t*)(F.ws + WS_WG) + (size_t)j * 2048 * 256, T, 2 * D, 256, D, 1, F.G, (int)blockIdx.x);
                pg8::EpiGates E{(const bf16_t*)(F.ws + WS_XC), (bf16_t*)(F.ws + WS_AF), (bf16_t*)(F.ws + WS_UF), PAR + PAR_LBA + (size_t)j * D, PAR + PAR_LBX + (size_t)j * D, (const float*)(F.ws + WS_SP8) + (size_t)j * D};
                pg8::gemm_phase<pg8::EpiGates, pg8::ProbPlain, true, true>(F.lds, tab, P, E); } } SEAM(pb + 3);
            if (EN(24) && IN(pb + 4)) { for (int rep_ = 0; rep_ < REPS(24); ++rep_) { if (rep_) __syncthreads(); PF(); phase_scan1(Fp); } } SEAM(pb + 4);
            if (EN(25) && IN(pb + 5)) { for (int rep_ = 0; rep_ < REPS(25); ++rep_) { if (rep_) __syncthreads(); PF(); phase_scan2(Fp); } } SEAM(pb + 5);
        } else {
            if (EN(31) && IN(pb + 1)) { for (int rep_ = 0; rep_ < REPS(31); ++rep_) { if (rep_) __syncthreads(); pg8::ProbPlain P; P.init((const bf16_t*)(F.ws + WS_H), (const bf16_t*)(F.ws + WS_WQKV) + (size_t)j * 3 * D * D, T, 3 * D, D, D, -1, F.G, (int)blockIdx.x);
                pg8::EpiQKV E{(bf16_t*)(F.ws + WS_Q), PAR + PAR_AQG + (size_t)j * HD, PAR + PAR_AKG + (size_t)j * HD, (float*)(F.ws + WS_KMEAN), (LAS float*)(F.lds + LDS_X)};
                pg8::gemm_phase<pg8::EpiQKV, pg8::ProbPlain, true, true>(F.lds, tab, P, E); } } SEAM(pb + 1);
            if (EN(34) && IN(pb + 4)) { for (int rep_ = 0; rep_ < REPS(34); ++rep_) { if (rep_) __syncthreads(); PF(); phase_attn(Fp, (char*)lds_); } } SEAM(pb + 4);
        }
        if (EN(16) && IN(pb + 6)) { for (int rep_ = 0; rep_ < REPS(16); ++rep_) { if (rep_) __syncthreads(); pg8::ProbPlain P; P.init((const bf16_t*)(F.ws + WS_YB), (const bf16_t*)(F.ws + (lru ? WS_WLO : WS_WAO)) + (size_t)j * D * D, T, D, D, D, -1, F.G, (int)blockIdx.x);
            pg8::EpiResid E{l == 0 ? xin : (const float*)(F.ws + WS_XB), (float*)(F.ws + WS_XB), (const float*)(F.ws + WS_MOD) + (size_t)l * BATCH * 6 * D + 2 * D};
            pg8::gemm_phase<pg8::EpiResid, pg8::ProbPlain, false, true>(F.lds, tab, P, E); } } SEAM(pb + 6);
        if (EN(17) && IN(pb + 7)) { PF(); phase_router(Fp, l); __syncthreads(); phase_convert_experts(Fp, wgu_in, wdn_in, l); } SEAM(pb + 7);
        if (EN(18) && IN(pb + 8)) { for (int rep_ = 0; rep_ < REPS(18); ++rep_) { if (rep_) __syncthreads(); PF(); const int nu = moe_units(Fp, l, 8);
            pg8::ProbMoE<true> P; P.A = (const bf16_t*)(F.ws + WS_H8); P.Bt = (const bf16_t*)(F.ws + WS_WGU) + (size_t)l * NE * D * D; P.K = D / 2; P.lda = D / 2; P.bstride = (size_t)D * D;
            P.rowlist = (const unsigned*)(F.ws + WS_ROWLIST); P.units = (const LAS int*)(F.lds + LDS_UNITS); P.nunits = nu;
            pg8::EpiSwiglu E{(unsigned char*)(F.ws + WS_ACT), PAR + PAR_BGU + (size_t)l * NE * 2 * D};
            pg8::gemm_phase<pg8::EpiSwiglu, pg8::ProbMoE<true>, true, true>(F.lds, tab, P, E); } } SEAM(pb + 8);
        if (EN(19) && IN(pb + 9)) { for (int rep_ = 0; rep_ < REPS(19); ++rep_) { if (rep_) __syncthreads(); PF(); const int nu = moe_units(Fp, l, 4);
            pg8::ProbMoE<false> P; P.A = (const bf16_t*)(F.ws + WS_ACT); P.Bt = (const bf16_t*)(F.ws + WS_WDN) + (size_t)l * NE * D * D / 2; P.K = D / 2; P.lda = D / 2; P.bstride = (size_t)D * D / 2;
            P.rowlist = (const unsigned*)(F.ws + WS_ROWLIST); P.units = (const LAS int*)(F.lds + LDS_UNITS); P.nunits = nu;
            pg8::EpiDown E{(const float*)(F.ws + WS_XB), l == DEPTH - 1 ? out : (float*)(F.ws + WS_XB), (const float*)(F.ws + WS_MOD) + (size_t)l * BATCH * 6 * D + 5 * D, PAR + PAR_BDN + (size_t)l * NE * D, (const unsigned*)(F.ws + WS_ROWLIST)};
            pg8::gemm_phase<pg8::EpiDown, pg8::ProbMoE<false>, true, true>(F.lds, tab, P, E); } } SEAM(pb + 9);
    }
#undef IN
#undef SEAM
#undef EN
}

#ifndef DEBUG_CHECKS
#define DEBUG_CHECKS 0
#endif
#ifndef CHK_FROM
#define CHK_FROM 0
#endif
#if DEBUG_CHECKS
constexpr int CW_CHK = 70000;
__device__ __forceinline__ unsigned hsh(unsigned x) { x ^= x >> 16; x *= 0x7feb352du; x ^= x >> 15; x *= 0x846ca68bu; x ^= x >> 16; return x; }
__device__ __forceinline__ bool cls(float got, float ref, float rt, float at) { return (fabsf(got - ref) <= rt * fabsf(ref) + at); }
__device__ __forceinline__ float bfq(const bf16_t* p, size_t i) { return __uint_as_float(((unsigned)p[i]) << 16); }
__device__ __forceinline__ float gelu_ref(float x) { return 0.5f * x * (1.0f + tanhf(0.7978845608028654f * (x + 0.044715f * x * x * x))); }
__global__ void __launch_bounds__(64) chk(Args a, int id, int l, int code) {
    const int j = l >> 1;
    unsigned char* ws = a.ws; unsigned* ctl = (unsigned*)(ws + WS_CTL); const int lane = threadIdx.x;
    const float* MOD = (const float*)(ws + WS_MOD); const float* PAR = (const float*)(ws + WS_PAR);
    const bf16_t* H = (const bf16_t*)(ws + WS_H);
    bool bad = false;
    for (int it = 0; it < 8; ++it) {
        const unsigned sd = hsh(blockIdx.x * 131u + it * 7919u + id * 104729u + 12345u);
        if (id == 1) {
            const int l = sd & 3, b = (sd >> 2) & 3, n = (sd >> 4) % (6 * D); float s = 0.f;
            for (int k = lane; k < D; k += 64) { const float c = a.in[IN_C][b * D + k]; s += (c / (1.0f + expf(-c))) * a.in[IN_WMOD][((size_t)l * D + k) * 6 * D + n]; }
            s = wave_sum(s) + a.in[IN_BMOD][l * 6 * D + n];
            if (!cls(MOD[((size_t)l * BATCH + b) * 6 * D + n], s, 1e-3f, 1e-3f)) bad = true;
        } else if (id == 2) {
            const int m = sd % T, b = m / SEQ; float ss = 0.f;
            for (int k = lane; k < D; k += 64) { const float x = a.in[IN_X][(size_t)m * D + k]; ss += x * x; }
            const float rstd = 1.0f / sqrtf(wave_sum(ss) / D + NORM_EPS);
            for (int k = lane; k < D; k += 64) { const float x = a.in[IN_X][(size_t)m * D + k];
                const float h = x * rstd * a.in[IN_NMG][k] * (1.0f + MOD[(size_t)b * 6 * D + D + k]) + MOD[(size_t)b * 6 * D + k];
                if (!cls(bfq(H, (size_t)m * D + k), h, 0.01f, 0.01f)) bad = true; }
        } else if (id == 3) {
            const int m = sd % T, n = (sd >> 14) % (2 * D); float s = 0.f;
            for (int k = lane; k < D; k += 64) s += bfq(H, (size_t)m * D + k) * a.in[IN_LWIN][((size_t)j * D + k) * 2 * D + n];
            s = wave_sum(s);
            const float got = n < D ? bfq((const bf16_t*)(ws + WS_GB), (size_t)m * D + n) : bfq((const bf16_t*)(ws + WS_RB), (size_t)m * D + n - D);
            const float ref = n < D ? gelu_ref(s) : s;
            if (!cls(got, ref, 0.02f, 0.02f)) bad = true;
        } else if (id == 4) {
            const int m = sd % T, c = (sd >> 14) % D, s0 = m % SEQ; const bf16_t* RB = (const bf16_t*)(ws + WS_RB);
            float y = a.in[IN_LCB][j * D + c];
            for (int k = 0; k < 4; ++k) { const int t = s0 - 3 + k; if (t >= 0) y += a.in[IN_LCW][(j * 4 + k) * D + c] * bfq(RB, (size_t)(m - 3 + k) * D + c); }
            if (!cls(bfq((const bf16_t*)(ws + WS_XC), (size_t)m * D + c), y, 0.01f, 0.01f)) bad = true;
        } else if (id == 5) {
            const int m = sd % T, ch = (sd >> 14) % D, g = ch >> 8, jc = ch & 255; const bf16_t* XC = (const bf16_t*)(ws + WS_XC);
            float sa = 0.f, sx = 0.f;
            for (int i = lane; i < 256; i += 64) { const float xv = bfq(XC, (size_t)m * D + g * 256 + i); sa += xv * a.in[IN_LWA][((size_t)(j * 4 + g) * 256 + i) * 256 + jc]; sx += xv * a.in[IN_LWX][((size_t)(j * 4 + g) * 256 + i) * 256 + jc]; }
            sa = wave_sum(sa) + a.in[IN_LBA][j * D + ch]; sx = wave_sum(sx) + a.in[IN_LBX][j * D + ch];
            const float r = 1.0f / (1.0f + expf(-sa)), ig = 1.0f / (1.0f + expf(-sx)); const float lam = a.in[IN_LLAM][j * D + ch];
            const float la = -8.0f * r * log1pf(expf(-lam)); const float av = expf(la), uv = sqrtf(-expm1f(2.0f * la)) * ig * bfq(XC, (size_t)m * D + ch);
            if (!cls(((const float*)(ws + WS_AF))[(size_t)m * D + ch], av, 2e-3f, 1e-4f)) bad = true;
            if (!cls(((const float*)(ws + WS_UF))[(size_t)m * D + ch], uv, 0.03f, 0.003f)) bad = true;
        } else if (id == 6) {
            const int b = sd & 3, ch = ((sd >> 2) + lane * 17) % D; const float* AF = (const float*)(ws + WS_AF); const float* UF = (const float*)(ws + WS_UF);
            const bf16_t* GB = (const bf16_t*)(ws + WS_GB); const bf16_t* YB = (const bf16_t*)(ws + WS_YB);
            float h = 0.f;
            for (int t = 0; t < SEQ; ++t) { const size_t o = ((size_t)b * SEQ + t) * D + ch; h = AF[o] * h + UF[o];
                if ((t & 127) == 77 || t == SEQ - 1 || t == 0 || t == 64) { if (!cls(bfq(YB, o), bfq(GB, o) * h, 0.02f, 0.01f)) bad = true; } }
        } else if (id == 7) {
            const int m = sd % T, n = (sd >> 14) % D, b = m / SEQ; float s = 0.f; const bf16_t* YB = (const bf16_t*)(ws + WS_YB);
            for (int k = lane; k < D; k += 64) s += bfq(YB, (size_t)m * D + k) * a.in[IN_LWOUT][((size_t)j * D + k) * D + n];
            s = wave_sum(s);
            const float ref = (l == 0 ? a.in[IN_X][(size_t)m * D + n] : ((const float*)(ws + WS_XA))[(size_t)m * D + n]) + MOD[((size_t)l * BATCH + b) * 6 * D + 2 * D + n] * s;
            if (!cls(((const float*)(ws + WS_XB))[(size_t)m * D + n], ref, 0.01f, 0.01f)) bad = true;
        } else if (id == 8) {
            __shared__ float hrow[D];
            const int m = sd % MOE_TOK, b = m / SEQ; const float* XB = (const float*)(ws + WS_XB); float ss = 0.f;
            for (int k = lane; k < D; k += 64) { const float x = XB[(size_t)m * D + k]; ss += x * x; }
            const float rstd = 1.0f / sqrtf(wave_sum(ss) / D + NORM_EPS);
            __syncthreads();
            for (int k = lane; k < D; k += 64) { const float x = XB[(size_t)m * D + k];
                const float h = x * rstd * a.in[IN_NFG][l * D + k] * (1.0f + MOD[((size_t)l * BATCH + b) * 6 * D + 4 * D + k]) + MOD[((size_t)l * BATCH + b) * 6 * D + 3 * D + k]; hrow[k] = h;
                if (!cls(bfq(H, (size_t)m * D + k), h, 0.01f, 0.01f)) bad = true; }
            __syncthreads();
            const int e = lane & 31; float lg = a.in[IN_RB][l * NE + e];
            for (int k = 0; k < D; ++k) lg += hrow[k] * a.in[IN_RW][((size_t)l * D + k) * NE + e];
            int rank = 0; float mx = -1e30f;
            for (int q = 0; q < 32; ++q) { const float o = __shfl(lg, q); if (o > lg || (o == lg && q < e)) ++rank; mx = fmaxf(mx, o); }
            const bool sel = rank < 4; float den = 0.f;
            for (int q = 0; q < 32; ++q) { const float o = __shfl(lg, q); const int rk = __shfl(rank, q); if (rk < 4) den += expf(o - mx); }
            const float wref = expf(lg - mx) / den;
            float v4 = 0.f, v5 = 0.f; for (int q = 0; q < 32; ++q) { const float o = __shfl(lg, q); const int rk = __shfl(rank, q); if (rk == 3) v4 = o; if (rk == 4) v5 = o; }
            const unsigned* gcnt = ctl + CW_CNT + 64 * l; const unsigned* RL = (const unsigned*)(ws + WS_ROWLIST); const float* TW = (const float*)(ws + WS_TOPW);
            if (v4 - v5 > 1e-3f && lane < 32) {
                const int cnt = (int)gcnt[e]; int found = -1;
                for (int p = 0; p < cnt; ++p) { const unsigned r = RL[(size_t)e * CAP + p]; if ((int)(r >> 2) == m) found = (int)r; }
                if (sel) { if (found < 0) bad = true; else if (!cls(TW[found], wref, 0.01f, 1e-3f)) bad = true; }
                else if (found >= 0) bad = true;
            }
            unsigned tot = 0; for (int q = 0; q < 32; ++q) tot += gcnt[q]; if (tot != (unsigned)T) bad = true;
        } else if (id == 9 || id == 10) {
            const unsigned* gcnt = ctl + CW_CNT + 64 * l; const unsigned* RL = (const unsigned*)(ws + WS_ROWLIST); const float* TW = (const float*)(ws + WS_TOPW);
            const int e = sd & 31; int ts = 0; for (int q = 0; q < e; ++q) ts += ((int)gcnt[q] + 255) >> 8;
            const int cnt = (int)gcnt[e]; if (cnt == 0) continue;
            const int pos = (sd >> 5) % cnt; const unsigned dest = RL[(size_t)e * CAP + pos]; const int tok = dest >> 2; const size_t arow = (size_t)ts * 256 + pos;
            const int col = (sd >> 17) % D; const bf16_t* ACT = (const bf16_t*)(ws + WS_ACT);
            if (id == 9) { float sg = 0.f, su = 0.f;
                for (int k = lane; k < D; k += 64) { const float hv = bfq(H, (size_t)tok * D + k); sg += hv * a.in[IN_WGU][((size_t)(l * NE + e) * D + k) * 2 * D + col]; su += hv * a.in[IN_WGU][((size_t)(l * NE + e) * D + k) * 2 * D + D + col]; }
                sg = wave_sum(sg) + a.in[IN_BGU][(size_t)(l * NE + e) * 2 * D + col]; su = wave_sum(su) + a.in[IN_BGU][(size_t)(l * NE + e) * 2 * D + D + col];
                const float gv = fminf(sg, 7.f), uv = fminf(fmaxf(su, -7.f), 7.f); const float ref = gv / (1.0f + expf(-1.702f * gv)) * (uv + 1.0f);
                if (!cls(bfq(ACT, arow * D + col), ref, 0.03f, 0.02f)) bad = true;
            } else { float s = 0.f;
                for (int k = lane; k < D; k += 64) s += bfq(ACT, arow * D + k) * a.in[IN_WDN][((size_t)(l * NE + e) * D + k) * D + col];
                s = (wave_sum(s) + a.in[IN_BDN][(size_t)(l * NE + e) * D + col]) * TW[dest];
                if (!cls(bfq((const bf16_t*)(ws + WS_YK), (size_t)dest * D + col), s, 0.03f, 0.01f)) bad = true; }
        } else if (id == 11) {
            const int m = sd % T, h = (sd >> 14) & 7, which = (sd >> 17) % 3; float r0 = 0.f, r1 = 0.f;
            for (int k = 0; k < D; ++k) { const float hv = bfq(H, (size_t)m * D + k); const float* w = a.in[IN_AQKV] + ((size_t)j * D + k) * 3 * D + which * D + h * HD; r0 += hv * w[lane]; r1 += hv * w[lane + 64]; }
            const bf16_t* buf = (const bf16_t*)(ws + (which == 0 ? WS_Q : (which == 1 ? WS_K : WS_V)));
            const float g0 = bfq(buf, (size_t)m * D + h * HD + lane), g1 = bfq(buf, (size_t)m * D + h * HD + lane + 64);
            if (which == 2) { if (!cls(g0, r0, 0.02f, 0.02f) || !cls(g1, r1, 0.02f, 0.02f)) bad = true; }
            else { const float rs = 1.0f / sqrtf(wave_sum(r0 * r0 + r1 * r1) / HD + NORM_EPS); const float* gg = a.in[which == 0 ? IN_AQG : IN_AKG] + j * HD;
                if (!cls(g0, r0 * rs * gg[lane], 0.03f, 0.03f) || !cls(g1, r1 * rs * gg[lane + 64], 0.03f, 0.03f)) bad = true; }
        } else if (id == 12) {
            const int b = sd & 3, h = (sd >> 2) & 7, blk = (sd >> 5) & 15; const bf16_t* Kb = (const bf16_t*)(ws + WS_K); const float* KM = (const float*)(ws + WS_KMEAN);
            float s0 = 0.f, s1 = 0.f;
            for (int r = 0; r < MBLK; ++r) { const size_t o = ((size_t)b * SEQ + blk * MBLK + r) * D + h * HD; s0 += bfq(Kb, o + lane); s1 += bfq(Kb, o + lane + 64); }
            const float* km = KM + (((size_t)b * NH + h) * NBLK + blk) * HD;
            if (!cls(km[lane], s0 / MBLK, 0.03f, 0.003f) || !cls(km[lane + 64], s1 / MBLK, 0.03f, 0.003f)) bad = true;
            const int s = (sd >> 9) % SEQ, qb = s >> 8; const bf16_t* Q = (const bf16_t*)(ws + WS_Q); const unsigned msk = ((const unsigned*)(ws + WS_SEL))[((size_t)b * NH + h) * SEQ + s];
            float sc[16]; const size_t qo = ((size_t)b * SEQ + s) * D + h * HD;
#pragma unroll
            for (int n = 0; n < 16; ++n) { const float* kk = KM + (((size_t)b * NH + h) * NBLK + n) * HD; sc[n] = wave_sum(bfq(Q, qo + lane) * kk[lane] + bfq(Q, qo + lane + 64) * kk[lane + 64]); }
            int cntb = 0; float minsel = 1e30f;
#pragma unroll
            for (int n = 0; n < 16; ++n) if ((msk >> n) & 1u) { ++cntb; if (n >= qb) bad = true; minsel = fminf(minsel, sc[n]); }
            if (cntb != (qb < 3 ? qb : 3) || (msk >> 16)) bad = true;
            int better = 0;
#pragma unroll
            for (int n = 0; n < 16; ++n) if (n < qb && !((msk >> n) & 1u) && sc[n] > minsel + 1e-3f) ++better;
            if (better) bad = true;
        } else if (id == 13) {
            const int b = sd & 3, h = (sd >> 2) & 7, s = (sd >> 5) % SEQ, qb = s >> 8;
            const bf16_t* Q = (const bf16_t*)(ws + WS_Q); const bf16_t* Kb = (const bf16_t*)(ws + WS_K); const bf16_t* V = (const bf16_t*)(ws + WS_V); const bf16_t* O = (const bf16_t*)(ws + WS_YB);
            const unsigned msk = ((const unsigned*)(ws + WS_SEL))[((size_t)b * NH + h) * SEQ + s] | (1u << qb);
            const size_t qo = ((size_t)b * SEQ + s) * D + h * HD;
            float mx = -1e30f;
            for (int pass = 0; pass < 2; ++pass) {
                float den = 0.f, o0 = 0.f, o1 = 0.f;
                for (int blk = 0; blk <= qb; ++blk) if ((msk >> blk) & 1u) {
                    const int kend = blk == qb ? (s & 255) + 1 : 256;
                    for (int kk = 0; kk < kend; ++kk) { const size_t ko = ((size_t)b * SEQ + blk * MBLK + kk) * D + h * HD;
                        const float sc = wave_sum(bfq(Q, qo + lane) * bfq(Kb, ko + lane) + bfq(Q, qo + lane + 64) * bfq(Kb, ko + lane + 64)) * 0.08838834764831845f;
                        if (pass == 0) mx = fmaxf(mx, sc); else { const float p = expf(sc - mx); den += p; o0 += p * bfq(V, ko + lane); o1 += p * bfq(V, ko + lane + 64); } } }
                if (pass == 1) { if (!cls(bfq(O, qo + lane), o0 / den, 0.03f, 0.01f) || !cls(bfq(O, qo + lane + 64), o1 / den, 0.03f, 0.01f)) bad = true; }
            }
        } else if (id == 14) {
            const int m = sd % T, n = (sd >> 14) % D, b = m / SEQ; float s = 0.f; const bf16_t* YB = (const bf16_t*)(ws + WS_YB);
            for (int k = lane; k < D; k += 64) s += bfq(YB, (size_t)m * D + k) * a.in[IN_AWOUT][((size_t)j * D + k) * D + n];
            s = wave_sum(s);
            const float ref = ((const float*)(ws + WS_XA))[(size_t)m * D + n] + MOD[((size_t)l * BATCH + b) * 6 * D + 2 * D + n] * s;
            if (!cls(((const float*)(ws + WS_XB))[(size_t)m * D + n], ref, 0.01f, 0.01f)) bad = true;
        } else if (id == 15) {
            const int m = sd % T, b = m / SEQ; float ss = 0.f; const float* XA = (const float*)(ws + WS_XA); const bf16_t* YK = (const bf16_t*)(ws + WS_YK);
            for (int k = lane; k < D; k += 64) { const float x = XA[(size_t)m * D + k]; ss += x * x;
                const float sy = bfq(YK, (size_t)m * D + k);
                if (!cls(x, ((const float*)(ws + WS_XB))[(size_t)m * D + k] + MOD[((size_t)(l - 1) * BATCH + b) * 6 * D + 5 * D + k] * sy, 1e-3f, 1e-3f)) bad = true; }
            const float rstd = 1.0f / sqrtf(wave_sum(ss) / D + NORM_EPS);
            for (int k = lane; k < D; k += 64) { const float x = XA[(size_t)m * D + k];
                const float hh = x * rstd * a.in[IN_NMG][l * D + k] * (1.0f + MOD[((size_t)l * BATCH + b) * 6 * D + D + k]) + MOD[((size_t)l * BATCH + b) * 6 * D + k];
                if (!cls(bfq(H, (size_t)m * D + k), hh, 0.01f, 0.01f)) bad = true; }
        }
    }
    if (id == 16) {
        for (int it = 0; it < 8; ++it) { const unsigned sd = hsh(blockIdx.x * 131u + it * 7919u + 777u); const int m = sd % T, b = m / SEQ; const bf16_t* YK = (const bf16_t*)(ws + WS_YK);
            for (int k = lane; k < D; k += 64) { const float sy = bfq(YK, (size_t)m * D + k);
                if (!cls(a.out[(size_t)m * D + k], ((const float*)(ws + WS_XB))[(size_t)m * D + k] + MOD[((size_t)3 * BATCH + b) * 6 * D + 5 * D + k] * sy, 1e-3f, 1e-3f)) bad = true; } } }
    if (id == 99) bad = true;
    if (__any(bad) && lane == 0) atomicMax(ctl + CW_CHK, (unsigned)(100 - code));
    (void)PAR;
}
__global__ void chk_encode(Args a) {
    const unsigned v = ((const unsigned*)(a.ws + WS_CTL))[CW_CHK]; if (v == 0u) return;
    const float f = 1.0f + (float)(100 - (int)v);
    for (size_t i = (size_t)blockIdx.x * blockDim.x + threadIdx.x; i < (size_t)T * D; i += (size_t)gridDim.x * blockDim.x) a.out[i] = a.in[IN_X][i] * f;
}
#endif

#ifndef N_LAUNCH_MODE
#define N_LAUNCH_MODE 1
#endif
extern "C" void kernel_launch(void* const* d_in, const int* in_sizes, int n_in, void* d_out, int out_size, void* d_ws, size_t ws_size, hipStream_t stream) {
    static int grid = 0;
    if (grid == 0) {
        if (n_in != 25 || out_size != T * D || ws_size < WS_END) { fprintf(stderr, "kernel_launch: unexpected shapes (n_in %d out %d ws %zu)\n", n_in, out_size, ws_size); grid = -1; return; }
        int dev = 0, cus = 0;
        if (hipGetDevice(&dev) != hipSuccess || hipDeviceGetAttribute(&cus, hipDeviceAttributeMultiprocessorCount, dev) != hipSuccess) { grid = -1; return; }
        if (hipFuncSetAttribute((const void*)fwd, hipFuncAttributeMaxDynamicSharedMemorySize, LDS_BYTES) != hipSuccess) { fprintf(stderr, "kernel_launch: hipFuncSetAttribute failed\n"); grid = -1; return; }
        int per_cu = 0;
        if (hipOccupancyMaxActiveBlocksPerMultiprocessor(&per_cu, (const void*)fwd, NTHR, LDS_BYTES) != hipSuccess || per_cu < 1) fprintf(stderr, "kernel_launch: occupancy query says %d\n", per_cu);
        (void)hipGetLastError();
        if (cus < 256) { fprintf(stderr, "kernel_launch: %d CUs < 256\n", cus); grid = -1; return; }
        grid = 256;
    }
    if (grid < 0) return;
    (void)hipMemsetAsync((char*)d_ws + WS_CTL, 0, CTL_ZERO_BYTES, stream);
    Args a{};
    for (int i = 0; i < 25; ++i) a.in[i] = (const float*)d_in[i];
    a.out = (float*)d_out; a.ws = (unsigned char*)d_ws; a.pad = 0;
#if N_LAUNCH_MODE == 1
    a.ph_lo = 0; a.ph_hi = NPH - 1; a.li = 0;
    hipLaunchKernelGGL(fwd, dim3(grid), dim3(NTHR), LDS_BYTES, stream, a);
#else
    int ordinal = 0; (void)ordinal;
    for (int p = 0; p < NPH; ++p) {
        const int l = (p - 1) / 10, o = (p - 1) % 10;
        if (p >= 1 && p <= 40 && (l & 1) == 1 && o == 5) continue;
        a.ph_lo = p; a.ph_hi = p + 1; a.li = 0;
        hipLaunchKernelGGL(fwd, dim3(grid), dim3(NTHR), LDS_BYTES, stream, a);
#if DEBUG_CHECKS
        {
            const int lch = (p - 1) / 10, och = (p - 1) % 10; int cid = 0;
            if (p == 0) cid = 1;
            else if (p == 41) cid = 16;
            else if ((lch & 1) == 0) { const int t[10] = {lch == 0 ? 2 : 15, 3, 4, 5, 0, 6, 7, 8, 9, 10}; cid = t[och]; }
            else { const int t[10] = {15, 0, 11, 12, 13, 0, 14, 8, 9, 10}; cid = t[och]; }
            if (cid && p >= CHK_FROM) { ++ordinal; hipLaunchKernelGGL(chk, dim3(64), dim3(64), 0, stream, a, cid, lch < 0 ? 0 : (p == 41 ? 3 : lch), ordinal); }
            if (p == 41) { ++ordinal; hipLaunchKernelGGL(chk, dim3(64), dim3(64), 0, stream, a, 99, 0, ordinal); }
        }
#endif
    }
#if DEBUG_CHECKS
    hipLaunchKernelGGL(chk_encode, dim3(1024), dim3(256), 0, stream, a);
#endif
#endif
}
```
